# Optimizing an MI355X kernel written in HIP

```python
import jax
import jax.numpy as jnp
from jax import lax
import numpy as np

D_MODEL = 1024
BATCH = 16
SEQ = 2048
DEPTH = 2

GRID_W = 64
CTX_LEN = 256
HEAD_DIM = 64
D_MIX = 1024
CONV_CH = 256
CONV_WIDTH = 31
NA_HEADS = 6
NA_WIN_H = 8
NA_WIN_W = 16
GQA_HEADS = 6
GQA_KV_HEADS = 2
ROPE_THETA = 10000.0
Q_BLOCK = 128
PEER_HEADS = 8
PEER_N_KEYS = 128
PEER_N_EXPERTS = PEER_N_KEYS * PEER_N_KEYS
PEER_D_KEY = 128
PEER_TOPK = 16
PEER_CHUNK = 128
EPS = 1e-6

NA_W = NA_HEADS * HEAD_DIM
GQA_W = GQA_HEADS * HEAD_DIM
GQA_KV_W = GQA_KV_HEADS * HEAD_DIM
OFF_A_VAL = 0
OFF_A_GATE = OFF_A_VAL + CONV_CH
OFF_NA_Q = OFF_A_GATE + CONV_CH
OFF_G_Q = OFF_NA_Q + NA_W
KV_START = OFF_G_Q + GQA_W
OFF_NA_K = KV_START
OFF_NA_V = OFF_NA_K + NA_W
OFF_G_K = OFF_NA_V + NA_W
OFF_G_V = OFF_G_K + GQA_KV_W
IN_COLS = OFF_G_V + GQA_KV_W

kernel_name = 'hymba_conformer_natten_gqa_peer_dit'


def _cols(z, off, width, base=0):
    return z[..., off - base: off - base + width]


def rms_norm(x, g):
    xf = x.astype(jnp.float32)
    y = xf * lax.rsqrt(jnp.mean(xf * xf, axis=-1, keepdims=True) + EPS)
    return (y * g.astype(jnp.float32)).astype(x.dtype)


def layer_norm(x, g, b):
    xf = x.astype(jnp.float32)
    mu = jnp.mean(xf, axis=-1, keepdims=True)
    var = jnp.mean(jnp.square(xf - mu), axis=-1, keepdims=True)
    y = (xf - mu) * lax.rsqrt(var + EPS)
    return (y * g.astype(jnp.float32) + b.astype(jnp.float32)).astype(x.dtype)


def modulate(h, shift, scale):
    return h * (1 + scale) + shift


def split_heads(z, n):
    B, L, _ = z.shape
    return z.reshape(B, L, n, HEAD_DIM).transpose(0, 2, 1, 3)


def merge_heads(o):
    B, H, L, d = o.shape
    return o.transpose(0, 2, 1, 3).reshape(B, L, H * d)


def axial_rope_tables(T, dtype):
    t = jnp.arange(T, dtype=jnp.int32)
    row = (t // GRID_W).astype(jnp.float32)
    col = (t % GRID_W).astype(jnp.float32)
    n_freq = HEAD_DIM // 4
    inv_freq = ROPE_THETA ** (-jnp.arange(n_freq, dtype=jnp.float32) / n_freq)
    ang = jnp.concatenate([row[:, None] * inv_freq, col[:, None] * inv_freq], axis=-1)
    return jnp.cos(ang).astype(dtype), jnp.sin(ang).astype(dtype)


def apply_rope(x, cos, sin):
    half = HEAD_DIM // 2
    x1, x2 = x[..., :half], x[..., half:]
    return jnp.concatenate([x1 * cos - x2 * sin, x1 * sin + x2 * cos], axis=-1)


def dense_attention(qh, kh, vh):
    B, Hq, L, d = qh.shape
    Hk = kh.shape[1]
    qg = qh.reshape(B, Hk, Hq // Hk, L, d) * (d ** -0.5)
    s = jnp.einsum('bkgqd,bksd->bkgqs', qg, kh).astype(jnp.float32)
    p = jax.nn.softmax(s, axis=-1).astype(vh.dtype)
    o = jnp.einsum('bkgqs,bksd->bkgqd', p, vh)
    return merge_heads(o.reshape(B, Hq, L, d))


def conformer_conv(val, gate, w_dw, b_dw, ln_g, ln_b):
    u = val * jax.nn.sigmoid(gate)
    pad = CONV_WIDTH // 2
    y = lax.conv_general_dilated(u, w_dw[:, None, :], window_strides=(1,), padding=[(pad, pad)],
                                 dimension_numbers=('NWC', 'WIO', 'NWC'),
                                 feature_group_count=CONV_CH) + b_dw
    return jax.nn.silu(layer_norm(y, ln_g, ln_b))


def neighbourhood_attention(q, k, v, kc, vc, rel_bias):
    B, T, _ = q.shape
    rows = T // GRID_W
    kh = min(NA_WIN_H, rows)
    n_loc = kh * NA_WIN_W

    def grid(z):
        return z.reshape(B, rows, GRID_W, NA_HEADS, HEAD_DIM).transpose(0, 3, 1, 2, 4)

    kg, vg = grid(k), grid(v)
    q_rows = grid(q * (HEAD_DIM ** -0.5)).transpose(2, 0, 1, 3, 4)
    kc_h, vc_h = split_heads(kc, NA_HEADS), split_heads(vc, NA_HEADS)
    cols = jnp.arange(GRID_W, dtype=jnp.int32)
    c0 = jnp.clip(cols - NA_WIN_W // 2, 0, GRID_W - NA_WIN_W)
    col_idx = c0[:, None] + jnp.arange(NA_WIN_W, dtype=jnp.int32)[None, :]
    col_bias_idx = col_idx - cols[:, None] + (NA_WIN_W - 1)

    def row_step(args):
        r, qr = args
        r0 = jnp.clip(r - kh // 2, 0, rows - kh)
        band_k = lax.dynamic_slice_in_dim(kg, r0, kh, axis=2)
        band_v = lax.dynamic_slice_in_dim(vg, r0, kh, axis=2)
        k_win = jnp.take(band_k, col_idx, axis=3)
        v_win = jnp.take(band_v, col_idx, axis=3)
        row_bias_idx = r0 + jnp.arange(kh, dtype=jnp.int32) - r + (NA_WIN_H - 1)
        bias = jnp.take(jnp.take(rel_bias, row_bias_idx, axis=1), col_bias_idx, axis=2)
        s_loc = jnp.einsum('bhqd,bhiqjd->bhqij', qr, k_win).astype(jnp.float32)
        s_loc = s_loc + bias.transpose(0, 2, 1, 3)[None].astype(jnp.float32)
        s_loc = s_loc.reshape(B, NA_HEADS, GRID_W, n_loc)
        s_ctx = jnp.einsum('bhqd,bhcd->bhqc', qr, kc_h).astype(jnp.float32)
        p = jax.nn.softmax(jnp.concatenate([s_loc, s_ctx], axis=-1), axis=-1).astype(qr.dtype)
        p_loc = p[..., :n_loc].reshape(B, NA_HEADS, GRID_W, kh, NA_WIN_W)
        p_ctx = p[..., n_loc:]
        return (jnp.einsum('bhqij,bhiqjd->bhqd', p_loc, v_win)
                + jnp.einsum('bhqc,bhcd->bhqd', p_ctx, vc_h))

    out = lax.map(row_step, (jnp.arange(rows, dtype=jnp.int32), q_rows))
    return out.transpose(1, 0, 3, 2, 4).reshape(B, T, NA_W)


def gqa_latent(q, k, v, kc_h, vc_h, q_g, k_g, cos, sin):
    B, T, _ = q.shape
    G = GQA_HEADS // GQA_KV_HEADS
    n_blk = T // Q_BLOCK
    qh = apply_rope(rms_norm(split_heads(q, GQA_HEADS), q_g), cos, sin) * (HEAD_DIM ** -0.5)
    kh = apply_rope(rms_norm(split_heads(k, GQA_KV_HEADS), k_g), cos, sin)
    k_all = jnp.concatenate([kh, kc_h], axis=2)
    v_all = jnp.concatenate([split_heads(v, GQA_KV_HEADS), vc_h], axis=2)
    qb = qh.reshape(B, GQA_KV_HEADS, G, n_blk, Q_BLOCK, HEAD_DIM).transpose(3, 0, 1, 2, 4, 5)

    def block_step(qq):
        s = jnp.einsum('bkgqd,bksd->bkgqs', qq, k_all).astype(jnp.float32)
        p = jax.nn.softmax(s, axis=-1).astype(v_all.dtype)
        return jnp.einsum('bkgqs,bksd->bkgqd', p, v_all)

    out = lax.map(block_step, qb)
    return out.transpose(1, 0, 4, 2, 3, 5).reshape(B, T, GQA_W)


def peer_ffn(h, w_q, sub_keys, u, v):
    B, L, D = h.shape
    chunks = h.reshape(-1, PEER_CHUNK, D)
    n_cand = PEER_TOPK * PEER_TOPK

    def chunk_step(xc):
        q = (xc @ w_q).reshape(PEER_CHUNK, PEER_HEADS, 2, PEER_D_KEY)
        s = jnp.einsum('chpk,hpnk->chpn', q, sub_keys).astype(jnp.float32)
        top_s, top_i = lax.top_k(s, PEER_TOPK)
        cand_s = top_s[:, :, 0, :, None] + top_s[:, :, 1, None, :]
        cand_i = top_i[:, :, 0, :, None] * PEER_N_KEYS + top_i[:, :, 1, None, :]
        best_s, best_pos = lax.top_k(cand_s.reshape(PEER_CHUNK, PEER_HEADS, n_cand), PEER_TOPK)
        idx = jnp.take_along_axis(cand_i.reshape(PEER_CHUNK, PEER_HEADS, n_cand), best_pos, axis=-1)
        g = jax.nn.softmax(best_s, axis=-1).astype(xc.dtype)
        act = jax.nn.gelu(jnp.einsum('cd,chkd->chk', xc, jnp.take(u, idx, axis=0)))
        return jnp.einsum('chk,chkd->cd', g * act, jnp.take(v, idx, axis=0))

    return lax.map(chunk_step, chunks).reshape(B, L, D)


def setup_inputs(seed: int = 0) -> dict:
    key = jax.random.key(seed)
    ks = jax.random.split(key, 24)
    f32 = jnp.float32

    def nrm(k, shape, s):
        return jax.random.normal(k, shape, f32) * s

    L, D = DEPTH, D_MODEL
    return {
        'x': nrm(ks[0], (BATCH, SEQ, D), 1.0),
        'c': nrm(ks[1], (BATCH, D), 1.0),
        'ctx': nrm(ks[2], (BATCH, CTX_LEN, D), 1.0),
        'c_ctx': nrm(ks[3], (D,), 1.0),
        'norm1_g': 1.0 + nrm(ks[4], (L, D), 0.05),
        'norm2_g': 1.0 + nrm(ks[5], (L, D), 0.05),
        'w_ada': nrm(ks[6], (L, D, 6 * D), 0.5 * D ** -0.5),
        'b_ada': nrm(ks[7], (L, 6 * D), 0.02),
        'w_in': nrm(ks[8], (L, D, IN_COLS), D ** -0.5),
        'conv_w': nrm(ks[9], (L, CONV_WIDTH, CONV_CH), CONV_WIDTH ** -0.5),
        'conv_b': nrm(ks[10], (L, CONV_CH), 0.02),
        'conv_ln_g': 1.0 + nrm(ks[11], (L, CONV_CH), 0.05),
        'conv_ln_b': nrm(ks[12], (L, CONV_CH), 0.02),
        'na_rel_bias': nrm(ks[13], (L, NA_HEADS, 2 * NA_WIN_H - 1, 2 * NA_WIN_W - 1), 0.1),
        'gqa_q_norm': 1.0 + nrm(ks[14], (L, HEAD_DIM), 0.05),
        'gqa_k_norm': 1.0 + nrm(ks[15], (L, HEAD_DIM), 0.05),
        'w_out': nrm(ks[16], (L, D_MIX, D), D_MIX ** -0.5),
        'peer_w_q': nrm(ks[17], (L, D, PEER_HEADS * 2 * PEER_D_KEY), D ** -0.5),
        'peer_keys': nrm(ks[18], (L, PEER_HEADS, 2, PEER_N_KEYS, PEER_D_KEY), PEER_D_KEY ** -0.5),
        'peer_u': nrm(ks[19], (L, PEER_N_EXPERTS, D), D ** -0.5),
        'peer_v': nrm(ks[20], (L, PEER_N_EXPERTS, D), 0.5),
        'final_norm_g': 1.0 + nrm(ks[21], (D,), 0.05),
    }


def reference(x, c, ctx, c_ctx, norm1_g, norm2_g, w_ada, b_ada, w_in, conv_w, conv_b, conv_ln_g,
              conv_ln_b, na_rel_bias, gqa_q_norm, gqa_k_norm, w_out, peer_w_q, peer_keys, peer_u,
              peer_v, final_norm_g):
    T = x.shape[1]
    cos, sin = axial_rope_tables(T, x.dtype)
    silu_c = jax.nn.silu(c)
    silu_cc = jax.nn.silu(c_ctx)
    for l in range(DEPTH):
        last = l == DEPTH - 1
        mod = (silu_c @ w_ada[l] + b_ada[l])[:, None, :]
        sh1, sc1, g1, sh2, sc2, g2 = jnp.split(mod, 6, axis=-1)
        mod_c = silu_cc @ w_ada[l] + b_ada[l]
        csh1, csc1, cg1, csh2, csc2, cg2 = jnp.split(mod_c, 6, axis=-1)

        h = modulate(rms_norm(x, norm1_g[l]), sh1, sc1)
        hc = modulate(rms_norm(ctx, norm1_g[l]), csh1, csc1)
        z = h @ w_in[l]
        zc_kv = hc @ w_in[l][:, KV_START:]
        kc_na = _cols(zc_kv, OFF_NA_K, NA_W, KV_START)
        vc_na = _cols(zc_kv, OFF_NA_V, NA_W, KV_START)
        kc_g = rms_norm(split_heads(_cols(zc_kv, OFF_G_K, GQA_KV_W, KV_START), GQA_KV_HEADS), gqa_k_norm[l])
        vc_g = split_heads(_cols(zc_kv, OFF_G_V, GQA_KV_W, KV_START), GQA_KV_HEADS)

        a = conformer_conv(_cols(z, OFF_A_VAL, CONV_CH), _cols(z, OFF_A_GATE, CONV_CH),
                           conv_w[l], conv_b[l], conv_ln_g[l], conv_ln_b[l])
        b = neighbourhood_attention(_cols(z, OFF_NA_Q, NA_W), _cols(z, OFF_NA_K, NA_W),
                                    _cols(z, OFF_NA_V, NA_W), kc_na, vc_na, na_rel_bias[l])
        g = gqa_latent(_cols(z, OFF_G_Q, GQA_W), _cols(z, OFF_G_K, GQA_KV_W), _cols(z, OFF_G_V, GQA_KV_W),
                       kc_g, vc_g, gqa_q_norm[l], gqa_k_norm[l], cos, sin)
        x = x + g1 * (jnp.concatenate([a, b, g], axis=-1) @ w_out[l])

        x = x + g2 * peer_ffn(modulate(rms_norm(x, norm2_g[l]), sh2, sc2),
                              peer_w_q[l], peer_keys[l], peer_u[l], peer_v[l])

        if not last:
            zc_q = hc @ w_in[l][:, :KV_START]
            ac = conformer_conv(_cols(zc_q, OFF_A_VAL, CONV_CH), _cols(zc_q, OFF_A_GATE, CONV_CH),
                                conv_w[l], conv_b[l], conv_ln_g[l], conv_ln_b[l])
            bc = dense_attention(split_heads(_cols(zc_q, OFF_NA_Q, NA_W), NA_HEADS),
                                 split_heads(kc_na, NA_HEADS), split_heads(vc_na, NA_HEADS))
            qc_g = rms_norm(split_heads(_cols(zc_q, OFF_G_Q, GQA_W), GQA_HEADS), gqa_q_norm[l])
            gc = dense_attention(qc_g, kc_g, vc_g)
            ctx = ctx + cg1 * (jnp.concatenate([ac, bc, gc], axis=-1) @ w_out[l])
            ctx = ctx + cg2 * peer_ffn(modulate(rms_norm(ctx, norm2_g[l]), csh2, csc2),
                                       peer_w_q[l], peer_keys[l], peer_u[l], peer_v[l])
    return rms_norm(x, final_norm_g)
```

```cpp
#include <hip/hip_runtime.h>
#include <stdint.h>

typedef __attribute__((ext_vector_type(8))) short bf16x8;
typedef __attribute__((ext_vector_type(16))) float f32x16;
typedef __attribute__((ext_vector_type(2))) __bf16 bf2_t;
typedef __attribute__((ext_vector_type(2))) float f2_t;
typedef unsigned short bf16;
typedef __attribute__((ext_vector_type(4))) unsigned u32x4;
typedef __attribute__((ext_vector_type(2))) unsigned u32x2;

#define DI __device__ __forceinline__
#ifndef PROBE
#define PROBE 0
#endif
#define MFMA(a, b, c) __builtin_amdgcn_mfma_f32_32x32x16_bf16((a), (b), (c), 0, 0, 0)

constexpr int D = 1024, NB = 16, T = 2048, CL = 256;
constexpr int NTOK = NB * T;
constexpr int NCTX = NB * CL;
constexpr int MTOT = NTOK + NCTX;
constexpr int INC = 2304;
constexpr int SEQ2 = T + CL;
constexpr int NEXP = 16384;
constexpr float EPS = 1e-6f;
constexpr float L2E = 1.4426950408889634f;

struct Params {
  const float *x, *c, *ctx, *c_ctx, *norm1_g, *norm2_g, *w_ada, *b_ada, *w_in, *conv_w, *conv_b, *conv_ln_g,
      *conv_ln_b, *na_rel_bias, *gqa_q_norm, *gqa_k_norm, *w_out, *peer_w_q, *peer_keys, *peer_u, *peer_v, *final_norm_g;
  float* out;
  bf16 *win, *wout, *wq, *pk, *pu, *pv;
  float *modp, *mod, *ropetab;
  bf16 *H, *U, *QN, *KN, *VNt, *QG, *KG, *VGt, *CAT;
  float *XC;
  int* ridx;
  float* rg;
};

DI unsigned pack2(float a, float b) {
  f2_t v = {a, b};
  bf2_t r = __builtin_convertvector(v, bf2_t);
  return __builtin_bit_cast(unsigned, r);
}
DI float bf_lo(unsigned u) { return __uint_as_float(u << 16); }
DI float bf_hi(unsigned u) { return __uint_as_float(u & 0xffff0000u); }
DI int crow(int e, int h) { return (e & 3) + 8 * (e >> 2) + 4 * h; }
DI float silu_f(float x) { return x / (1.f + __expf(-x)); }
DI float sigmoid_f(float x) { return 1.f / (1.f + __expf(-x)); }
DI float gelu_tanh(float x) {
  float u = 0.7978845608028654f * (x + 0.044715f * x * x * x);
  float t = 1.f - 2.f / (1.f + __expf(2.f * u));
  return 0.5f * x * (1.f + t);
}
DI float wave_sum(float v) {
#pragma unroll
  for (int o = 32; o >= 1; o >>= 1) v += __shfl_xor(v, o);
  return v;
}
DI float* xres_row(const Params& p, int row) { return row < NTOK ? p.out + (size_t)row * D : p.XC + (size_t)(row - NTOK) * D; }
DI const float* xin_row(const Params& p, int layer, int row) {
  if (layer == 0) return row < NTOK ? p.x + (size_t)row * D : p.ctx + (size_t)(row - NTOK) * D;
  return xres_row(p, row);
}
DI int mod_row(int row) { return row < NTOK ? (row >> 11) : 16; }
DI int batch_of(int row) { return row < NTOK ? (row >> 11) : ((row - NTOK) >> 8); }
DI int pos_of(int row) { return row < NTOK ? (row & 2047) : (T + ((row - NTOK) & 255)); }

DI int perm_in(int n) {
  if (n >= 512) return n;
  int c = n >> 6, w = n & 63;
  return w < 32 ? 32 * c + w : 256 + 32 * c + (w - 32);
}
DI void convT_tile(const float* __restrict__ src, bf16* __restrict__ dst, int K, int N, int k0, int n0, bool perm, float* tile  ) {
  const int tx = threadIdx.x & 63, ty = threadIdx.x >> 6;
  const int ns = perm ? perm_in(n0 + tx) : n0 + tx;
#pragma unroll
  for (int i = 0; i < 16; ++i) { int k = ty + 4 * i; tile[k * 65 + tx] = src[(size_t)(k0 + k) * N + ns]; }
  __syncthreads();
#pragma unroll
  for (int i = 0; i < 16; ++i) {
    int n = ty + 4 * i;
    dst[(size_t)(n0 + n) * K + k0 + tx] = (bf16)(pack2(tile[tx * 65 + n], 0.f) & 0xffff);
  }
  __syncthreads();
}
constexpr int CONVT_ITEMS = 2 * 1344;
DI void stage_convT(const Params& p, int item, char* smem) {
  float* tile = (float*)smem;
  int l = item / 1344, r = item % 1344;
  if (r < 576) { int kt = r / 36, nt = r % 36; convT_tile(p.w_in + (size_t)l * D * INC, p.win + (size_t)l * INC * D, D, INC, kt * 64, nt * 64, true, tile); }
  else if (r < 832) { r -= 576; int kt = r / 16, nt = r % 16; convT_tile(p.w_out + (size_t)l * D * D, p.wout + (size_t)l * D * D, D, D, kt * 64, nt * 64, false, tile); }
  else { r -= 832; int kt = r / 32, nt = r % 32; convT_tile(p.peer_w_q + (size_t)l * D * 2048, p.wq + (size_t)l * 2048 * D, D, 2048, kt * 64, nt * 64, false, tile); }
}
constexpr size_t PK_N = (size_t)2 * 16 * 128 * 128, PU_N = (size_t)2 * NEXP * D;
constexpr int CONVS_ITEMS = (int)((PK_N + 2 * PU_N) / 2048);
DI void stage_convS(const Params& p, int item) {
  size_t e = (size_t)item * 2048 + threadIdx.x * 8;
  const float* src; bf16* dst;
  if (e < PK_N) { src = p.peer_keys + e; dst = p.pk + e; }
  else if (e < PK_N + PU_N) { src = p.peer_u + (e - PK_N); dst = p.pu + (e - PK_N); }
  else { src = p.peer_v + (e - PK_N - PU_N); dst = p.pv + (e - PK_N - PU_N); }
  float4 a = ((const float4*)src)[0], b = ((const float4*)src)[1];
  u32x4 o = {pack2(a.x, a.y), pack2(a.z, a.w), pack2(b.x, b.y), pack2(b.z, b.w)};
  *(u32x4*)dst = o;
}
DI void stage_rope(const Params& p) {
  for (int i = threadIdx.x; i < 64 * 16; i += 256) {
    int pos = i >> 4, f = i & 15;
    float inv = powf(10000.f, -(float)f / 16.f);
    float ang = (float)pos * inv;
    p.ropetab[2 * i] = cosf(ang); p.ropetab[2 * i + 1] = sinf(ang);
  }
}

constexpr int MODP_ITEMS = 2 * 8 * 24;
DI void stage_mod_partial(const Params& p, int item, char* smem) {
  float* sc = (float*)smem;
  int l = item / 192, r = item % 192, kc = r / 24, nc = r % 24;
  for (int i = threadIdx.x; i < 17 * 128; i += 256) {
    int rr = i >> 7, k = i & 127;
    float v = rr < 16 ? p.c[rr * D + kc * 128 + k] : p.c_ctx[kc * 128 + k];
    sc[i] = silu_f(v);
  }
  __syncthreads();
  float acc[17];
#pragma unroll
  for (int i = 0; i < 17; ++i) acc[i] = 0.f;
  const int n = nc * 256 + threadIdx.x;
  const float* w = p.w_ada + ((size_t)l * D + kc * 128) * 6144 + n;
  for (int k = 0; k < 128; ++k) {
    float wv = w[(size_t)k * 6144];
#pragma unroll
    for (int i = 0; i < 17; ++i) acc[i] += sc[i * 128 + k] * wv;
  }
#pragma unroll
  for (int i = 0; i < 17; ++i) p.modp[(((size_t)l * 8 + kc) * 17 + i) * 6144 + n] = acc[i];
  __syncthreads();
}
constexpr int MODR_ITEMS = 2 * 17 * 6144 / 256;
DI void stage_mod_reduce(const Params& p, int item) {
  int idx = item * 256 + threadIdx.x;
  int l = idx / (17 * 6144), rem = idx % (17 * 6144), n = rem % 6144;
  float s = p.b_ada[l * 6144 + n];
#pragma unroll
  for (int kc = 0; kc < 8; ++kc) s += p.modp[((size_t)l * 8 + kc) * 17 * 6144 + rem];
  p.mod[idx] = s;
}

DI void norm_row(const Params& p, const float* __restrict__ xr, const float* __restrict__ g, const float* __restrict__ sh,
                 const float* __restrict__ sc, bf16* __restrict__ hr) {
  const int lane = threadIdx.x & 63;
  float4 v[4]; float ss = 0.f;
#pragma unroll
  for (int i = 0; i < 4; ++i) { v[i] = ((const float4*)xr)[lane + 64 * i]; ss += v[i].x * v[i].x + v[i].y * v[i].y + v[i].z * v[i].z + v[i].w * v[i].w; }
  ss = wave_sum(ss);
  const float rstd = rsqrtf(ss * (1.f / D) + EPS);
#pragma unroll
  for (int i = 0; i < 4; ++i) {
    float4 gg = ((const float4*)g)[lane + 64 * i], s1 = ((const float4*)sh)[lane + 64 * i], s2 = ((const float4*)sc)[lane + 64 * i];
    float a = v[i].x * rstd * gg.x * (1.f + s2.x) + s1.x, b = v[i].y * rstd * gg.y * (1.f + s2.y) + s1.y;
    float c = v[i].z * rstd * gg.z * (1.f + s2.z) + s1.z, d = v[i].w * rstd * gg.w * (1.f + s2.w) + s1.w;
    u32x2 o = {pack2(a, b), pack2(c, d)};
    ((u32x2*)hr)[lane + 64 * i] = o;
  }
}
DI void stage_norm(const Params& p, int layer, int which, int item) {
  int row = item * 4 + (threadIdx.x >> 6);
  const float* xr = which == 0 ? xin_row(p, layer, row) : xres_row(p, row);
  const float* g = (which == 0 ? p.norm1_g : p.norm2_g) + layer * D;
  const float* m = p.mod + ((size_t)layer * 17 + mod_row(row)) * 6144 + (which == 0 ? 0 : 3072);
  norm_row(p, xr, g, m, m + D, p.H + (size_t)row * D);
}
DI void stage_final(const Params& p, int item) {
  int row = item * 4 + (threadIdx.x >> 6);
  const int lane = threadIdx.x & 63;
  const float* xr = p.out + (size_t)row * D;
  float4 v[4]; float ss = 0.f;
#pragma unroll
  for (int i = 0; i < 4; ++i) { v[i] = ((const float4*)xr)[lane + 64 * i]; ss += v[i].x * v[i].x + v[i].y * v[i].y + v[i].z * v[i].z + v[i].w * v[i].w; }
  ss = wave_sum(ss);
  const float rstd = rsqrtf(ss * (1.f / D) + EPS);
#pragma unroll
  for (int i = 0; i < 4; ++i) {
    float4 gg = ((const float4*)p.final_norm_g)[lane + 64 * i];
    float4 o = {v[i].x * rstd * gg.x, v[i].y * rstd * gg.y, v[i].z * rstd * gg.z, v[i].w * rstd * gg.w};
    ((float4*)(p.out + (size_t)row * D))[lane + 64 * i] = o;
  }
}

constexpr int LROW = 144;
constexpr int LTILE = 128 * LROW;
constexpr int GEMM_SMEM = 4 * LTILE;

template <bool ORIENT_T>
DI void gemm_core(const bf16* __restrict__ A, const bf16* __restrict__ W, char* smem, f32x16 (&acc)[2][2]) {
  const int tid = threadIdx.x, lane = tid & 63, wave = tid >> 6;
  const int wm = wave >> 1, wn = wave & 1, l31 = lane & 31, hh = lane >> 5;
  const int lrow = tid >> 3, kc = tid & 7;
#pragma unroll
  for (int i = 0; i < 2; ++i)
#pragma unroll
    for (int j = 0; j < 2; ++j)
#pragma unroll
      for (int e = 0; e < 16; ++e) acc[i][j][e] = 0.f;
  u32x4 ra[4], rw[4];
  const bf16* ap = A + (size_t)lrow * D + kc * 8;
  const bf16* wp = W + (size_t)lrow * D + kc * 8;
#pragma unroll
  for (int i = 0; i < 4; ++i) { ra[i] = *(const u32x4*)(ap + (size_t)(32 * i) * D); rw[i] = *(const u32x4*)(wp + (size_t)(32 * i) * D); }
  for (int kt = 0; kt < 16; ++kt) {
    char* sa = smem + (kt & 1) * 2 * LTILE;
    char* sw = sa + LTILE;
#pragma unroll
    for (int i = 0; i < 4; ++i) {
      *(u32x4*)(sa + (lrow + 32 * i) * LROW + kc * 16) = ra[i];
      *(u32x4*)(sw + (lrow + 32 * i) * LROW + kc * 16) = rw[i];
    }
    __syncthreads();
    if (kt + 1 < 16) {
#pragma unroll
      for (int i = 0; i < 4; ++i) {
        ra[i] = *(const u32x4*)(ap + (size_t)(32 * i) * D + (kt + 1) * 64);
        rw[i] = *(const u32x4*)(wp + (size_t)(32 * i) * D + (kt + 1) * 64);
      }
    }
#pragma unroll
    for (int s = 0; s < 4; ++s) {
      bf16x8 af[2], wf[2];
#pragma unroll
      for (int t = 0; t < 2; ++t) {
        af[t] = *(const bf16x8*)(sa + (wm * 64 + t * 32 + l31) * LROW + (s * 16 + hh * 8) * 2);
        wf[t] = *(const bf16x8*)(sw + (wn * 64 + t * 32 + l31) * LROW + (s * 16 + hh * 8) * 2);
      }
#pragma unroll
      for (int ft = 0; ft < 2; ++ft)
#pragma unroll
        for (int tt = 0; tt < 2; ++tt)
          acc[ft][tt] = ORIENT_T ? MFMA(wf[ft], af[tt], acc[ft][tt]) : MFMA(af[tt], wf[ft], acc[ft][tt]);
    }
  }
  __syncthreads();
}

constexpr int INPROJ_ITEMS = 288 * 18;
DI void store4(bf16* dst, float a, float b, float c, float d) { u32x2 o = {pack2(a, b), pack2(c, d)}; *(u32x2*)dst = o; }

DI void stage_inproj(const Params& p, int layer, int item, char* smem) {
  const int mt = item / 18, nt = item % 18;
  if (layer == 1 && mt >= 256 && nt < 10) return;
  const int row0 = mt * 128, n0 = nt * 128;
  const bf16* A = p.H + (size_t)row0 * D;
  const bf16* W = p.win + ((size_t)layer * INC + n0) * D;
  const int lane = threadIdx.x & 63, wave = threadIdx.x >> 6, wm = wave >> 1, wn = wave & 1, l31 = lane & 31, hh = lane >> 5;
  const bool vtile = (nt >= 13 && nt <= 15) || nt == 17;
  f32x16 acc[2][2];
  const int b = batch_of(row0);
  if (vtile) {
    gemm_core<false>(A, W, smem, acc);
    bf16* base; int head;
    if (nt == 17) { head = wn; base = p.VGt + ((size_t)(b * 2 + head) * 64) * SEQ2; }
    else { head = (nt - 13) * 2 + wn; base = p.VNt + ((size_t)(b * 6 + head) * 64) * SEQ2; }
    const int pos0 = pos_of(row0) + wm * 64;
#pragma unroll
    for (int ft = 0; ft < 2; ++ft) {
      const int d = ft * 32 + l31;
#pragma unroll
      for (int tt = 0; tt < 2; ++tt)
#pragma unroll
        for (int g = 0; g < 4; ++g)
          store4(base + (size_t)d * SEQ2 + pos0 + tt * 32 + 8 * g + 4 * hh, acc[ft][tt][4 * g], acc[ft][tt][4 * g + 1], acc[ft][tt][4 * g + 2], acc[ft][tt][4 * g + 3]);
    }
    return;
  }
  gemm_core<true>(A, W, smem, acc);
  const int chunk = nt * 2 + wn;
#pragma unroll
  for (int tt = 0; tt < 2; ++tt) {
    const int row = row0 + wm * 64 + tt * 32 + l31;
    const int pos = pos_of(row);
    const bool isctx = row >= NTOK;
    if (chunk < 8) {
      bf16* dst = p.U + (size_t)row * 256 + 32 * chunk;
#pragma unroll
      for (int g = 0; g < 4; ++g) {
        float u0 = acc[0][tt][4 * g] * sigmoid_f(acc[1][tt][4 * g]), u1 = acc[0][tt][4 * g + 1] * sigmoid_f(acc[1][tt][4 * g + 1]);
        float u2 = acc[0][tt][4 * g + 2] * sigmoid_f(acc[1][tt][4 * g + 2]), u3 = acc[0][tt][4 * g + 3] * sigmoid_f(acc[1][tt][4 * g + 3]);
        store4(dst + 8 * g + 4 * hh, u0, u1, u2, u3);
      }
    } else if (chunk < 14 || (chunk >= 20 && chunk < 26)) {
      const bool isq = chunk < 14;
      const int head = isq ? chunk - 8 : chunk - 20;
      const float sc = isq ? 0.125f : 1.f;
      bf16* dst = (isq ? p.QN : p.KN) + ((size_t)(b * 6 + head) * SEQ2 + pos) * 64;
#pragma unroll
      for (int ft = 0; ft < 2; ++ft)
#pragma unroll
        for (int g = 0; g < 4; ++g)
          store4(dst + ft * 32 + 8 * g + 4 * hh, acc[ft][tt][4 * g] * sc, acc[ft][tt][4 * g + 1] * sc, acc[ft][tt][4 * g + 2] * sc, acc[ft][tt][4 * g + 3] * sc);
    } else {
      const bool isq = chunk < 20;
      const int head = isq ? chunk - 14 : chunk - 32;
      const float* gn = (isq ? p.gqa_q_norm : p.gqa_k_norm) + layer * 64;
      float ss = 0.f;
#pragma unroll
      for (int ft = 0; ft < 2; ++ft)
#pragma unroll
        for (int e = 0; e < 16; ++e) ss += acc[ft][tt][e] * acc[ft][tt][e];
      ss += __shfl_xor(ss, 32);
      const float rstd = rsqrtf(ss * (1.f / 64.f) + EPS) ;
      const float sc = isq ? 0.125f : 1.f;
      bf16* dst = (isq ? p.QG + ((size_t)(b * 6 + head) * SEQ2 + pos) * 64 : p.KG + ((size_t)(b * 2 + head) * SEQ2 + pos) * 64);
      const int prow = pos >> 6, pcol = pos & 63;
#pragma unroll
      for (int g = 0; g < 4; ++g) {
        float o1[4], o2[4];
#pragma unroll
        for (int j = 0; j < 4; ++j) {
          const int i = 8 * g + 4 * hh + j;
          float x1 = acc[0][tt][4 * g + j] * rstd * gn[i];
          float x2 = acc[1][tt][4 * g + j] * rstd * gn[32 + i];
          if (!isctx) {
            const int ppos = (g < 2) ? prow : pcol;
            const float2 cs = *(const float2*)(p.ropetab + 2 * (ppos * 16 + (i & 15)));
            float y1 = x1 * cs.x - x2 * cs.y, y2 = x1 * cs.y + x2 * cs.x;
            x1 = y1; x2 = y2;
          }
          o1[j] = x1 * sc; o2[j] = x2 * sc;
        }
        store4(dst + 8 * g + 4 * hh, o1[0], o1[1], o1[2], o1[3]);
        store4(dst + 32 + 8 * g + 4 * hh, o2[0], o2[1], o2[2], o2[3]);
      }
    }
  }
}

constexpr int CONV_TT = 32;
constexpr int CONV_SMEM = (CONV_TT + 30) * 512 + CONV_TT * 1024;
DI void stage_conv(const Params& p, int layer, int item, char* smem) {
  bf16* ub = (bf16*)smem;
  float* yb = (float*)(smem + (CONV_TT + 30) * 512);
  const int tid = threadIdx.x;
  int row0, seq_lo, seq_hi;
  if (item < 1024) { row0 = item * CONV_TT; seq_lo = row0 & ~2047; seq_hi = seq_lo + 2048; }
  else { row0 = NTOK + (item - 1024) * CONV_TT; seq_lo = NTOK + (((item - 1024) * CONV_TT) & ~255); seq_hi = seq_lo + 256; }
  for (int c = tid; c < 62 * 32; c += 256) {
    int r = c >> 5, cc = c & 31;
    int row = row0 - 15 + r;
    u32x4 v = {0u, 0u, 0u, 0u};
    if (row >= seq_lo && row < seq_hi) v = *(const u32x4*)(p.U + (size_t)row * 256 + cc * 8);
    *(u32x4*)(ub + r * 256 + cc * 8) = v;
  }
  __syncthreads();
  {
    const int ch = tid;
    float w[31];
#pragma unroll
    for (int j = 0; j < 31; ++j) w[j] = p.conv_w[((size_t)layer * 31 + j) * 256 + ch];
    const float bias = p.conv_b[layer * 256 + ch];
#pragma unroll 1
    for (int t0 = 0; t0 < CONV_TT; t0 += 8) {
      float in[38];
#pragma unroll
      for (int j = 0; j < 38; ++j) in[j] = __uint_as_float((unsigned)ub[(t0 + j) * 256 + ch] << 16);
#pragma unroll
      for (int t = 0; t < 8; ++t) {
        float a = bias;
#pragma unroll
        for (int j = 0; j < 31; ++j) a += in[t + j] * w[j];
        yb[(t0 + t) * 256 + ch] = a;
      }
    }
  }
  __syncthreads();
  {
    const int wave = tid >> 6, lane = tid & 63;
    const float4 g = ((const float4*)(p.conv_ln_g + layer * 256))[lane], bb = ((const float4*)(p.conv_ln_b + layer * 256))[lane];
    for (int t = wave * 8; t < wave * 8 + 8; ++t) {
      float4 v = ((const float4*)(yb + t * 256))[lane];
      float mu = wave_sum(v.x + v.y + v.z + v.w) * (1.f / 256.f);
      float dx = v.x - mu, dy = v.y - mu, dz = v.z - mu, dw = v.w - mu;
      float var = wave_sum(dx * dx + dy * dy + dz * dz + dw * dw) * (1.f / 256.f);
      float rs = rsqrtf(var + EPS);
      float a = silu_f(dx * rs * g.x + bb.x), b = silu_f(dy * rs * g.y + bb.y), c = silu_f(dz * rs * g.z + bb.z), d = silu_f(dw * rs * g.w + bb.w);
      store4(p.CAT + (size_t)(row0 + t) * D + lane * 4, a, b, c, d);
    }
  }
  __syncthreads();
}

DI int kperm(int i) { return (i & 19) | ((i & 4) << 1) | ((i & 8) >> 1); }
DI int keyoff(int e, int h) { return (e & 3) + 4 * ((e >> 2) & 1) + 8 * h + 16 * (e >> 3); }
DI bf16x8 pack8(const f32x16& x, int s) {
  u32x4 r = {pack2(x[8 * s], x[8 * s + 1]), pack2(x[8 * s + 2], x[8 * s + 3]), pack2(x[8 * s + 4], x[8 * s + 5]), pack2(x[8 * s + 6], x[8 * s + 7])};
  return __builtin_bit_cast(bf16x8, r);
}

constexpr int NA_ITEMS = 6144 / 4;
DI void stage_na(const Params& p, int layer, int item) {
  const int lane = threadIdx.x & 63, wave = threadIdx.x >> 6, l31 = lane & 31, hh = lane >> 5;
  const int wi = item * 4 + wave;
  const int qhalf = wi & 1, head = (wi >> 1) % 6, br = wi / 12, r = br & 31, b = br >> 5;
  const int r0 = min(max(r - 4, 0), 24);
  const size_t hb = (size_t)(b * 6 + head);
  const bf16* Q = p.QN + (hb * SEQ2 + r * 64 + qhalf * 32 + l31) * 64;
  const bf16* Kb = p.KN + hb * SEQ2 * 64;
  const bf16* Vb = p.VNt + hb * 64 * SEQ2;
  const float* bias = p.na_rel_bias + ((size_t)layer * 6 + head) * 15 * 31;
  bf16x8 qf[4];
#pragma unroll
  for (int s = 0; s < 4; ++s) qf[s] = *(const bf16x8*)(Q + 16 * s + 8 * hh);
  f32x16 o[2];
#pragma unroll
  for (int e = 0; e < 16; ++e) { o[0][e] = 0.f; o[1][e] = 0.f; }
  float m = -1e30f, l = 0.f;
  const int qc = qhalf * 32 + l31;
  const int c0 = min(max(qc - 8, 0), 48);
  const int kp = kperm(l31);
#pragma unroll 1
  for (int t = 0; t < 24; ++t) {
    int key0, brow = 0, cs = 0;
    const bool local = t >= 8;
    if (!local) key0 = T + t * 32;
    else { brow = (t - 8) >> 1; cs = (t - 8) & 1; key0 = (r0 + brow) * 64 + cs * 32; }
    f32x16 st;
#pragma unroll
    for (int e = 0; e < 16; ++e) st[e] = 0.f;
    const bf16* kr = Kb + (size_t)(key0 + kp) * 64 + 8 * hh;
#pragma unroll
    for (int s = 0; s < 4; ++s) { bf16x8 kf = *(const bf16x8*)(kr + 16 * s); st = MFMA(kf, qf[s], st); }
    if (local) {
      const int rb = (r0 + brow) - r + 7;
#pragma unroll
      for (int e = 0; e < 16; ++e) {
        const int kc = cs * 32 + keyoff(e, hh);
        const bool valid = (kc >= c0) && (kc < c0 + 16);
        const int ci = min(max(kc - qc + 15, 0), 30);
        const float bv = bias[rb * 31 + ci];
        st[e] = valid ? st[e] + bv : -1e30f;
      }
    }
    float mx = st[0];
#pragma unroll
    for (int e = 1; e < 16; ++e) mx = fmaxf(mx, st[e]);
    mx = fmaxf(mx, __shfl_xor(mx, 32));
    const float mn = fmaxf(m, mx);
    const float alpha = exp2f((m - mn) * L2E);
    float ls = 0.f;
#pragma unroll
    for (int e = 0; e < 16; ++e) { st[e] = exp2f((st[e] - mn) * L2E); ls += st[e]; }
    l = l * alpha + ls; m = mn;
#pragma unroll
    for (int e = 0; e < 16; ++e) { o[0][e] *= alpha; o[1][e] *= alpha; }
    bf16x8 pf0 = pack8(st, 0), pf1 = pack8(st, 1);
#pragma unroll
    for (int dt = 0; dt < 2; ++dt) {
      const bf16* vr = Vb + (size_t)(dt * 32 + l31) * SEQ2 + key0 + 8 * hh;
      bf16x8 v0 = *(const bf16x8*)(vr), v1 = *(const bf16x8*)(vr + 16);
      o[dt] = MFMA(v0, pf0, o[dt]);
      o[dt] = MFMA(v1, pf1, o[dt]);
    }
  }
  l += __shfl_xor(l, 32);
  const float inv = 1.f / l;
  bf16* dst = p.CAT + (size_t)(b * T + r * 64 + qc) * D + 256 + head * 64;
#pragma unroll
  for (int dt = 0; dt < 2; ++dt)
#pragma unroll
    for (int g = 0; g < 4; ++g)
      store4(dst + dt * 32 + 8 * g + 4 * hh, o[dt][4 * g] * inv, o[dt][4 * g + 1] * inv, o[dt][4 * g + 2] * inv, o[dt][4 * g + 3] * inv);
}

constexpr int FA_SMEM = 2 * 2 * 64 * LROW;
DI void flash_block(const bf16* __restrict__ Q, const bf16* __restrict__ K, const bf16* __restrict__ Vt, int q0, int kt0, int kt1,
                    bf16* __restrict__ dst  , char* smem) {
  const int tid = threadIdx.x, lane = tid & 63, wave = tid >> 6, l31 = lane & 31, hh = lane >> 5;
  const int lrow = tid >> 3, kc = tid & 7;
  bf16x8 qf[4];
  const bf16* qp = Q + (size_t)(q0 + wave * 32 + l31) * 64 + 8 * hh;
#pragma unroll
  for (int s = 0; s < 4; ++s) qf[s] = *(const bf16x8*)(qp + 16 * s);
  f32x16 o[2];
#pragma unroll
  for (int e = 0; e < 16; ++e) { o[0][e] = 0.f; o[1][e] = 0.f; }
  float m = -1e30f, l = 0.f;
  const int kp = kperm(l31);
  u32x4 rk[2], rv[2];
#pragma unroll
  for (int i = 0; i < 2; ++i) {
    rk[i] = *(const u32x4*)(K + (size_t)(kt0 * 64 + lrow + 32 * i) * 64 + kc * 8);
    rv[i] = *(const u32x4*)(Vt + (size_t)(lrow + 32 * i) * SEQ2 + kt0 * 64 + kc * 8);
  }
  for (int kt = kt0; kt < kt1; ++kt) {
    char* sk = smem + ((kt - kt0) & 1) * 2 * 64 * LROW;
    char* sv = sk + 64 * LROW;
#pragma unroll
    for (int i = 0; i < 2; ++i) {
      *(u32x4*)(sk + (lrow + 32 * i) * LROW + kc * 16) = rk[i];
      *(u32x4*)(sv + (lrow + 32 * i) * LROW + kc * 16) = rv[i];
    }
    __syncthreads();
    if (kt + 1 < kt1) {
#pragma unroll
      for (int i = 0; i < 2; ++i) {
        rk[i] = *(const u32x4*)(K + (size_t)((kt + 1) * 64 + lrow + 32 * i) * 64 + kc * 8);
        rv[i] = *(const u32x4*)(Vt + (size_t)(lrow + 32 * i) * SEQ2 + (kt + 1) * 64 + kc * 8);
      }
    }
    f32x16 st[2];
#pragma unroll
    for (int k2 = 0; k2 < 2; ++k2) {
#pragma unroll
      for (int e = 0; e < 16; ++e) st[k2][e] = 0.f;
#pragma unroll
      for (int s = 0; s < 4; ++s) {
        bf16x8 kf = *(const bf16x8*)(sk + (k2 * 32 + kp) * LROW + (16 * s + 8 * hh) * 2);
        st[k2] = MFMA(kf, qf[s], st[k2]);
      }
    }
    float mx = st[0][0];
#pragma unroll
    for (int e = 1; e < 16; ++e) mx = fmaxf(mx, st[0][e]);
#pragma unroll
    for (int e = 0; e < 16; ++e) mx = fmaxf(mx, st[1][e]);
    mx = fmaxf(mx, __shfl_xor(mx, 32));
    const float mn = fmaxf(m, mx);
    const float alpha = exp2f((m - mn) * L2E);
    float ls = 0.f;
#pragma unroll
    for (int k2 = 0; k2 < 2; ++k2)
#pragma unroll
      for (int e = 0; e < 16; ++e) { st[k2][e] = exp2f((st[k2][e] - mn) * L2E); ls += st[k2][e]; }
    l = l * alpha + ls; m = mn;
#pragma unroll
    for (int e = 0; e < 16; ++e) { o[0][e] *= alpha; o[1][e] *= alpha; }
#pragma unroll
    for (int k2 = 0; k2 < 2; ++k2)
#pragma unroll
      for (int s2 = 0; s2 < 2; ++s2) {
        bf16x8 pf = pack8(st[k2], s2);
#pragma unroll
        for (int dt = 0; dt < 2; ++dt) {
          bf16x8 vf = *(const bf16x8*)(sv + (dt * 32 + l31) * LROW + (k2 * 32 + 16 * s2 + 8 * hh) * 2);
          o[dt] = MFMA(vf, pf, o[dt]);
        }
      }
  }
  l += __shfl_xor(l, 32);
  const float inv = 1.f / l;
  bf16* d2 = dst + (size_t)(wave * 32 + l31) * D;
#pragma unroll
  for (int dt = 0; dt < 2; ++dt)
#pragma unroll
    for (int g = 0; g < 4; ++g)
      store4(d2 + dt * 32 + 8 * g + 4 * hh, o[dt][4 * g] * inv, o[dt][4 * g + 1] * inv, o[dt][4 * g + 2] * inv, o[dt][4 * g + 3] * inv);
  __syncthreads();
}
constexpr int GQA_ITEMS = 16 * 6 * 16;
DI void stage_gqa(const Params& p, int item, char* smem) {
  const int qt = item & 15, hq = (item >> 4) % 6, b = item / 96;
  const int kvh = hq / 3;
  flash_block(p.QG + (size_t)(b * 6 + hq) * SEQ2 * 64, p.KG + (size_t)(b * 2 + kvh) * SEQ2 * 64, p.VGt + (size_t)(b * 2 + kvh) * 64 * SEQ2,
              qt * 128, 0, 36, p.CAT + (size_t)(b * T + qt * 128) * D + 640 + hq * 64, smem);
}
constexpr int CTXATT_ITEMS = 384;
DI void stage_ctxatt(const Params& p, int item, char* smem) {
  const int qt = item & 1, head = (item >> 1) % 6, which = (item / 12) & 1, b = item / 24;
  bf16* dst = p.CAT + (size_t)(NTOK + b * CL + qt * 128) * D;
  if (which == 0)
    flash_block(p.QN + (size_t)(b * 6 + head) * SEQ2 * 64, p.KN + (size_t)(b * 6 + head) * SEQ2 * 64, p.VNt + (size_t)(b * 6 + head) * 64 * SEQ2,
                T + qt * 128, 32, 36, dst + 256 + head * 64, smem);
  else
    flash_block(p.QG + (size_t)(b * 6 + head) * SEQ2 * 64, p.KG + (size_t)(b * 2 + head / 3) * SEQ2 * 64, p.VGt + (size_t)(b * 2 + head / 3) * 64 * SEQ2,
                T + qt * 128, 32, 36, dst + 640 + head * 64, smem);
}

constexpr int OUTPROJ_ITEMS = 288 * 8;
DI void stage_outproj(const Params& p, int layer, int item, char* smem) {
  const int mt = item >> 3, nt = item & 7;
  if (layer == 1 && mt >= 256) return;
  const int row0 = mt * 128, n0 = nt * 128;
  f32x16 acc[2][2];
  gemm_core<true>(p.CAT + (size_t)row0 * D, p.wout + ((size_t)layer * D + n0) * D, smem, acc);
  const int lane = threadIdx.x & 63, wave = threadIdx.x >> 6, wm = wave >> 1, wn = wave & 1, l31 = lane & 31, hh = lane >> 5;
  const float* g1 = p.mod + ((size_t)layer * 17 + mod_row(row0)) * 6144 + 2048;
#pragma unroll
  for (int tt = 0; tt < 2; ++tt) {
    const int row = row0 + wm * 64 + tt * 32 + l31;
    const float* xr = xin_row(p, layer, row);
    float* dr = xres_row(p, row);
#pragma unroll
    for (int ft = 0; ft < 2; ++ft)
#pragma unroll
      for (int g = 0; g < 4; ++g) {
        const int n = n0 + wn * 64 + ft * 32 + 8 * g + 4 * hh;
        float4 xv = *(const float4*)(xr + n), gv = *(const float4*)(g1 + n);
        if (PROBE == 2) { gv.x = gv.y = gv.z = gv.w = 0.f; }
        float4 o = {xv.x + gv.x * acc[ft][tt][4 * g], xv.y + gv.y * acc[ft][tt][4 * g + 1], xv.z + gv.z * acc[ft][tt][4 * g + 2], xv.w + gv.w * acc[ft][tt][4 * g + 3]};
        *(float4*)(dr + n) = o;
      }
  }
}

constexpr int ROUTE_ITEMS = 288 * 8;
constexpr int QROW = 272;
DI int to_sortable(int b) { return b ^ ((b >> 31) & 0x7fffffff); }

#define CAND_LIST(X) \
  X(0,0,0) X(1,0,1) X(2,0,2) X(3,0,3) X(4,0,4) X(5,0,5) X(6,0,6) X(7,0,7) X(8,0,8) X(9,0,9) X(10,0,10) X(11,0,11) X(12,0,12) X(13,0,13) X(14,0,14) X(15,0,15) \
  X(16,1,1) X(17,1,2) X(18,1,3) X(19,1,4) X(20,1,5) X(21,1,6) X(22,1,7) \
  X(23,2,2) X(24,2,3) X(25,2,4) \
  X(26,3,3)

DI void stage_route(const Params& p, int layer, int item, char* smem) {
  const int mt = item >> 3, head = item & 7;
  if (layer == 1 && mt >= 256) return;
  const int row0 = mt * 128;
  const int tid = threadIdx.x, lane = tid & 63, wave = tid >> 6, wm = wave >> 1, wn = wave & 1, l31 = lane & 31, hh = lane >> 5;
  int topk[2][16];
  char* Qs = smem;
  char* Ks = smem + 2 * LTILE;
#pragma unroll
  for (int pp = 0; pp < 2; ++pp) {
    {
      f32x16 acc[2][2];
      gemm_core<true>(p.H + (size_t)row0 * D, p.wq + ((size_t)layer * 2048 + (head * 2 + pp) * 128) * D, smem, acc);
#pragma unroll
      for (int tt = 0; tt < 2; ++tt)
#pragma unroll
        for (int ft = 0; ft < 2; ++ft)
#pragma unroll
          for (int g = 0; g < 4; ++g) {
            const int tok = wm * 64 + tt * 32 + l31, kf = wn * 64 + ft * 32 + 8 * g + 4 * hh;
            u32x2 o = {pack2(acc[ft][tt][4 * g], acc[ft][tt][4 * g + 1]), pack2(acc[ft][tt][4 * g + 2], acc[ft][tt][4 * g + 3])};
            *(u32x2*)(Qs + tok * QROW + kf * 2) = o;
          }
    }
    const bf16* kp = p.pk + ((size_t)((layer * 8 + head) * 2 + pp) * 128) * 128;
#pragma unroll
    for (int i = 0; i < 8; ++i) {
      const int c = tid + 256 * i, n = c >> 4, kc = c & 15;
      *(u32x4*)(Ks + n * QROW + kc * 16) = *(const u32x4*)(kp + n * 128 + kc * 8);
    }
    __syncthreads();
    int key[64];
    {
      f32x16 sc[4];
#pragma unroll
      for (int nt = 0; nt < 4; ++nt)
#pragma unroll
        for (int e = 0; e < 16; ++e) sc[nt][e] = 0.f;
#pragma unroll
      for (int s = 0; s < 8; ++s) {
        bf16x8 qb = *(const bf16x8*)(Qs + (wave * 32 + l31) * QROW + (16 * s + 8 * hh) * 2);
#pragma unroll
        for (int nt = 0; nt < 4; ++nt) {
          bf16x8 ka = *(const bf16x8*)(Ks + (nt * 32 + l31) * QROW + (16 * s + 8 * hh) * 2);
          sc[nt] = MFMA(ka, qb, sc[nt]);
        }
      }
#pragma unroll
      for (int nt = 0; nt < 4; ++nt)
#pragma unroll
        for (int e = 0; e < 16; ++e) {
          const int n = nt * 32 + crow(e, hh);
          int b = (__float_as_int(sc[nt][e]) & ~127) | n;
          key[nt * 16 + e] = to_sortable(b);
        }
    }
#pragma unroll
    for (int r = 0; r < 16; ++r) {
      int mx = key[0];
#pragma unroll
      for (int i = 1; i < 64; ++i) mx = max(mx, key[i]);
      mx = max(mx, __shfl_xor(mx, 32));
      topk[pp][r] = mx;
#pragma unroll
      for (int i = 0; i < 64; ++i) key[i] = (key[i] == mx) ? (int)0x80000000 : key[i];
    }
    __syncthreads();
  }
  float av[16], bv[16]; int ai[16], bi[16];
#pragma unroll
  for (int i = 0; i < 16; ++i) {
    int k1 = to_sortable(topk[0][i]), k2 = to_sortable(topk[1][i]);
    int a = hh ? k2 : k1, b = hh ? k1 : k2;
    av[i] = __int_as_float(a & ~127); ai[i] = a & 127;
    bv[i] = __int_as_float(b & ~127); bi[i] = b & 127;
  }
  int cand[27], eid[27];
#define MKC(c, i, j) { int b = __float_as_int(av[i] + bv[j]); cand[c] = (to_sortable(b) & ~63) | (c * 2 + hh); \
                       eid[c] = hh ? (bi[j] * 128 + ai[i]) : (ai[i] * 128 + bi[j]); \
                       if (i == j && hh) cand[c] = (int)0x80000000; }
  CAND_LIST(MKC)
#undef MKC
  int win[16], weid[16];
#pragma unroll
  for (int r = 0; r < 16; ++r) {
    int mx = cand[0];
#pragma unroll
    for (int c = 1; c < 27; ++c) mx = max(mx, cand[c]);
    mx = max(mx, __shfl_xor(mx, 32));
    int e = 0;
#pragma unroll
    for (int c = 0; c < 27; ++c) { const bool hit = cand[c] == mx; e = hit ? eid[c] : e; cand[c] = hit ? (int)0x80000000 : cand[c]; }
    e |= __shfl_xor(e, 32);
    win[r] = mx; weid[r] = e;
  }
  float gsum = 0.f, gv[16];
  const float v0 = __int_as_float(to_sortable(win[0]) & ~63);
#pragma unroll
  for (int r = 0; r < 16; ++r) { gv[r] = __expf(__int_as_float(to_sortable(win[r]) & ~63) - v0); gsum += gv[r]; }
  const float ginv = 1.f / gsum;
  const int row = row0 + wave * 32 + l31;
  if (hh == 0) {
    int4* d = (int4*)(p.ridx + ((size_t)row * 8 + head) * 16);
#pragma unroll
    for (int q = 0; q < 4; ++q) { int4 o = {weid[4 * q], weid[4 * q + 1], weid[4 * q + 2], weid[4 * q + 3]}; d[q] = o; }
  } else {
    float4* d = (float4*)(p.rg + ((size_t)row * 8 + head) * 16);
#pragma unroll
    for (int q = 0; q < 4; ++q) { float4 o = {gv[4 * q] * ginv, gv[4 * q + 1] * ginv, gv[4 * q + 2] * ginv, gv[4 * q + 3] * ginv}; d[q] = o; }
  }
}

DI float dot2(unsigned a, unsigned b, float acc) {
  bf2_t x = __builtin_bit_cast(bf2_t, a), y = __builtin_bit_cast(bf2_t, b);
  return __builtin_amdgcn_fdot2_f32_bf16(x, y, acc, false);
}
DI float dot8(u32x4 a, u32x4 b, float acc) {
  const unsigned a0 = a[0], a1 = a[1], a2 = a[2], a3 = a[3], b0 = b[0], b1 = b[1], b2 = b[2], b3 = b[3];
  acc = dot2(a0, b0, acc); acc = dot2(a1, b1, acc); acc = dot2(a2, b2, acc); acc = dot2(a3, b3, acc);
  return acc;
}
DI void axpy8(float (&o)[8], float w, u32x4 v) {
  o[0] += w * bf_lo(v.x); o[1] += w * bf_hi(v.x); o[2] += w * bf_lo(v.y); o[3] += w * bf_hi(v.y);
  o[4] += w * bf_lo(v.z); o[5] += w * bf_hi(v.z); o[6] += w * bf_lo(v.w); o[7] += w * bf_hi(v.w);
}
constexpr int GATHER_ITEMS = MTOT / 4;
DI void stage_gather(const Params& p, int layer, int item) {
  const int lane = threadIdx.x & 63, wave = threadIdx.x >> 6;
  const int row = item * 4 + wave;
  if (layer == 1 && row >= NTOK) return;
  const bf16* hr = p.H + (size_t)row * D;
  const u32x4 h0 = *(const u32x4*)(hr + lane * 8), h1 = *(const u32x4*)(hr + 512 + lane * 8);
  float o0[8], o1[8];
#pragma unroll
  for (int i = 0; i < 8; ++i) { o0[i] = 0.f; o1[i] = 0.f; }
  const bf16* Ub = p.pu + (size_t)layer * NEXP * D;
  const bf16* Vb = p.pv + (size_t)layer * NEXP * D;
#pragma unroll 1
  for (int head = 0; head < 8; ++head) {
    const int myidx = p.ridx[((size_t)row * 8 + head) * 16 + (lane & 15)];
    const float myg = p.rg[((size_t)row * 8 + head) * 16 + ((lane >> 2) & 15)];
    float part[16];
#pragma unroll
    for (int k = 0; k < 16; ++k) {
      const int e = __builtin_amdgcn_readlane(myidx, k);
      const bf16* ur = Ub + (size_t)e * D;
      const u32x4 a = *(const u32x4*)(ur + lane * 8), b = *(const u32x4*)(ur + 512 + lane * 8);
      part[k] = dot8(b, h1, dot8(a, h0, 0.f));
    }
    float r8[8], r4[4], r2[2], r1;
    {
      const bool up = lane & 32;
#pragma unroll
      for (int k = 0; k < 8; ++k) { float keep = up ? part[k + 8] : part[k], give = up ? part[k] : part[k + 8]; r8[k] = keep + __shfl_xor(give, 32); }
    }
    {
      const bool up = lane & 16;
#pragma unroll
      for (int k = 0; k < 4; ++k) { float keep = up ? r8[k + 4] : r8[k], give = up ? r8[k] : r8[k + 4]; r4[k] = keep + __shfl_xor(give, 16); }
    }
    {
      const bool up = lane & 8;
#pragma unroll
      for (int k = 0; k < 2; ++k) { float keep = up ? r4[k + 2] : r4[k], give = up ? r4[k] : r4[k + 2]; r2[k] = keep + __shfl_xor(give, 8); }
    }
    {
      const bool up = lane & 4;
      float keep = up ? r2[1] : r2[0], give = up ? r2[0] : r2[1];
      r1 = keep + __shfl_xor(give, 4);
    }
    r1 += __shfl_xor(r1, 2);
    r1 += __shfl_xor(r1, 1);
    const float w = gelu_tanh(r1) * myg;
#pragma unroll
    for (int k = 0; k < 16; ++k) {
      const int e = __builtin_amdgcn_readlane(myidx, k);
      const float wk = __int_as_float(__builtin_amdgcn_readlane(__float_as_int(w), k << 2));
      const bf16* vr = Vb + (size_t)e * D;
      const u32x4 a = *(const u32x4*)(vr + lane * 8), b = *(const u32x4*)(vr + 512 + lane * 8);
      axpy8(o0, wk, a); axpy8(o1, wk, b);
    }
  }
  const float* g2 = p.mod + ((size_t)layer * 17 + mod_row(row)) * 6144 + 5120;
  if (PROBE == 1) { for (int i = 0; i < 8; ++i) { o0[i] = 0.f; o1[i] = 0.f; } }
  if (PROBE == 5) { for (int i = 0; i < 8; ++i) { o0[i] *= 2.f; o1[i] *= 2.f; } }
  if (PROBE == 3 && layer == 1) { for (int i = 0; i < 8; ++i) { o0[i] = 0.f; o1[i] = 0.f; } }
  if (PROBE == 4 && layer == 0) { for (int i = 0; i < 8; ++i) { o0[i] = 0.f; o1[i] = 0.f; } }
  float* dr = xres_row(p, row);
  const float* xr = dr;
#pragma unroll
  for (int q = 0; q < 2; ++q) {
    float4 xv = *(const float4*)(xr + lane * 8 + 4 * q), gv = *(const float4*)(g2 + lane * 8 + 4 * q);
    float4 o = {xv.x + gv.x * o0[4 * q], xv.y + gv.y * o0[4 * q + 1], xv.z + gv.z * o0[4 * q + 2], xv.w + gv.w * o0[4 * q + 3]};
    *(float4*)(dr + lane * 8 + 4 * q) = o;
    float4 xv2 = *(const float4*)(xr + 512 + lane * 8 + 4 * q), gv2 = *(const float4*)(g2 + 512 + lane * 8 + 4 * q);
    float4 o2 = {xv2.x + gv2.x * o1[4 * q], xv2.y + gv2.y * o1[4 * q + 1], xv2.z + gv2.z * o1[4 * q + 2], xv2.w + gv2.w * o1[4 * q + 3]};
    *(float4*)(dr + 512 + lane * 8 + 4 * q) = o2;
  }
}

enum { S_CONVT, S_CONVS, S_ROPE, S_MODP, S_MODR, S_NORM1, S_INPROJ, S_CONV, S_NA, S_GQA, S_CTXATT, S_OUTPROJ, S_NORM2, S_ROUTE, S_GATHER, S_FINAL };
constexpr int SMEM_BYTES = GEMM_SMEM;

template <int S>
__global__ void __launch_bounds__(256) k_stage(Params p, int layer) {
  __shared__ __attribute__((aligned(16))) char smem[SMEM_BYTES];
  const int item = blockIdx.x;
  if (S == S_CONVT) stage_convT(p, item, smem);
  else if (S == S_CONVS) stage_convS(p, item);
  else if (S == S_ROPE) stage_rope(p);
  else if (S == S_MODP) stage_mod_partial(p, item, smem);
  else if (S == S_MODR) stage_mod_reduce(p, item);
  else if (S == S_NORM1) stage_norm(p, layer, 0, item);
  else if (S == S_INPROJ) stage_inproj(p, layer, item, smem);
  else if (S == S_CONV) stage_conv(p, layer, item, smem);
  else if (S == S_NA) stage_na(p, layer, item);
  else if (S == S_GQA) stage_gqa(p, item, smem);
  else if (S == S_CTXATT) stage_ctxatt(p, item, smem);
  else if (S == S_OUTPROJ) stage_outproj(p, layer, item, smem);
  else if (S == S_NORM2) stage_norm(p, layer, 1, item);
  else if (S == S_ROUTE) stage_route(p, layer, item, smem);
  else if (S == S_GATHER) stage_gather(p, layer, item);
  else if (S == S_FINAL) stage_final(p, item);
}

extern "C" void kernel_launch(void* const* d_in, const int* in_sizes, int n_in, void* d_out, int out_size, void* d_ws, size_t ws_size,
                              hipStream_t stream) {
  Params p{};
  const float** f = (const float**)&p;
  for (int i = 0; i < 22; ++i) f[i] = (const float*)d_in[i];
  p.out = (float*)d_out;
  char* w = (char*)d_ws; size_t off = 0;
  auto take = [&](size_t bytes) { char* r = w + off; off += (bytes + 255) & ~(size_t)255; return r; };
  p.win = (bf16*)take((size_t)2 * INC * D * 2);
  p.wout = (bf16*)take((size_t)2 * D * D * 2);
  p.wq = (bf16*)take((size_t)2 * 2048 * D * 2);
  p.pk = (bf16*)take(PK_N * 2);
  p.pu = (bf16*)take(PU_N * 2);
  p.pv = (bf16*)take(PU_N * 2);
  p.modp = (float*)take((size_t)2 * 8 * 17 * 6144 * 4);
  p.mod = (float*)take((size_t)2 * 17 * 6144 * 4);
  p.ropetab = (float*)take(64 * 16 * 2 * 4);
  p.H = (bf16*)take((size_t)MTOT * D * 2);
  p.CAT = p.H;
  p.U = (bf16*)take((size_t)MTOT * 256 * 2);
  p.QN = (bf16*)take((size_t)NB * 6 * SEQ2 * 64 * 2);
  p.KN = (bf16*)take((size_t)NB * 6 * SEQ2 * 64 * 2);
  p.VNt = (bf16*)take((size_t)NB * 6 * SEQ2 * 64 * 2);
  p.QG = (bf16*)take((size_t)NB * 6 * SEQ2 * 64 * 2);
  p.KG = (bf16*)take((size_t)NB * 2 * SEQ2 * 64 * 2);
  p.VGt = (bf16*)take((size_t)NB * 2 * SEQ2 * 64 * 2);
  p.XC = (float*)take((size_t)NCTX * D * 4);
  p.ridx = (int*)take((size_t)MTOT * 128 * 4);
  p.rg = (float*)take((size_t)MTOT * 128 * 4);
  if (off > ws_size) return;
  k_stage<S_CONVT><<<CONVT_ITEMS, 256, 0, stream>>>(p, 0);
  k_stage<S_CONVS><<<CONVS_ITEMS, 256, 0, stream>>>(p, 0);
  k_stage<S_ROPE><<<1, 256, 0, stream>>>(p, 0);
  k_stage<S_MODP><<<MODP_ITEMS, 256, 0, stream>>>(p, 0);
  k_stage<S_MODR><<<MODR_ITEMS, 256, 0, stream>>>(p, 0);
  for (int l = 0; l < 2; ++l) {
    k_stage<S_NORM1><<<MTOT / 4, 256, 0, stream>>>(p, l);
    k_stage<S_INPROJ><<<INPROJ_ITEMS, 256, 0, stream>>>(p, l);
    k_stage<S_CONV><<<l == 0 ? 1152 : 1024, 256, 0, stream>>>(p, l);
    k_stage<S_NA><<<NA_ITEMS, 256, 0, stream>>>(p, l);
    k_stage<S_GQA><<<GQA_ITEMS, 256, 0, stream>>>(p, l);
    if (l == 0) k_stage<S_CTXATT><<<CTXATT_ITEMS, 256, 0, stream>>>(p, l);
    k_stage<S_OUTPROJ><<<OUTPROJ_ITEMS, 256, 0, stream>>>(p, l);
    k_stage<S_NORM2><<<(l == 0 ? MTOT : NTOK) / 4, 256, 0, stream>>>(p, l);
    k_stage<S_ROUTE><<<ROUTE_ITEMS, 256, 0, stream>>>(p, l);
    k_stage<S_GATHER><<<(l == 0 ? MTOT : NTOK) / 4, 256, 0, stream>>>(p, l);
  }
  k_stage<S_FINAL><<<NTOK / 4, 256, 0, stream>>>(p, 0);
}
```

```cpp
#include <hip/hip_runtime.h>
#include <stdint.h>

typedef __attribute__((ext_vector_type(8))) short bf16x8;
typedef __attribute__((ext_vector_type(16))) float f32x16;
typedef __attribute__((ext_vector_type(2))) __bf16 bf2_t;
typedef __attribute__((ext_vector_type(2))) float f2_t;
typedef unsigned short bf16;
typedef __attribute__((ext_vector_type(4))) unsigned u32x4;
typedef __attribute__((ext_vector_type(2))) unsigned u32x2;

#define DI __device__ __forceinline__
#ifndef PROBE
#define PROBE 0
#endif
#define MFMA(a, b, c) __builtin_amdgcn_mfma_f32_32x32x16_bf16((a), (b), (c), 0, 0, 0)

constexpr int D = 1024, NB = 16, T = 2048, CL = 256;
constexpr int NTOK = NB * T;
constexpr int NCTX = NB * CL;
constexpr int MTOT = NTOK + NCTX;
constexpr int INC = 2304;
constexpr int SEQ2 = T + CL;
constexpr int NEXP = 16384;
constexpr float EPS = 1e-6f;
constexpr float L2E = 1.4426950408889634f;

struct Params {
  const float *x, *c, *ctx, *c_ctx, *norm1_g, *norm2_g, *w_ada, *b_ada, *w_in, *conv_w, *conv_b, *conv_ln_g,
      *conv_ln_b, *na_rel_bias, *gqa_q_norm, *gqa_k_norm, *w_out, *peer_w_q, *peer_keys, *peer_u, *peer_v, *final_norm_g;
  float* out;
  bf16 *win, *wout, *wq, *pk, *pu, *pv;
  float *modp, *mod, *ropetab;
  bf16 *H, *U, *QN, *KN, *VNt, *QG, *KG, *VGt, *CAT;
  float *XC;
  int* ridx;
  float* rg;
};

DI int tid_now() { int t; asm volatile("v_mov_b32 %0, %1" : "=v"(t) : "v"((int)__builtin_amdgcn_workitem_id_x())); return t; }
DI unsigned pack2(float a, float b) {
  f2_t v = {a, b};
  bf2_t r = __builtin_convertvector(v, bf2_t);
  return __builtin_bit_cast(unsigned, r);
}
DI float bf_lo(unsigned u) { return __uint_as_float(u << 16); }
DI float bf_hi(unsigned u) { return __uint_as_float(u & 0xffff0000u); }
DI int crow(int e, int h) { return (e & 3) + 8 * (e >> 2) + 4 * h; }
DI float silu_f(float x) { return x / (1.f + __expf(-x)); }
DI float sigmoid_f(float x) { return 1.f / (1.f + __expf(-x)); }
DI float gelu_tanh(float x) {
  float u = 0.7978845608028654f * (x + 0.044715f * x * x * x);
  float t = 1.f - 2.f / (1.f + __expf(2.f * u));
  return 0.5f * x * (1.f + t);
}
DI float wave_sum(float v) {
#pragma unroll
  for (int o = 32; o >= 1; o >>= 1) v += __shfl_xor(v, o);
  return v;
}
DI float* xres_row(const Params& p, int row) { return row < NTOK ? p.out + (size_t)row * D : p.XC + (size_t)(row - NTOK) * D; }
DI const float* xin_row(const Params& p, int layer, int row) {
  if (layer == 0) return row < NTOK ? p.x + (size_t)row * D : p.ctx + (size_t)(row - NTOK) * D;
  return xres_row(p, row);
}
DI int mod_row(int row) { return row < NTOK ? (row >> 11) : 16; }
DI int batch_of(int row) { return row < NTOK ? (row >> 11) : ((row - NTOK) >> 8); }
DI int pos_of(int row) { return row < NTOK ? (row & 2047) : (T + ((row - NTOK) & 255)); }

DI int perm_in(int n) {
  if (n >= 512) return n;
  int c = n >> 6, w = n & 63;
  return w < 32 ? 32 * c + w : 256 + 32 * c + (w - 32);
}
DI void convT_tile(const float* __restrict__ src, bf16* __restrict__ dst, int K, int N, int k0, int n0, bool perm, float* tile  ) {
  const int tx = tid_now() & 63, ty = tid_now() >> 6;
  const int ns = perm ? perm_in(n0 + tx) : n0 + tx;
#pragma unroll
  for (int i = 0; i < 16; ++i) { int k = ty + 4 * i; tile[k * 65 + tx] = src[(size_t)(k0 + k) * N + ns]; }
  __syncthreads();
#pragma unroll
  for (int i = 0; i < 16; ++i) {
    int n = ty + 4 * i;
    dst[(size_t)(n0 + n) * K + k0 + tx] = (bf16)(pack2(tile[tx * 65 + n], 0.f) & 0xffff);
  }
  __syncthreads();
}
constexpr int CONVT_ITEMS = 2 * 1344;
DI void stage_convT(const Params& p, int item, char* smem) {
  float* tile = (float*)smem;
  int l = item / 1344, r = item % 1344;
  if (r < 576) { int kt = r / 36, nt = r % 36; convT_tile(p.w_in + (size_t)l * D * INC, p.win + (size_t)l * INC * D, D, INC, kt * 64, nt * 64, true, tile); }
  else if (r < 832) { r -= 576; int kt = r / 16, nt = r % 16; convT_tile(p.w_out + (size_t)l * D * D, p.wout + (size_t)l * D * D, D, D, kt * 64, nt * 64, false, tile); }
  else { r -= 832; int kt = r / 32, nt = r % 32; convT_tile(p.peer_w_q + (size_t)l * D * 2048, p.wq + (size_t)l * 2048 * D, D, 2048, kt * 64, nt * 64, false, tile); }
}
constexpr size_t PK_N = (size_t)2 * 16 * 128 * 128, PU_N = (size_t)2 * NEXP * D;
constexpr int CONVS_ITEMS = (int)((PK_N + 2 * PU_N) / 2048);
DI void stage_convS(const Params& p, int item) {
  size_t e = (size_t)item * 2048 + tid_now() * 8;
  const float* src; bf16* dst;
  if (e < PK_N) { src = p.peer_keys + e; dst = p.pk + e; }
  else if (e < PK_N + PU_N) { src = p.peer_u + (e - PK_N); dst = p.pu + (e - PK_N); }
  else { src = p.peer_v + (e - PK_N - PU_N); dst = p.pv + (e - PK_N - PU_N); }
  float4 a = ((const float4*)src)[0], b = ((const float4*)src)[1];
  u32x4 o = {pack2(a.x, a.y), pack2(a.z, a.w), pack2(b.x, b.y), pack2(b.z, b.w)};
  *(u32x4*)dst = o;
}
DI void stage_rope(const Params& p) {
  for (int i = tid_now(); i < 64 * 16; i += 256) {
    int pos = i >> 4, f = i & 15;
    float inv = powf(10000.f, -(float)f / 16.f);
    float ang = (float)pos * inv;
    p.ropetab[2 * i] = cosf(ang); p.ropetab[2 * i + 1] = sinf(ang);
  }
}

constexpr int MODP_ITEMS = 2 * 8 * 24;
DI void stage_mod_partial(const Params& p, int item, char* smem) {
  float* sc = (float*)smem;
  int l = item / 192, r = item % 192, kc = r / 24, nc = r % 24;
  for (int i = tid_now(); i < 17 * 128; i += 256) {
    int rr = i >> 7, k = i & 127;
    float v = rr < 16 ? p.c[rr * D + kc * 128 + k] : p.c_ctx[kc * 128 + k];
    sc[i] = silu_f(v);
  }
  __syncthreads();
  float acc[17];
#pragma unroll
  for (int i = 0; i < 17; ++i) acc[i] = 0.f;
  const int n = nc * 256 + tid_now();
  const float* w = p.w_ada + ((size_t)l * D + kc * 128) * 6144 + n;
  for (int k = 0; k < 128; ++k) {
    float wv = w[(size_t)k * 6144];
#pragma unroll
    for (int i = 0; i < 17; ++i) acc[i] += sc[i * 128 + k] * wv;
  }
#pragma unroll
  for (int i = 0; i < 17; ++i) p.modp[(((size_t)l * 8 + kc) * 17 + i) * 6144 + n] = acc[i];
  __syncthreads();
}
constexpr int MODR_ITEMS = 2 * 17 * 6144 / 256;
DI void stage_mod_reduce(const Params& p, int item) {
  int idx = item * 256 + tid_now();
  int l = idx / (17 * 6144), rem = idx % (17 * 6144), n = rem % 6144;
  float s = p.b_ada[l * 6144 + n];
#pragma unroll
  for (int kc = 0; kc < 8; ++kc) s += p.modp[((size_t)l * 8 + kc) * 17 * 6144 + rem];
  p.mod[idx] = s;
}

DI void norm_row(const Params& p, const float* __restrict__ xr, const float* __restrict__ g, const float* __restrict__ sh,
                 const float* __restrict__ sc, bf16* __restrict__ hr) {
  const int lane = tid_now() & 63;
  float4 v[4]; float ss = 0.f;
#pragma unroll
  for (int i = 0; i < 4; ++i) { v[i] = ((const float4*)xr)[lane + 64 * i]; ss += v[i].x * v[i].x + v[i].y * v[i].y + v[i].z * v[i].z + v[i].w * v[i].w; }
  ss = wave_sum(ss);
  const float rstd = rsqrtf(ss * (1.f / D) + EPS);
#pragma unroll
  for (int i = 0; i < 4; ++i) {
    float4 gg = ((const float4*)g)[lane + 64 * i], s1 = ((const float4*)sh)[lane + 64 * i], s2 = ((const float4*)sc)[lane + 64 * i];
    float a = v[i].x * rstd * gg.x * (1.f + s2.x) + s1.x, b = v[i].y * rstd * gg.y * (1.f + s2.y) + s1.y;
    float c = v[i].z * rstd * gg.z * (1.f + s2.z) + s1.z, d = v[i].w * rstd * gg.w * (1.f + s2.w) + s1.w;
    u32x2 o = {pack2(a, b), pack2(c, d)};
    ((u32x2*)hr)[lane + 64 * i] = o;
  }
}
DI void stage_norm(const Params& p, int layer, int which, int item) {
  int row = item * 4 + (tid_now() >> 6);
  const float* xr = which == 0 ? xin_row(p, layer, row) : xres_row(p, row);
  const float* g = (which == 0 ? p.norm1_g : p.norm2_g) + layer * D;
  const float* m = p.mod + ((size_t)layer * 17 + mod_row(row)) * 6144 + (which == 0 ? 0 : 3072);
  norm_row(p, xr, g, m, m + D, p.H + (size_t)row * D);
}
DI void stage_final(const Params& p, int item) {
  int row = item * 4 + (tid_now() >> 6);
  const int lane = tid_now() & 63;
  const float* xr = p.out + (size_t)row * D;
  float4 v[4]; float ss = 0.f;
#pragma unroll
  for (int i = 0; i < 4; ++i) { v[i] = ((const float4*)xr)[lane + 64 * i]; ss += v[i].x * v[i].x + v[i].y * v[i].y + v[i].z * v[i].z + v[i].w * v[i].w; }
  ss = wave_sum(ss);
  const float rstd = rsqrtf(ss * (1.f / D) + EPS);
#pragma unroll
  for (int i = 0; i < 4; ++i) {
    float4 gg = ((const float4*)p.final_norm_g)[lane + 64 * i];
    float4 o = {v[i].x * rstd * gg.x, v[i].y * rstd * gg.y, v[i].z * rstd * gg.z, v[i].w * rstd * gg.w};
    ((float4*)(p.out + (size_t)row * D))[lane + 64 * i] = o;
  }
}

constexpr int LROW = 144;
constexpr int LTILE = 128 * LROW;
constexpr int GEMM_SMEM = 4 * LTILE;

template <bool ORIENT_T>
DI void gemm_core(const bf16* __restrict__ A, const bf16* __restrict__ W, char* smem, f32x16 (&acc)[2][2]) {
  const int tid = tid_now(), lane = tid & 63, wave = tid >> 6;
  const int wm = wave >> 1, wn = wave & 1, l31 = lane & 31, hh = lane >> 5;
  const int lrow = tid >> 3, kc = tid & 7;
#pragma unroll
  for (int i = 0; i < 2; ++i)
#pragma unroll
    for (int j = 0; j < 2; ++j)
#pragma unroll
      for (int e = 0; e < 16; ++e) acc[i][j][e] = 0.f;
  u32x4 ra[4], rw[4];
  const bf16* ap = A + (size_t)lrow * D + kc * 8;
  const bf16* wp = W + (size_t)lrow * D + kc * 8;
#pragma unroll
  for (int i = 0; i < 4; ++i) { ra[i] = *(const u32x4*)(ap + (size_t)(32 * i) * D); rw[i] = *(const u32x4*)(wp + (size_t)(32 * i) * D); }
  for (int kt = 0; kt < 16; ++kt) {
    char* sa = smem + (kt & 1) * 2 * LTILE;
    char* sw = sa + LTILE;
#pragma unroll
    for (int i = 0; i < 4; ++i) {
      *(u32x4*)(sa + (lrow + 32 * i) * LROW + kc * 16) = ra[i];
      *(u32x4*)(sw + (lrow + 32 * i) * LROW + kc * 16) = rw[i];
    }
    __syncthreads();
    if (kt + 1 < 16) {
#pragma unroll
      for (int i = 0; i < 4; ++i) {
        ra[i] = *(const u32x4*)(ap + (size_t)(32 * i) * D + (kt + 1) * 64);
        rw[i] = *(const u32x4*)(wp + (size_t)(32 * i) * D + (kt + 1) * 64);
      }
    }
#pragma unroll
    for (int s = 0; s < 4; ++s) {
      bf16x8 af[2], wf[2];
#pragma unroll
      for (int t = 0; t < 2; ++t) {
        af[t] = *(const bf16x8*)(sa + (wm * 64 + t * 32 + l31) * LROW + (s * 16 + hh * 8) * 2);
        wf[t] = *(const bf16x8*)(sw + (wn * 64 + t * 32 + l31) * LROW + (s * 16 + hh * 8) * 2);
      }
#pragma unroll
      for (int ft = 0; ft < 2; ++ft)
#pragma unroll
        for (int tt = 0; tt < 2; ++tt)
          acc[ft][tt] = ORIENT_T ? MFMA(wf[ft], af[tt], acc[ft][tt]) : MFMA(af[tt], wf[ft], acc[ft][tt]);
    }
  }
  __syncthreads();
}

constexpr int INPROJ_ITEMS = 288 * 18;
DI void store4(bf16* dst, float a, float b, float c, float d) { u32x2 o = {pack2(a, b), pack2(c, d)}; *(u32x2*)dst = o; }

DI void stage_inproj(const Params& p, int layer, int item, char* smem) {
  const int mt = item / 18, nt = item % 18;
  if (layer == 1 && mt >= 256 && nt < 10) return;
  const int row0 = mt * 128, n0 = nt * 128;
  const bf16* A = p.H + (size_t)row0 * D;
  const bf16* W = p.win + ((size_t)layer * INC + n0) * D;
  const int lane = tid_now() & 63, wave = tid_now() >> 6, wm = wave >> 1, wn = wave & 1, l31 = lane & 31, hh = lane >> 5;
  const bool vtile = (nt >= 13 && nt <= 15) || nt == 17;
  f32x16 acc[2][2];
  const int b = batch_of(row0);
  if (vtile) {
    gemm_core<false>(A, W, smem, acc);
    bf16* base; int head;
    if (nt == 17) { head = wn; base = p.VGt + ((size_t)(b * 2 + head) * 64) * SEQ2; }
    else { head = (nt - 13) * 2 + wn; base = p.VNt + ((size_t)(b * 6 + head) * 64) * SEQ2; }
    const int pos0 = pos_of(row0) + wm * 64;
#pragma unroll
    for (int ft = 0; ft < 2; ++ft) {
      const int d = ft * 32 + l31;
#pragma unroll
      for (int tt = 0; tt < 2; ++tt)
#pragma unroll
        for (int g = 0; g < 4; ++g)
          store4(base + (size_t)d * SEQ2 + pos0 + tt * 32 + 8 * g + 4 * hh, acc[ft][tt][4 * g], acc[ft][tt][4 * g + 1], acc[ft][tt][4 * g + 2], acc[ft][tt][4 * g + 3]);
    }
    return;
  }
  gemm_core<true>(A, W, smem, acc);
  const int chunk = nt * 2 + wn;
#pragma unroll
  for (int tt = 0; tt < 2; ++tt) {
    const int row = row0 + wm * 64 + tt * 32 + l31;
    const int pos = pos_of(row);
    const bool isctx = row >= NTOK;
    if (chunk < 8) {
      bf16* dst = p.U + (size_t)row * 256 + 32 * chunk;
#pragma unroll
      for (int g = 0; g < 4; ++g) {
        float u0 = acc[0][tt][4 * g] * sigmoid_f(acc[1][tt][4 * g]), u1 = acc[0][tt][4 * g + 1] * sigmoid_f(acc[1][tt][4 * g + 1]);
        float u2 = acc[0][tt][4 * g + 2] * sigmoid_f(acc[1][tt][4 * g + 2]), u3 = acc[0][tt][4 * g + 3] * sigmoid_f(acc[1][tt][4 * g + 3]);
        store4(dst + 8 * g + 4 * hh, u0, u1, u2, u3);
      }
    } else if (chunk < 14 || (chunk >= 20 && chunk < 26)) {
      const bool isq = chunk < 14;
      const int head = isq ? chunk - 8 : chunk - 20;
      const float sc = isq ? 0.125f : 1.f;
      bf16* dst = (isq ? p.QN : p.KN) + ((size_t)(b * 6 + head) * SEQ2 + pos) * 64;
#pragma unroll
      for (int ft = 0; ft < 2; ++ft)
#pragma unroll
        for (int g = 0; g < 4; ++g)
          store4(dst + ft * 32 + 8 * g + 4 * hh, acc[ft][tt][4 * g] * sc, acc[ft][tt][4 * g + 1] * sc, acc[ft][tt][4 * g + 2] * sc, acc[ft][tt][4 * g + 3] * sc);
    } else {
      const bool isq = chunk < 20;
      const int head = isq ? chunk - 14 : chunk - 32;
      const float* gn = (isq ? p.gqa_q_norm : p.gqa_k_norm) + layer * 64;
      float ss = 0.f;
#pragma unroll
      for (int ft = 0; ft < 2; ++ft)
#pragma unroll
        for (int e = 0; e < 16; ++e) ss += acc[ft][tt][e] * acc[ft][tt][e];
      ss += __shfl_xor(ss, 32);
      const float rstd = rsqrtf(ss * (1.f / 64.f) + EPS) ;
      const float sc = isq ? 0.125f : 1.f;
      bf16* dst = (isq ? p.QG + ((size_t)(b * 6 + head) * SEQ2 + pos) * 64 : p.KG + ((size_t)(b * 2 + head) * SEQ2 + pos) * 64);
      const int prow = pos >> 6, pcol = pos & 63;
#pragma unroll
      for (int g = 0; g < 4; ++g) {
        float o1[4], o2[4];
#pragma unroll
        for (int j = 0; j < 4; ++j) {
          const int i = 8 * g + 4 * hh + j;
          float x1 = acc[0][tt][4 * g + j] * rstd * gn[i];
          float x2 = acc[1][tt][4 * g + j] * rstd * gn[32 + i];
          if (!isctx && PROBE != 13) {
            const int ppos = (g < 2) ? prow : pcol;
            const float2 cs = *(const float2*)(p.ropetab + 2 * (ppos * 16 + (i & 15)));
            float y1 = x1 * cs.x - x2 * cs.y, y2 = x1 * cs.y + x2 * cs.x;
            x1 = y1; x2 = y2;
          }
          o1[j] = x1 * sc; o2[j] = x2 * sc;
        }
        store4(dst + 8 * g + 4 * hh, o1[0], o1[1], o1[2], o1[3]);
        store4(dst + 32 + 8 * g + 4 * hh, o2[0], o2[1], o2[2], o2[3]);
      }
    }
  }
}

constexpr int CONV_TT = 32;
constexpr int CONV_SMEM = (CONV_TT + 30) * 512 + CONV_TT * 1024;
DI void stage_conv(const Params& p, int layer, int item, char* smem) {
  bf16* ub = (bf16*)smem;
  float* yb = (float*)(smem + (CONV_TT + 30) * 512);
  const int tid = tid_now();
  int row0, seq_lo, seq_hi;
  if (item < 1024) { row0 = item * CONV_TT; seq_lo = row0 & ~2047; seq_hi = seq_lo + 2048; }
  else { row0 = NTOK + (item - 1024) * CONV_TT; seq_lo = NTOK + (((item - 1024) * CONV_TT) & ~255); seq_hi = seq_lo + 256; }
  for (int c = tid; c < 62 * 32; c += 256) {
    int r = c >> 5, cc = c & 31;
    int row = row0 - 15 + r;
    u32x4 v = {0u, 0u, 0u, 0u};
    if (row >= seq_lo && row < seq_hi) v = *(const u32x4*)(p.U + (size_t)row * 256 + cc * 8);
    *(u32x4*)(ub + r * 256 + cc * 8) = v;
  }
  __syncthreads();
  {
    const int ch = tid;
    float w[31];
#pragma unroll
    for (int j = 0; j < 31; ++j) w[j] = p.conv_w[((size_t)layer * 31 + j) * 256 + ch];
    const float bias = p.conv_b[layer * 256 + ch];
#pragma unroll 1
    for (int t0 = 0; t0 < CONV_TT; t0 += 8) {
      float in[38];
#pragma unroll
      for (int j = 0; j < 38; ++j) in[j] = __uint_as_float((unsigned)ub[(t0 + j) * 256 + ch] << 16);
#pragma unroll
      for (int t = 0; t < 8; ++t) {
        float a = bias;
#pragma unroll
        for (int j = 0; j < 31; ++j) a += in[t + j] * w[j];
        yb[(t0 + t) * 256 + ch] = a;
      }
    }
  }
  __syncthreads();
  {
    const int wave = tid >> 6, lane = tid & 63;
    const float4 g = ((const float4*)(p.conv_ln_g + layer * 256))[lane], bb = ((const float4*)(p.conv_ln_b + layer * 256))[lane];
    for (int t = wave * 8; t < wave * 8 + 8; ++t) {
      float4 v = ((const float4*)(yb + t * 256))[lane];
      float mu = wave_sum(v.x + v.y + v.z + v.w) * (1.f / 256.f);
      float dx = v.x - mu, dy = v.y - mu, dz = v.z - mu, dw = v.w - mu;
      float var = wave_sum(dx * dx + dy * dy + dz * dz + dw * dw) * (1.f / 256.f);
      float rs = rsqrtf(var + EPS);
      float a = silu_f(dx * rs * g.x + bb.x), b = silu_f(dy * rs * g.y + bb.y), c = silu_f(dz * rs * g.z + bb.z), d = silu_f(dw * rs * g.w + bb.w);
      store4(p.CAT + (size_t)(row0 + t) * D + lane * 4, a, b, c, d);
    }
  }
  __syncthreads();
}

DI int kperm(int i) { return (i & 19) | ((i & 4) << 1) | ((i & 8) >> 1); }
DI int keyoff(int e, int h) { return (e & 3) + 4 * ((e >> 2) & 1) + 8 * h + 16 * (e >> 3); }
DI bf16x8 pack8(const f32x16& x, int s) {
  u32x4 r = {pack2(x[8 * s], x[8 * s + 1]), pack2(x[8 * s + 2], x[8 * s + 3]), pack2(x[8 * s + 4], x[8 * s + 5]), pack2(x[8 * s + 6], x[8 * s + 7])};
  return __builtin_bit_cast(bf16x8, r);
}

constexpr int NA_ITEMS = 6144 / 4;
DI void stage_na(const Params& p, int layer, int item) {
  const int lane = tid_now() & 63, wave = tid_now() >> 6, l31 = lane & 31, hh = lane >> 5;
  const int wi = item * 4 + wave;
  const int qhalf = wi & 1, head = (wi >> 1) % 6, br = wi / 12, r = br & 31, b = br >> 5;
  const int r0 = min(max(r - 4, 0), 24);
  const size_t hb = (size_t)(b * 6 + head);
  const bf16* Q = p.QN + (hb * SEQ2 + r * 64 + qhalf * 32 + l31) * 64;
  const bf16* Kb = p.KN + hb * SEQ2 * 64;
  const bf16* Vb = p.VNt + hb * 64 * SEQ2;
  const float* bias = p.na_rel_bias + ((size_t)layer * 6 + head) * 15 * 31;
  bf16x8 qf[4];
#pragma unroll
  for (int s = 0; s < 4; ++s) qf[s] = *(const bf16x8*)(Q + 16 * s + 8 * hh);
  f32x16 o[2];
#pragma unroll
  for (int e = 0; e < 16; ++e) { o[0][e] = 0.f; o[1][e] = 0.f; }
  float m = -1e30f, l = 0.f;
  const int qc = qhalf * 32 + l31;
  const int c0 = min(max(qc - 8, 0), 48);
  const int kp = kperm(l31);
#pragma unroll 1
  for (int t = 0; t < 24; ++t) {
    int key0, brow = 0, cs = 0;
    const bool local = t >= 8;
    if (!local) key0 = T + t * 32;
    else { brow = (t - 8) >> 1; cs = (t - 8) & 1; key0 = (r0 + brow) * 64 + cs * 32; }
    f32x16 st;
#pragma unroll
    for (int e = 0; e < 16; ++e) st[e] = 0.f;
    const bf16* kr = Kb + (size_t)(key0 + kp) * 64 + 8 * hh;
#pragma unroll
    for (int s = 0; s < 4; ++s) { bf16x8 kf = *(const bf16x8*)(kr + 16 * s); st = MFMA(kf, qf[s], st); }
    if (local) {
      const int rb = (r0 + brow) - r + 7;
#pragma unroll
      for (int e = 0; e < 16; ++e) {
        const int kc = cs * 32 + keyoff(e, hh);
        const bool valid = (kc >= c0) && (kc < c0 + 16);
        const int ci = min(max(kc - qc + 15, 0), 30);
        const float bv = (PROBE == 12) ? 0.f : bias[rb * 31 + ci];
        st[e] = valid ? st[e] + bv : -1e30f;
      }
    }
    float mx = st[0];
#pragma unroll
    for (int e = 1; e < 16; ++e) mx = fmaxf(mx, st[e]);
    mx = fmaxf(mx, __shfl_xor(mx, 32));
    const float mn = fmaxf(m, mx);
    const float alpha = exp2f((m - mn) * L2E);
    float ls = 0.f;
#pragma unroll
    for (int e = 0; e < 16; ++e) { st[e] = exp2f((st[e] - mn) * L2E); ls += st[e]; }
    l = l * alpha + ls; m = mn;
#pragma unroll
    for (int e = 0; e < 16; ++e) { o[0][e] *= alpha; o[1][e] *= alpha; }
    bf16x8 pf0 = pack8(st, 0), pf1 = pack8(st, 1);
#pragma unroll
    for (int dt = 0; dt < 2; ++dt) {
      const bf16* vr = Vb + (size_t)(dt * 32 + l31) * SEQ2 + key0 + 8 * hh;
      bf16x8 v0 = *(const bf16x8*)(vr), v1 = *(const bf16x8*)(vr + 16);
      o[dt] = MFMA(v0, pf0, o[dt]);
      o[dt] = MFMA(v1, pf1, o[dt]);
    }
  }
  l += __shfl_xor(l, 32);
  const float inv = (PROBE == 10) ? 0.f : 1.f / l;
  bf16* dst = p.CAT + (size_t)(b * T + r * 64 + qc) * D + 256 + head * 64;
#pragma unroll
  for (int dt = 0; dt < 2; ++dt)
#pragma unroll
    for (int g = 0; g < 4; ++g)
      store4(dst + dt * 32 + 8 * g + 4 * hh, o[dt][4 * g] * inv, o[dt][4 * g + 1] * inv, o[dt][4 * g + 2] * inv, o[dt][4 * g + 3] * inv);
}

constexpr int FA_SMEM = 2 * 2 * 64 * LROW;
DI void flash_block(const bf16* __restrict__ Q, const bf16* __restrict__ K, const bf16* __restrict__ Vt, int q0, int kt0, int kt1,
                    bf16* __restrict__ dst  , char* smem) {
  const int tid = tid_now(), lane = tid & 63, wave = tid >> 6, l31 = lane & 31, hh = lane >> 5;
  const int lrow = tid >> 3, kc = tid & 7;
  bf16x8 qf[4];
  const bf16* qp = Q + (size_t)(q0 + wave * 32 + l31) * 64 + 8 * hh;
#pragma unroll
  for (int s = 0; s < 4; ++s) qf[s] = *(const bf16x8*)(qp + 16 * s);
  f32x16 o[2];
#pragma unroll
  for (int e = 0; e < 16; ++e) { o[0][e] = 0.f; o[1][e] = 0.f; }
  float m = -1e30f, l = 0.f;
  const int kp = kperm(l31);
  u32x4 rk[2], rv[2];
#pragma unroll
  for (int i = 0; i < 2; ++i) {
    rk[i] = *(const u32x4*)(K + (size_t)(kt0 * 64 + lrow + 32 * i) * 64 + kc * 8);
    rv[i] = *(const u32x4*)(Vt + (size_t)(lrow + 32 * i) * SEQ2 + kt0 * 64 + kc * 8);
  }
  for (int kt = kt0; kt < kt1; ++kt) {
    char* sk = smem + ((kt - kt0) & 1) * 2 * 64 * LROW;
    char* sv = sk + 64 * LROW;
#pragma unroll
    for (int i = 0; i < 2; ++i) {
      *(u32x4*)(sk + (lrow + 32 * i) * LROW + kc * 16) = rk[i];
      *(u32x4*)(sv + (lrow + 32 * i) * LROW + kc * 16) = rv[i];
    }
    __syncthreads();
    if (kt + 1 < kt1) {
#pragma unroll
      for (int i = 0; i < 2; ++i) {
        rk[i] = *(const u32x4*)(K + (size_t)((kt + 1) * 64 + lrow + 32 * i) * 64 + kc * 8);
        rv[i] = *(const u32x4*)(Vt + (size_t)(lrow + 32 * i) * SEQ2 + (kt + 1) * 64 + kc * 8);
      }
    }
    f32x16 st[2];
#pragma unroll
    for (int k2 = 0; k2 < 2; ++k2) {
#pragma unroll
      for (int e = 0; e < 16; ++e) st[k2][e] = 0.f;
#pragma unroll
      for (int s = 0; s < 4; ++s) {
        bf16x8 kf = *(const bf16x8*)(sk + (k2 * 32 + kp) * LROW + (16 * s + 8 * hh) * 2);
        st[k2] = MFMA(kf, qf[s], st[k2]);
      }
    }
    float mx = st[0][0];
#pragma unroll
    for (int e = 1; e < 16; ++e) mx = fmaxf(mx, st[0][e]);
#pragma unroll
    for (int e = 0; e < 16; ++e) mx = fmaxf(mx, st[1][e]);
    mx = fmaxf(mx, __shfl_xor(mx, 32));
    const float mn = fmaxf(m, mx);
    const float alpha = exp2f((m - mn) * L2E);
    float ls = 0.f;
#pragma unroll
    for (int k2 = 0; k2 < 2; ++k2)
#pragma unroll
      for (int e = 0; e < 16; ++e) { st[k2][e] = exp2f((st[k2][e] - mn) * L2E); ls += st[k2][e]; }
    l = l * alpha + ls; m = mn;
#pragma unroll
    for (int e = 0; e < 16; ++e) { o[0][e] *= alpha; o[1][e] *= alpha; }
#pragma unroll
    for (int k2 = 0; k2 < 2; ++k2)
#pragma unroll
      for (int s2 = 0; s2 < 2; ++s2) {
        bf16x8 pf = pack8(st[k2], s2);
#pragma unroll
        for (int dt = 0; dt < 2; ++dt) {
          bf16x8 vf = *(const bf16x8*)(sv + (dt * 32 + l31) * LROW + (k2 * 32 + 16 * s2 + 8 * hh) * 2);
          o[dt] = MFMA(vf, pf, o[dt]);
        }
      }
  }
  l += __shfl_xor(l, 32);
  const float inv = (PROBE == 11) ? 0.f : 1.f / l;
  bf16* d2 = dst + (size_t)(wave * 32 + l31) * D;
#pragma unroll
  for (int dt = 0; dt < 2; ++dt)
#pragma unroll
    for (int g = 0; g < 4; ++g)
      store4(d2 + dt * 32 + 8 * g + 4 * hh, o[dt][4 * g] * inv, o[dt][4 * g + 1] * inv, o[dt][4 * g + 2] * inv, o[dt][4 * g + 3] * inv);
  __syncthreads();
}
constexpr int GQA_ITEMS = 16 * 6 * 16;
DI void stage_gqa(const Params& p, int item, char* smem) {
  const int qt = item & 15, hq = (item >> 4) % 6, b = item / 96;
  const int kvh = hq / 3;
  flash_block(p.QG + (size_t)(b * 6 + hq) * SEQ2 * 64, p.KG + (size_t)(b * 2 + kvh) * SEQ2 * 64, p.VGt + (size_t)(b * 2 + kvh) * 64 * SEQ2,
              qt * 128, 0, 36, p.CAT + (size_t)(b * T + qt * 128) * D + 640 + hq * 64, smem);
}
constexpr int CTXATT_ITEMS = 384;
DI void stage_ctxatt(const Params& p, int item, char* smem) {
  const int qt = item & 1, head = (item >> 1) % 6, which = (item / 12) & 1, b = item / 24;
  bf16* dst = p.CAT + (size_t)(NTOK + b * CL + qt * 128) * D;
  if (which == 0)
    flash_block(p.QN + (size_t)(b * 6 + head) * SEQ2 * 64, p.KN + (size_t)(b * 6 + head) * SEQ2 * 64, p.VNt + (size_t)(b * 6 + head) * 64 * SEQ2,
                T + qt * 128, 32, 36, dst + 256 + head * 64, smem);
  else
    flash_block(p.QG + (size_t)(b * 6 + head) * SEQ2 * 64, p.KG + (size_t)(b * 2 + head / 3) * SEQ2 * 64, p.VGt + (size_t)(b * 2 + head / 3) * 64 * SEQ2,
                T + qt * 128, 32, 36, dst + 640 + head * 64, smem);
}

constexpr int OUTPROJ_ITEMS = 288 * 8;
DI void stage_outproj(const Params& p, int layer, int item, char* smem) {
  const int mt = item >> 3, nt = item & 7;
  if (layer == 1 && mt >= 256) return;
  const int row0 = mt * 128, n0 = nt * 128;
  f32x16 acc[2][2];
  gemm_core<true>(p.CAT + (size_t)row0 * D, p.wout + ((size_t)layer * D + n0) * D, smem, acc);
  const int lane = tid_now() & 63, wave = tid_now() >> 6, wm = wave >> 1, wn = wave & 1, l31 = lane & 31, hh = lane >> 5;
  const float* g1 = p.mod + ((size_t)layer * 17 + mod_row(row0)) * 6144 + 2048;
#pragma unroll
  for (int tt = 0; tt < 2; ++tt) {
    const int row = row0 + wm * 64 + tt * 32 + l31;
    const float* xr = xin_row(p, layer, row);
    float* dr = xres_row(p, row);
#pragma unroll
    for (int ft = 0; ft < 2; ++ft)
#pragma unroll
      for (int g = 0; g < 4; ++g) {
        const int n = n0 + wn * 64 + ft * 32 + 8 * g + 4 * hh;
        float4 xv = *(const float4*)(xr + n), gv = *(const float4*)(g1 + n);
        if (PROBE == 2) { gv.x = gv.y = gv.z = gv.w = 0.f; }
        float4 o = {xv.x + gv.x * acc[ft][tt][4 * g], xv.y + gv.y * acc[ft][tt][4 * g + 1], xv.z + gv.z * acc[ft][tt][4 * g + 2], xv.w + gv.w * acc[ft][tt][4 * g + 3]};
        *(float4*)(dr + n) = o;
      }
  }
}

constexpr int ROUTE_ITEMS = 288 * 8;
constexpr int QROW = 272;
DI int to_sortable(int b) { return b ^ ((b >> 31) & 0x7fffffff); }

#define CAND_LIST(X) \
  X(0,0,0) X(1,0,1) X(2,0,2) X(3,0,3) X(4,0,4) X(5,0,5) X(6,0,6) X(7,0,7) X(8,0,8) X(9,0,9) X(10,0,10) X(11,0,11) X(12,0,12) X(13,0,13) X(14,0,14) X(15,0,15) \
  X(16,1,1) X(17,1,2) X(18,1,3) X(19,1,4) X(20,1,5) X(21,1,6) X(22,1,7) \
  X(23,2,2) X(24,2,3) X(25,2,4) \
  X(26,3,3)

DI void stage_route(const Params& p, int layer, int item, char* smem) {
  const int mt = item >> 3, head = item & 7;
  if (layer == 1 && mt >= 256) return;
  const int row0 = mt * 128;
  const int tid = tid_now(), lane = tid & 63, wave = tid >> 6, wm = wave >> 1, wn = wave & 1, l31 = lane & 31, hh = lane >> 5;
  int topk[2][16];
  char* Qs = smem;
  char* Ks = smem + 2 * LTILE;
#pragma unroll
  for (int pp = 0; pp < 2; ++pp) {
    {
      f32x16 acc[2][2];
      gemm_core<true>(p.H + (size_t)row0 * D, p.wq + ((size_t)layer * 2048 + (head * 2 + pp) * 128) * D, smem, acc);
#pragma unroll
      for (int tt = 0; tt < 2; ++tt)
#pragma unroll
        for (int ft = 0; ft < 2; ++ft)
#pragma unroll
          for (int g = 0; g < 4; ++g) {
            const int tok = wm * 64 + tt * 32 + l31, kf = wn * 64 + ft * 32 + 8 * g + 4 * hh;
            u32x2 o = {pack2(acc[ft][tt][4 * g], acc[ft][tt][4 * g + 1]), pack2(acc[ft][tt][4 * g + 2], acc[ft][tt][4 * g + 3])};
            *(u32x2*)(Qs + tok * QROW + kf * 2) = o;
          }
    }
    const bf16* kp = p.pk + ((size_t)((layer * 8 + head) * 2 + pp) * 128) * 128;
#pragma unroll
    for (int i = 0; i < 8; ++i) {
      const int c = tid + 256 * i, n = c >> 4, kc = c & 15;
      *(u32x4*)(Ks + n * QROW + kc * 16) = *(const u32x4*)(kp + n * 128 + kc * 8);
    }
    __syncthreads();
    int key[64];
    {
      f32x16 sc[4];
#pragma unroll
      for (int nt = 0; nt < 4; ++nt)
#pragma unroll
        for (int e = 0; e < 16; ++e) sc[nt][e] = 0.f;
#pragma unroll
      for (int s = 0; s < 8; ++s) {
        bf16x8 qb = *(const bf16x8*)(Qs + (wave * 32 + l31) * QROW + (16 * s + 8 * hh) * 2);
#pragma unroll
        for (int nt = 0; nt < 4; ++nt) {
          bf16x8 ka = *(const bf16x8*)(Ks + (nt * 32 + l31) * QROW + (16 * s + 8 * hh) * 2);
          sc[nt] = MFMA(ka, qb, sc[nt]);
        }
      }
#pragma unroll
      for (int nt = 0; nt < 4; ++nt)
#pragma unroll
        for (int e = 0; e < 16; ++e) {
          const int n = nt * 32 + crow(e, hh);
          int b = (__float_as_int(sc[nt][e]) & ~127) | n;
          key[nt * 16 + e] = to_sortable(b);
        }
    }
#pragma unroll
    for (int r = 0; r < 16; ++r) {
      int mx = key[0];
#pragma unroll
      for (int i = 1; i < 64; ++i) mx = max(mx, key[i]);
      mx = max(mx, __shfl_xor(mx, 32));
      topk[pp][r] = mx;
#pragma unroll
      for (int i = 0; i < 64; ++i) key[i] = (key[i] == mx) ? (int)0x80000000 : key[i];
    }
    __syncthreads();
  }
  float av[16], bv[16]; int ai[16], bi[16];
#pragma unroll
  for (int i = 0; i < 16; ++i) {
    int k1 = to_sortable(topk[0][i]), k2 = to_sortable(topk[1][i]);
    int a = hh ? k2 : k1, b = hh ? k1 : k2;
    av[i] = __int_as_float(a & ~127); ai[i] = a & 127;
    bv[i] = __int_as_float(b & ~127); bi[i] = b & 127;
  }
  int cand[27], eid[27];
#define MKC(c, i, j) { int b = __float_as_int(av[i] + bv[j]); cand[c] = (to_sortable(b) & ~63) | (c * 2 + hh); \
                       eid[c] = hh ? (bi[j] * 128 + ai[i]) : (ai[i] * 128 + bi[j]); \
                       if (i == j && hh) cand[c] = (int)0x80000000; }
  CAND_LIST(MKC)
#undef MKC
  int win[16], weid[16];
#pragma unroll
  for (int r = 0; r < 16; ++r) {
    int mx = cand[0];
#pragma unroll
    for (int c = 1; c < 27; ++c) mx = max(mx, cand[c]);
    mx = max(mx, __shfl_xor(mx, 32));
    int e = 0;
#pragma unroll
    for (int c = 0; c < 27; ++c) { const bool hit = cand[c] == mx; e = hit ? eid[c] : e; cand[c] = hit ? (int)0x80000000 : cand[c]; }
    e |= __shfl_xor(e, 32);
    win[r] = mx; weid[r] = e;
  }
  float gsum = 0.f, gv[16];
  const float v0 = __int_as_float(to_sortable(win[0]) & ~63);
#pragma unroll
  for (int r = 0; r < 16; ++r) { gv[r] = __expf(__int_as_float(to_sortable(win[r]) & ~63) - v0); gsum += gv[r]; }
  const float ginv = 1.f / gsum;
  const int row = row0 + wave * 32 + l31;
  if (hh == 0) {
    int4* d = (int4*)(p.ridx + ((size_t)row * 8 + head) * 16);
#pragma unroll
    for (int q = 0; q < 4; ++q) { int4 o = {weid[4 * q], weid[4 * q + 1], weid[4 * q + 2], weid[4 * q + 3]}; d[q] = o; }
  } else {
    float4* d = (float4*)(p.rg + ((size_t)row * 8 + head) * 16);
#pragma unroll
    for (int q = 0; q < 4; ++q) { float4 o = {gv[4 * q] * ginv, gv[4 * q + 1] * ginv, gv[4 * q + 2] * ginv, gv[4 * q + 3] * ginv}; d[q] = o; }
  }
}

DI float dot2(unsigned a, unsigned b, float acc) {
  bf2_t x = __builtin_bit_cast(bf2_t, a), y = __builtin_bit_cast(bf2_t, b);
  return __builtin_amdgcn_fdot2_f32_bf16(x, y, acc, false);
}
DI float dot8(u32x4 a, u32x4 b, float acc) {
  const unsigned a0 = a[0], a1 = a[1], a2 = a[2], a3 = a[3], b0 = b[0], b1 = b[1], b2 = b[2], b3 = b[3];
  acc = dot2(a0, b0, acc); acc = dot2(a1, b1, acc); acc = dot2(a2, b2, acc); acc = dot2(a3, b3, acc);
  return acc;
}
DI void axpy8(float (&o)[8], float w, u32x4 v) {
  o[0] += w * bf_lo(v.x); o[1] += w * bf_hi(v.x); o[2] += w * bf_lo(v.y); o[3] += w * bf_hi(v.y);
  o[4] += w * bf_lo(v.z); o[5] += w * bf_hi(v.z); o[6] += w * bf_lo(v.w); o[7] += w * bf_hi(v.w);
}
constexpr int GATHER_ITEMS = MTOT / 4;
DI void stage_gather(const Params& p, int layer, int item) {
  const int lane = tid_now() & 63, wave = tid_now() >> 6;
  const int row = item * 4 + wave;
  if (layer == 1 && row >= NTOK) return;
  const bf16* hr = p.H + (size_t)row * D;
  const u32x4 h0 = *(const u32x4*)(hr + lane * 8), h1 = *(const u32x4*)(hr + 512 + lane * 8);
  float o0[8], o1[8];
#pragma unroll
  for (int i = 0; i < 8; ++i) { o0[i] = 0.f; o1[i] = 0.f; }
  const bf16* Ub = p.pu + (size_t)layer * NEXP * D;
  const bf16* Vb = p.pv + (size_t)layer * NEXP * D;
#pragma unroll 1
  for (int head = 0; head < 8; ++head) {
    const int myidx = p.ridx[((size_t)row * 8 + head) * 16 + (lane & 15)];
    const float myg = p.rg[((size_t)row * 8 + head) * 16 + ((lane >> 2) & 15)];
    float part[16];
#pragma unroll
    for (int k = 0; k < 16; ++k) {
      const int e = __builtin_amdgcn_readlane(myidx, k);
      const bf16* ur = Ub + (size_t)e * D;
      const u32x4 a = *(const u32x4*)(ur + lane * 8), b = *(const u32x4*)(ur + 512 + lane * 8);
      part[k] = dot8(b, h1, dot8(a, h0, 0.f));
    }
    float r8[8], r4[4], r2[2], r1;
    {
      const bool up = lane & 32;
#pragma unroll
      for (int k = 0; k < 8; ++k) { float keep = up ? part[k + 8] : part[k], give = up ? part[k] : part[k + 8]; r8[k] = keep + __shfl_xor(give, 32); }
    }
    {
      const bool up = lane & 16;
#pragma unroll
      for (int k = 0; k < 4; ++k) { float keep = up ? r8[k + 4] : r8[k], give = up ? r8[k] : r8[k + 4]; r4[k] = keep + __shfl_xor(give, 16); }
    }
    {
      const bool up = lane & 8;
#pragma unroll
      for (int k = 0; k < 2; ++k) { float keep = up ? r4[k + 2] : r4[k], give = up ? r4[k] : r4[k + 2]; r2[k] = keep + __shfl_xor(give, 8); }
    }
    {
      const bool up = lane & 4;
      float keep = up ? r2[1] : r2[0], give = up ? r2[0] : r2[1];
      r1 = keep + __shfl_xor(give, 4);
    }
    r1 += __shfl_xor(r1, 2);
    r1 += __shfl_xor(r1, 1);
    const float w = gelu_tanh(r1) * myg;
#pragma unroll
    for (int k = 0; k < 16; ++k) {
      const int e = __builtin_amdgcn_readlane(myidx, k);
      const float wk = __int_as_float(__builtin_amdgcn_readlane(__float_as_int(w), k << 2));
      const bf16* vr = Vb + (size_t)e * D;
      const u32x4 a = *(const u32x4*)(vr + lane * 8), b = *(const u32x4*)(vr + 512 + lane * 8);
      axpy8(o0, wk, a); axpy8(o1, wk, b);
    }
  }
  const float* g2 = p.mod + ((size_t)layer * 17 + mod_row(row)) * 6144 + 5120;
  if (PROBE == 1) { for (int i = 0; i < 8; ++i) { o0[i] = 0.f; o1[i] = 0.f; } }
  if (PROBE == 5) { for (int i = 0; i < 8; ++i) { o0[i] *= 2.f; o1[i] *= 2.f; } }
  if (PROBE == 3 && layer == 1) { for (int i = 0; i < 8; ++i) { o0[i] = 0.f; o1[i] = 0.f; } }
  if (PROBE == 4 && layer == 0) { for (int i = 0; i < 8; ++i) { o0[i] = 0.f; o1[i] = 0.f; } }
  float* dr = xres_row(p, row);
  const float* xr = dr;
#pragma unroll
  for (int q = 0; q < 2; ++q) {
    float4 xv = *(const float4*)(xr + lane * 8 + 4 * q), gv = *(const float4*)(g2 + lane * 8 + 4 * q);
    float4 o = {xv.x + gv.x * o0[4 * q], xv.y + gv.y * o0[4 * q + 1], xv.z + gv.z * o0[4 * q + 2], xv.w + gv.w * o0[4 * q + 3]};
    *(float4*)(dr + lane * 8 + 4 * q) = o;
    float4 xv2 = *(const float4*)(xr + 512 + lane * 8 + 4 * q), gv2 = *(const float4*)(g2 + 512 + lane * 8 + 4 * q);
    float4 o2 = {xv2.x + gv2.x * o1[4 * q], xv2.y + gv2.y * o1[4 * q + 1], xv2.z + gv2.z * o1[4 * q + 2], xv2.w + gv2.w * o1[4 * q + 3]};
    *(float4*)(dr + 512 + lane * 8 + 4 * q) = o2;
  }
}


#include <hip/hip_cooperative_groups.h>
namespace cg = cooperative_groups;
constexpr int SMEM_BYTES = GEMM_SMEM;

#define GRID_BARRIER() grid.sync()

__global__ void __launch_bounds__(256, 2) mega_kernel(Params p) {
  __shared__ __attribute__((aligned(16))) char smem[SMEM_BYTES];
  cg::grid_group grid = cg::this_grid();
  const int G = gridDim.x, bid = blockIdx.x;
  for (int it = bid; it < MODP_ITEMS + CONVT_ITEMS + CONVS_ITEMS + 1; it += G) {
    if (it < MODP_ITEMS) stage_mod_partial(p, it, smem);
    else if (it < MODP_ITEMS + CONVT_ITEMS) stage_convT(p, it - MODP_ITEMS, smem);
    else if (it < MODP_ITEMS + CONVT_ITEMS + CONVS_ITEMS) stage_convS(p, it - MODP_ITEMS - CONVT_ITEMS);
    else stage_rope(p);
  }
  GRID_BARRIER();
  for (int it = bid; it < MODR_ITEMS; it += G) stage_mod_reduce(p, it);
  GRID_BARRIER();
#pragma unroll 1
  for (int l = 0; l < 2; ++l) {
    for (int it = bid; it < MTOT / 4; it += G) stage_norm(p, l, 0, it);
    GRID_BARRIER();
    {
      const int n = l == 0 ? INPROJ_ITEMS : 256 * 18 + 32 * 8;
      for (int it = bid; it < n; it += G) {
        int item = it;
        if (it >= 256 * 18) { const int r = it - 256 * 18; item = l == 0 ? it : (256 + (r >> 3)) * 18 + 10 + (r & 7); }
        stage_inproj(p, l, item, smem);
      }
    }
    GRID_BARRIER();
    {
      const int nconv = l == 0 ? 1152 : 1024, nctx = l == 0 ? CTXATT_ITEMS : 0;
      const int n = GQA_ITEMS + NA_ITEMS + nconv + nctx;
      for (int it = bid; it < n; it += G) {
        if (it < GQA_ITEMS) stage_gqa(p, it, smem);
        else if (it < GQA_ITEMS + NA_ITEMS) stage_na(p, l, it - GQA_ITEMS);
        else if (it < GQA_ITEMS + NA_ITEMS + nconv) stage_conv(p, l, it - GQA_ITEMS - NA_ITEMS, smem);
        else stage_ctxatt(p, it - GQA_ITEMS - NA_ITEMS - nconv, smem);
      }
    }
    GRID_BARRIER();
    {
      const int n = (l == 0 ? 288 : 256) * 8;
      for (int it = bid; it < n; it += G) stage_outproj(p, l, it, smem);
    }
    GRID_BARRIER();
    {
      const int n = (l == 0 ? MTOT : NTOK) / 4;
      for (int it = bid; it < n; it += G) stage_norm(p, l, 1, it);
    }
    GRID_BARRIER();
    {
      const int n = (l == 0 ? 288 : 256) * 8;
      for (int it = bid; it < n; it += G) stage_route(p, l, it, smem);
    }
    GRID_BARRIER();
    {
      const int n = (l == 0 ? MTOT : NTOK) / 4;
      for (int it = bid; it < n; it += G) stage_gather(p, l, it);
    }
    GRID_BARRIER();
  }
  for (int it = bid; it < NTOK / 4; it += G) stage_final(p, it);
}

extern "C" void kernel_launch(void* const* d_in, const int* in_sizes, int n_in, void* d_out, int out_size, void* d_ws, size_t ws_size,
                              hipStream_t stream) {
  Params p{};
  const float** f = (const float**)&p;
  for (int i = 0; i < 22; ++i) f[i] = (const float*)d_in[i];
  p.out = (float*)d_out;
  char* w = (char*)d_ws; size_t off = 0;
  auto take = [&](size_t bytes) { char* r = w + off; off += (bytes + 255) & ~(size_t)255; return r; };
  p.win = (bf16*)take((size_t)2 * INC * D * 2);
  p.wout = (bf16*)take((size_t)2 * D * D * 2);
  p.wq = (bf16*)take((size_t)2 * 2048 * D * 2);
  p.pk = (bf16*)take(PK_N * 2);
  p.pu = (bf16*)take(PU_N * 2);
  p.pv = (bf16*)take(PU_N * 2);
  p.modp = (float*)take((size_t)2 * 8 * 17 * 6144 * 4);
  p.mod = (float*)take((size_t)2 * 17 * 6144 * 4);
  p.ropetab = (float*)take(64 * 16 * 2 * 4);
  p.H = (bf16*)take((size_t)MTOT * D * 2);
  p.CAT = p.H;
  p.U = (bf16*)take((size_t)MTOT * 256 * 2);
  p.QN = (bf16*)take((size_t)NB * 6 * SEQ2 * 64 * 2);
  p.KN = (bf16*)take((size_t)NB * 6 * SEQ2 * 64 * 2);
  p.VNt = (bf16*)take((size_t)NB * 6 * SEQ2 * 64 * 2);
  p.QG = (bf16*)take((size_t)NB * 6 * SEQ2 * 64 * 2);
  p.KG = (bf16*)take((size_t)NB * 2 * SEQ2 * 64 * 2);
  p.VGt = (bf16*)take((size_t)NB * 2 * SEQ2 * 64 * 2);
  p.XC = (float*)take((size_t)NCTX * D * 4);
  p.ridx = (int*)take((size_t)MTOT * 128 * 4);
  p.rg = (float*)take((size_t)MTOT * 128 * 4);
  if (off > ws_size) return;
  static int grid_blocks = 0;
  if (!grid_blocks) {
    int dev = 0, cus = 0, per_cu = 0;
    hipGetDevice(&dev);
    hipDeviceGetAttribute(&cus, hipDeviceAttributeMultiprocessorCount, dev);
    hipOccupancyMaxActiveBlocksPerMultiprocessor(&per_cu, mega_kernel, 256, 0);
    if (per_cu > 2) per_cu = 2;
    grid_blocks = cus * per_cu;
  }
  void* args[] = {&p};
  hipLaunchCooperativeKernel((void*)mega_kernel, dim3(grid_blocks), dim3(256), args, 0, stream);
}
```

```cpp
#include <hip/hip_runtime.h>
#include <stdint.h>

typedef __attribute__((ext_vector_type(8))) short bf16x8;
typedef __attribute__((ext_vector_type(16))) float f32x16;
typedef __attribute__((ext_vector_type(2))) __bf16 bf2_t;
typedef __attribute__((ext_vector_type(2))) float f2_t;
typedef unsigned short bf16;
typedef __attribute__((ext_vector_type(4))) unsigned u32x4;
typedef __attribute__((ext_vector_type(2))) unsigned u32x2;

#define DI __device__ __forceinline__
#ifndef PROBE
#define PROBE 0
#endif
#ifndef DUP
#define DUP 0
#endif
#define MFMA(a, b, c) __builtin_amdgcn_mfma_f32_32x32x16_bf16((a), (b), (c), 0, 0, 0)

constexpr int D = 1024, NB = 16, T = 2048, CL = 256;
constexpr int NTOK = NB * T;
constexpr int NCTX = NB * CL;
constexpr int MTOT = NTOK + NCTX;
constexpr int INC = 2304;
constexpr int SEQ2 = T + CL;
constexpr int NEXP = 16384;
constexpr float EPS = 1e-6f;
constexpr float L2E = 1.4426950408889634f;

struct Params {
  const float *x, *c, *ctx, *c_ctx, *norm1_g, *norm2_g, *w_ada, *b_ada, *w_in, *conv_w, *conv_b, *conv_ln_g,
      *conv_ln_b, *na_rel_bias, *gqa_q_norm, *gqa_k_norm, *w_out, *peer_w_q, *peer_keys, *peer_u, *peer_v, *final_norm_g;
  float* out;
  bf16 *win, *wout, *wq, *pk, *pu, *pv;
  float *modp, *mod, *ropetab;
  bf16 *H, *U, *QN, *KN, *VNt, *QG, *KG, *VGt, *CAT;
  float *XC;
  int* ridx;
  float* rg;
  unsigned* bar;
};

DI int tid_now() { int t; asm volatile("v_mov_b32 %0, %1" : "=v"(t) : "v"((int)__builtin_amdgcn_workitem_id_x())); return t; }
DI unsigned pack2(float a, float b) {
  f2_t v = {a, b};
  bf2_t r = __builtin_convertvector(v, bf2_t);
  return __builtin_bit_cast(unsigned, r);
}
DI float bf_lo(unsigned u) { return __uint_as_float(u << 16); }
DI float bf_hi(unsigned u) { return __uint_as_float(u & 0xffff0000u); }
DI int crow(int e, int h) { return (e & 3) + 8 * (e >> 2) + 4 * h; }
DI float silu_f(float x) { return x / (1.f + __expf(-x)); }
DI float sigmoid_f(float x) { return 1.f / (1.f + __expf(-x)); }
DI float gelu_tanh(float x) {
  float u = 0.7978845608028654f * (x + 0.044715f * x * x * x);
  float t = 1.f - 2.f / (1.f + __expf(2.f * u));
  return 0.5f * x * (1.f + t);
}
DI float wave_sum(float v) {
#pragma unroll
  for (int o = 32; o >= 1; o >>= 1) v += __shfl_xor(v, o);
  return v;
}
DI float* xres_row(const Params& p, int row) { return row < NTOK ? p.out + (size_t)row * D : p.XC + (size_t)(row - NTOK) * D; }
DI const float* xin_row(const Params& p, int layer, int row) {
  if (layer == 0) return row < NTOK ? p.x + (size_t)row * D : p.ctx + (size_t)(row - NTOK) * D;
  return xres_row(p, row);
}
DI int mod_row(int row) { return row < NTOK ? (row >> 11) : 16; }
DI int batch_of(int row) { return row < NTOK ? (row >> 11) : ((row - NTOK) >> 8); }
DI int pos_of(int row) { return row < NTOK ? (row & 2047) : (T + ((row - NTOK) & 255)); }

DI int perm_in(int n) {
  if (n >= 512) return n;
  int c = n >> 6, w = n & 63;
  return w < 32 ? 32 * c + w : 256 + 32 * c + (w - 32);
}
DI void convT_tile(const float* __restrict__ src, bf16* __restrict__ dst, int K, int N, int k0, int n0, bool perm, float* tile  ) {
  const int tx = tid_now() & 63, ty = tid_now() >> 6;
  const int ns = perm ? perm_in(n0 + tx) : n0 + tx;
#pragma unroll
  for (int i = 0; i < 16; ++i) { int k = ty + 4 * i; tile[k * 65 + tx] = src[(size_t)(k0 + k) * N + ns]; }
  __syncthreads();
#pragma unroll
  for (int i = 0; i < 16; ++i) {
    int n = ty + 4 * i;
    dst[(size_t)(n0 + n) * K + k0 + tx] = (bf16)(pack2(tile[tx * 65 + n], 0.f) & 0xffff);
  }
  __syncthreads();
}
constexpr int CONVT_ITEMS = 2 * 1344;
DI void stage_convT(const Params& p, int item, char* smem) {
  float* tile = (float*)smem;
  int l = item / 1344, r = item % 1344;
  if (r < 576) { int kt = r / 36, nt = r % 36; convT_tile(p.w_in + (size_t)l * D * INC, p.win + (size_t)l * INC * D, D, INC, kt * 64, nt * 64, true, tile); }
  else if (r < 832) { r -= 576; int kt = r / 16, nt = r % 16; convT_tile(p.w_out + (size_t)l * D * D, p.wout + (size_t)l * D * D, D, D, kt * 64, nt * 64, false, tile); }
  else { r -= 832; int kt = r / 32, nt = r % 32; convT_tile(p.peer_w_q + (size_t)l * D * 2048, p.wq + (size_t)l * 2048 * D, D, 2048, kt * 64, nt * 64, false, tile); }
}
constexpr size_t PK_N = (size_t)2 * 16 * 128 * 128, PU_N = (size_t)2 * NEXP * D;
constexpr int CONVS_ITEMS = (int)((PK_N + 2 * PU_N) / 2048);
DI void stage_convS(const Params& p, int item) {
  size_t e = (size_t)item * 2048 + tid_now() * 8;
  const float* src; bf16* dst;
  if (e < PK_N) { src = p.peer_keys + e; dst = p.pk + e; }
  else if (e < PK_N + PU_N) { src = p.peer_u + (e - PK_N); dst = p.pu + (e - PK_N); }
  else { src = p.peer_v + (e - PK_N - PU_N); dst = p.pv + (e - PK_N - PU_N); }
  float4 a = ((const float4*)src)[0], b = ((const float4*)src)[1];
  u32x4 o = {pack2(a.x, a.y), pack2(a.z, a.w), pack2(b.x, b.y), pack2(b.z, b.w)};
  *(u32x4*)dst = o;
}
DI void stage_rope(const Params& p) {
  for (int i = tid_now(); i < 64 * 16; i += 256) {
    int pos = i >> 4, f = i & 15;
    float inv = powf(10000.f, -(float)f / 16.f);
    float ang = (float)pos * inv;
    p.ropetab[2 * i] = cosf(ang); p.ropetab[2 * i + 1] = sinf(ang);
  }
}

constexpr int MODP_ITEMS = 2 * 8 * 24;
DI void stage_mod_partial(const Params& p, int item, char* smem) {
  float* sc = (float*)smem;
  int l = item / 192, r = item % 192, kc = r / 24, nc = r % 24;
  for (int i = tid_now(); i < 17 * 128; i += 256) {
    int rr = i >> 7, k = i & 127;
    float v = rr < 16 ? p.c[rr * D + kc * 128 + k] : p.c_ctx[kc * 128 + k];
    sc[i] = silu_f(v);
  }
  __syncthreads();
  float acc[17];
#pragma unroll
  for (int i = 0; i < 17; ++i) acc[i] = 0.f;
  const int n = nc * 256 + tid_now();
  const float* w = p.w_ada + ((size_t)l * D + kc * 128) * 6144 + n;
  for (int k = 0; k < 128; ++k) {
    float wv = w[(size_t)k * 6144];
#pragma unroll
    for (int i = 0; i < 17; ++i) acc[i] += sc[i * 128 + k] * wv;
  }
#pragma unroll
  for (int i = 0; i < 17; ++i) p.modp[(((size_t)l * 8 + kc) * 17 + i) * 6144 + n] = acc[i];
  __syncthreads();
}
constexpr int MODR_ITEMS = 2 * 17 * 6144 / 256;
DI void stage_mod_reduce(const Params& p, int item) {
  int idx = item * 256 + tid_now();
  int l = idx / (17 * 6144), rem = idx % (17 * 6144), n = rem % 6144;
  float s = p.b_ada[l * 6144 + n];
#pragma unroll
  for (int kc = 0; kc < 8; ++kc) s += p.modp[((size_t)l * 8 + kc) * 17 * 6144 + rem];
  p.mod[idx] = s;
}

DI void norm_row(const Params& p, const float* __restrict__ xr, const float* __restrict__ g, const float* __restrict__ sh,
                 const float* __restrict__ sc, bf16* __restrict__ hr) {
  const int lane = tid_now() & 63;
  float4 v[4]; float ss = 0.f;
#pragma unroll
  for (int i = 0; i < 4; ++i) { v[i] = ((const float4*)xr)[lane + 64 * i]; ss += v[i].x * v[i].x + v[i].y * v[i].y + v[i].z * v[i].z + v[i].w * v[i].w; }
  ss = wave_sum(ss);
  const float rstd = rsqrtf(ss * (1.f / D) + EPS);
#pragma unroll
  for (int i = 0; i < 4; ++i) {
    float4 gg = ((const float4*)g)[lane + 64 * i], s1 = ((const float4*)sh)[lane + 64 * i], s2 = ((const float4*)sc)[lane + 64 * i];
    float a = v[i].x * rstd * gg.x * (1.f + s2.x) + s1.x, b = v[i].y * rstd * gg.y * (1.f + s2.y) + s1.y;
    float c = v[i].z * rstd * gg.z * (1.f + s2.z) + s1.z, d = v[i].w * rstd * gg.w * (1.f + s2.w) + s1.w;
    u32x2 o = {pack2(a, b), pack2(c, d)};
    ((u32x2*)hr)[lane + 64 * i] = o;
  }
}
DI void stage_norm(const Params& p, int layer, int which, int item) {
  int row = item * 4 + (tid_now() >> 6);
  const float* xr = which == 0 ? xin_row(p, layer, row) : xres_row(p, row);
  const float* g = (which == 0 ? p.norm1_g : p.norm2_g) + layer * D;
  const float* m = p.mod + ((size_t)layer * 17 + mod_row(row)) * 6144 + (which == 0 ? 0 : 3072);
  norm_row(p, xr, g, m, m + D, p.H + (size_t)row * D);
}
DI void stage_final(const Params& p, int item) {
  int row = item * 4 + (tid_now() >> 6);
  const int lane = tid_now() & 63;
  const float* xr = p.out + (size_t)row * D;
  float4 v[4]; float ss = 0.f;
#pragma unroll
  for (int i = 0; i < 4; ++i) { v[i] = ((const float4*)xr)[lane + 64 * i]; ss += v[i].x * v[i].x + v[i].y * v[i].y + v[i].z * v[i].z + v[i].w * v[i].w; }
  ss = wave_sum(ss);
  const float rstd = rsqrtf(ss * (1.f / D) + EPS);
#pragma unroll
  for (int i = 0; i < 4; ++i) {
    float4 gg = ((const float4*)p.final_norm_g)[lane + 64 * i];
    float4 o = {v[i].x * rstd * gg.x, v[i].y * rstd * gg.y, v[i].z * rstd * gg.z, v[i].w * rstd * gg.w};
    ((float4*)(p.out + (size_t)row * D))[lane + 64 * i] = o;
  }
}

constexpr int LROW = 144;
constexpr int LTILE = 128 * LROW;
constexpr int GEMM_SMEM = 4 * LTILE;

template <bool ORIENT_T>
DI void gemm_core(const bf16* __restrict__ A, const bf16* __restrict__ W, char* smem, f32x16 (&acc)[2][2]) {
  const int tid = tid_now(), lane = tid & 63, wave = tid >> 6;
  const int wm = wave >> 1, wn = wave & 1, l31 = lane & 31, hh = lane >> 5;
  const int lrow = tid >> 3, kc = tid & 7;
#pragma unroll
  for (int i = 0; i < 2; ++i)
#pragma unroll
    for (int j = 0; j < 2; ++j)
#pragma unroll
      for (int e = 0; e < 16; ++e) acc[i][j][e] = 0.f;
  u32x4 ra[4], rw[4];
  const bf16* ap = A + (size_t)lrow * D + kc * 8;
  const bf16* wp = W + (size_t)lrow * D + kc * 8;
#pragma unroll
  for (int i = 0; i < 4; ++i) { ra[i] = *(const u32x4*)(ap + (size_t)(32 * i) * D); rw[i] = *(const u32x4*)(wp + (size_t)(32 * i) * D); }
  for (int kt = 0; kt < 16; ++kt) {
    char* sa = smem + (kt & 1) * 2 * LTILE;
    char* sw = sa + LTILE;
#pragma unroll
    for (int i = 0; i < 4; ++i) {
      *(u32x4*)(sa + (lrow + 32 * i) * LROW + kc * 16) = ra[i];
      *(u32x4*)(sw + (lrow + 32 * i) * LROW + kc * 16) = rw[i];
    }
    __syncthreads();
    if (kt + 1 < 16) {
#pragma unroll
      for (int i = 0; i < 4; ++i) {
        ra[i] = *(const u32x4*)(ap + (size_t)(32 * i) * D + (kt + 1) * 64);
        rw[i] = *(const u32x4*)(wp + (size_t)(32 * i) * D + (kt + 1) * 64);
      }
    }
#pragma unroll
    for (int s = 0; s < 4; ++s) {
      bf16x8 af[2], wf[2];
#pragma unroll
      for (int t = 0; t < 2; ++t) {
        af[t] = *(const bf16x8*)(sa + (wm * 64 + t * 32 + l31) * LROW + (s * 16 + hh * 8) * 2);
        wf[t] = *(const bf16x8*)(sw + (wn * 64 + t * 32 + l31) * LROW + (s * 16 + hh * 8) * 2);
      }
#pragma unroll
      for (int ft = 0; ft < 2; ++ft)
#pragma unroll
        for (int tt = 0; tt < 2; ++tt)
          acc[ft][tt] = ORIENT_T ? MFMA(wf[ft], af[tt], acc[ft][tt]) : MFMA(af[tt], wf[ft], acc[ft][tt]);
    }
  }
  __syncthreads();
}

constexpr int INPROJ_ITEMS = 288 * 18;
DI void store4(bf16* dst, float a, float b, float c, float d) { u32x2 o = {pack2(a, b), pack2(c, d)}; *(u32x2*)dst = o; }

DI void stage_inproj(const Params& p, int layer, int item, char* smem) {
  const int mt = item / 18, nt = item % 18;
  if (layer == 1 && mt >= 256 && nt < 10) return;
  const int row0 = mt * 128, n0 = nt * 128;
  const bf16* A = p.H + (size_t)row0 * D;
  const bf16* W = p.win + ((size_t)layer * INC + n0) * D;
  const int lane = tid_now() & 63, wave = tid_now() >> 6, wm = wave >> 1, wn = wave & 1, l31 = lane & 31, hh = lane >> 5;
  const bool vtile = (nt >= 13 && nt <= 15) || nt == 17;
  f32x16 acc[2][2];
  const int b = batch_of(row0);
  if (vtile) {
    gemm_core<false>(A, W, smem, acc);
    bf16* base; int head;
    if (nt == 17) { head = wn; base = p.VGt + ((size_t)(b * 2 + head) * 64) * SEQ2; }
    else { head = (nt - 13) * 2 + wn; base = p.VNt + ((size_t)(b * 6 + head) * 64) * SEQ2; }
    const int pos0 = pos_of(row0) + wm * 64;
#pragma unroll
    for (int ft = 0; ft < 2; ++ft) {
      const int d = ft * 32 + l31;
#pragma unroll
      for (int tt = 0; tt < 2; ++tt)
#pragma unroll
        for (int g = 0; g < 4; ++g)
          store4(base + (size_t)d * SEQ2 + pos0 + tt * 32 + 8 * g + 4 * hh, acc[ft][tt][4 * g], acc[ft][tt][4 * g + 1], acc[ft][tt][4 * g + 2], acc[ft][tt][4 * g + 3]);
    }
    return;
  }
  gemm_core<true>(A, W, smem, acc);
  const int chunk = nt * 2 + wn;
#pragma unroll
  for (int tt = 0; tt < 2; ++tt) {
    const int row = row0 + wm * 64 + tt * 32 + l31;
    const int pos = pos_of(row);
    const bool isctx = row >= NTOK;
    if (chunk < 8) {
      bf16* dst = p.U + (size_t)row * 256 + 32 * chunk;
#pragma unroll
      for (int g = 0; g < 4; ++g) {
        float u0 = acc[0][tt][4 * g] * sigmoid_f(acc[1][tt][4 * g]), u1 = acc[0][tt][4 * g + 1] * sigmoid_f(acc[1][tt][4 * g + 1]);
        float u2 = acc[0][tt][4 * g + 2] * sigmoid_f(acc[1][tt][4 * g + 2]), u3 = acc[0][tt][4 * g + 3] * sigmoid_f(acc[1][tt][4 * g + 3]);
        store4(dst + 8 * g + 4 * hh, u0, u1, u2, u3);
      }
    } else if (chunk < 14 || (chunk >= 20 && chunk < 26)) {
      const bool isq = chunk < 14;
      const int head = isq ? chunk - 8 : chunk - 20;
      const float sc = isq ? 0.125f : 1.f;
      bf16* dst = (isq ? p.QN : p.KN) + ((size_t)(b * 6 + head) * SEQ2 + pos) * 64;
#pragma unroll
      for (int ft = 0; ft < 2; ++ft)
#pragma unroll
        for (int g = 0; g < 4; ++g)
          store4(dst + ft * 32 + 8 * g + 4 * hh, acc[ft][tt][4 * g] * sc, acc[ft][tt][4 * g + 1] * sc, acc[ft][tt][4 * g + 2] * sc, acc[ft][tt][4 * g + 3] * sc);
    } else {
      const bool isq = chunk < 20;
      const int head = isq ? chunk - 14 : chunk - 32;
      const float* gn = (isq ? p.gqa_q_norm : p.gqa_k_norm) + layer * 64;
      float ss = 0.f;
#pragma unroll
      for (int ft = 0; ft < 2; ++ft)
#pragma unroll
        for (int e = 0; e < 16; ++e) ss += acc[ft][tt][e] * acc[ft][tt][e];
      ss += __shfl_xor(ss, 32);
      const float rstd = rsqrtf(ss * (1.f / 64.f) + EPS) ;
      const float sc = isq ? 0.125f : 1.f;
      bf16* dst = (isq ? p.QG + ((size_t)(b * 6 + head) * SEQ2 + pos) * 64 : p.KG + ((size_t)(b * 2 + head) * SEQ2 + pos) * 64);
      const int prow = pos >> 6, pcol = pos & 63;
#pragma unroll
      for (int g = 0; g < 4; ++g) {
        float o1[4], o2[4];
#pragma unroll
        for (int j = 0; j < 4; ++j) {
          const int i = 8 * g + 4 * hh + j;
          float x1 = acc[0][tt][4 * g + j] * rstd * gn[i];
          float x2 = acc[1][tt][4 * g + j] * rstd * gn[32 + i];
          if (!isctx && PROBE != 13) {
            const int ppos = (g < 2) ? prow : pcol;
            const float2 cs = *(const float2*)(p.ropetab + 2 * (ppos * 16 + (i & 15)));
            float y1 = x1 * cs.x - x2 * cs.y, y2 = x1 * cs.y + x2 * cs.x;
            x1 = y1; x2 = y2;
          }
          o1[j] = x1 * sc; o2[j] = x2 * sc;
        }
        store4(dst + 8 * g + 4 * hh, o1[0], o1[1], o1[2], o1[3]);
        store4(dst + 32 + 8 * g + 4 * hh, o2[0], o2[1], o2[2], o2[3]);
      }
    }
  }
}

constexpr int CONV_TT = 32;
constexpr int CONV_SMEM = (CONV_TT + 30) * 512 + CONV_TT * 1024;
DI void stage_conv(const Params& p, int layer, int item, char* smem) {
  bf16* ub = (bf16*)smem;
  float* yb = (float*)(smem + (CONV_TT + 30) * 512);
  const int tid = tid_now();
  int row0, seq_lo, seq_hi;
  if (item < 1024) { row0 = item * CONV_TT; seq_lo = row0 & ~2047; seq_hi = seq_lo + 2048; }
  else { row0 = NTOK + (item - 1024) * CONV_TT; seq_lo = NTOK + (((item - 1024) * CONV_TT) & ~255); seq_hi = seq_lo + 256; }
  for (int c = tid; c < 62 * 32; c += 256) {
    int r = c >> 5, cc = c & 31;
    int row = row0 - 15 + r;
    u32x4 v = {0u, 0u, 0u, 0u};
    if (row >= seq_lo && row < seq_hi) v = *(const u32x4*)(p.U + (size_t)row * 256 + cc * 8);
    *(u32x4*)(ub + r * 256 + cc * 8) = v;
  }
  __syncthreads();
  {
    const int ch = tid;
    float w[31];
#pragma unroll
    for (int j = 0; j < 31; ++j) w[j] = p.conv_w[((size_t)layer * 31 + j) * 256 + ch];
    const float bias = p.conv_b[layer * 256 + ch];
#pragma unroll 1
    for (int t0 = 0; t0 < CONV_TT; t0 += 8) {
      float in[38];
#pragma unroll
      for (int j = 0; j < 38; ++j) in[j] = __uint_as_float((unsigned)ub[(t0 + j) * 256 + ch] << 16);
#pragma unroll
      for (int t = 0; t < 8; ++t) {
        float a = bias;
#pragma unroll
        for (int j = 0; j < 31; ++j) a += in[t + j] * w[j];
        yb[(t0 + t) * 256 + ch] = a;
      }
    }
  }
  __syncthreads();
  {
    const int wave = tid >> 6, lane = tid & 63;
    const float4 g = ((const float4*)(p.conv_ln_g + layer * 256))[lane], bb = ((const float4*)(p.conv_ln_b + layer * 256))[lane];
    for (int t = wave * 8; t < wave * 8 + 8; ++t) {
      float4 v = ((const float4*)(yb + t * 256))[lane];
      float mu = wave_sum(v.x + v.y + v.z + v.w) * (1.f / 256.f);
      float dx = v.x - mu, dy = v.y - mu, dz = v.z - mu, dw = v.w - mu;
      float var = wave_sum(dx * dx + dy * dy + dz * dz + dw * dw) * (1.f / 256.f);
      float rs = rsqrtf(var + EPS);
      float a = silu_f(dx * rs * g.x + bb.x), b = silu_f(dy * rs * g.y + bb.y), c = silu_f(dz * rs * g.z + bb.z), d = silu_f(dw * rs * g.w + bb.w);
      store4(p.CAT + (size_t)(row0 + t) * D + lane * 4, a, b, c, d);
    }
  }
  __syncthreads();
}

DI int kperm(int i) { return (i & 19) | ((i & 4) << 1) | ((i & 8) >> 1); }
DI int keyoff(int e, int h) { return (e & 3) + 4 * ((e >> 2) & 1) + 8 * h + 16 * (e >> 3); }
DI bf16x8 pack8(const f32x16& x, int s) {
  u32x4 r = {pack2(x[8 * s], x[8 * s + 1]), pack2(x[8 * s + 2], x[8 * s + 3]), pack2(x[8 * s + 4], x[8 * s + 5]), pack2(x[8 * s + 6], x[8 * s + 7])};
  return __builtin_bit_cast(bf16x8, r);
}

constexpr int NA_ITEMS = 6144 / 4;
DI void stage_na(const Params& p, int layer, int item) {
  const int lane = tid_now() & 63, wave = tid_now() >> 6, l31 = lane & 31, hh = lane >> 5;
  const int wi = item * 4 + wave;
  const int qhalf = wi & 1, head = (wi >> 1) % 6, br = wi / 12, r = br & 31, b = br >> 5;
  const int r0 = min(max(r - 4, 0), 24);
  const size_t hb = (size_t)(b * 6 + head);
  const bf16* Q = p.QN + (hb * SEQ2 + r * 64 + qhalf * 32 + l31) * 64;
  const bf16* Kb = p.KN + hb * SEQ2 * 64;
  const bf16* Vb = p.VNt + hb * 64 * SEQ2;
  const float* bias = p.na_rel_bias + ((size_t)layer * 6 + head) * 15 * 31;
  bf16x8 qf[4];
#pragma unroll
  for (int s = 0; s < 4; ++s) qf[s] = *(const bf16x8*)(Q + 16 * s + 8 * hh);
  f32x16 o[2];
#pragma unroll
  for (int e = 0; e < 16; ++e) { o[0][e] = 0.f; o[1][e] = 0.f; }
  float m = -1e30f, l = 0.f;
  const int qc = qhalf * 32 + l31;
  const int c0 = min(max(qc - 8, 0), 48);
  const int kp = kperm(l31);
#pragma unroll 1
  for (int t = 0; t < 24; ++t) {
    int key0, brow = 0, cs = 0;
    const bool local = t >= 8;
    if (!local) key0 = T + t * 32;
    else { brow = (t - 8) >> 1; cs = (t - 8) & 1; key0 = (r0 + brow) * 64 + cs * 32; }
    f32x16 st;
#pragma unroll
    for (int e = 0; e < 16; ++e) st[e] = 0.f;
    const bf16* kr = Kb + (size_t)(key0 + kp) * 64 + 8 * hh;
#pragma unroll
    for (int s = 0; s < 4; ++s) { bf16x8 kf = *(const bf16x8*)(kr + 16 * s); st = MFMA(kf, qf[s], st); }
    if (local) {
      const int rb = (r0 + brow) - r + 7;
#pragma unroll
      for (int e = 0; e < 16; ++e) {
        const int kc = cs * 32 + keyoff(e, hh);
        const bool valid = (kc >= c0) && (kc < c0 + 16);
        const int ci = min(max(kc - qc + 15, 0), 30);
        const float bv = (PROBE == 12) ? 0.f : bias[rb * 31 + ci];
        st[e] = valid ? st[e] + bv : -1e30f;
      }
    }
    float mx = st[0];
#pragma unroll
    for (int e = 1; e < 16; ++e) mx = fmaxf(mx, st[e]);
    mx = fmaxf(mx, __shfl_xor(mx, 32));
    const float mn = fmaxf(m, mx);
    const float alpha = exp2f((m - mn) * L2E);
    float ls = 0.f;
#pragma unroll
    for (int e = 0; e < 16; ++e) { st[e] = exp2f((st[e] - mn) * L2E); ls += st[e]; }
    l = l * alpha + ls; m = mn;
#pragma unroll
    for (int e = 0; e < 16; ++e) { o[0][e] *= alpha; o[1][e] *= alpha; }
    bf16x8 pf0 = pack8(st, 0), pf1 = pack8(st, 1);
#pragma unroll
    for (int dt = 0; dt < 2; ++dt) {
      const bf16* vr = Vb + (size_t)(dt * 32 + l31) * SEQ2 + key0 + 8 * hh;
      bf16x8 v0 = *(const bf16x8*)(vr), v1 = *(const bf16x8*)(vr + 16);
      o[dt] = MFMA(v0, pf0, o[dt]);
      o[dt] = MFMA(v1, pf1, o[dt]);
    }
  }
  l += __shfl_xor(l, 32);
  const float inv = (PROBE == 10) ? 0.f : 1.f / l;
  bf16* dst = p.CAT + (size_t)(b * T + r * 64 + qc) * D + 256 + head * 64;
#pragma unroll
  for (int dt = 0; dt < 2; ++dt)
#pragma unroll
    for (int g = 0; g < 4; ++g)
      store4(dst + dt * 32 + 8 * g + 4 * hh, o[dt][4 * g] * inv, o[dt][4 * g + 1] * inv, o[dt][4 * g + 2] * inv, o[dt][4 * g + 3] * inv);
}

constexpr int FA_SMEM = 2 * 2 * 64 * LROW;
DI void flash_block(const bf16* __restrict__ Q, const bf16* __restrict__ K, const bf16* __restrict__ Vt, int q0, int kt0, int kt1,
                    bf16* __restrict__ dst  , char* smem) {
  const int tid = tid_now(), lane = tid & 63, wave = tid >> 6, l31 = lane & 31, hh = lane >> 5;
  const int lrow = tid >> 3, kc = tid & 7;
  bf16x8 qf[4];
  const bf16* qp = Q + (size_t)(q0 + wave * 32 + l31) * 64 + 8 * hh;
#pragma unroll
  for (int s = 0; s < 4; ++s) qf[s] = *(const bf16x8*)(qp + 16 * s);
  f32x16 o[2];
#pragma unroll
  for (int e = 0; e < 16; ++e) { o[0][e] = 0.f; o[1][e] = 0.f; }
  float m = -1e30f, l = 0.f;
  const int kp = kperm(l31);
  u32x4 rk[2], rv[2];
#pragma unroll
  for (int i = 0; i < 2; ++i) {
    rk[i] = *(const u32x4*)(K + (size_t)(kt0 * 64 + lrow + 32 * i) * 64 + kc * 8);
    rv[i] = *(const u32x4*)(Vt + (size_t)(lrow + 32 * i) * SEQ2 + kt0 * 64 + kc * 8);
  }
  for (int kt = kt0; kt < kt1; ++kt) {
    char* sk = smem + ((kt - kt0) & 1) * 2 * 64 * LROW;
    char* sv = sk + 64 * LROW;
#pragma unroll
    for (int i = 0; i < 2; ++i) {
      *(u32x4*)(sk + (lrow + 32 * i) * LROW + kc * 16) = rk[i];
      *(u32x4*)(sv + (lrow + 32 * i) * LROW + kc * 16) = rv[i];
    }
    __syncthreads();
    if (kt + 1 < kt1) {
#pragma unroll
      for (int i = 0; i < 2; ++i) {
        rk[i] = *(const u32x4*)(K + (size_t)((kt + 1) * 64 + lrow + 32 * i) * 64 + kc * 8);
        rv[i] = *(const u32x4*)(Vt + (size_t)(lrow + 32 * i) * SEQ2 + (kt + 1) * 64 + kc * 8);
      }
    }
    f32x16 st[2];
#pragma unroll
    for (int k2 = 0; k2 < 2; ++k2) {
#pragma unroll
      for (int e = 0; e < 16; ++e) st[k2][e] = 0.f;
#pragma unroll
      for (int s = 0; s < 4; ++s) {
        bf16x8 kf = *(const bf16x8*)(sk + (k2 * 32 + kp) * LROW + (16 * s + 8 * hh) * 2);
        st[k2] = MFMA(kf, qf[s], st[k2]);
      }
    }
    float mx = st[0][0];
#pragma unroll
    for (int e = 1; e < 16; ++e) mx = fmaxf(mx, st[0][e]);
#pragma unroll
    for (int e = 0; e < 16; ++e) mx = fmaxf(mx, st[1][e]);
    mx = fmaxf(mx, __shfl_xor(mx, 32));
    const float mn = fmaxf(m, mx);
    const float alpha = exp2f((m - mn) * L2E);
    float ls = 0.f;
#pragma unroll
    for (int k2 = 0; k2 < 2; ++k2)
#pragma unroll
      for (int e = 0; e < 16; ++e) { st[k2][e] = exp2f((st[k2][e] - mn) * L2E); ls += st[k2][e]; }
    l = l * alpha + ls; m = mn;
#pragma unroll
    for (int e = 0; e < 16; ++e) { o[0][e] *= alpha; o[1][e] *= alpha; }
#pragma unroll
    for (int k2 = 0; k2 < 2; ++k2)
#pragma unroll
      for (int s2 = 0; s2 < 2; ++s2) {
        bf16x8 pf = pack8(st[k2], s2);
#pragma unroll
        for (int dt = 0; dt < 2; ++dt) {
          bf16x8 vf = *(const bf16x8*)(sv + (dt * 32 + l31) * LROW + (k2 * 32 + 16 * s2 + 8 * hh) * 2);
          o[dt] = MFMA(vf, pf, o[dt]);
        }
      }
  }
  l += __shfl_xor(l, 32);
  const float inv = (PROBE == 11) ? 0.f : 1.f / l;
  bf16* d2 = dst + (size_t)(wave * 32 + l31) * D;
#pragma unroll
  for (int dt = 0; dt < 2; ++dt)
#pragma unroll
    for (int g = 0; g < 4; ++g)
      store4(d2 + dt * 32 + 8 * g + 4 * hh, o[dt][4 * g] * inv, o[dt][4 * g + 1] * inv, o[dt][4 * g + 2] * inv, o[dt][4 * g + 3] * inv);
  __syncthreads();
}
constexpr int GQA_ITEMS = 16 * 6 * 16;
DI void stage_gqa(const Params& p, int item, char* smem) {
  const int qt = item & 15, hq = (item >> 4) % 6, b = item / 96;
  const int kvh = hq / 3;
  flash_block(p.QG + (size_t)(b * 6 + hq) * SEQ2 * 64, p.KG + (size_t)(b * 2 + kvh) * SEQ2 * 64, p.VGt + (size_t)(b * 2 + kvh) * 64 * SEQ2,
              qt * 128, 0, 36, p.CAT + (size_t)(b * T + qt * 128) * D + 640 + hq * 64, smem);
}
constexpr int CTXATT_ITEMS = 384;
DI void stage_ctxatt(const Params& p, int item, char* smem) {
  const int qt = item & 1, head = (item >> 1) % 6, which = (item / 12) & 1, b = item / 24;
  bf16* dst = p.CAT + (size_t)(NTOK + b * CL + qt * 128) * D;
  if (which == 0)
    flash_block(p.QN + (size_t)(b * 6 + head) * SEQ2 * 64, p.KN + (size_t)(b * 6 + head) * SEQ2 * 64, p.VNt + (size_t)(b * 6 + head) * 64 * SEQ2,
                T + qt * 128, 32, 36, dst + 256 + head * 64, smem);
  else
    flash_block(p.QG + (size_t)(b * 6 + head) * SEQ2 * 64, p.KG + (size_t)(b * 2 + head / 3) * SEQ2 * 64, p.VGt + (size_t)(b * 2 + head / 3) * 64 * SEQ2,
                T + qt * 128, 32, 36, dst + 640 + head * 64, smem);
}

constexpr int OUTPROJ_ITEMS = 288 * 8;
DI void stage_outproj(const Params& p, int layer, int item, char* smem) {
  const int mt = item >> 3, nt = item & 7;
  if (layer == 1 && mt >= 256) return;
  const int row0 = mt * 128, n0 = nt * 128;
  f32x16 acc[2][2];
  gemm_core<true>(p.CAT + (size_t)row0 * D, p.wout + ((size_t)layer * D + n0) * D, smem, acc);
  const int lane = tid_now() & 63, wave = tid_now() >> 6, wm = wave >> 1, wn = wave & 1, l31 = lane & 31, hh = lane >> 5;
  const float* g1 = p.mod + ((size_t)layer * 17 + mod_row(row0)) * 6144 + 2048;
#pragma unroll
  for (int tt = 0; tt < 2; ++tt) {
    const int row = row0 + wm * 64 + tt * 32 + l31;
    const float* xr = xin_row(p, layer, row);
    float* dr = xres_row(p, row);
#pragma unroll
    for (int ft = 0; ft < 2; ++ft)
#pragma unroll
      for (int g = 0; g < 4; ++g) {
        const int n = n0 + wn * 64 + ft * 32 + 8 * g + 4 * hh;
        float4 xv = *(const float4*)(xr + n), gv = *(const float4*)(g1 + n);
        if (PROBE == 2) { gv.x = gv.y = gv.z = gv.w = 0.f; }
        float4 o = {xv.x + gv.x * acc[ft][tt][4 * g], xv.y + gv.y * acc[ft][tt][4 * g + 1], xv.z + gv.z * acc[ft][tt][4 * g + 2], xv.w + gv.w * acc[ft][tt][4 * g + 3]};
        *(float4*)(dr + n) = o;
      }
  }
}

constexpr int ROUTE_ITEMS = 288 * 8;
constexpr int QROW = 272;
DI int to_sortable(int b) { return b ^ ((b >> 31) & 0x7fffffff); }

#define CAND_LIST(X) \
  X(0,0,0) X(1,0,1) X(2,0,2) X(3,0,3) X(4,0,4) X(5,0,5) X(6,0,6) X(7,0,7) X(8,0,8) X(9,0,9) X(10,0,10) X(11,0,11) X(12,0,12) X(13,0,13) X(14,0,14) X(15,0,15) \
  X(16,1,1) X(17,1,2) X(18,1,3) X(19,1,4) X(20,1,5) X(21,1,6) X(22,1,7) \
  X(23,2,2) X(24,2,3) X(25,2,4) \
  X(26,3,3)

DI void stage_route(const Params& p, int layer, int item, char* smem) {
  const int mt = item >> 3, head = item & 7;
  if (layer == 1 && mt >= 256) return;
  const int row0 = mt * 128;
  const int tid = tid_now(), lane = tid & 63, wave = tid >> 6, wm = wave >> 1, wn = wave & 1, l31 = lane & 31, hh = lane >> 5;
  int topk[2][16];
  char* Qs = smem;
  char* Ks = smem + 2 * LTILE;
#pragma unroll
  for (int pp = 0; pp < 2; ++pp) {
    {
      f32x16 acc[2][2];
      gemm_core<true>(p.H + (size_t)row0 * D, p.wq + ((size_t)layer * 2048 + (head * 2 + pp) * 128) * D, smem, acc);
#pragma unroll
      for (int tt = 0; tt < 2; ++tt)
#pragma unroll
        for (int ft = 0; ft < 2; ++ft)
#pragma unroll
          for (int g = 0; g < 4; ++g) {
            const int tok = wm * 64 + tt * 32 + l31, kf = wn * 64 + ft * 32 + 8 * g + 4 * hh;
            u32x2 o = {pack2(acc[ft][tt][4 * g], acc[ft][tt][4 * g + 1]), pack2(acc[ft][tt][4 * g + 2], acc[ft][tt][4 * g + 3])};
            *(u32x2*)(Qs + tok * QROW + kf * 2) = o;
          }
    }
    const bf16* kp = p.pk + ((size_t)((layer * 8 + head) * 2 + pp) * 128) * 128;
#pragma unroll
    for (int i = 0; i < 8; ++i) {
      const int c = tid + 256 * i, n = c >> 4, kc = c & 15;
      *(u32x4*)(Ks + n * QROW + kc * 16) = *(const u32x4*)(kp + n * 128 + kc * 8);
    }
    __syncthreads();
    int key[64];
    {
      f32x16 sc[4];
#pragma unroll
      for (int nt = 0; nt < 4; ++nt)
#pragma unroll
        for (int e = 0; e < 16; ++e) sc[nt][e] = 0.f;
#pragma unroll
      for (int s = 0; s < 8; ++s) {
        bf16x8 qb = *(const bf16x8*)(Qs + (wave * 32 + l31) * QROW + (16 * s + 8 * hh) * 2);
#pragma unroll
        for (int nt = 0; nt < 4; ++nt) {
          bf16x8 ka = *(const bf16x8*)(Ks + (nt * 32 + l31) * QROW + (16 * s + 8 * hh) * 2);
          sc[nt] = MFMA(ka, qb, sc[nt]);
        }
      }
#pragma unroll
      for (int nt = 0; nt < 4; ++nt)
#pragma unroll
        for (int e = 0; e < 16; ++e) {
          const int n = nt * 32 + crow(e, hh);
          int b = (__float_as_int(sc[nt][e]) & ~127) | n;
          key[nt * 16 + e] = to_sortable(b);
        }
    }
#pragma unroll
    for (int r = 0; r < 16; ++r) {
      int mx = key[0];
#pragma unroll
      for (int i = 1; i < 64; ++i) mx = max(mx, key[i]);
      mx = max(mx, __shfl_xor(mx, 32));
      topk[pp][r] = mx;
#pragma unroll
      for (int i = 0; i < 64; ++i) key[i] = (key[i] == mx) ? (int)0x80000000 : key[i];
    }
    __syncthreads();
  }
  float av[16], bv[16]; int ai[16], bi[16];
#pragma unroll
  for (int i = 0; i < 16; ++i) {
    int k1 = to_sortable(topk[0][i]), k2 = to_sortable(topk[1][i]);
    int a = hh ? k2 : k1, b = hh ? k1 : k2;
    av[i] = __int_as_float(a & ~127); ai[i] = a & 127;
    bv[i] = __int_as_float(b & ~127); bi[i] = b & 127;
  }
  int cand[27], eid[27];
#define MKC(c, i, j) { int b = __float_as_int(av[i] + bv[j]); cand[c] = (to_sortable(b) & ~63) | (c * 2 + hh); \
                       eid[c] = hh ? (bi[j] * 128 + ai[i]) : (ai[i] * 128 + bi[j]); \
                       if (i == j && hh) cand[c] = (int)0x80000000; }
  CAND_LIST(MKC)
#undef MKC
  int win[16], weid[16];
#pragma unroll
  for (int r = 0; r < 16; ++r) {
    int mx = cand[0];
#pragma unroll
    for (int c = 1; c < 27; ++c) mx = max(mx, cand[c]);
    mx = max(mx, __shfl_xor(mx, 32));
    int e = 0;
#pragma unroll
    for (int c = 0; c < 27; ++c) { const bool hit = cand[c] == mx; e = hit ? eid[c] : e; cand[c] = hit ? (int)0x80000000 : cand[c]; }
    e |= __shfl_xor(e, 32);
    win[r] = mx; weid[r] = e;
  }
  float gsum = 0.f, gv[16];
  const float v0 = __int_as_float(to_sortable(win[0]) & ~63);
#pragma unroll
  for (int r = 0; r < 16; ++r) { gv[r] = __expf(__int_as_float(to_sortable(win[r]) & ~63) - v0); gsum += gv[r]; }
  const float ginv = 1.f / gsum;
  const int row = row0 + wave * 32 + l31;
  if (hh == 0) {
    int4* d = (int4*)(p.ridx + ((size_t)row * 8 + head) * 16);
#pragma unroll
    for (int q = 0; q < 4; ++q) { int4 o = {weid[4 * q], weid[4 * q + 1], weid[4 * q + 2], weid[4 * q + 3]}; d[q] = o; }
  } else {
    float4* d = (float4*)(p.rg + ((size_t)row * 8 + head) * 16);
#pragma unroll
    for (int q = 0; q < 4; ++q) { float4 o = {gv[4 * q] * ginv, gv[4 * q + 1] * ginv, gv[4 * q + 2] * ginv, gv[4 * q + 3] * ginv}; d[q] = o; }
  }
}

DI float dot2(unsigned a, unsigned b, float acc) {
  bf2_t x = __builtin_bit_cast(bf2_t, a), y = __builtin_bit_cast(bf2_t, b);
  return __builtin_amdgcn_fdot2_f32_bf16(x, y, acc, false);
}
DI float dot8(u32x4 a, u32x4 b, float acc) {
  const unsigned a0 = a[0], a1 = a[1], a2 = a[2], a3 = a[3], b0 = b[0], b1 = b[1], b2 = b[2], b3 = b[3];
  acc = dot2(a0, b0, acc); acc = dot2(a1, b1, acc); acc = dot2(a2, b2, acc); acc = dot2(a3, b3, acc);
  return acc;
}
DI void axpy8(float (&o)[8], float w, u32x4 v) {
  o[0] += w * bf_lo(v.x); o[1] += w * bf_hi(v.x); o[2] += w * bf_lo(v.y); o[3] += w * bf_hi(v.y);
  o[4] += w * bf_lo(v.z); o[5] += w * bf_hi(v.z); o[6] += w * bf_lo(v.w); o[7] += w * bf_hi(v.w);
}
constexpr int GATHER_ITEMS = MTOT / 4;
DI void stage_gather(const Params& p, int layer, int item) {
  const int lane = tid_now() & 63, wave = tid_now() >> 6;
  const int row = item * 4 + wave;
  if (layer == 1 && row >= NTOK) return;
  const bf16* hr = p.H + (size_t)row * D;
  const u32x4 h0 = *(const u32x4*)(hr + lane * 8), h1 = *(const u32x4*)(hr + 512 + lane * 8);
  float o0[8], o1[8];
#pragma unroll
  for (int i = 0; i < 8; ++i) { o0[i] = 0.f; o1[i] = 0.f; }
  const bf16* Ub = p.pu + (size_t)layer * NEXP * D;
  const bf16* Vb = p.pv + (size_t)layer * NEXP * D;
#pragma unroll 1
  for (int head_ = 0; head_ < (DUP == 8 ? 16 : 8); ++head_) {
    const int head = head_ & 7;
    const int myidx = p.ridx[((size_t)row * 8 + head) * 16 + (lane & 15)];
    const float myg = p.rg[((size_t)row * 8 + head) * 16 + ((lane >> 2) & 15)];
    float part[16];
#pragma unroll
    for (int k = 0; k < 16; ++k) {
      const int e = __builtin_amdgcn_readlane(myidx, k);
      const bf16* ur = Ub + (size_t)e * D;
      const u32x4 a = *(const u32x4*)(ur + lane * 8), b = *(const u32x4*)(ur + 512 + lane * 8);
      part[k] = dot8(b, h1, dot8(a, h0, 0.f));
    }
    float r8[8], r4[4], r2[2], r1;
    {
      const bool up = lane & 32;
#pragma unroll
      for (int k = 0; k < 8; ++k) { float keep = up ? part[k + 8] : part[k], give = up ? part[k] : part[k + 8]; r8[k] = keep + __shfl_xor(give, 32); }
    }
    {
      const bool up = lane & 16;
#pragma unroll
      for (int k = 0; k < 4; ++k) { float keep = up ? r8[k + 4] : r8[k], give = up ? r8[k] : r8[k + 4]; r4[k] = keep + __shfl_xor(give, 16); }
    }
    {
      const bool up = lane & 8;
#pragma unroll
      for (int k = 0; k < 2; ++k) { float keep = up ? r4[k + 2] : r4[k], give = up ? r4[k] : r4[k + 2]; r2[k] = keep + __shfl_xor(give, 8); }
    }
    {
      const bool up = lane & 4;
      float keep = up ? r2[1] : r2[0], give = up ? r2[0] : r2[1];
      r1 = keep + __shfl_xor(give, 4);
    }
    r1 += __shfl_xor(r1, 2);
    r1 += __shfl_xor(r1, 1);
    const float w = gelu_tanh(r1) * myg;
#pragma unroll
    for (int k = 0; k < 16; ++k) {
      const int e = __builtin_amdgcn_readlane(myidx, k);
      const float wk = __int_as_float(__builtin_amdgcn_readlane(__float_as_int(w), k << 2));
      const bf16* vr = Vb + (size_t)e * D;
      const u32x4 a = *(const u32x4*)(vr + lane * 8), b = *(const u32x4*)(vr + 512 + lane * 8);
      axpy8(o0, wk, a); axpy8(o1, wk, b);
    }
  }
  const float* g2 = p.mod + ((size_t)layer * 17 + mod_row(row)) * 6144 + 5120;
  if (DUP == 8) { for (int i = 0; i < 8; ++i) { o0[i] *= 0.5f; o1[i] *= 0.5f; } }
  if (PROBE == 1) { for (int i = 0; i < 8; ++i) { o0[i] = 0.f; o1[i] = 0.f; } }
  if (PROBE == 5) { for (int i = 0; i < 8; ++i) { o0[i] *= 2.f; o1[i] *= 2.f; } }
  if (PROBE == 3 && layer == 1) { for (int i = 0; i < 8; ++i) { o0[i] = 0.f; o1[i] = 0.f; } }
  if (PROBE == 4 && layer == 0) { for (int i = 0; i < 8; ++i) { o0[i] = 0.f; o1[i] = 0.f; } }
  float* dr = xres_row(p, row);
  const float* xr = dr;
#pragma unroll
  for (int q = 0; q < 2; ++q) {
    float4 xv = *(const float4*)(xr + lane * 8 + 4 * q), gv = *(const float4*)(g2 + lane * 8 + 4 * q);
    float4 o = {xv.x + gv.x * o0[4 * q], xv.y + gv.y * o0[4 * q + 1], xv.z + gv.z * o0[4 * q + 2], xv.w + gv.w * o0[4 * q + 3]};
    *(float4*)(dr + lane * 8 + 4 * q) = o;
    float4 xv2 = *(const float4*)(xr + 512 + lane * 8 + 4 * q), gv2 = *(const float4*)(g2 + 512 + lane * 8 + 4 * q);
    float4 o2 = {xv2.x + gv2.x * o1[4 * q], xv2.y + gv2.y * o1[4 * q + 1], xv2.z + gv2.z * o1[4 * q + 2], xv2.w + gv2.w * o1[4 * q + 3]};
    *(float4*)(dr + 512 + lane * 8 + 4 * q) = o2;
  }
}


#include <hip/hip_cooperative_groups.h>
namespace cg = cooperative_groups;
constexpr int SMEM_BYTES = GEMM_SMEM;


#define XB_TMO      128
#define XB_XCNT(j)  (256  + 64 * (j))
#define XB_XSUB(j)  (1280 + 64 * (j))
#define XB_XGEN(j)  (2304 + 64 * (j))
#define XB_TOP      3328
#define XB_TOPGEN   3392
#define XCD_BAR_WORDS 3456
#define XB_SPIN_CAP (1u << 22)
#define LAS __attribute__((address_space(3)))
DI unsigned xb_ld(unsigned* p) { return __hip_atomic_load(p, __ATOMIC_RELAXED, __HIP_MEMORY_SCOPE_AGENT); }
DI unsigned xb_add(unsigned* p, unsigned v) { return __hip_atomic_fetch_add(p, v, __ATOMIC_RELAXED, __HIP_MEMORY_SCOPE_AGENT); }
DI unsigned xb_xcc_id() { return (unsigned)__builtin_amdgcn_s_getreg((3 << 11) | 20) & 0xFu; }
#define XB_SPIN(cond, bar) do { unsigned _sp = 0; while (cond) { __builtin_amdgcn_s_sleep(1); \
    if ((++_sp & 255u) == 0u) { if (xb_ld(&(bar)[XB_TMO])) break; if (_sp > XB_SPIN_CAP) { atomicAdd(&(bar)[XB_TMO], 1u); break; } } } } while (0)
struct XcdBarrier { unsigned* bar; unsigned x; volatile LAS unsigned* st; };
DI XcdBarrier xcd_barrier_post(unsigned* bar, volatile LAS unsigned* st) {
  XcdBarrier b; b.bar = bar; b.x = xb_xcc_id(); b.st = st;
  if (tid_now() == 0) (void)xb_add(&bar[XB_XCNT(b.x)], 1u);
  return b;
}
DI void xcd_barrier_complete(unsigned* bar, unsigned x, unsigned& nloc, unsigned& nx) {
  const unsigned G = gridDim.x;
  unsigned sum, cnt, mine, sp = 0u;
  for (;;) {
    sum = 0u; cnt = 0u; mine = 0u;
#pragma unroll
    for (unsigned j = 0; j < 16; ++j) { const unsigned c = xb_ld(&bar[XB_XCNT(j)]); sum += c; cnt += (c > 0u) ? 1u : 0u; mine = (j == x) ? c : mine; }
    if (sum == G) break;
    __builtin_amdgcn_s_sleep(1);
    if ((++sp & 255u) == 0u) { if (xb_ld(&bar[XB_TMO])) break; if (sp > XB_SPIN_CAP) { atomicAdd(&bar[XB_TMO], 1u); break; } }
  }
  nloc = mine > 0u ? mine : 1u; nx = cnt > 0u ? cnt : 1u;
}
DI void xcd_barrier(const XcdBarrier& b) {
  asm volatile("s_waitcnt vmcnt(0)" ::: "memory");
  __syncthreads();
  if (tid_now() == 0) {
    unsigned* bar = b.bar;
    __builtin_amdgcn_s_waitcnt(0);
    unsigned nloc = b.st[0], nx = b.st[1];
    if (nloc == 0u) { xcd_barrier_complete(bar, b.x, nloc, nx); b.st[0] = nloc; b.st[1] = nx; }
    const unsigned old = xb_add(&bar[XB_XSUB(b.x)], 1u);
    const unsigned gen = old / nloc;
    if (old + 1u == (gen + 1u) * nloc) {
      __builtin_amdgcn_fence(__ATOMIC_RELEASE, "agent");
      asm volatile("s_waitcnt vmcnt(0)" ::: "memory");
      const unsigned og = xb_add(&bar[XB_TOP], 1u);
      const unsigned tg = og / nx;
      if (og + 1u == (tg + 1u) * nx) xb_add(&bar[XB_TOPGEN], 1u);
      else XB_SPIN(xb_ld(&bar[XB_TOPGEN]) == tg, bar);
      __builtin_amdgcn_fence(__ATOMIC_ACQUIRE, "agent");
      xb_add(&bar[XB_XGEN(b.x)], 1u);
      asm volatile("s_waitcnt vmcnt(0)" ::: "memory");
    } else {
      XB_SPIN(xb_ld(&bar[XB_XGEN(b.x)]) == gen, bar);
      __builtin_amdgcn_fence(__ATOMIC_ACQUIRE, "agent");
      asm volatile("s_waitcnt vmcnt(0)" ::: "memory");
    }
  }
  __syncthreads();
}

#define GRID_BARRIER() xcd_barrier(xb)
#define REP(k) for (int rep_ = 0; rep_ < (DUP == (k) ? 2 : 1); ++rep_)

__global__ void __launch_bounds__(256, 2) mega_kernel(Params p) {
  __shared__ __attribute__((aligned(16))) char smem[SMEM_BYTES];
  cg::grid_group grid = cg::this_grid();
  const int G = gridDim.x, bid = blockIdx.x;
  __shared__ uint4 xb_words;
  if (tid_now() == 0) xb_words = make_uint4(0u, 0u, 0u, 0u);
  if (bid == 0) for (int i = tid_now(); i < XCD_BAR_WORDS; i += 256) p.bar[i] = 0u;
  REP(1) for (int it = bid; it < MODP_ITEMS + CONVT_ITEMS + CONVS_ITEMS + 1; it += G) {
    if (it < MODP_ITEMS) stage_mod_partial(p, it, smem);
    else if (it < MODP_ITEMS + CONVT_ITEMS) stage_convT(p, it - MODP_ITEMS, smem);
    else if (it < MODP_ITEMS + CONVT_ITEMS + CONVS_ITEMS) stage_convS(p, it - MODP_ITEMS - CONVT_ITEMS);
    else stage_rope(p);
  }
  grid.sync();
  XcdBarrier xb = xcd_barrier_post(p.bar, (volatile LAS unsigned*)&xb_words);
  for (int it = bid; it < MODR_ITEMS; it += G) stage_mod_reduce(p, it);
  GRID_BARRIER();
#pragma unroll 1
  for (int l = 0; l < 2; ++l) {
    REP(2) for (int it = bid; it < MTOT / 4; it += G) stage_norm(p, l, 0, it);
    GRID_BARRIER();
    {
      const int n = l == 0 ? INPROJ_ITEMS : 256 * 18 + 32 * 8;
      REP(3) for (int it = bid; it < n; it += G) {
        int item = it;
        if (it >= 256 * 18) { const int r = it - 256 * 18; item = l == 0 ? it : (256 + (r >> 3)) * 18 + 10 + (r & 7); }
        stage_inproj(p, l, item, smem);
      }
    }
    GRID_BARRIER();
    {
      const int nconv = l == 0 ? 1152 : 1024, nctx = l == 0 ? CTXATT_ITEMS : 0;
      const int n = GQA_ITEMS + NA_ITEMS + nconv + nctx;
      REP(4) for (int it = bid; it < n; it += G) {
        if (it < GQA_ITEMS) { if (DUP != 41 && DUP != 42) stage_gqa(p, it, smem); if (DUP == 40) stage_gqa(p, it, smem); }
        else if (it < GQA_ITEMS + NA_ITEMS) { stage_na(p, l, it - GQA_ITEMS); if (DUP == 43) stage_na(p, l, it - GQA_ITEMS); }
        else if (it < GQA_ITEMS + NA_ITEMS + nconv) { stage_conv(p, l, it - GQA_ITEMS - NA_ITEMS, smem); if (DUP == 44) stage_conv(p, l, it - GQA_ITEMS - NA_ITEMS, smem); }
        else stage_ctxatt(p, it - GQA_ITEMS - NA_ITEMS - nconv, smem);
      }
    }
    GRID_BARRIER();
    {
      const int n = (l == 0 ? 288 : 256) * 8;
      for (int it = bid; it < n; it += G) stage_outproj(p, l, it, smem);
    }
    GRID_BARRIER();
    {
      const int n = (l == 0 ? MTOT : NTOK) / 4;
      REP(6) for (int it = bid; it < n; it += G) stage_norm(p, l, 1, it);
    }
    GRID_BARRIER();
    {
      const int n = (l == 0 ? 288 : 256) * 8;
      REP(7) for (int it = bid; it < n; it += G) stage_route(p, l, it, smem);
    }
    GRID_BARRIER();
    {
      const int n = (l == 0 ? MTOT : NTOK) / 4;
      for (int it = bid; it < n; it += G) stage_gather(p, l, it);
    }
    GRID_BARRIER();
  }
  for (int it = bid; it < NTOK / 4; it += G) stage_final(p, it);
}

extern "C" void kernel_launch(void* const* d_in, const int* in_sizes, int n_in, void* d_out, int out_size, void* d_ws, size_t ws_size,
                              hipStream_t stream) {
  Params p{};
  const float** f = (const float**)&p;
  for (int i = 0; i < 22; ++i) f[i] = (const float*)d_in[i];
  p.out = (float*)d_out;
  char* w = (char*)d_ws; size_t off = 0;
  auto take = [&](size_t bytes) { char* r = w + off; off += (bytes + 255) & ~(size_t)255; return r; };
  p.win = (bf16*)take((size_t)2 * INC * D * 2);
  p.wout = (bf16*)take((size_t)2 * D * D * 2);
  p.wq = (bf16*)take((size_t)2 * 2048 * D * 2);
  p.pk = (bf16*)take(PK_N * 2);
  p.pu = (bf16*)take(PU_N * 2);
  p.pv = (bf16*)take(PU_N * 2);
  p.modp = (float*)take((size_t)2 * 8 * 17 * 6144 * 4);
  p.mod = (float*)take((size_t)2 * 17 * 6144 * 4);
  p.ropetab = (float*)take(64 * 16 * 2 * 4);
  p.H = (bf16*)take((size_t)MTOT * D * 2);
  p.CAT = p.H;
  p.U = (bf16*)take((size_t)MTOT * 256 * 2);
  p.QN = (bf16*)take((size_t)NB * 6 * SEQ2 * 64 * 2);
  p.KN = (bf16*)take((size_t)NB * 6 * SEQ2 * 64 * 2);
  p.VNt = (bf16*)take((size_t)NB * 6 * SEQ2 * 64 * 2);
  p.QG = (bf16*)take((size_t)NB * 6 * SEQ2 * 64 * 2);
  p.KG = (bf16*)take((size_t)NB * 2 * SEQ2 * 64 * 2);
  p.VGt = (bf16*)take((size_t)NB * 2 * SEQ2 * 64 * 2);
  p.XC = (float*)take((size_t)NCTX * D * 4);
  p.ridx = (int*)take((size_t)MTOT * 128 * 4);
  p.rg = (float*)take((size_t)MTOT * 128 * 4);
  p.bar = (unsigned*)take(XCD_BAR_WORDS * 4);
  if (off > ws_size) return;
  static int grid_blocks = 0;
  if (!grid_blocks) {
    int dev = 0, cus = 0, per_cu = 0;
    hipGetDevice(&dev);
    hipDeviceGetAttribute(&cus, hipDeviceAttributeMultiprocessorCount, dev);
    hipOccupancyMaxActiveBlocksPerMultiprocessor(&per_cu, mega_kernel, 256, 0);
    if (per_cu > 2) per_cu = 2;
    grid_blocks = cus * per_cu;
  }
  void* args[] = {&p};
  hipLaunchCooperativeKernel((void*)mega_kernel, dim3(grid_blocks), dim3(256), args, 0, stream);
}
```

```cpp
#include <hip/hip_runtime.h>
#include <stdint.h>

typedef __attribute__((ext_vector_type(8))) short bf16x8;
typedef __attribute__((ext_vector_type(16))) float f32x16;
typedef __attribute__((ext_vector_type(2))) __bf16 bf2_t;
typedef __attribute__((ext_vector_type(2))) float f2_t;
typedef unsigned short bf16;
typedef __attribute__((ext_vector_type(4))) unsigned u32x4;
typedef __attribute__((ext_vector_type(2))) unsigned u32x2;

#define DI __device__ __forceinline__
#ifndef PROBE
#define PROBE 0
#endif
#ifndef DUP
#define DUP 0
#endif
#define MFMA(a, b, c) __builtin_amdgcn_mfma_f32_32x32x16_bf16((a), (b), (c), 0, 0, 0)

constexpr int D = 1024, NB = 16, T = 2048, CL = 256;
constexpr int NTOK = NB * T;
constexpr int NCTX = NB * CL;
constexpr int MTOT = NTOK + NCTX;
constexpr int INC = 2304;
constexpr int SEQ2 = T + CL;
constexpr int NEXP = 16384;
constexpr float EPS = 1e-6f;
constexpr float L2E = 1.4426950408889634f;

struct Params {
  const float *x, *c, *ctx, *c_ctx, *norm1_g, *norm2_g, *w_ada, *b_ada, *w_in, *conv_w, *conv_b, *conv_ln_g,
      *conv_ln_b, *na_rel_bias, *gqa_q_norm, *gqa_k_norm, *w_out, *peer_w_q, *peer_keys, *peer_u, *peer_v, *final_norm_g;
  float* out;
  bf16 *win, *wout, *wq, *pk;
  unsigned char *pu8, *pv8;
  float *modp, *mod, *ropetab;
  bf16 *H, *U, *QN, *KN, *VNt, *QG, *KG, *VGt, *CAT;
  float *XC;
  int* ridx;
  float* rg;
  unsigned* bar;
};

DI int tid_now() { int t; asm volatile("v_mov_b32 %0, %1" : "=v"(t) : "v"((int)__builtin_amdgcn_workitem_id_x())); return t; }
DI unsigned pack2(float a, float b) {
  f2_t v = {a, b};
  bf2_t r = __builtin_convertvector(v, bf2_t);
  return __builtin_bit_cast(unsigned, r);
}
DI float bf_lo(unsigned u) { return __uint_as_float(u << 16); }
DI float bf_hi(unsigned u) { return __uint_as_float(u & 0xffff0000u); }
DI int crow(int e, int h) { return (e & 3) + 8 * (e >> 2) + 4 * h; }
DI float silu_f(float x) { return x / (1.f + __expf(-x)); }
DI float sigmoid_f(float x) { return 1.f / (1.f + __expf(-x)); }
DI float gelu_tanh(float x) {
  float u = 0.7978845608028654f * (x + 0.044715f * x * x * x);
  float t = 1.f - 2.f / (1.f + __expf(2.f * u));
  return 0.5f * x * (1.f + t);
}
DI float shx(float v, int m, int lane) { return __int_as_float(__builtin_amdgcn_ds_bpermute((lane ^ m) << 2, __float_as_int(v))); }
DI int shxi(int v, int m, int lane) { return __builtin_amdgcn_ds_bpermute((lane ^ m) << 2, v); }
DI float wave_sum(float v, int lane) {
#pragma unroll
  for (int o = 32; o >= 1; o >>= 1) v += shx(v, o, lane);
  return v;
}
DI float* xres_row(const Params& p, int row) { return row < NTOK ? p.out + (size_t)row * D : p.XC + (size_t)(row - NTOK) * D; }
DI const float* xin_row(const Params& p, int layer, int row) {
  if (layer == 0) return row < NTOK ? p.x + (size_t)row * D : p.ctx + (size_t)(row - NTOK) * D;
  return xres_row(p, row);
}
DI int mod_row(int row) { return row < NTOK ? (row >> 11) : 16; }
DI int batch_of(int row) { return row < NTOK ? (row >> 11) : ((row - NTOK) >> 8); }
DI int pos_of(int row) { return row < NTOK ? (row & 2047) : (T + ((row - NTOK) & 255)); }

DI int perm_in(int n) {
  if (n >= 512) return n;
  int c = n >> 6, w = n & 63;
  return w < 32 ? 32 * c + w : 256 + 32 * c + (w - 32);
}
DI void convT_tile(const float* __restrict__ src, bf16* __restrict__ dst, int K, int N, int k0, int n0, bool perm, float* tile  ) {
  const int tx = tid_now() & 63, ty = tid_now() >> 6;
  const int ns = perm ? perm_in(n0 + tx) : n0 + tx;
#pragma unroll
  for (int i = 0; i < 16; ++i) { int k = ty + 4 * i; tile[k * 65 + tx] = src[(size_t)(k0 + k) * N + ns]; }
  __syncthreads();
#pragma unroll
  for (int i = 0; i < 16; ++i) {
    int n = ty + 4 * i;
    dst[(size_t)(n0 + n) * K + k0 + tx] = (bf16)(pack2(tile[tx * 65 + n], 0.f) & 0xffff);
  }
  __syncthreads();
}
constexpr int CONVT_ITEMS = 2 * 1344;
DI void stage_convT(const Params& p, int item, char* smem) {
  float* tile = (float*)smem;
  int l = item / 1344, r = item % 1344;
  if (r < 576) { int kt = r / 36, nt = r % 36; convT_tile(p.w_in + (size_t)l * D * INC, p.win + (size_t)l * INC * D, D, INC, kt * 64, nt * 64, true, tile); }
  else if (r < 832) { r -= 576; int kt = r / 16, nt = r % 16; convT_tile(p.w_out + (size_t)l * D * D, p.wout + (size_t)l * D * D, D, D, kt * 64, nt * 64, false, tile); }
  else { r -= 832; int kt = r / 32, nt = r % 32; convT_tile(p.peer_w_q + (size_t)l * D * 2048, p.wq + (size_t)l * 2048 * D, D, 2048, kt * 64, nt * 64, false, tile); }
}
constexpr size_t PK_N = (size_t)2 * 16 * 128 * 128, PU_N = (size_t)2 * NEXP * D;
constexpr float SU = 1024.f, SV = 64.f;
constexpr int CONVK_ITEMS = (int)(PK_N / 2048), CONVUV_ITEMS = (int)(PU_N / 4096);
constexpr int CONVS_ITEMS = CONVK_ITEMS + 2 * CONVUV_ITEMS;
DI unsigned pack_fp8x4(float4 a, float s) {
  int r = 0;
  r = __builtin_amdgcn_cvt_pk_fp8_f32(a.x * s, a.y * s, r, false);
  r = __builtin_amdgcn_cvt_pk_fp8_f32(a.z * s, a.w * s, r, true);
  return (unsigned)r;
}
DI void stage_convS(const Params& p, int item) {
  if (item < CONVK_ITEMS) {
    size_t e = (size_t)item * 2048 + tid_now() * 8;
    const float* src = p.peer_keys + e;
    float4 a = ((const float4*)src)[0], b = ((const float4*)src)[1];
    u32x4 o = {pack2(a.x, a.y), pack2(a.z, a.w), pack2(b.x, b.y), pack2(b.z, b.w)};
    *(u32x4*)(p.pk + e) = o;
    return;
  }
  item -= CONVK_ITEMS;
  const bool isv = item >= CONVUV_ITEMS;
  if (isv) item -= CONVUV_ITEMS;
  size_t e = (size_t)item * 4096 + tid_now() * 16;
  const float* src = (isv ? p.peer_v : p.peer_u) + e;
  const float s = isv ? SV : SU;
  float4 a = ((const float4*)src)[0], b = ((const float4*)src)[1], c = ((const float4*)src)[2], d = ((const float4*)src)[3];
  u32x4 o = {pack_fp8x4(a, s), pack_fp8x4(b, s), pack_fp8x4(c, s), pack_fp8x4(d, s)};
  *(u32x4*)((isv ? p.pv8 : p.pu8) + e) = o;
}
DI void stage_rope(const Params& p) {
  for (int i = tid_now(); i < 64 * 16; i += 256) {
    int pos = i >> 4, f = i & 15;
    float inv = powf(10000.f, -(float)f / 16.f);
    float ang = (float)pos * inv;
    p.ropetab[2 * i] = cosf(ang); p.ropetab[2 * i + 1] = sinf(ang);
  }
}

constexpr int MODP_ITEMS = 2 * 8 * 24;
DI void stage_mod_partial(const Params& p, int item, char* smem) {
  float* sc = (float*)smem;
  int l = item / 192, r = item % 192, kc = r / 24, nc = r % 24;
  for (int i = tid_now(); i < 17 * 128; i += 256) {
    int rr = i >> 7, k = i & 127;
    float v = rr < 16 ? p.c[rr * D + kc * 128 + k] : p.c_ctx[kc * 128 + k];
    sc[i] = silu_f(v);
  }
  __syncthreads();
  float acc[17];
#pragma unroll
  for (int i = 0; i < 17; ++i) acc[i] = 0.f;
  const int n = nc * 256 + tid_now();
  const float* w = p.w_ada + ((size_t)l * D + kc * 128) * 6144 + n;
  for (int k = 0; k < 128; ++k) {
    float wv = w[(size_t)k * 6144];
#pragma unroll
    for (int i = 0; i < 17; ++i) acc[i] += sc[i * 128 + k] * wv;
  }
#pragma unroll
  for (int i = 0; i < 17; ++i) p.modp[(((size_t)l * 8 + kc) * 17 + i) * 6144 + n] = acc[i];
  __syncthreads();
}
constexpr int MODR_ITEMS = 2 * 17 * 6144 / 256;
DI void stage_mod_reduce(const Params& p, int item) {
  int idx = item * 256 + tid_now();
  int l = idx / (17 * 6144), rem = idx % (17 * 6144), n = rem % 6144;
  float s = p.b_ada[l * 6144 + n];
#pragma unroll
  for (int kc = 0; kc < 8; ++kc) s += p.modp[((size_t)l * 8 + kc) * 17 * 6144 + rem];
  p.mod[idx] = s;
}

DI void norm_row(const Params& p, const float* __restrict__ xr, const float* __restrict__ g, const float* __restrict__ sh,
                 const float* __restrict__ sc, bf16* __restrict__ hr) {
  const int lane = tid_now() & 63;
  float4 v[4]; float ss = 0.f;
#pragma unroll
  for (int i = 0; i < 4; ++i) { v[i] = ((const float4*)xr)[lane + 64 * i]; ss += v[i].x * v[i].x + v[i].y * v[i].y + v[i].z * v[i].z + v[i].w * v[i].w; }
  ss = wave_sum(ss, lane);
  const float rstd = rsqrtf(ss * (1.f / D) + EPS);
#pragma unroll
  for (int i = 0; i < 4; ++i) {
    float4 gg = ((const float4*)g)[lane + 64 * i], s1 = ((const float4*)sh)[lane + 64 * i], s2 = ((const float4*)sc)[lane + 64 * i];
    float a = v[i].x * rstd * gg.x * (1.f + s2.x) + s1.x, b = v[i].y * rstd * gg.y * (1.f + s2.y) + s1.y;
    float c = v[i].z * rstd * gg.z * (1.f + s2.z) + s1.z, d = v[i].w * rstd * gg.w * (1.f + s2.w) + s1.w;
    u32x2 o = {pack2(a, b), pack2(c, d)};
    ((u32x2*)hr)[lane + 64 * i] = o;
  }
}
DI void stage_norm(const Params& p, int layer, int which, int item) {
  int row = item * 4 + (tid_now() >> 6);
  const float* xr = which == 0 ? xin_row(p, layer, row) : xres_row(p, row);
  const float* g = (which == 0 ? p.norm1_g : p.norm2_g) + layer * D;
  const float* m = p.mod + ((size_t)layer * 17 + mod_row(row)) * 6144 + (which == 0 ? 0 : 3072);
  norm_row(p, xr, g, m, m + D, p.H + (size_t)row * D);
}
DI void stage_final(const Params& p, int item) {
  int row = item * 4 + (tid_now() >> 6);
  const int lane = tid_now() & 63;
  const float* xr = p.out + (size_t)row * D;
  float4 v[4]; float ss = 0.f;
#pragma unroll
  for (int i = 0; i < 4; ++i) { v[i] = ((const float4*)xr)[lane + 64 * i]; ss += v[i].x * v[i].x + v[i].y * v[i].y + v[i].z * v[i].z + v[i].w * v[i].w; }
  ss = wave_sum(ss, lane);
  const float rstd = rsqrtf(ss * (1.f / D) + EPS);
#pragma unroll
  for (int i = 0; i < 4; ++i) {
    float4 gg = ((const float4*)p.final_norm_g)[lane + 64 * i];
    float4 o = {v[i].x * rstd * gg.x, v[i].y * rstd * gg.y, v[i].z * rstd * gg.z, v[i].w * rstd * gg.w};
    ((float4*)(p.out + (size_t)row * D))[lane + 64 * i] = o;
  }
}

constexpr int LROW = 144;
constexpr int LTILE = 128 * LROW;
constexpr int GEMM_SMEM = 4 * LTILE;

template <bool ORIENT_T>
DI void gemm_core(const bf16* __restrict__ A, const bf16* __restrict__ W, char* smem, f32x16 (&acc)[2][2]) {
  const int tid = tid_now(), lane = tid & 63, wave = tid >> 6;
  const int wm = wave >> 1, wn = wave & 1, l31 = lane & 31, hh = lane >> 5;
  const int lrow = tid >> 3, kc = tid & 7;
#pragma unroll
  for (int i = 0; i < 2; ++i)
#pragma unroll
    for (int j = 0; j < 2; ++j)
#pragma unroll
      for (int e = 0; e < 16; ++e) acc[i][j][e] = 0.f;
  u32x4 ra[4], rw[4];
  const bf16* ap = A + (size_t)lrow * D + kc * 8;
  const bf16* wp = W + (size_t)lrow * D + kc * 8;
#pragma unroll
  for (int i = 0; i < 4; ++i) { ra[i] = *(const u32x4*)(ap + (size_t)(32 * i) * D); rw[i] = *(const u32x4*)(wp + (size_t)(32 * i) * D); }
  for (int kt = 0; kt < 16; ++kt) {
    char* sa = smem + (kt & 1) * 2 * LTILE;
    char* sw = sa + LTILE;
#pragma unroll
    for (int i = 0; i < 4; ++i) {
      *(u32x4*)(sa + (lrow + 32 * i) * LROW + kc * 16) = ra[i];
      *(u32x4*)(sw + (lrow + 32 * i) * LROW + kc * 16) = rw[i];
    }
    __syncthreads();
    if (kt + 1 < 16) {
#pragma unroll
      for (int i = 0; i < 4; ++i) {
        ra[i] = *(const u32x4*)(ap + (size_t)(32 * i) * D + (kt + 1) * 64);
        rw[i] = *(const u32x4*)(wp + (size_t)(32 * i) * D + (kt + 1) * 64);
      }
    }
#pragma unroll
    for (int s = 0; s < 4; ++s) {
      bf16x8 af[2], wf[2];
#pragma unroll
      for (int t = 0; t < 2; ++t) {
        af[t] = *(const bf16x8*)(sa + (wm * 64 + t * 32 + l31) * LROW + (s * 16 + hh * 8) * 2);
        wf[t] = *(const bf16x8*)(sw + (wn * 64 + t * 32 + l31) * LROW + (s * 16 + hh * 8) * 2);
      }
#pragma unroll
      for (int ft = 0; ft < 2; ++ft)
#pragma unroll
        for (int tt = 0; tt < 2; ++tt)
          acc[ft][tt] = ORIENT_T ? MFMA(wf[ft], af[tt], acc[ft][tt]) : MFMA(af[tt], wf[ft], acc[ft][tt]);
    }
  }
  __syncthreads();
}

constexpr int INPROJ_ITEMS = 288 * 18;
DI void store4(bf16* dst, float a, float b, float c, float d) { u32x2 o = {pack2(a, b), pack2(c, d)}; *(u32x2*)dst = o; }

DI void stage_inproj(const Params& p, int layer, int item, char* smem) {
  const int mt = item / 18, nt = item % 18;
  if (layer == 1 && mt >= 256 && nt < 10) return;
  const int row0 = mt * 128, n0 = nt * 128;
  const bf16* A = p.H + (size_t)row0 * D;
  const bf16* W = p.win + ((size_t)layer * INC + n0) * D;
  const int lane = tid_now() & 63, wave = tid_now() >> 6, wm = wave >> 1, wn = wave & 1, l31 = lane & 31, hh = lane >> 5;
  const bool vtile = (nt >= 13 && nt <= 15) || nt == 17;
  f32x16 acc[2][2];
  const int b = batch_of(row0);
  if (vtile) {
    gemm_core<false>(A, W, smem, acc);
    bf16* base; int head;
    if (nt == 17) { head = wn; base = p.VGt + ((size_t)(b * 2 + head) * 64) * SEQ2; }
    else { head = (nt - 13) * 2 + wn; base = p.VNt + ((size_t)(b * 6 + head) * 64) * SEQ2; }
    const int pos0 = pos_of(row0) + wm * 64;
#pragma unroll
    for (int ft = 0; ft < 2; ++ft) {
      const int d = ft * 32 + l31;
#pragma unroll
      for (int tt = 0; tt < 2; ++tt)
#pragma unroll
        for (int g = 0; g < 4; ++g)
          store4(base + (size_t)d * SEQ2 + pos0 + tt * 32 + 8 * g + 4 * hh, acc[ft][tt][4 * g], acc[ft][tt][4 * g + 1], acc[ft][tt][4 * g + 2], acc[ft][tt][4 * g + 3]);
    }
    return;
  }
  gemm_core<true>(A, W, smem, acc);
  const int chunk = nt * 2 + wn;
#pragma unroll
  for (int tt = 0; tt < 2; ++tt) {
    const int row = row0 + wm * 64 + tt * 32 + l31;
    const int pos = pos_of(row);
    const bool isctx = row >= NTOK;
    if (chunk < 8) {
      bf16* dst = p.U + (size_t)row * 256 + 32 * chunk;
#pragma unroll
      for (int g = 0; g < 4; ++g) {
        float u0 = acc[0][tt][4 * g] * sigmoid_f(acc[1][tt][4 * g]), u1 = acc[0][tt][4 * g + 1] * sigmoid_f(acc[1][tt][4 * g + 1]);
        float u2 = acc[0][tt][4 * g + 2] * sigmoid_f(acc[1][tt][4 * g + 2]), u3 = acc[0][tt][4 * g + 3] * sigmoid_f(acc[1][tt][4 * g + 3]);
        store4(dst + 8 * g + 4 * hh, u0, u1, u2, u3);
      }
    } else if (chunk < 14 || (chunk >= 20 && chunk < 26)) {
      const bool isq = chunk < 14;
      const int head = isq ? chunk - 8 : chunk - 20;
      const float sc = isq ? 0.125f : 1.f;
      bf16* dst = (isq ? p.QN : p.KN) + ((size_t)(b * 6 + head) * SEQ2 + pos) * 64;
#pragma unroll
      for (int ft = 0; ft < 2; ++ft)
#pragma unroll
        for (int g = 0; g < 4; ++g)
          store4(dst + ft * 32 + 8 * g + 4 * hh, acc[ft][tt][4 * g] * sc, acc[ft][tt][4 * g + 1] * sc, acc[ft][tt][4 * g + 2] * sc, acc[ft][tt][4 * g + 3] * sc);
    } else {
      const bool isq = chunk < 20;
      const int head = isq ? chunk - 14 : chunk - 32;
      const float* gn = (isq ? p.gqa_q_norm : p.gqa_k_norm) + layer * 64;
      float ss = 0.f;
#pragma unroll
      for (int ft = 0; ft < 2; ++ft)
#pragma unroll
        for (int e = 0; e < 16; ++e) ss += acc[ft][tt][e] * acc[ft][tt][e];
      ss += shx(ss, 32, lane);
      const float rstd = rsqrtf(ss * (1.f / 64.f) + EPS) ;
      const float sc = isq ? 0.125f : 1.f;
      bf16* dst = (isq ? p.QG + ((size_t)(b * 6 + head) * SEQ2 + pos) * 64 : p.KG + ((size_t)(b * 2 + head) * SEQ2 + pos) * 64);
      const int prow = pos >> 6, pcol = pos & 63;
#pragma unroll
      for (int g = 0; g < 4; ++g) {
        float o1[4], o2[4];
#pragma unroll
        for (int j = 0; j < 4; ++j) {
          const int i = 8 * g + 4 * hh + j;
          float x1 = acc[0][tt][4 * g + j] * rstd * gn[i];
          float x2 = acc[1][tt][4 * g + j] * rstd * gn[32 + i];
          if (!isctx && PROBE != 13) {
            const int ppos = (g < 2) ? prow : pcol;
            const float2 cs = *(const float2*)(p.ropetab + 2 * (ppos * 16 + (i & 15)));
            float y1 = x1 * cs.x - x2 * cs.y, y2 = x1 * cs.y + x2 * cs.x;
            x1 = y1; x2 = y2;
          }
          o1[j] = x1 * sc; o2[j] = x2 * sc;
        }
        store4(dst + 8 * g + 4 * hh, o1[0], o1[1], o1[2], o1[3]);
        store4(dst + 32 + 8 * g + 4 * hh, o2[0], o2[1], o2[2], o2[3]);
      }
    }
  }
}

constexpr int CONV_TT = 32;
constexpr int CONV_SMEM = (CONV_TT + 30) * 512 + CONV_TT * 1024;
DI void stage_conv(const Params& p, int layer, int item, char* smem) {
  bf16* ub = (bf16*)smem;
  float* yb = (float*)(smem + (CONV_TT + 30) * 512);
  const int tid = tid_now();
  int row0, seq_lo, seq_hi;
  if (item < 1024) { row0 = item * CONV_TT; seq_lo = row0 & ~2047; seq_hi = seq_lo + 2048; }
  else { row0 = NTOK + (item - 1024) * CONV_TT; seq_lo = NTOK + (((item - 1024) * CONV_TT) & ~255); seq_hi = seq_lo + 256; }
  for (int c = tid; c < 62 * 32; c += 256) {
    int r = c >> 5, cc = c & 31;
    int row = row0 - 15 + r;
    u32x4 v = {0u, 0u, 0u, 0u};
    if (row >= seq_lo && row < seq_hi) v = *(const u32x4*)(p.U + (size_t)row * 256 + cc * 8);
    *(u32x4*)(ub + r * 256 + cc * 8) = v;
  }
  __syncthreads();
  {
    const int ch = tid;
    float w[31];
#pragma unroll
    for (int j = 0; j < 31; ++j) w[j] = p.conv_w[((size_t)layer * 31 + j) * 256 + ch];
    const float bias = p.conv_b[layer * 256 + ch];
#pragma unroll 1
    for (int t0 = 0; t0 < CONV_TT; t0 += 8) {
      float in[38];
#pragma unroll
      for (int j = 0; j < 38; ++j) in[j] = __uint_as_float((unsigned)ub[(t0 + j) * 256 + ch] << 16);
#pragma unroll
      for (int t = 0; t < 8; ++t) {
        float a = bias;
#pragma unroll
        for (int j = 0; j < 31; ++j) a += in[t + j] * w[j];
        yb[(t0 + t) * 256 + ch] = a;
      }
    }
  }
  __syncthreads();
  {
    const int wave = tid >> 6, lane = tid & 63;
    const float4 g = ((const float4*)(p.conv_ln_g + layer * 256))[lane], bb = ((const float4*)(p.conv_ln_b + layer * 256))[lane];
    for (int t = wave * 8; t < wave * 8 + 8; ++t) {
      float4 v = ((const float4*)(yb + t * 256))[lane];
      float mu = wave_sum(v.x + v.y + v.z + v.w, lane) * (1.f / 256.f);
      float dx = v.x - mu, dy = v.y - mu, dz = v.z - mu, dw = v.w - mu;
      float var = wave_sum(dx * dx + dy * dy + dz * dz + dw * dw, lane) * (1.f / 256.f);
      float rs = rsqrtf(var + EPS);
      float a = silu_f(dx * rs * g.x + bb.x), b = silu_f(dy * rs * g.y + bb.y), c = silu_f(dz * rs * g.z + bb.z), d = silu_f(dw * rs * g.w + bb.w);
      store4(p.CAT + (size_t)(row0 + t) * D + lane * 4, a, b, c, d);
    }
  }
  __syncthreads();
}

DI int kperm(int i) { return (i & 19) | ((i & 4) << 1) | ((i & 8) >> 1); }
DI int keyoff(int e, int h) { return (e & 3) + 4 * ((e >> 2) & 1) + 8 * h + 16 * (e >> 3); }
DI bf16x8 pack8(const f32x16& x, int s) {
  u32x4 r = {pack2(x[8 * s], x[8 * s + 1]), pack2(x[8 * s + 2], x[8 * s + 3]), pack2(x[8 * s + 4], x[8 * s + 5]), pack2(x[8 * s + 6], x[8 * s + 7])};
  return __builtin_bit_cast(bf16x8, r);
}

constexpr int NA_ITEMS = 6144 / 4;
DI void stage_na(const Params& p, int layer, int item) {
  const int lane = tid_now() & 63, wave = tid_now() >> 6, l31 = lane & 31, hh = lane >> 5;
  const int wi = item * 4 + wave;
  const int qhalf = wi & 1, head = (wi >> 1) % 6, br = wi / 12, r = br & 31, b = br >> 5;
  const int r0 = min(max(r - 4, 0), 24);
  const size_t hb = (size_t)(b * 6 + head);
  const bf16* Q = p.QN + (hb * SEQ2 + r * 64 + qhalf * 32 + l31) * 64;
  const bf16* Kb = p.KN + hb * SEQ2 * 64;
  const bf16* Vb = p.VNt + hb * 64 * SEQ2;
  const float* bias = p.na_rel_bias + ((size_t)layer * 6 + head) * 15 * 31;
  bf16x8 qf[4];
#pragma unroll
  for (int s = 0; s < 4; ++s) qf[s] = *(const bf16x8*)(Q + 16 * s + 8 * hh);
  f32x16 o[2];
#pragma unroll
  for (int e = 0; e < 16; ++e) { o[0][e] = 0.f; o[1][e] = 0.f; }
  float m = -1e30f, l = 0.f;
  const int qc = qhalf * 32 + l31;
  const int c0 = min(max(qc - 8, 0), 48);
  const int kp = kperm(l31);
#pragma unroll 1
  for (int t = 0; t < 24; ++t) {
    int key0, brow = 0, cs = 0;
    const bool local = t >= 8;
    if (!local) key0 = T + t * 32;
    else { brow = (t - 8) >> 1; cs = (t - 8) & 1; key0 = (r0 + brow) * 64 + cs * 32; }
    f32x16 st;
#pragma unroll
    for (int e = 0; e < 16; ++e) st[e] = 0.f;
    const bf16* kr = Kb + (size_t)(key0 + kp) * 64 + 8 * hh;
#pragma unroll
    for (int s = 0; s < 4; ++s) { bf16x8 kf = *(const bf16x8*)(kr + 16 * s); st = MFMA(kf, qf[s], st); }
    if (local) {
      const int rb = (r0 + brow) - r + 7;
#pragma unroll
      for (int e = 0; e < 16; ++e) {
        const int kc = cs * 32 + keyoff(e, hh);
        const bool valid = (kc >= c0) && (kc < c0 + 16);
        const int ci = min(max(kc - qc + 15, 0), 30);
        const float bv = (PROBE == 12) ? 0.f : bias[rb * 31 + ci];
        st[e] = valid ? st[e] + bv : -1e30f;
      }
    }
    float mx = st[0];
#pragma unroll
    for (int e = 1; e < 16; ++e) mx = fmaxf(mx, st[e]);
    mx = fmaxf(mx, shx(mx, 32, lane));
    const float mn = fmaxf(m, mx);
    const float alpha = exp2f((m - mn) * L2E);
    float ls = 0.f;
#pragma unroll
    for (int e = 0; e < 16; ++e) { st[e] = exp2f((st[e] - mn) * L2E); ls += st[e]; }
    l = l * alpha + ls; m = mn;
#pragma unroll
    for (int e = 0; e < 16; ++e) { o[0][e] *= alpha; o[1][e] *= alpha; }
    bf16x8 pf0 = pack8(st, 0), pf1 = pack8(st, 1);
#pragma unroll
    for (int dt = 0; dt < 2; ++dt) {
      const bf16* vr = Vb + (size_t)(dt * 32 + l31) * SEQ2 + key0 + 8 * hh;
      bf16x8 v0 = *(const bf16x8*)(vr), v1 = *(const bf16x8*)(vr + 16);
      o[dt] = MFMA(v0, pf0, o[dt]);
      o[dt] = MFMA(v1, pf1, o[dt]);
    }
  }
  l += shx(l, 32, lane);
  const float inv = (PROBE == 10) ? 0.f : 1.f / l;
  bf16* dst = p.CAT + (size_t)(b * T + r * 64 + qc) * D + 256 + head * 64;
#pragma unroll
  for (int dt = 0; dt < 2; ++dt)
#pragma unroll
    for (int g = 0; g < 4; ++g)
      store4(dst + dt * 32 + 8 * g + 4 * hh, o[dt][4 * g] * inv, o[dt][4 * g + 1] * inv, o[dt][4 * g + 2] * inv, o[dt][4 * g + 3] * inv);
}

constexpr int FA_SMEM = 2 * 2 * 64 * LROW;
DI void flash_block(const bf16* __restrict__ Q, const bf16* __restrict__ K, const bf16* __restrict__ Vt, int q0, int kt0, int kt1,
                    bf16* __restrict__ dst  , char* smem) {
  const int tid = tid_now(), lane = tid & 63, wave = tid >> 6, l31 = lane & 31, hh = lane >> 5;
  const int lrow = tid >> 3, kc = tid & 7;
  bf16x8 qf[4];
  const bf16* qp = Q + (size_t)(q0 + wave * 32 + l31) * 64 + 8 * hh;
#pragma unroll
  for (int s = 0; s < 4; ++s) qf[s] = *(const bf16x8*)(qp + 16 * s);
  f32x16 o[2];
#pragma unroll
  for (int e = 0; e < 16; ++e) { o[0][e] = 0.f; o[1][e] = 0.f; }
  float m = -1e30f, l = 0.f;
  const int kp = kperm(l31);
  u32x4 rk[2], rv[2];
#pragma unroll
  for (int i = 0; i < 2; ++i) {
    rk[i] = *(const u32x4*)(K + (size_t)(kt0 * 64 + lrow + 32 * i) * 64 + kc * 8);
    rv[i] = *(const u32x4*)(Vt + (size_t)(lrow + 32 * i) * SEQ2 + kt0 * 64 + kc * 8);
  }
  for (int kt = kt0; kt < kt1; ++kt) {
    char* sk = smem + ((kt - kt0) & 1) * 2 * 64 * LROW;
    char* sv = sk + 64 * LROW;
#pragma unroll
    for (int i = 0; i < 2; ++i) {
      *(u32x4*)(sk + (lrow + 32 * i) * LROW + kc * 16) = rk[i];
      *(u32x4*)(sv + (lrow + 32 * i) * LROW + kc * 16) = rv[i];
    }
    __syncthreads();
    if (kt + 1 < kt1) {
#pragma unroll
      for (int i = 0; i < 2; ++i) {
        rk[i] = *(const u32x4*)(K + (size_t)((kt + 1) * 64 + lrow + 32 * i) * 64 + kc * 8);
        rv[i] = *(const u32x4*)(Vt + (size_t)(lrow + 32 * i) * SEQ2 + (kt + 1) * 64 + kc * 8);
      }
    }
    f32x16 st[2];
#pragma unroll
    for (int k2 = 0; k2 < 2; ++k2) {
#pragma unroll
      for (int e = 0; e < 16; ++e) st[k2][e] = 0.f;
#pragma unroll
      for (int s = 0; s < 4; ++s) {
        bf16x8 kf = *(const bf16x8*)(sk + (k2 * 32 + kp) * LROW + (16 * s + 8 * hh) * 2);
        st[k2] = MFMA(kf, qf[s], st[k2]);
      }
    }
    float mx = st[0][0];
#pragma unroll
    for (int e = 1; e < 16; ++e) mx = fmaxf(mx, st[0][e]);
#pragma unroll
    for (int e = 0; e < 16; ++e) mx = fmaxf(mx, st[1][e]);
    mx = fmaxf(mx, shx(mx, 32, lane));
    const float mn = fmaxf(m, mx);
    const float alpha = exp2f((m - mn) * L2E);
    float ls = 0.f;
#pragma unroll
    for (int k2 = 0; k2 < 2; ++k2)
#pragma unroll
      for (int e = 0; e < 16; ++e) { st[k2][e] = exp2f((st[k2][e] - mn) * L2E); ls += st[k2][e]; }
    l = l * alpha + ls; m = mn;
#pragma unroll
    for (int e = 0; e < 16; ++e) { o[0][e] *= alpha; o[1][e] *= alpha; }
#pragma unroll
    for (int k2 = 0; k2 < 2; ++k2)
#pragma unroll
      for (int s2 = 0; s2 < 2; ++s2) {
        bf16x8 pf = pack8(st[k2], s2);
#pragma unroll
        for (int dt = 0; dt < 2; ++dt) {
          bf16x8 vf = *(const bf16x8*)(sv + (dt * 32 + l31) * LROW + (k2 * 32 + 16 * s2 + 8 * hh) * 2);
          o[dt] = MFMA(vf, pf, o[dt]);
        }
      }
  }
  l += shx(l, 32, lane);
  const float inv = (PROBE == 11) ? 0.f : 1.f / l;
  bf16* d2 = dst + (size_t)(wave * 32 + l31) * D;
#pragma unroll
  for (int dt = 0; dt < 2; ++dt)
#pragma unroll
    for (int g = 0; g < 4; ++g)
      store4(d2 + dt * 32 + 8 * g + 4 * hh, o[dt][4 * g] * inv, o[dt][4 * g + 1] * inv, o[dt][4 * g + 2] * inv, o[dt][4 * g + 3] * inv);
  __syncthreads();
}
constexpr int GQA_ITEMS = 16 * 6 * 16;
DI void stage_gqa(const Params& p, int item, char* smem) {
  const int qt = item & 15, hq = (item >> 4) % 6, b = item / 96;
  const int kvh = hq / 3;
  flash_block(p.QG + (size_t)(b * 6 + hq) * SEQ2 * 64, p.KG + (size_t)(b * 2 + kvh) * SEQ2 * 64, p.VGt + (size_t)(b * 2 + kvh) * 64 * SEQ2,
              qt * 128, 0, 36, p.CAT + (size_t)(b * T + qt * 128) * D + 640 + hq * 64, smem);
}
constexpr int CTXATT_ITEMS = 384;
DI void stage_ctxatt(const Params& p, int item, char* smem) {
  const int qt = item & 1, head = (item >> 1) % 6, which = (item / 12) & 1, b = item / 24;
  bf16* dst = p.CAT + (size_t)(NTOK + b * CL + qt * 128) * D;
  if (which == 0)
    flash_block(p.QN + (size_t)(b * 6 + head) * SEQ2 * 64, p.KN + (size_t)(b * 6 + head) * SEQ2 * 64, p.VNt + (size_t)(b * 6 + head) * 64 * SEQ2,
                T + qt * 128, 32, 36, dst + 256 + head * 64, smem);
  else
    flash_block(p.QG + (size_t)(b * 6 + head) * SEQ2 * 64, p.KG + (size_t)(b * 2 + head / 3) * SEQ2 * 64, p.VGt + (size_t)(b * 2 + head / 3) * 64 * SEQ2,
                T + qt * 128, 32, 36, dst + 640 + head * 64, smem);
}

constexpr int OUTPROJ_ITEMS = 288 * 8;
DI void stage_outproj(const Params& p, int layer, int item, char* smem) {
  const int mt = item >> 3, nt = item & 7;
  if (layer == 1 && mt >= 256) return;
  const int row0 = mt * 128, n0 = nt * 128;
  f32x16 acc[2][2];
  gemm_core<true>(p.CAT + (size_t)row0 * D, p.wout + ((size_t)layer * D + n0) * D, smem, acc);
  const int lane = tid_now() & 63, wave = tid_now() >> 6, wm = wave >> 1, wn = wave & 1, l31 = lane & 31, hh = lane >> 5;
  const float* g1 = p.mod + ((size_t)layer * 17 + mod_row(row0)) * 6144 + 2048;
#pragma unroll
  for (int tt = 0; tt < 2; ++tt) {
    const int row = row0 + wm * 64 + tt * 32 + l31;
    const float* xr = xin_row(p, layer, row);
    float* dr = xres_row(p, row);
#pragma unroll
    for (int ft = 0; ft < 2; ++ft)
#pragma unroll
      for (int g = 0; g < 4; ++g) {
        const int n = n0 + wn * 64 + ft * 32 + 8 * g + 4 * hh;
        float4 xv = *(const float4*)(xr + n), gv = *(const float4*)(g1 + n);
        if (PROBE == 2) { gv.x = gv.y = gv.z = gv.w = 0.f; }
        float4 o = {xv.x + gv.x * acc[ft][tt][4 * g], xv.y + gv.y * acc[ft][tt][4 * g + 1], xv.z + gv.z * acc[ft][tt][4 * g + 2], xv.w + gv.w * acc[ft][tt][4 * g + 3]};
        *(float4*)(dr + n) = o;
      }
  }
}

constexpr int ROUTE_ITEMS = 288 * 8;
constexpr int QROW = 272;
DI int to_sortable(int b) { return b ^ ((b >> 31) & 0x7fffffff); }

#define CAND_LIST(X) \
  X(0,0,0) X(1,0,1) X(2,0,2) X(3,0,3) X(4,0,4) X(5,0,5) X(6,0,6) X(7,0,7) X(8,0,8) X(9,0,9) X(10,0,10) X(11,0,11) X(12,0,12) X(13,0,13) X(14,0,14) X(15,0,15) \
  X(16,1,1) X(17,1,2) X(18,1,3) X(19,1,4) X(20,1,5) X(21,1,6) X(22,1,7) \
  X(23,2,2) X(24,2,3) X(25,2,4) \
  X(26,3,3)

DI void stage_route(const Params& p, int layer, int item, char* smem) {
  const int mt = item >> 3, head = item & 7;
  if (layer == 1 && mt >= 256) return;
  const int row0 = mt * 128;
  const int tid = tid_now(), lane = tid & 63, wave = tid >> 6, wm = wave >> 1, wn = wave & 1, l31 = lane & 31, hh = lane >> 5;
  int topk[2][16];
  char* Qs = smem;
  char* Ks = smem + 2 * LTILE;
#pragma unroll
  for (int pp = 0; pp < 2; ++pp) {
    {
      f32x16 acc[2][2];
      gemm_core<true>(p.H + (size_t)row0 * D, p.wq + ((size_t)layer * 2048 + (head * 2 + pp) * 128) * D, smem, acc);
#pragma unroll
      for (int tt = 0; tt < 2; ++tt)
#pragma unroll
        for (int ft = 0; ft < 2; ++ft)
#pragma unroll
          for (int g = 0; g < 4; ++g) {
            const int tok = wm * 64 + tt * 32 + l31, kf = wn * 64 + ft * 32 + 8 * g + 4 * hh;
            u32x2 o = {pack2(acc[ft][tt][4 * g], acc[ft][tt][4 * g + 1]), pack2(acc[ft][tt][4 * g + 2], acc[ft][tt][4 * g + 3])};
            *(u32x2*)(Qs + tok * QROW + kf * 2) = o;
          }
    }
    const bf16* kp = p.pk + ((size_t)((layer * 8 + head) * 2 + pp) * 128) * 128;
#pragma unroll
    for (int i = 0; i < 8; ++i) {
      const int c = tid + 256 * i, n = c >> 4, kc = c & 15;
      *(u32x4*)(Ks + n * QROW + kc * 16) = *(const u32x4*)(kp + n * 128 + kc * 8);
    }
    __syncthreads();
    int key[64];
    {
      f32x16 sc[4];
#pragma unroll
      for (int nt = 0; nt < 4; ++nt)
#pragma unroll
        for (int e = 0; e < 16; ++e) sc[nt][e] = 0.f;
#pragma unroll
      for (int s = 0; s < 8; ++s) {
        bf16x8 qb = *(const bf16x8*)(Qs + (wave * 32 + l31) * QROW + (16 * s + 8 * hh) * 2);
#pragma unroll
        for (int nt = 0; nt < 4; ++nt) {
          bf16x8 ka = *(const bf16x8*)(Ks + (nt * 32 + l31) * QROW + (16 * s + 8 * hh) * 2);
          sc[nt] = MFMA(ka, qb, sc[nt]);
        }
      }
#pragma unroll
      for (int nt = 0; nt < 4; ++nt)
#pragma unroll
        for (int e = 0; e < 16; ++e) {
          const int n = nt * 32 + crow(e, hh);
          int b = (__float_as_int(sc[nt][e]) & ~127) | n;
          key[nt * 16 + e] = to_sortable(b);
        }
    }
#pragma unroll
    for (int r = 0; r < 16; ++r) {
      int mx = key[0];
#pragma unroll
      for (int i = 1; i < 64; ++i) mx = max(mx, key[i]);
      mx = max(mx, shxi(mx, 32, lane));
      topk[pp][r] = mx;
#pragma unroll
      for (int i = 0; i < 64; ++i) key[i] = (key[i] == mx) ? (int)0x80000000 : key[i];
    }
    __syncthreads();
  }
  float av[16], bv[16]; int ai[16], bi[16];
#pragma unroll
  for (int i = 0; i < 16; ++i) {
    int k1 = to_sortable(topk[0][i]), k2 = to_sortable(topk[1][i]);
    int a = hh ? k2 : k1, b = hh ? k1 : k2;
    av[i] = __int_as_float(a & ~127); ai[i] = a & 127;
    bv[i] = __int_as_float(b & ~127); bi[i] = b & 127;
  }
  int cand[27], eid[27];
#define MKC(c, i, j) { int b = __float_as_int(av[i] + bv[j]); cand[c] = (to_sortable(b) & ~63) | (c * 2 + hh); \
                       eid[c] = hh ? (bi[j] * 128 + ai[i]) : (ai[i] * 128 + bi[j]); \
                       if (i == j && hh) cand[c] = (int)0x80000000; }
  CAND_LIST(MKC)
#undef MKC
  int win[16], weid[16];
#pragma unroll
  for (int r = 0; r < 16; ++r) {
    int mx = cand[0];
#pragma unroll
    for (int c = 1; c < 27; ++c) mx = max(mx, cand[c]);
    mx = max(mx, shxi(mx, 32, lane));
    int e = 0;
#pragma unroll
    for (int c = 0; c < 27; ++c) { const bool hit = cand[c] == mx; e = hit ? eid[c] : e; cand[c] = hit ? (int)0x80000000 : cand[c]; }
    e |= shxi(e, 32, lane);
    win[r] = mx; weid[r] = e;
  }
  float gsum = 0.f, gv[16];
  const float v0 = __int_as_float(to_sortable(win[0]) & ~63);
#pragma unroll
  for (int r = 0; r < 16; ++r) { gv[r] = __expf(__int_as_float(to_sortable(win[r]) & ~63) - v0); gsum += gv[r]; }
  const float ginv = 1.f / gsum;
  const int row = row0 + wave * 32 + l31;
  if (hh == 0) {
    int4* d = (int4*)(p.ridx + ((size_t)row * 8 + head) * 16);
#pragma unroll
    for (int q = 0; q < 4; ++q) { int4 o = {weid[4 * q], weid[4 * q + 1], weid[4 * q + 2], weid[4 * q + 3]}; d[q] = o; }
  } else {
    float4* d = (float4*)(p.rg + ((size_t)row * 8 + head) * 16);
#pragma unroll
    for (int q = 0; q < 4; ++q) { float4 o = {gv[4 * q] * ginv, gv[4 * q + 1] * ginv, gv[4 * q + 2] * ginv, gv[4 * q + 3] * ginv}; d[q] = o; }
  }
}

DI float dot2(unsigned a, unsigned b, float acc) {
  bf2_t x = __builtin_bit_cast(bf2_t, a), y = __builtin_bit_cast(bf2_t, b);
  return __builtin_amdgcn_fdot2_f32_bf16(x, y, acc, false);
}
DI float dot8(u32x4 a, u32x4 b, float acc) {
  const unsigned a0 = a[0], a1 = a[1], a2 = a[2], a3 = a[3], b0 = b[0], b1 = b[1], b2 = b[2], b3 = b[3];
  acc = dot2(a0, b0, acc); acc = dot2(a1, b1, acc); acc = dot2(a2, b2, acc); acc = dot2(a3, b3, acc);
  return acc;
}
DI void axpy8(float (&o)[8], float w, u32x4 v) {
  o[0] += w * bf_lo(v.x); o[1] += w * bf_hi(v.x); o[2] += w * bf_lo(v.y); o[3] += w * bf_hi(v.y);
  o[4] += w * bf_lo(v.z); o[5] += w * bf_hi(v.z); o[6] += w * bf_lo(v.w); o[7] += w * bf_hi(v.w);
}
constexpr int GATHER_ITEMS = MTOT / 4;
DI float dot4f8(unsigned u, unsigned hlo, unsigned hhi, float acc) {
  bf2_t a = __builtin_amdgcn_cvt_scalef32_pk_bf16_fp8((int)u, 1.0f, false);
  bf2_t b = __builtin_amdgcn_cvt_scalef32_pk_bf16_fp8((int)u, 1.0f, true);
  bf2_t x = __builtin_bit_cast(bf2_t, hlo), y = __builtin_bit_cast(bf2_t, hhi);
  acc = __builtin_amdgcn_fdot2_f32_bf16(a, x, acc, false);
  acc = __builtin_amdgcn_fdot2_f32_bf16(b, y, acc, false);
  return acc;
}
DI void axpy4f8(float& o0, float& o1, float& o2, float& o3, float w, unsigned v) {
  f2_t lo = __builtin_amdgcn_cvt_pk_f32_fp8((int)v, false), hi = __builtin_amdgcn_cvt_pk_f32_fp8((int)v, true);
  o0 += w * lo[0]; o1 += w * lo[1]; o2 += w * hi[0]; o3 += w * hi[1];
}
DI void stage_gather(const Params& p, int layer, int item) {
  const int lane = tid_now() & 63, wave = tid_now() >> 6;
  const int row = item * 4 + wave;
  if (layer == 1 && row >= NTOK) return;
  const int idxA = p.ridx[(size_t)row * 128 + lane], idxB = p.ridx[(size_t)row * 128 + 64 + lane];
  const float gA = p.rg[(size_t)row * 128 + lane], gB = p.rg[(size_t)row * 128 + 64 + lane];
  const bf16* hr = p.H + (size_t)row * D + lane * 16;
  const u32x4 hA = *(const u32x4*)(hr), hB = *(const u32x4*)(hr + 8);
  const unsigned h0 = hA[0], h1 = hA[1], h2 = hA[2], h3 = hA[3], h4 = hB[0], h5 = hB[1], h6 = hB[2], h7 = hB[3];
  float o[16];
#pragma unroll
  for (int i = 0; i < 16; ++i) o[i] = 0.f;
  const __amdgpu_buffer_rsrc_t rU = __builtin_amdgcn_make_buffer_rsrc((void*)(p.pu8 + (size_t)layer * NEXP * D), 0, NEXP * D, 0x00020000);
  const __amdgpu_buffer_rsrc_t rV = __builtin_amdgcn_make_buffer_rsrc((void*)(p.pv8 + (size_t)layer * NEXP * D), 0, NEXP * D, 0x00020000);
  const int voff = lane * 16;
  u32x4 ua[16], va[16];
#pragma unroll
  for (int k = 0; k < 16; ++k) {
    const int e = __builtin_amdgcn_readlane(idxA, k);
    ua[k] = __builtin_amdgcn_raw_buffer_load_b128(rU, voff, e * D, 0);
  }
#pragma unroll
  for (int k = 0; k < 16; ++k) {
    const int e = __builtin_amdgcn_readlane(idxA, k);
    va[k] = __builtin_amdgcn_raw_buffer_load_b128(rV, voff, e * D, 0);
  }
#pragma unroll
  for (int head = 0; head < 8; ++head) {
    float part[16];
#pragma unroll
    for (int k = 0; k < 16; ++k) {
      const unsigned a0 = ua[k][0], a1 = ua[k][1], a2 = ua[k][2], a3 = ua[k][3];
      float s = dot4f8(a0, h0, h1, 0.f);
      s = dot4f8(a1, h2, h3, s); s = dot4f8(a2, h4, h5, s); s = dot4f8(a3, h6, h7, s);
      part[k] = s;
    }
    if (head < 7) {
#pragma unroll
      for (int k = 0; k < 16; ++k) {
        const int e = __builtin_amdgcn_readlane((head + 1) < 4 ? idxA : idxB, ((head + 1) & 3) * 16 + k);
        ua[k] = __builtin_amdgcn_raw_buffer_load_b128(rU, voff, e * D, 0);
      }
    }
    float r8[8], r4[4], r2[2], r1;
    {
      const bool up = lane & 32;
#pragma unroll
      for (int k = 0; k < 8; ++k) { float keep = up ? part[k + 8] : part[k], give = up ? part[k] : part[k + 8]; r8[k] = keep + shx(give, 32, lane); }
    }
    {
      const bool up = lane & 16;
#pragma unroll
      for (int k = 0; k < 4; ++k) { float keep = up ? r8[k + 4] : r8[k], give = up ? r8[k] : r8[k + 4]; r4[k] = keep + shx(give, 16, lane); }
    }
    {
      const bool up = lane & 8;
#pragma unroll
      for (int k = 0; k < 2; ++k) { float keep = up ? r4[k + 2] : r4[k], give = up ? r4[k] : r4[k + 2]; r2[k] = keep + shx(give, 8, lane); }
    }
    {
      const bool up = lane & 4;
      float keep = up ? r2[1] : r2[0], give = up ? r2[0] : r2[1];
      r1 = keep + shx(give, 4, lane);
    }
    r1 += shx(r1, 2, lane);
    r1 += shx(r1, 1, lane);
    const float myg = __int_as_float(__builtin_amdgcn_ds_bpermute(((head & 3) * 16 + ((lane >> 2) & 15)) << 2, __float_as_int(head < 4 ? gA : gB)));
    const float w = gelu_tanh(r1 * (1.f / SU)) * myg * (1.f / SV);
#pragma unroll
    for (int k = 0; k < 16; ++k) {
      const float wk = __int_as_float(__builtin_amdgcn_readlane(__float_as_int(w), k << 2));
      const unsigned a0 = va[k][0], a1 = va[k][1], a2 = va[k][2], a3 = va[k][3];
      axpy4f8(o[0], o[1], o[2], o[3], wk, a0); axpy4f8(o[4], o[5], o[6], o[7], wk, a1);
      axpy4f8(o[8], o[9], o[10], o[11], wk, a2); axpy4f8(o[12], o[13], o[14], o[15], wk, a3);
    }
    if (head < 7) {
#pragma unroll
      for (int k = 0; k < 16; ++k) {
        const int e = __builtin_amdgcn_readlane((head + 1) < 4 ? idxA : idxB, ((head + 1) & 3) * 16 + k);
        va[k] = __builtin_amdgcn_raw_buffer_load_b128(rV, voff, e * D, 0);
      }
    }
  }
  const float* g2 = p.mod + ((size_t)layer * 17 + mod_row(row)) * 6144 + 5120 + lane * 16;
  float* dr = xres_row(p, row) + lane * 16;
#pragma unroll
  for (int q = 0; q < 4; ++q) {
    float4 xv = *(const float4*)(dr + 4 * q), gv = *(const float4*)(g2 + 4 * q);
    float4 r = {xv.x + gv.x * o[4 * q], xv.y + gv.y * o[4 * q + 1], xv.z + gv.z * o[4 * q + 2], xv.w + gv.w * o[4 * q + 3]};
    *(float4*)(dr + 4 * q) = r;
  }
}

#include <hip/hip_cooperative_groups.h>
namespace cg = cooperative_groups;
constexpr int SMEM_BYTES = GEMM_SMEM;


#define XB_TMO      128
#define XB_XCNT(j)  (256  + 64 * (j))
#define XB_XSUB(j)  (1280 + 64 * (j))
#define XB_XGEN(j)  (2304 + 64 * (j))
#define XB_TOP      3328
#define XB_TOPGEN   3392
#define XCD_BAR_WORDS 3456
#define XB_SPIN_CAP (1u << 22)
#define LAS __attribute__((address_space(3)))
DI unsigned xb_ld(unsigned* p) { return __hip_atomic_load(p, __ATOMIC_RELAXED, __HIP_MEMORY_SCOPE_AGENT); }
DI unsigned xb_add(unsigned* p, unsigned v) { return __hip_atomic_fetch_add(p, v, __ATOMIC_RELAXED, __HIP_MEMORY_SCOPE_AGENT); }
DI unsigned xb_xcc_id() { return (unsigned)__builtin_amdgcn_s_getreg((3 << 11) | 20) & 0xFu; }
#define XB_SPIN(cond, bar) do { unsigned _sp = 0; while (cond) { __builtin_amdgcn_s_sleep(1); \
    if ((++_sp & 255u) == 0u) { if (xb_ld(&(bar)[XB_TMO])) break; if (_sp > XB_SPIN_CAP) { atomicAdd(&(bar)[XB_TMO], 1u); break; } } } } while (0)
struct XcdBarrier { unsigned* bar; unsigned x; volatile LAS unsigned* st; };
DI XcdBarrier xcd_barrier_post(unsigned* bar, volatile LAS unsigned* st) {
  XcdBarrier b; b.bar = bar; b.x = xb_xcc_id(); b.st = st;
  if (tid_now() == 0) (void)xb_add(&bar[XB_XCNT(b.x)], 1u);
  return b;
}
DI void xcd_barrier_complete(unsigned* bar, unsigned x, unsigned& nloc, unsigned& nx) {
  const unsigned G = gridDim.x;
  unsigned sum, cnt, mine, sp = 0u;
  for (;;) {
    sum = 0u; cnt = 0u; mine = 0u;
#pragma unroll
    for (unsigned j = 0; j < 16; ++j) { const unsigned c = xb_ld(&bar[XB_XCNT(j)]); sum += c; cnt += (c > 0u) ? 1u : 0u; mine = (j == x) ? c : mine; }
    if (sum == G) break;
    __builtin_amdgcn_s_sleep(1);
    if ((++sp & 255u) == 0u) { if (xb_ld(&bar[XB_TMO])) break; if (sp > XB_SPIN_CAP) { atomicAdd(&bar[XB_TMO], 1u); break; } }
  }
  nloc = mine > 0u ? mine : 1u; nx = cnt > 0u ? cnt : 1u;
}
DI void xcd_barrier(const XcdBarrier& b) {
  asm volatile("s_waitcnt vmcnt(0)" ::: "memory");
  __syncthreads();
  if (tid_now() == 0) {
    unsigned* bar = b.bar;
    __builtin_amdgcn_s_waitcnt(0);
    unsigned nloc = b.st[0], nx = b.st[1];
    if (nloc == 0u) { xcd_barrier_complete(bar, b.x, nloc, nx); b.st[0] = nloc; b.st[1] = nx; }
    const unsigned old = xb_add(&bar[XB_XSUB(b.x)], 1u);
    const unsigned gen = old / nloc;
    if (old + 1u == (gen + 1u) * nloc) {
      __builtin_amdgcn_fence(__ATOMIC_RELEASE, "agent");
      asm volatile("s_waitcnt vmcnt(0)" ::: "memory");
      const unsigned og = xb_add(&bar[XB_TOP], 1u);
      const unsigned tg = og / nx;
      if (og + 1u == (tg + 1u) * nx) xb_add(&bar[XB_TOPGEN], 1u);
      else XB_SPIN(xb_ld(&bar[XB_TOPGEN]) == tg, bar);
      __builtin_amdgcn_fence(__ATOMIC_ACQUIRE, "agent");
      xb_add(&bar[XB_XGEN(b.x)], 1u);
      asm volatile("s_waitcnt vmcnt(0)" ::: "memory");
    } else {
      XB_SPIN(xb_ld(&bar[XB_XGEN(b.x)]) == gen, bar);
      __builtin_amdgcn_fence(__ATOMIC_ACQUIRE, "agent");
      asm volatile("s_waitcnt vmcnt(0)" ::: "memory");
    }
  }
  __syncthreads();
}

#define GRID_BARRIER() xcd_barrier(xb)
#define REP(k) for (int rep_ = 0; rep_ < (DUP == (k) ? 2 : 1); ++rep_)

__global__ void __launch_bounds__(256, 2) mega_kernel(Params p) {
  __shared__ __attribute__((aligned(16))) char smem[SMEM_BYTES];
  cg::grid_group grid = cg::this_grid();
  const int G = gridDim.x, bid = blockIdx.x;
  __shared__ uint4 xb_words;
  if (tid_now() == 0) xb_words = make_uint4(0u, 0u, 0u, 0u);
  if (bid == 0) for (int i = tid_now(); i < XCD_BAR_WORDS; i += 256) p.bar[i] = 0u;
  REP(1) for (int it = bid; it < MODP_ITEMS + CONVT_ITEMS + CONVS_ITEMS + 1; it += G) {
    if (it < MODP_ITEMS) stage_mod_partial(p, it, smem);
    else if (it < MODP_ITEMS + CONVT_ITEMS) stage_convT(p, it - MODP_ITEMS, smem);
    else if (it < MODP_ITEMS + CONVT_ITEMS + CONVS_ITEMS) stage_convS(p, it - MODP_ITEMS - CONVT_ITEMS);
    else stage_rope(p);
  }
  grid.sync();
  XcdBarrier xb = xcd_barrier_post(p.bar, (volatile LAS unsigned*)&xb_words);
  for (int it = bid; it < MODR_ITEMS; it += G) stage_mod_reduce(p, it);
  GRID_BARRIER();
#pragma unroll 1
  for (int l = 0; l < 2; ++l) {
    REP(2) for (int it = bid; it < MTOT / 4; it += G) stage_norm(p, l, 0, it);
    GRID_BARRIER();
    {
      const int n = l == 0 ? INPROJ_ITEMS : 256 * 18 + 32 * 8;
      REP(3) for (int it = bid; it < n; it += G) {
        int item = it;
        if (it >= 256 * 18) { const int r = it - 256 * 18; item = l == 0 ? it : (256 + (r >> 3)) * 18 + 10 + (r & 7); }
        stage_inproj(p, l, item, smem);
      }
    }
    GRID_BARRIER();
    {
      const int nconv = l == 0 ? 1152 : 1024, nctx = l == 0 ? CTXATT_ITEMS : 0;
      const int n = GQA_ITEMS + NA_ITEMS + nconv + nctx;
      REP(4) for (int it = bid; it < n; it += G) {
        if (it < GQA_ITEMS) { if (DUP != 41 && DUP != 42) stage_gqa(p, it, smem); if (DUP == 40) stage_gqa(p, it, smem); }
        else if (it < GQA_ITEMS + NA_ITEMS) { stage_na(p, l, it - GQA_ITEMS); if (DUP == 43) stage_na(p, l, it - GQA_ITEMS); }
        else if (it < GQA_ITEMS + NA_ITEMS + nconv) { stage_conv(p, l, it - GQA_ITEMS - NA_ITEMS, smem); if (DUP == 44) stage_conv(p, l, it - GQA_ITEMS - NA_ITEMS, smem); }
        else stage_ctxatt(p, it - GQA_ITEMS - NA_ITEMS - nconv, smem);
      }
    }
    GRID_BARRIER();
    {
      const int n = (l == 0 ? 288 : 256) * 8;
      for (int it = bid; it < n; it += G) stage_outproj(p, l, it, smem);
    }
    GRID_BARRIER();
    {
      const int n = (l == 0 ? MTOT : NTOK) / 4;
      REP(6) for (int it = bid; it < n; it += G) stage_norm(p, l, 1, it);
    }
    GRID_BARRIER();
    {
      const int n = (l == 0 ? 288 : 256) * 8;
      REP(7) for (int it = bid; it < n; it += G) stage_route(p, l, it, smem);
    }
    GRID_BARRIER();
    {
      const int n = (l == 0 ? MTOT : NTOK) / 4;
      for (int it = bid; it < n; it += G) stage_gather(p, l, it);
    }
    GRID_BARRIER();
  }
  for (int it = bid; it < NTOK / 4; it += G) stage_final(p, it);
}

extern "C" void kernel_launch(void* const* d_in, const int* in_sizes, int n_in, void* d_out, int out_size, void* d_ws, size_t ws_size,
                              hipStream_t stream) {
  Params p{};
  const float** f = (const float**)&p;
  for (int i = 0; i < 22; ++i) f[i] = (const float*)d_in[i];
  p.out = (float*)d_out;
  char* w = (char*)d_ws; size_t off = 0;
  auto take = [&](size_t bytes) { char* r = w + off; off += (bytes + 255) & ~(size_t)255; return r; };
  p.win = (bf16*)take((size_t)2 * INC * D * 2);
  p.wout = (bf16*)take((size_t)2 * D * D * 2);
  p.wq = (bf16*)take((size_t)2 * 2048 * D * 2);
  p.pk = (bf16*)take(PK_N * 2);
  p.pu8 = (unsigned char*)take(PU_N);
  p.pv8 = (unsigned char*)take(PU_N);
  p.modp = (float*)take((size_t)2 * 8 * 17 * 6144 * 4);
  p.mod = (float*)take((size_t)2 * 17 * 6144 * 4);
  p.ropetab = (float*)take(64 * 16 * 2 * 4);
  p.H = (bf16*)take((size_t)MTOT * D * 2);
  p.CAT = p.H;
  p.U = (bf16*)take((size_t)MTOT * 256 * 2);
  p.QN = (bf16*)take((size_t)NB * 6 * SEQ2 * 64 * 2);
  p.KN = (bf16*)take((size_t)NB * 6 * SEQ2 * 64 * 2);
  p.VNt = (bf16*)take((size_t)NB * 6 * SEQ2 * 64 * 2);
  p.QG = (bf16*)take((size_t)NB * 6 * SEQ2 * 64 * 2);
  p.KG = (bf16*)take((size_t)NB * 2 * SEQ2 * 64 * 2);
  p.VGt = (bf16*)take((size_t)NB * 2 * SEQ2 * 64 * 2);
  p.XC = (float*)take((size_t)NCTX * D * 4);
  p.ridx = (int*)take((size_t)MTOT * 128 * 4);
  p.rg = (float*)take((size_t)MTOT * 128 * 4);
  p.bar = (unsigned*)take(XCD_BAR_WORDS * 4);
  if (off > ws_size) return;
  static int grid_blocks = 0;
  if (!grid_blocks) {
    int dev = 0, cus = 0, per_cu = 0;
    hipGetDevice(&dev);
    hipDeviceGetAttribute(&cus, hipDeviceAttributeMultiprocessorCount, dev);
    hipOccupancyMaxActiveBlocksPerMultiprocessor(&per_cu, mega_kernel, 256, 0);
    if (per_cu > 2) per_cu = 2;
    grid_blocks = cus * per_cu;
  }
  void* args[] = {&p};
  hipLaunchCooperativeKernel((void*)mega_kernel, dim3(grid_blocks), dim3(256), args, 0, stream);
}
```

```cpp
#include <hip/hip_runtime.h>
#include <stdint.h>

typedef __attribute__((ext_vector_type(8))) short bf16x8;
typedef __attribute__((ext_vector_type(16))) float f32x16;
typedef __attribute__((ext_vector_type(2))) __bf16 bf2_t;
typedef __attribute__((ext_vector_type(2))) float f2_t;
typedef unsigned short bf16;
typedef __attribute__((ext_vector_type(4))) unsigned u32x4;
typedef __attribute__((ext_vector_type(2))) unsigned u32x2;

#define DI __device__ __forceinline__
#ifndef PROBE
#define PROBE 0
#endif
#ifndef DUP
#define DUP 0
#endif
#define MFMA(a, b, c) __builtin_amdgcn_mfma_f32_32x32x16_bf16((a), (b), (c), 0, 0, 0)

constexpr int D = 1024, NB = 16, T = 2048, CL = 256;
constexpr int NTOK = NB * T;
constexpr int NCTX = NB * CL;
constexpr int MTOT = NTOK + NCTX;
constexpr int INC = 2304;
constexpr int SEQ2 = T + CL;
constexpr int NEXP = 16384;
constexpr float EPS = 1e-6f;
constexpr float L2E = 1.4426950408889634f;

struct Params {
  const float *x, *c, *ctx, *c_ctx, *norm1_g, *norm2_g, *w_ada, *b_ada, *w_in, *conv_w, *conv_b, *conv_ln_g,
      *conv_ln_b, *na_rel_bias, *gqa_q_norm, *gqa_k_norm, *w_out, *peer_w_q, *peer_keys, *peer_u, *peer_v, *final_norm_g;
  float* out;
  bf16 *win, *wout, *wq, *pk;
  unsigned char *pu8, *pv8;
  float *modp, *mod, *ropetab;
  bf16 *H, *U, *QN, *KN, *VNt, *QG, *KG, *VGt, *CAT;
  float *XC;
  int* ridx;
  float* rg;
  unsigned* bar;
};

DI int tid_now() { int t; asm volatile("v_mov_b32 %0, %1" : "=v"(t) : "v"((int)__builtin_amdgcn_workitem_id_x())); return t; }
DI unsigned pack2(float a, float b) {
  f2_t v = {a, b};
  bf2_t r = __builtin_convertvector(v, bf2_t);
  return __builtin_bit_cast(unsigned, r);
}
DI float bf_lo(unsigned u) { return __uint_as_float(u << 16); }
DI float bf_hi(unsigned u) { return __uint_as_float(u & 0xffff0000u); }
DI int crow(int e, int h) { return (e & 3) + 8 * (e >> 2) + 4 * h; }
DI float fexp2(float x) { return __builtin_amdgcn_exp2f(x); }
DI float silu_f(float x) { return x / (1.f + __expf(-x)); }
DI float sigmoid_f(float x) { return 1.f / (1.f + __expf(-x)); }
DI float gelu_tanh(float x) {
  float u = 0.7978845608028654f * (x + 0.044715f * x * x * x);
  float t = 1.f - 2.f / (1.f + __expf(2.f * u));
  return 0.5f * x * (1.f + t);
}
DI float shx(float v, int m, int lane) { return __int_as_float(__builtin_amdgcn_ds_bpermute((lane ^ m) << 2, __float_as_int(v))); }
DI int shxi(int v, int m, int lane) { return __builtin_amdgcn_ds_bpermute((lane ^ m) << 2, v); }
DI float wave_sum(float v, int lane) {
#pragma unroll
  for (int o = 32; o >= 1; o >>= 1) v += shx(v, o, lane);
  return v;
}
DI float* xres_row(const Params& p, int row) { return row < NTOK ? p.out + (size_t)row * D : p.XC + (size_t)(row - NTOK) * D; }
DI const float* xin_row(const Params& p, int layer, int row) {
  if (layer == 0) return row < NTOK ? p.x + (size_t)row * D : p.ctx + (size_t)(row - NTOK) * D;
  return xres_row(p, row);
}
DI int mod_row(int row) { return row < NTOK ? (row >> 11) : 16; }
DI int batch_of(int row) { return row < NTOK ? (row >> 11) : ((row - NTOK) >> 8); }
DI int pos_of(int row) { return row < NTOK ? (row & 2047) : (T + ((row - NTOK) & 255)); }

DI int perm_in(int n) {
  if (n >= 512) return n;
  int c = n >> 6, w = n & 63;
  return w < 32 ? 32 * c + w : 256 + 32 * c + (w - 32);
}
DI void convT_tile(const float* __restrict__ src, bf16* __restrict__ dst, int K, int N, int k0, int n0, bool perm, float* tile  ) {
  const int tx = tid_now() & 63, ty = tid_now() >> 6;
  const int ns = perm ? perm_in(n0 + tx) : n0 + tx;
#pragma unroll
  for (int i = 0; i < 16; ++i) { int k = ty + 4 * i; tile[k * 65 + tx] = src[(size_t)(k0 + k) * N + ns]; }
  __syncthreads();
#pragma unroll
  for (int i = 0; i < 16; ++i) {
    int n = ty + 4 * i;
    dst[(size_t)(n0 + n) * K + k0 + tx] = (bf16)(pack2(tile[tx * 65 + n], 0.f) & 0xffff);
  }
  __syncthreads();
}
constexpr int CONVT_ITEMS = 2 * 1344;
DI void stage_convT(const Params& p, int item, char* smem) {
  float* tile = (float*)smem;
  int l = item / 1344, r = item % 1344;
  if (r < 576) { int kt = r / 36, nt = r % 36; convT_tile(p.w_in + (size_t)l * D * INC, p.win + (size_t)l * INC * D, D, INC, kt * 64, nt * 64, true, tile); }
  else if (r < 832) { r -= 576; int kt = r / 16, nt = r % 16; convT_tile(p.w_out + (size_t)l * D * D, p.wout + (size_t)l * D * D, D, D, kt * 64, nt * 64, false, tile); }
  else { r -= 832; int kt = r / 32, nt = r % 32; convT_tile(p.peer_w_q + (size_t)l * D * 2048, p.wq + (size_t)l * 2048 * D, D, 2048, kt * 64, nt * 64, false, tile); }
}
constexpr size_t PK_N = (size_t)2 * 16 * 128 * 128, PU_N = (size_t)2 * NEXP * D;
constexpr float SU = 1024.f, SV = 64.f;
constexpr int CONVK_ITEMS = (int)(PK_N / 2048), CONVUV_ITEMS = (int)(PU_N / 4096);
constexpr int CONVS_ITEMS = CONVK_ITEMS + 2 * CONVUV_ITEMS;
DI unsigned pack_fp8x4(float4 a, float s) {
  int r = 0;
  r = __builtin_amdgcn_cvt_pk_fp8_f32(a.x * s, a.y * s, r, false);
  r = __builtin_amdgcn_cvt_pk_fp8_f32(a.z * s, a.w * s, r, true);
  return (unsigned)r;
}
DI void stage_convS(const Params& p, int item) {
  if (item < CONVK_ITEMS) {
    size_t e = (size_t)item * 2048 + tid_now() * 8;
    const float* src = p.peer_keys + e;
    float4 a = ((const float4*)src)[0], b = ((const float4*)src)[1];
    u32x4 o = {pack2(a.x, a.y), pack2(a.z, a.w), pack2(b.x, b.y), pack2(b.z, b.w)};
    *(u32x4*)(p.pk + e) = o;
    return;
  }
  item -= CONVK_ITEMS;
  const bool isv = item >= CONVUV_ITEMS;
  if (isv) item -= CONVUV_ITEMS;
  size_t e = (size_t)item * 4096 + tid_now() * 16;
  const float* src = (isv ? p.peer_v : p.peer_u) + e;
  const float s = isv ? SV : SU;
  float4 a = ((const float4*)src)[0], b = ((const float4*)src)[1], c = ((const float4*)src)[2], d = ((const float4*)src)[3];
  u32x4 o = {pack_fp8x4(a, s), pack_fp8x4(b, s), pack_fp8x4(c, s), pack_fp8x4(d, s)};
  *(u32x4*)((isv ? p.pv8 : p.pu8) + e) = o;
}
DI void stage_rope(const Params& p) {
  for (int i = tid_now(); i < 64 * 16; i += 256) {
    int pos = i >> 4, f = i & 15;
    float inv = powf(10000.f, -(float)f / 16.f);
    float ang = (float)pos * inv;
    p.ropetab[2 * i] = cosf(ang); p.ropetab[2 * i + 1] = sinf(ang);
  }
}

constexpr int MODP_ITEMS = 2 * 8 * 24;
DI void stage_mod_partial(const Params& p, int item, char* smem) {
  float* sc = (float*)smem;
  int l = item / 192, r = item % 192, kc = r / 24, nc = r % 24;
  for (int i = tid_now(); i < 17 * 128; i += 256) {
    int rr = i >> 7, k = i & 127;
    float v = rr < 16 ? p.c[rr * D + kc * 128 + k] : p.c_ctx[kc * 128 + k];
    sc[i] = silu_f(v);
  }
  __syncthreads();
  float acc[17];
#pragma unroll
  for (int i = 0; i < 17; ++i) acc[i] = 0.f;
  const int n = nc * 256 + tid_now();
  const float* w = p.w_ada + ((size_t)l * D + kc * 128) * 6144 + n;
  for (int k = 0; k < 128; ++k) {
    float wv = w[(size_t)k * 6144];
#pragma unroll
    for (int i = 0; i < 17; ++i) acc[i] += sc[i * 128 + k] * wv;
  }
#pragma unroll
  for (int i = 0; i < 17; ++i) p.modp[(((size_t)l * 8 + kc) * 17 + i) * 6144 + n] = acc[i];
  __syncthreads();
}
constexpr int MODR_ITEMS = 2 * 17 * 6144 / 256;
DI void stage_mod_reduce(const Params& p, int item) {
  int idx = item * 256 + tid_now();
  int l = idx / (17 * 6144), rem = idx % (17 * 6144), n = rem % 6144;
  float s = p.b_ada[l * 6144 + n];
#pragma unroll
  for (int kc = 0; kc < 8; ++kc) s += p.modp[((size_t)l * 8 + kc) * 17 * 6144 + rem];
  p.mod[idx] = s;
}

DI void norm_row(const Params& p, const float* __restrict__ xr, const float* __restrict__ g, const float* __restrict__ sh,
                 const float* __restrict__ sc, bf16* __restrict__ hr) {
  const int lane = tid_now() & 63;
  float4 v[4]; float ss = 0.f;
#pragma unroll
  for (int i = 0; i < 4; ++i) { v[i] = ((const float4*)xr)[lane + 64 * i]; ss += v[i].x * v[i].x + v[i].y * v[i].y + v[i].z * v[i].z + v[i].w * v[i].w; }
  ss = wave_sum(ss, lane);
  const float rstd = rsqrtf(ss * (1.f / D) + EPS);
#pragma unroll
  for (int i = 0; i < 4; ++i) {
    float4 gg = ((const float4*)g)[lane + 64 * i], s1 = ((const float4*)sh)[lane + 64 * i], s2 = ((const float4*)sc)[lane + 64 * i];
    float a = v[i].x * rstd * gg.x * (1.f + s2.x) + s1.x, b = v[i].y * rstd * gg.y * (1.f + s2.y) + s1.y;
    float c = v[i].z * rstd * gg.z * (1.f + s2.z) + s1.z, d = v[i].w * rstd * gg.w * (1.f + s2.w) + s1.w;
    u32x2 o = {pack2(a, b), pack2(c, d)};
    ((u32x2*)hr)[lane + 64 * i] = o;
  }
}
DI void stage_norm(const Params& p, int layer, int which, int item) {
  int row = item * 4 + (tid_now() >> 6);
  const float* xr = which == 0 ? xin_row(p, layer, row) : xres_row(p, row);
  const float* g = (which == 0 ? p.norm1_g : p.norm2_g) + layer * D;
  const float* m = p.mod + ((size_t)layer * 17 + mod_row(row)) * 6144 + (which == 0 ? 0 : 3072);
  norm_row(p, xr, g, m, m + D, p.H + (size_t)row * D);
}
DI void stage_final(const Params& p, int item) {
  int row = item * 4 + (tid_now() >> 6);
  const int lane = tid_now() & 63;
  const float* xr = p.out + (size_t)row * D;
  float4 v[4]; float ss = 0.f;
#pragma unroll
  for (int i = 0; i < 4; ++i) { v[i] = ((const float4*)xr)[lane + 64 * i]; ss += v[i].x * v[i].x + v[i].y * v[i].y + v[i].z * v[i].z + v[i].w * v[i].w; }
  ss = wave_sum(ss, lane);
  const float rstd = rsqrtf(ss * (1.f / D) + EPS);
#pragma unroll
  for (int i = 0; i < 4; ++i) {
    float4 gg = ((const float4*)p.final_norm_g)[lane + 64 * i];
    float4 o = {v[i].x * rstd * gg.x, v[i].y * rstd * gg.y, v[i].z * rstd * gg.z, v[i].w * rstd * gg.w};
    ((float4*)(p.out + (size_t)row * D))[lane + 64 * i] = o;
  }
}

constexpr int LROW = 144;
constexpr int LTILE = 128 * LROW;
constexpr int GEMM_SMEM = 4 * LTILE;

template <bool ORIENT_T>
DI void gemm_core(const bf16* __restrict__ A, const bf16* __restrict__ W, char* smem, f32x16 (&acc)[2][2]) {
  const int tid = tid_now(), lane = tid & 63, wave = tid >> 6;
  const int wm = wave >> 1, wn = wave & 1, l31 = lane & 31, hh = lane >> 5;
  const int lrow = tid >> 3, kc = tid & 7;
#pragma unroll
  for (int i = 0; i < 2; ++i)
#pragma unroll
    for (int j = 0; j < 2; ++j)
#pragma unroll
      for (int e = 0; e < 16; ++e) acc[i][j][e] = 0.f;
  u32x4 ra[4], rw[4];
  const bf16* ap = A + (size_t)lrow * D + kc * 8;
  const bf16* wp = W + (size_t)lrow * D + kc * 8;
#pragma unroll
  for (int i = 0; i < 4; ++i) { ra[i] = *(const u32x4*)(ap + (size_t)(32 * i) * D); rw[i] = *(const u32x4*)(wp + (size_t)(32 * i) * D); }
  for (int kt = 0; kt < 16; ++kt) {
    char* sa = smem + (kt & 1) * 2 * LTILE;
    char* sw = sa + LTILE;
#pragma unroll
    for (int i = 0; i < 4; ++i) {
      *(u32x4*)(sa + (lrow + 32 * i) * LROW + kc * 16) = ra[i];
      *(u32x4*)(sw + (lrow + 32 * i) * LROW + kc * 16) = rw[i];
    }
    __syncthreads();
    if (kt + 1 < 16) {
#pragma unroll
      for (int i = 0; i < 4; ++i) {
        ra[i] = *(const u32x4*)(ap + (size_t)(32 * i) * D + (kt + 1) * 64);
        rw[i] = *(const u32x4*)(wp + (size_t)(32 * i) * D + (kt + 1) * 64);
      }
    }
#pragma unroll
    for (int s = 0; s < 4; ++s) {
      bf16x8 af[2], wf[2];
#pragma unroll
      for (int t = 0; t < 2; ++t) {
        af[t] = *(const bf16x8*)(sa + (wm * 64 + t * 32 + l31) * LROW + (s * 16 + hh * 8) * 2);
        wf[t] = *(const bf16x8*)(sw + (wn * 64 + t * 32 + l31) * LROW + (s * 16 + hh * 8) * 2);
      }
#pragma unroll
      for (int ft = 0; ft < 2; ++ft)
#pragma unroll
        for (int tt = 0; tt < 2; ++tt)
          acc[ft][tt] = ORIENT_T ? MFMA(wf[ft], af[tt], acc[ft][tt]) : MFMA(af[tt], wf[ft], acc[ft][tt]);
    }
  }
  __syncthreads();
}

constexpr int INPROJ_ITEMS = 288 * 18;
DI void store4(bf16* dst, float a, float b, float c, float d) { u32x2 o = {pack2(a, b), pack2(c, d)}; *(u32x2*)dst = o; }

DI void stage_inproj(const Params& p, int layer, int item, char* smem) {
  const int mt = item / 18, nt = item % 18;
  if (layer == 1 && mt >= 256 && nt < 10) return;
  const int row0 = mt * 128, n0 = nt * 128;
  const bf16* A = p.H + (size_t)row0 * D;
  const bf16* W = p.win + ((size_t)layer * INC + n0) * D;
  const int lane = tid_now() & 63, wave = tid_now() >> 6, wm = wave >> 1, wn = wave & 1, l31 = lane & 31, hh = lane >> 5;
  const bool vtile = (nt >= 13 && nt <= 15) || nt == 17;
  f32x16 acc[2][2];
  const int b = batch_of(row0);
  if (vtile) {
    gemm_core<false>(A, W, smem, acc);
    bf16* base; int head;
    if (nt == 17) { head = wn; base = p.VGt + ((size_t)(b * 2 + head) * 64) * SEQ2; }
    else { head = (nt - 13) * 2 + wn; base = p.VNt + ((size_t)(b * 6 + head) * 64) * SEQ2; }
    const int pos0 = pos_of(row0) + wm * 64;
#pragma unroll
    for (int ft = 0; ft < 2; ++ft) {
      const int d = ft * 32 + l31;
#pragma unroll
      for (int tt = 0; tt < 2; ++tt)
#pragma unroll
        for (int g = 0; g < 4; ++g)
          store4(base + (size_t)d * SEQ2 + pos0 + tt * 32 + 8 * g + 4 * hh, acc[ft][tt][4 * g], acc[ft][tt][4 * g + 1], acc[ft][tt][4 * g + 2], acc[ft][tt][4 * g + 3]);
    }
    return;
  }
  gemm_core<true>(A, W, smem, acc);
  const int chunk = nt * 2 + wn;
#pragma unroll
  for (int tt = 0; tt < 2; ++tt) {
    const int row = row0 + wm * 64 + tt * 32 + l31;
    const int pos = pos_of(row);
    const bool isctx = row >= NTOK;
    if (chunk < 8) {
      bf16* dst = p.U + (size_t)row * 256 + 32 * chunk;
#pragma unroll
      for (int g = 0; g < 4; ++g) {
        float u0 = acc[0][tt][4 * g] * sigmoid_f(acc[1][tt][4 * g]), u1 = acc[0][tt][4 * g + 1] * sigmoid_f(acc[1][tt][4 * g + 1]);
        float u2 = acc[0][tt][4 * g + 2] * sigmoid_f(acc[1][tt][4 * g + 2]), u3 = acc[0][tt][4 * g + 3] * sigmoid_f(acc[1][tt][4 * g + 3]);
        store4(dst + 8 * g + 4 * hh, u0, u1, u2, u3);
      }
    } else if (chunk < 14 || (chunk >= 20 && chunk < 26)) {
      const bool isq = chunk < 14;
      const int head = isq ? chunk - 8 : chunk - 20;
      const float sc = isq ? 0.125f : 1.f;
      bf16* dst = (isq ? p.QN : p.KN) + ((size_t)(b * 6 + head) * SEQ2 + pos) * 64;
#pragma unroll
      for (int ft = 0; ft < 2; ++ft)
#pragma unroll
        for (int g = 0; g < 4; ++g)
          store4(dst + ft * 32 + 8 * g + 4 * hh, acc[ft][tt][4 * g] * sc, acc[ft][tt][4 * g + 1] * sc, acc[ft][tt][4 * g + 2] * sc, acc[ft][tt][4 * g + 3] * sc);
    } else {
      const bool isq = chunk < 20;
      const int head = isq ? chunk - 14 : chunk - 32;
      const float* gn = (isq ? p.gqa_q_norm : p.gqa_k_norm) + layer * 64;
      float ss = 0.f;
#pragma unroll
      for (int ft = 0; ft < 2; ++ft)
#pragma unroll
        for (int e = 0; e < 16; ++e) ss += acc[ft][tt][e] * acc[ft][tt][e];
      ss += shx(ss, 32, lane);
      const float rstd = rsqrtf(ss * (1.f / 64.f) + EPS) ;
      const float sc = isq ? 0.125f : 1.f;
      bf16* dst = (isq ? p.QG + ((size_t)(b * 6 + head) * SEQ2 + pos) * 64 : p.KG + ((size_t)(b * 2 + head) * SEQ2 + pos) * 64);
      const int prow = pos >> 6, pcol = pos & 63;
#pragma unroll
      for (int g = 0; g < 4; ++g) {
        float o1[4], o2[4];
#pragma unroll
        for (int j = 0; j < 4; ++j) {
          const int i = 8 * g + 4 * hh + j;
          float x1 = acc[0][tt][4 * g + j] * rstd * gn[i];
          float x2 = acc[1][tt][4 * g + j] * rstd * gn[32 + i];
          if (!isctx && PROBE != 13) {
            const int ppos = (g < 2) ? prow : pcol;
            const float2 cs = *(const float2*)(p.ropetab + 2 * (ppos * 16 + (i & 15)));
            float y1 = x1 * cs.x - x2 * cs.y, y2 = x1 * cs.y + x2 * cs.x;
            x1 = y1; x2 = y2;
          }
          o1[j] = x1 * sc; o2[j] = x2 * sc;
        }
        store4(dst + 8 * g + 4 * hh, o1[0], o1[1], o1[2], o1[3]);
        store4(dst + 32 + 8 * g + 4 * hh, o2[0], o2[1], o2[2], o2[3]);
      }
    }
  }
}

constexpr int CONV_TT = 32;
constexpr int CONV_SMEM = (CONV_TT + 30) * 512 + CONV_TT * 1024;
DI void stage_conv(const Params& p, int layer, int item, char* smem) {
  bf16* ub = (bf16*)smem;
  float* yb = (float*)(smem + (CONV_TT + 30) * 512);
  const int tid = tid_now();
  int row0, seq_lo, seq_hi;
  if (item < 1024) { row0 = item * CONV_TT; seq_lo = row0 & ~2047; seq_hi = seq_lo + 2048; }
  else { row0 = NTOK + (item - 1024) * CONV_TT; seq_lo = NTOK + (((item - 1024) * CONV_TT) & ~255); seq_hi = seq_lo + 256; }
  for (int c = tid; c < 62 * 32; c += 256) {
    int r = c >> 5, cc = c & 31;
    int row = row0 - 15 + r;
    u32x4 v = {0u, 0u, 0u, 0u};
    if (row >= seq_lo && row < seq_hi) v = *(const u32x4*)(p.U + (size_t)row * 256 + cc * 8);
    *(u32x4*)(ub + r * 256 + cc * 8) = v;
  }
  __syncthreads();
  {
    const int ch = tid;
    float w[31];
#pragma unroll
    for (int j = 0; j < 31; ++j) w[j] = p.conv_w[((size_t)layer * 31 + j) * 256 + ch];
    const float bias = p.conv_b[layer * 256 + ch];
#pragma unroll 1
    for (int t0 = 0; t0 < CONV_TT; t0 += 8) {
      float in[38];
#pragma unroll
      for (int j = 0; j < 38; ++j) in[j] = __uint_as_float((unsigned)ub[(t0 + j) * 256 + ch] << 16);
#pragma unroll
      for (int t = 0; t < 8; ++t) {
        float a = bias;
#pragma unroll
        for (int j = 0; j < 31; ++j) a += in[t + j] * w[j];
        yb[(t0 + t) * 256 + ch] = a;
      }
    }
  }
  __syncthreads();
  {
    const int wave = tid >> 6, lane = tid & 63;
    const float4 g = ((const float4*)(p.conv_ln_g + layer * 256))[lane], bb = ((const float4*)(p.conv_ln_b + layer * 256))[lane];
    for (int t = wave * 8; t < wave * 8 + 8; ++t) {
      float4 v = ((const float4*)(yb + t * 256))[lane];
      float mu = wave_sum(v.x + v.y + v.z + v.w, lane) * (1.f / 256.f);
      float dx = v.x - mu, dy = v.y - mu, dz = v.z - mu, dw = v.w - mu;
      float var = wave_sum(dx * dx + dy * dy + dz * dz + dw * dw, lane) * (1.f / 256.f);
      float rs = rsqrtf(var + EPS);
      float a = silu_f(dx * rs * g.x + bb.x), b = silu_f(dy * rs * g.y + bb.y), c = silu_f(dz * rs * g.z + bb.z), d = silu_f(dw * rs * g.w + bb.w);
      store4(p.CAT + (size_t)(row0 + t) * D + lane * 4, a, b, c, d);
    }
  }
  __syncthreads();
}

DI int kperm(int i) { return (i & 19) | ((i & 4) << 1) | ((i & 8) >> 1); }
DI int keyoff(int e, int h) { return (e & 3) + 4 * ((e >> 2) & 1) + 8 * h + 16 * (e >> 3); }
DI bf16x8 pack8(const f32x16& x, int s) {
  u32x4 r = {pack2(x[8 * s], x[8 * s + 1]), pack2(x[8 * s + 2], x[8 * s + 3]), pack2(x[8 * s + 4], x[8 * s + 5]), pack2(x[8 * s + 6], x[8 * s + 7])};
  return __builtin_bit_cast(bf16x8, r);
}

constexpr int NA_ITEMS = 6144 / 4;
DI void stage_na(const Params& p, int layer, int item) {
  const int lane = tid_now() & 63, wave = tid_now() >> 6, l31 = lane & 31, hh = lane >> 5;
  const int wi = item * 4 + wave;
  const int qhalf = wi & 1, head = (wi >> 1) % 6, br = wi / 12, r = br & 31, b = br >> 5;
  const int r0 = min(max(r - 4, 0), 24);
  const size_t hb = (size_t)(b * 6 + head);
  const bf16* Q = p.QN + (hb * SEQ2 + r * 64 + qhalf * 32 + l31) * 64;
  const bf16* Kb = p.KN + hb * SEQ2 * 64;
  const bf16* Vb = p.VNt + hb * 64 * SEQ2;
  const float* bias = p.na_rel_bias + ((size_t)layer * 6 + head) * 15 * 31;
  bf16x8 qf[4];
#pragma unroll
  for (int s = 0; s < 4; ++s) qf[s] = *(const bf16x8*)(Q + 16 * s + 8 * hh);
  f32x16 o[2];
#pragma unroll
  for (int e = 0; e < 16; ++e) { o[0][e] = 0.f; o[1][e] = 0.f; }
  float m = -1e30f, l = 0.f;
  const int qc = qhalf * 32 + l31;
  const int c0 = min(max(qc - 8, 0), 48);
  const int kp = kperm(l31);
#pragma unroll 1
  for (int t = 0; t < 24; ++t) {
    int key0, brow = 0, cs = 0;
    const bool local = t >= 8;
    if (!local) key0 = T + t * 32;
    else { brow = (t - 8) >> 1; cs = (t - 8) & 1; key0 = (r0 + brow) * 64 + cs * 32; }
    f32x16 st;
#pragma unroll
    for (int e = 0; e < 16; ++e) st[e] = 0.f;
    const bf16* kr = Kb + (size_t)(key0 + kp) * 64 + 8 * hh;
#pragma unroll
    for (int s = 0; s < 4; ++s) { bf16x8 kf = *(const bf16x8*)(kr + 16 * s); st = MFMA(kf, qf[s], st); }
    if (local) {
      const int rb = (r0 + brow) - r + 7;
#pragma unroll
      for (int e = 0; e < 16; ++e) {
        const int kc = cs * 32 + keyoff(e, hh);
        const bool valid = (kc >= c0) && (kc < c0 + 16);
        const int ci = min(max(kc - qc + 15, 0), 30);
        const float bv = (PROBE == 12) ? 0.f : bias[rb * 31 + ci];
        st[e] = valid ? st[e] + bv : -1e30f;
      }
    }
    float mx = st[0];
#pragma unroll
    for (int e = 1; e < 16; ++e) mx = fmaxf(mx, st[e]);
    mx = fmaxf(mx, shx(mx, 32, lane));
    const float mn = fmaxf(m, mx);
    const float alpha = exp2f((m - mn) * L2E);
    float ls = 0.f;
#pragma unroll
    for (int e = 0; e < 16; ++e) { st[e] = exp2f((st[e] - mn) * L2E); ls += st[e]; }
    l = l * alpha + ls; m = mn;
#pragma unroll
    for (int e = 0; e < 16; ++e) { o[0][e] *= alpha; o[1][e] *= alpha; }
    bf16x8 pf0 = pack8(st, 0), pf1 = pack8(st, 1);
#pragma unroll
    for (int dt = 0; dt < 2; ++dt) {
      const bf16* vr = Vb + (size_t)(dt * 32 + l31) * SEQ2 + key0 + 8 * hh;
      bf16x8 v0 = *(const bf16x8*)(vr), v1 = *(const bf16x8*)(vr + 16);
      o[dt] = MFMA(v0, pf0, o[dt]);
      o[dt] = MFMA(v1, pf1, o[dt]);
    }
  }
  l += shx(l, 32, lane);
  const float inv = (PROBE == 10) ? 0.f : 1.f / l;
  bf16* dst = p.CAT + (size_t)(b * T + r * 64 + qc) * D + 256 + head * 64;
#pragma unroll
  for (int dt = 0; dt < 2; ++dt)
#pragma unroll
    for (int g = 0; g < 4; ++g)
      store4(dst + dt * 32 + 8 * g + 4 * hh, o[dt][4 * g] * inv, o[dt][4 * g + 1] * inv, o[dt][4 * g + 2] * inv, o[dt][4 * g + 3] * inv);
}

constexpr int NA2_ITEMS = 16 * 6 * 16;
DI void stage_na2(const Params& p, int layer, int item, char* smem) {
  const int tid = tid_now(), lane = tid & 63, wave = tid >> 6, l31 = lane & 31, hh = lane >> 5;
  const int lrow = tid >> 3, kc8 = tid & 7;
  const int rp = item & 15, head = (item >> 4) % 6, b = item / 96;
  const int qrow = 2 * rp + (wave >> 1), qhalf = wave & 1;
  const int r0w = min(max(qrow - 4, 0), 24);
  const int rlo = min(max(2 * rp - 4, 0), 24), rhi = min(max(2 * rp - 3, 0), 24) + 7;
  const int ntile = 4 + (rhi - rlo + 1);
  const size_t hb = (size_t)(b * 6 + head);
  const bf16* K = p.KN + hb * SEQ2 * 64;
  const bf16* Vt = p.VNt + hb * 64 * SEQ2;
  float* bl = (float*)(smem + 2 * 2 * 64 * LROW);
  for (int i = tid; i < 15 * 31; i += 256) bl[i] = p.na_rel_bias[((size_t)layer * 6 + head) * 465 + i];
  bf16x8 qf[4];
  const int qc = qhalf * 32 + l31;
  const bf16* qp = p.QN + (hb * SEQ2 + qrow * 64 + qc) * 64 + 8 * hh;
#pragma unroll
  for (int s = 0; s < 4; ++s) qf[s] = *(const bf16x8*)(qp + 16 * s);
  f32x16 o[2];
#pragma unroll
  for (int e = 0; e < 16; ++e) { o[0][e] = 0.f; o[1][e] = 0.f; }
  float m = -1e30f, l = 0.f;
  const int kp = kperm(l31);
  const int c0 = min(max(qc - 8, 0), 48);
  u32x4 rk[2], rv[2];
  auto key0_of = [&](int t) { return t < 4 ? T + 64 * t : (rlo + t - 4) * 64; };
  {
    const int k0 = key0_of(0);
#pragma unroll
    for (int i = 0; i < 2; ++i) {
      rk[i] = *(const u32x4*)(K + (size_t)(k0 + lrow + 32 * i) * 64 + kc8 * 8);
      rv[i] = *(const u32x4*)(Vt + (size_t)(lrow + 32 * i) * SEQ2 + k0 + kc8 * 8);
    }
  }
#pragma unroll 1
  for (int t = 0; t < ntile; ++t) {
    char* sk = smem + (t & 1) * 2 * 64 * LROW;
    char* sv = sk + 64 * LROW;
#pragma unroll
    for (int i = 0; i < 2; ++i) {
      *(u32x4*)(sk + (lrow + 32 * i) * LROW + kc8 * 16) = rk[i];
      *(u32x4*)(sv + (lrow + 32 * i) * LROW + kc8 * 16) = rv[i];
    }
    __syncthreads();
    if (t + 1 < ntile) {
      const int k0 = key0_of(t + 1);
#pragma unroll
      for (int i = 0; i < 2; ++i) {
        rk[i] = *(const u32x4*)(K + (size_t)(k0 + lrow + 32 * i) * 64 + kc8 * 8);
        rv[i] = *(const u32x4*)(Vt + (size_t)(lrow + 32 * i) * SEQ2 + k0 + kc8 * 8);
      }
    }
    const int R = rlo + t - 4;
    const bool local = t >= 4;
    if (!local || (R >= r0w && R < r0w + 8)) {
      f32x16 st[2];
#pragma unroll
      for (int k2 = 0; k2 < 2; ++k2) {
#pragma unroll
        for (int e = 0; e < 16; ++e) st[k2][e] = 0.f;
#pragma unroll
        for (int s = 0; s < 4; ++s) {
          bf16x8 kf = *(const bf16x8*)(sk + (k2 * 32 + kp) * LROW + (16 * s + 8 * hh) * 2);
          st[k2] = MFMA(kf, qf[s], st[k2]);
        }
      }
      if (local) {
        const float* brow = bl + (R - qrow + 7) * 31 + (15 - qc);
#pragma unroll
        for (int k2 = 0; k2 < 2; ++k2)
#pragma unroll
          for (int e = 0; e < 16; ++e) {
            const int kc = k2 * 32 + keyoff(e, hh);
            const bool valid = (kc >= c0) && (kc < c0 + 16);
            const float bv = brow[valid ? kc : qc];
            st[k2][e] = valid ? st[k2][e] + bv : -1e30f;
          }
      }
      float mx = st[0][0];
#pragma unroll
      for (int e = 1; e < 16; ++e) mx = fmaxf(mx, st[0][e]);
#pragma unroll
      for (int e = 0; e < 16; ++e) mx = fmaxf(mx, st[1][e]);
      mx = fmaxf(mx, shx(mx, 32, lane));
      const float mn = fmaxf(m, mx);
      const float mnl = mn * L2E;
      const float alpha = fexp2(m * L2E - mnl);
      float ls = 0.f;
#pragma unroll
      for (int k2 = 0; k2 < 2; ++k2)
#pragma unroll
        for (int e = 0; e < 16; ++e) { st[k2][e] = fexp2(st[k2][e] * L2E - mnl); ls += st[k2][e]; }
      l = l * alpha + ls; m = mn;
#pragma unroll
      for (int e = 0; e < 16; ++e) { o[0][e] *= alpha; o[1][e] *= alpha; }
#pragma unroll
      for (int k2 = 0; k2 < 2; ++k2)
#pragma unroll
        for (int s2 = 0; s2 < 2; ++s2) {
          bf16x8 pf = pack8(st[k2], s2);
#pragma unroll
          for (int dt = 0; dt < 2; ++dt) {
            bf16x8 vf = *(const bf16x8*)(sv + (dt * 32 + l31) * LROW + (k2 * 32 + 16 * s2 + 8 * hh) * 2);
            o[dt] = MFMA(vf, pf, o[dt]);
          }
        }
    }
  }
  l += shx(l, 32, lane);
  const float inv = 1.f / l;
  bf16* dst = p.CAT + (size_t)(b * T + qrow * 64 + qc) * D + 256 + head * 64;
#pragma unroll
  for (int dt = 0; dt < 2; ++dt)
#pragma unroll
    for (int g = 0; g < 4; ++g)
      store4(dst + dt * 32 + 8 * g + 4 * hh, o[dt][4 * g] * inv, o[dt][4 * g + 1] * inv, o[dt][4 * g + 2] * inv, o[dt][4 * g + 3] * inv);
  __syncthreads();
}

constexpr int FA_SMEM = 2 * 2 * 64 * LROW;
DI void flash_block(const bf16* __restrict__ Q, const bf16* __restrict__ K, const bf16* __restrict__ Vt, int q0, int kt0, int kt1,
                    bf16* __restrict__ dst  , char* smem) {
  const int tid = tid_now(), lane = tid & 63, wave = tid >> 6, l31 = lane & 31, hh = lane >> 5;
  const int lrow = tid >> 3, kc = tid & 7;
  bf16x8 qf[4];
  const bf16* qp = Q + (size_t)(q0 + wave * 32 + l31) * 64 + 8 * hh;
#pragma unroll
  for (int s = 0; s < 4; ++s) qf[s] = *(const bf16x8*)(qp + 16 * s);
  f32x16 o[2];
#pragma unroll
  for (int e = 0; e < 16; ++e) { o[0][e] = 0.f; o[1][e] = 0.f; }
  float m = -1e30f, l = 0.f;
  const int kp = kperm(l31);
  u32x4 rk[2], rv[2];
#pragma unroll
  for (int i = 0; i < 2; ++i) {
    rk[i] = *(const u32x4*)(K + (size_t)(kt0 * 64 + lrow + 32 * i) * 64 + kc * 8);
    rv[i] = *(const u32x4*)(Vt + (size_t)(lrow + 32 * i) * SEQ2 + kt0 * 64 + kc * 8);
  }
  for (int kt = kt0; kt < kt1; ++kt) {
    char* sk = smem + ((kt - kt0) & 1) * 2 * 64 * LROW;
    char* sv = sk + 64 * LROW;
#pragma unroll
    for (int i = 0; i < 2; ++i) {
      *(u32x4*)(sk + (lrow + 32 * i) * LROW + kc * 16) = rk[i];
      *(u32x4*)(sv + (lrow + 32 * i) * LROW + kc * 16) = rv[i];
    }
    __syncthreads();
    if (kt + 1 < kt1) {
#pragma unroll
      for (int i = 0; i < 2; ++i) {
        rk[i] = *(const u32x4*)(K + (size_t)((kt + 1) * 64 + lrow + 32 * i) * 64 + kc * 8);
        rv[i] = *(const u32x4*)(Vt + (size_t)(lrow + 32 * i) * SEQ2 + (kt + 1) * 64 + kc * 8);
      }
    }
    f32x16 st[2];
#pragma unroll
    for (int k2 = 0; k2 < 2; ++k2) {
#pragma unroll
      for (int e = 0; e < 16; ++e) st[k2][e] = 0.f;
#pragma unroll
      for (int s = 0; s < 4; ++s) {
        bf16x8 kf = *(const bf16x8*)(sk + (k2 * 32 + kp) * LROW + (16 * s + 8 * hh) * 2);
        st[k2] = MFMA(kf, qf[s], st[k2]);
      }
    }
    float mx = st[0][0];
#pragma unroll
    for (int e = 1; e < 16; ++e) mx = fmaxf(mx, st[0][e]);
#pragma unroll
    for (int e = 0; e < 16; ++e) mx = fmaxf(mx, st[1][e]);
    mx = fmaxf(mx, shx(mx, 32, lane));
    const float mn = fmaxf(m, mx);
    const float mnl = mn * L2E;
    const float alpha = fexp2(m * L2E - mnl);
    float ls = 0.f;
#pragma unroll
    for (int k2 = 0; k2 < 2; ++k2)
#pragma unroll
      for (int e = 0; e < 16; ++e) { st[k2][e] = fexp2(st[k2][e] * L2E - mnl); ls += st[k2][e]; }
    l = l * alpha + ls; m = mn;
#pragma unroll
    for (int e = 0; e < 16; ++e) { o[0][e] *= alpha; o[1][e] *= alpha; }
#pragma unroll
    for (int k2 = 0; k2 < 2; ++k2)
#pragma unroll
      for (int s2 = 0; s2 < 2; ++s2) {
        bf16x8 pf = pack8(st[k2], s2);
#pragma unroll
        for (int dt = 0; dt < 2; ++dt) {
          bf16x8 vf = *(const bf16x8*)(sv + (dt * 32 + l31) * LROW + (k2 * 32 + 16 * s2 + 8 * hh) * 2);
          o[dt] = MFMA(vf, pf, o[dt]);
        }
      }
  }
  l += shx(l, 32, lane);
  const float inv = (PROBE == 11) ? 0.f : 1.f / l;
  bf16* d2 = dst + (size_t)(wave * 32 + l31) * D;
#pragma unroll
  for (int dt = 0; dt < 2; ++dt)
#pragma unroll
    for (int g = 0; g < 4; ++g)
      store4(d2 + dt * 32 + 8 * g + 4 * hh, o[dt][4 * g] * inv, o[dt][4 * g + 1] * inv, o[dt][4 * g + 2] * inv, o[dt][4 * g + 3] * inv);
  __syncthreads();
}
constexpr int GQA_ITEMS = 16 * 6 * 16;
DI void stage_gqa(const Params& p, int item, char* smem) {
  const int qt = item & 15, hq = (item >> 4) % 6, b = item / 96;
  const int kvh = hq / 3;
  flash_block(p.QG + (size_t)(b * 6 + hq) * SEQ2 * 64, p.KG + (size_t)(b * 2 + kvh) * SEQ2 * 64, p.VGt + (size_t)(b * 2 + kvh) * 64 * SEQ2,
              qt * 128, 0, 36, p.CAT + (size_t)(b * T + qt * 128) * D + 640 + hq * 64, smem);
}
constexpr int CTXATT_ITEMS = 384;
DI void stage_ctxatt(const Params& p, int item, char* smem) {
  const int qt = item & 1, head = (item >> 1) % 6, which = (item / 12) & 1, b = item / 24;
  bf16* dst = p.CAT + (size_t)(NTOK + b * CL + qt * 128) * D;
  if (which == 0)
    flash_block(p.QN + (size_t)(b * 6 + head) * SEQ2 * 64, p.KN + (size_t)(b * 6 + head) * SEQ2 * 64, p.VNt + (size_t)(b * 6 + head) * 64 * SEQ2,
                T + qt * 128, 32, 36, dst + 256 + head * 64, smem);
  else
    flash_block(p.QG + (size_t)(b * 6 + head) * SEQ2 * 64, p.KG + (size_t)(b * 2 + head / 3) * SEQ2 * 64, p.VGt + (size_t)(b * 2 + head / 3) * 64 * SEQ2,
                T + qt * 128, 32, 36, dst + 640 + head * 64, smem);
}

constexpr int OUTPROJ_ITEMS = 288 * 8;
DI void stage_outproj(const Params& p, int layer, int item, char* smem) {
  const int mt = item >> 3, nt = item & 7;
  if (layer == 1 && mt >= 256) return;
  const int row0 = mt * 128, n0 = nt * 128;
  f32x16 acc[2][2];
  gemm_core<true>(p.CAT + (size_t)row0 * D, p.wout + ((size_t)layer * D + n0) * D, smem, acc);
  const int lane = tid_now() & 63, wave = tid_now() >> 6, wm = wave >> 1, wn = wave & 1, l31 = lane & 31, hh = lane >> 5;
  const float* g1 = p.mod + ((size_t)layer * 17 + mod_row(row0)) * 6144 + 2048;
#pragma unroll
  for (int tt = 0; tt < 2; ++tt) {
    const int row = row0 + wm * 64 + tt * 32 + l31;
    const float* xr = xin_row(p, layer, row);
    float* dr = xres_row(p, row);
#pragma unroll
    for (int ft = 0; ft < 2; ++ft)
#pragma unroll
      for (int g = 0; g < 4; ++g) {
        const int n = n0 + wn * 64 + ft * 32 + 8 * g + 4 * hh;
        float4 xv = *(const float4*)(xr + n), gv = *(const float4*)(g1 + n);
        if (PROBE == 2) { gv.x = gv.y = gv.z = gv.w = 0.f; }
        float4 o = {xv.x + gv.x * acc[ft][tt][4 * g], xv.y + gv.y * acc[ft][tt][4 * g + 1], xv.z + gv.z * acc[ft][tt][4 * g + 2], xv.w + gv.w * acc[ft][tt][4 * g + 3]};
        *(float4*)(dr + n) = o;
      }
  }
}

constexpr int ROUTE_ITEMS = 288 * 8;
constexpr int QROW = 272;
DI int to_sortable(int b) { return b ^ ((b >> 31) & 0x7fffffff); }

#define CAND_LIST(X) \
  X(0,0,0) X(1,0,1) X(2,0,2) X(3,0,3) X(4,0,4) X(5,0,5) X(6,0,6) X(7,0,7) X(8,0,8) X(9,0,9) X(10,0,10) X(11,0,11) X(12,0,12) X(13,0,13) X(14,0,14) X(15,0,15) \
  X(16,1,1) X(17,1,2) X(18,1,3) X(19,1,4) X(20,1,5) X(21,1,6) X(22,1,7) \
  X(23,2,2) X(24,2,3) X(25,2,4) \
  X(26,3,3)

DI void stage_route(const Params& p, int layer, int item, char* smem) {
  const int mt = item >> 3, head = item & 7;
  if (layer == 1 && mt >= 256) return;
  const int row0 = mt * 128;
  const int tid = tid_now(), lane = tid & 63, wave = tid >> 6, wm = wave >> 1, wn = wave & 1, l31 = lane & 31, hh = lane >> 5;
  int topk[2][16];
  char* Qs = smem;
  char* Ks = smem + 2 * LTILE;
#pragma unroll
  for (int pp = 0; pp < 2; ++pp) {
    {
      f32x16 acc[2][2];
      gemm_core<true>(p.H + (size_t)row0 * D, p.wq + ((size_t)layer * 2048 + (head * 2 + pp) * 128) * D, smem, acc);
#pragma unroll
      for (int tt = 0; tt < 2; ++tt)
#pragma unroll
        for (int ft = 0; ft < 2; ++ft)
#pragma unroll
          for (int g = 0; g < 4; ++g) {
            const int tok = wm * 64 + tt * 32 + l31, kf = wn * 64 + ft * 32 + 8 * g + 4 * hh;
            u32x2 o = {pack2(acc[ft][tt][4 * g], acc[ft][tt][4 * g + 1]), pack2(acc[ft][tt][4 * g + 2], acc[ft][tt][4 * g + 3])};
            *(u32x2*)(Qs + tok * QROW + kf * 2) = o;
          }
    }
    const bf16* kp = p.pk + ((size_t)((layer * 8 + head) * 2 + pp) * 128) * 128;
#pragma unroll
    for (int i = 0; i < 8; ++i) {
      const int c = tid + 256 * i, n = c >> 4, kc = c & 15;
      *(u32x4*)(Ks + n * QROW + kc * 16) = *(const u32x4*)(kp + n * 128 + kc * 8);
    }
    __syncthreads();
    int key[64];
    {
      f32x16 sc[4];
#pragma unroll
      for (int nt = 0; nt < 4; ++nt)
#pragma unroll
        for (int e = 0; e < 16; ++e) sc[nt][e] = 0.f;
#pragma unroll
      for (int s = 0; s < 8; ++s) {
        bf16x8 qb = *(const bf16x8*)(Qs + (wave * 32 + l31) * QROW + (16 * s + 8 * hh) * 2);
#pragma unroll
        for (int nt = 0; nt < 4; ++nt) {
          bf16x8 ka = *(const bf16x8*)(Ks + (nt * 32 + l31) * QROW + (16 * s + 8 * hh) * 2);
          sc[nt] = MFMA(ka, qb, sc[nt]);
        }
      }
#pragma unroll
      for (int nt = 0; nt < 4; ++nt)
#pragma unroll
        for (int e = 0; e < 16; ++e) {
          const int n = nt * 32 + crow(e, hh);
          int b = (__float_as_int(sc[nt][e]) & ~127) | n;
          key[nt * 16 + e] = to_sortable(b);
        }
    }
#pragma unroll
    for (int r = 0; r < 16; ++r) {
      int mx = key[0];
#pragma unroll
      for (int i = 1; i < 64; ++i) mx = max(mx, key[i]);
      mx = max(mx, shxi(mx, 32, lane));
      topk[pp][r] = mx;
#pragma unroll
      for (int i = 0; i < 64; ++i) key[i] = (key[i] == mx) ? (int)0x80000000 : key[i];
    }
    __syncthreads();
  }
  float av[16], bv[16]; int ai[16], bi[16];
#pragma unroll
  for (int i = 0; i < 16; ++i) {
    int k1 = to_sortable(topk[0][i]), k2 = to_sortable(topk[1][i]);
    int a = hh ? k2 : k1, b = hh ? k1 : k2;
    av[i] = __int_as_float(a & ~127); ai[i] = a & 127;
    bv[i] = __int_as_float(b & ~127); bi[i] = b & 127;
  }
  int cand[27], eid[27];
#define MKC(c, i, j) { int b = __float_as_int(av[i] + bv[j]); cand[c] = (to_sortable(b) & ~63) | (c * 2 + hh); \
                       eid[c] = hh ? (bi[j] * 128 + ai[i]) : (ai[i] * 128 + bi[j]); \
                       if (i == j && hh) cand[c] = (int)0x80000000; }
  CAND_LIST(MKC)
#undef MKC
  int win[16], weid[16];
#pragma unroll
  for (int r = 0; r < 16; ++r) {
    int mx = cand[0];
#pragma unroll
    for (int c = 1; c < 27; ++c) mx = max(mx, cand[c]);
    mx = max(mx, shxi(mx, 32, lane));
    int e = 0;
#pragma unroll
    for (int c = 0; c < 27; ++c) { const bool hit = cand[c] == mx; e = hit ? eid[c] : e; cand[c] = hit ? (int)0x80000000 : cand[c]; }
    e |= shxi(e, 32, lane);
    win[r] = mx; weid[r] = e;
  }
  float gsum = 0.f, gv[16];
  const float v0 = __int_as_float(to_sortable(win[0]) & ~63);
#pragma unroll
  for (int r = 0; r < 16; ++r) { gv[r] = __expf(__int_as_float(to_sortable(win[r]) & ~63) - v0); gsum += gv[r]; }
  const float ginv = 1.f / gsum;
  const int row = row0 + wave * 32 + l31;
  if (hh == 0) {
    int4* d = (int4*)(p.ridx + ((size_t)row * 8 + head) * 16);
#pragma unroll
    for (int q = 0; q < 4; ++q) { int4 o = {weid[4 * q], weid[4 * q + 1], weid[4 * q + 2], weid[4 * q + 3]}; d[q] = o; }
  } else {
    float4* d = (float4*)(p.rg + ((size_t)row * 8 + head) * 16);
#pragma unroll
    for (int q = 0; q < 4; ++q) { float4 o = {gv[4 * q] * ginv, gv[4 * q + 1] * ginv, gv[4 * q + 2] * ginv, gv[4 * q + 3] * ginv}; d[q] = o; }
  }
}

DI float dot2(unsigned a, unsigned b, float acc) {
  bf2_t x = __builtin_bit_cast(bf2_t, a), y = __builtin_bit_cast(bf2_t, b);
  return __builtin_amdgcn_fdot2_f32_bf16(x, y, acc, false);
}
DI float dot8(u32x4 a, u32x4 b, float acc) {
  const unsigned a0 = a[0], a1 = a[1], a2 = a[2], a3 = a[3], b0 = b[0], b1 = b[1], b2 = b[2], b3 = b[3];
  acc = dot2(a0, b0, acc); acc = dot2(a1, b1, acc); acc = dot2(a2, b2, acc); acc = dot2(a3, b3, acc);
  return acc;
}
DI void axpy8(float (&o)[8], float w, u32x4 v) {
  o[0] += w * bf_lo(v.x); o[1] += w * bf_hi(v.x); o[2] += w * bf_lo(v.y); o[3] += w * bf_hi(v.y);
  o[4] += w * bf_lo(v.z); o[5] += w * bf_hi(v.z); o[6] += w * bf_lo(v.w); o[7] += w * bf_hi(v.w);
}
constexpr int GATHER_ITEMS = MTOT / 4;
DI float dot4f8(unsigned u, unsigned hlo, unsigned hhi, float acc) {
  bf2_t a = __builtin_amdgcn_cvt_scalef32_pk_bf16_fp8((int)u, 1.0f, false);
  bf2_t b = __builtin_amdgcn_cvt_scalef32_pk_bf16_fp8((int)u, 1.0f, true);
  bf2_t x = __builtin_bit_cast(bf2_t, hlo), y = __builtin_bit_cast(bf2_t, hhi);
  acc = __builtin_amdgcn_fdot2_f32_bf16(a, x, acc, false);
  acc = __builtin_amdgcn_fdot2_f32_bf16(b, y, acc, false);
  return acc;
}
DI void axpy4f8(float& o0, float& o1, float& o2, float& o3, float w, unsigned v) {
  f2_t lo = __builtin_amdgcn_cvt_pk_f32_fp8((int)v, false), hi = __builtin_amdgcn_cvt_pk_f32_fp8((int)v, true);
  o0 += w * lo[0]; o1 += w * lo[1]; o2 += w * hi[0]; o3 += w * hi[1];
}
DI void stage_gather(const Params& p, int layer, int item) {
  const int lane = tid_now() & 63, wave = tid_now() >> 6;
  const int row = item * 4 + wave;
  if (layer == 1 && row >= NTOK) return;
  const int idxA = p.ridx[(size_t)row * 128 + lane], idxB = p.ridx[(size_t)row * 128 + 64 + lane];
  const float gA = p.rg[(size_t)row * 128 + lane], gB = p.rg[(size_t)row * 128 + 64 + lane];
  const bf16* hr = p.H + (size_t)row * D + lane * 16;
  const u32x4 hA = *(const u32x4*)(hr), hB = *(const u32x4*)(hr + 8);
  const unsigned h0 = hA[0], h1 = hA[1], h2 = hA[2], h3 = hA[3], h4 = hB[0], h5 = hB[1], h6 = hB[2], h7 = hB[3];
  float o[16];
#pragma unroll
  for (int i = 0; i < 16; ++i) o[i] = 0.f;
  const __amdgpu_buffer_rsrc_t rU = __builtin_amdgcn_make_buffer_rsrc((void*)(p.pu8 + (size_t)layer * NEXP * D), 0, NEXP * D, 0x00020000);
  const __amdgpu_buffer_rsrc_t rV = __builtin_amdgcn_make_buffer_rsrc((void*)(p.pv8 + (size_t)layer * NEXP * D), 0, NEXP * D, 0x00020000);
  const int voff = lane * 16;
  u32x4 ua[16], va[16];
#pragma unroll
  for (int k = 0; k < 16; ++k) {
    const int e = __builtin_amdgcn_readlane(idxA, k);
    ua[k] = __builtin_amdgcn_raw_buffer_load_b128(rU, voff, e * D, 0);
  }
#pragma unroll
  for (int k = 0; k < 16; ++k) {
    const int e = __builtin_amdgcn_readlane(idxA, k);
    va[k] = __builtin_amdgcn_raw_buffer_load_b128(rV, voff, e * D, 0);
  }
#pragma unroll
  for (int head = 0; head < 8; ++head) {
    float part[16];
#pragma unroll
    for (int k = 0; k < 16; ++k) {
      const unsigned a0 = ua[k][0], a1 = ua[k][1], a2 = ua[k][2], a3 = ua[k][3];
      float s = dot4f8(a0, h0, h1, 0.f);
      s = dot4f8(a1, h2, h3, s); s = dot4f8(a2, h4, h5, s); s = dot4f8(a3, h6, h7, s);
      part[k] = s;
    }
    if (head < 7) {
#pragma unroll
      for (int k = 0; k < 16; ++k) {
        const int e = __builtin_amdgcn_readlane((head + 1) < 4 ? idxA : idxB, ((head + 1) & 3) * 16 + k);
        ua[k] = __builtin_amdgcn_raw_buffer_load_b128(rU, voff, e * D, 0);
      }
    }
    float r8[8], r4[4], r2[2], r1;
    {
      const bool up = lane & 32;
#pragma unroll
      for (int k = 0; k < 8; ++k) { float keep = up ? part[k + 8] : part[k], give = up ? part[k] : part[k + 8]; r8[k] = keep + shx(give, 32, lane); }
    }
    {
      const bool up = lane & 16;
#pragma unroll
      for (int k = 0; k < 4; ++k) { float keep = up ? r8[k + 4] : r8[k], give = up ? r8[k] : r8[k + 4]; r4[k] = keep + shx(give, 16, lane); }
    }
    {
      const bool up = lane & 8;
#pragma unroll
      for (int k = 0; k < 2; ++k) { float keep = up ? r4[k + 2] : r4[k], give = up ? r4[k] : r4[k + 2]; r2[k] = keep + shx(give, 8, lane); }
    }
    {
      const bool up = lane & 4;
      float keep = up ? r2[1] : r2[0], give = up ? r2[0] : r2[1];
      r1 = keep + shx(give, 4, lane);
    }
    r1 += shx(r1, 2, lane);
    r1 += shx(r1, 1, lane);
    const float myg = __int_as_float(__builtin_amdgcn_ds_bpermute(((head & 3) * 16 + ((lane >> 2) & 15)) << 2, __float_as_int(head < 4 ? gA : gB)));
    const float w = gelu_tanh(r1 * (1.f / SU)) * myg * (1.f / SV);
#pragma unroll
    for (int k = 0; k < 16; ++k) {
      const float wk = __int_as_float(__builtin_amdgcn_readlane(__float_as_int(w), k << 2));
      const unsigned a0 = va[k][0], a1 = va[k][1], a2 = va[k][2], a3 = va[k][3];
      axpy4f8(o[0], o[1], o[2], o[3], wk, a0); axpy4f8(o[4], o[5], o[6], o[7], wk, a1);
      axpy4f8(o[8], o[9], o[10], o[11], wk, a2); axpy4f8(o[12], o[13], o[14], o[15], wk, a3);
    }
    if (head < 7) {
#pragma unroll
      for (int k = 0; k < 16; ++k) {
        const int e = __builtin_amdgcn_readlane((head + 1) < 4 ? idxA : idxB, ((head + 1) & 3) * 16 + k);
        va[k] = __builtin_amdgcn_raw_buffer_load_b128(rV, voff, e * D, 0);
      }
    }
  }
  const float* g2 = p.mod + ((size_t)layer * 17 + mod_row(row)) * 6144 + 5120 + lane * 16;
  float* dr = xres_row(p, row) + lane * 16;
#pragma unroll
  for (int q = 0; q < 4; ++q) {
    float4 xv = *(const float4*)(dr + 4 * q), gv = *(const float4*)(g2 + 4 * q);
    float4 r = {xv.x + gv.x * o[4 * q], xv.y + gv.y * o[4 * q + 1], xv.z + gv.z * o[4 * q + 2], xv.w + gv.w * o[4 * q + 3]};
    *(float4*)(dr + 4 * q) = r;
  }
}

#include <hip/hip_cooperative_groups.h>
namespace cg = cooperative_groups;
constexpr int SMEM_BYTES = GEMM_SMEM;


#define XB_TMO      128
#define XB_XCNT(j)  (256  + 64 * (j))
#define XB_XSUB(j)  (1280 + 64 * (j))
#define XB_XGEN(j)  (2304 + 64 * (j))
#define XB_TOP      3328
#define XB_TOPGEN   3392
#define XCD_BAR_WORDS 3456
#define XB_SPIN_CAP (1u << 22)
#define LAS __attribute__((address_space(3)))
DI unsigned xb_ld(unsigned* p) { return __hip_atomic_load(p, __ATOMIC_RELAXED, __HIP_MEMORY_SCOPE_AGENT); }
DI unsigned xb_add(unsigned* p, unsigned v) { return __hip_atomic_fetch_add(p, v, __ATOMIC_RELAXED, __HIP_MEMORY_SCOPE_AGENT); }
DI unsigned xb_xcc_id() { return (unsigned)__builtin_amdgcn_s_getreg((3 << 11) | 20) & 0xFu; }
#define XB_SPIN(cond, bar) do { unsigned _sp = 0; while (cond) { __builtin_amdgcn_s_sleep(1); \
    if ((++_sp & 255u) == 0u) { if (xb_ld(&(bar)[XB_TMO])) break; if (_sp > XB_SPIN_CAP) { atomicAdd(&(bar)[XB_TMO], 1u); break; } } } } while (0)
struct XcdBarrier { unsigned* bar; unsigned x; volatile LAS unsigned* st; };
DI XcdBarrier xcd_barrier_post(unsigned* bar, volatile LAS unsigned* st) {
  XcdBarrier b; b.bar = bar; b.x = xb_xcc_id(); b.st = st;
  if (tid_now() == 0) (void)xb_add(&bar[XB_XCNT(b.x)], 1u);
  return b;
}
DI void xcd_barrier_complete(unsigned* bar, unsigned x, unsigned& nloc, unsigned& nx) {
  const unsigned G = gridDim.x;
  unsigned sum, cnt, mine, sp = 0u;
  for (;;) {
    sum = 0u; cnt = 0u; mine = 0u;
#pragma unroll
    for (unsigned j = 0; j < 16; ++j) { const unsigned c = xb_ld(&bar[XB_XCNT(j)]); sum += c; cnt += (c > 0u) ? 1u : 0u; mine = (j == x) ? c : mine; }
    if (sum == G) break;
    __builtin_amdgcn_s_sleep(1);
    if ((++sp & 255u) == 0u) { if (xb_ld(&bar[XB_TMO])) break; if (sp > XB_SPIN_CAP) { atomicAdd(&bar[XB_TMO], 1u); break; } }
  }
  nloc = mine > 0u ? mine : 1u; nx = cnt > 0u ? cnt : 1u;
}
DI void xcd_barrier(const XcdBarrier& b) {
  asm volatile("s_waitcnt vmcnt(0)" ::: "memory");
  __syncthreads();
  if (tid_now() == 0) {
    unsigned* bar = b.bar;
    __builtin_amdgcn_s_waitcnt(0);
    unsigned nloc = b.st[0], nx = b.st[1];
    if (nloc == 0u) { xcd_barrier_complete(bar, b.x, nloc, nx); b.st[0] = nloc; b.st[1] = nx; }
    const unsigned old = xb_add(&bar[XB_XSUB(b.x)], 1u);
    const unsigned gen = old / nloc;
    if (old + 1u == (gen + 1u) * nloc) {
      __builtin_amdgcn_fence(__ATOMIC_RELEASE, "agent");
      asm volatile("s_waitcnt vmcnt(0)" ::: "memory");
      const unsigned og = xb_add(&bar[XB_TOP], 1u);
      const unsigned tg = og / nx;
      if (og + 1u == (tg + 1u) * nx) xb_add(&bar[XB_TOPGEN], 1u);
      else XB_SPIN(xb_ld(&bar[XB_TOPGEN]) == tg, bar);
      __builtin_amdgcn_fence(__ATOMIC_ACQUIRE, "agent");
      xb_add(&bar[XB_XGEN(b.x)], 1u);
      asm volatile("s_waitcnt vmcnt(0)" ::: "memory");
    } else {
      XB_SPIN(xb_ld(&bar[XB_XGEN(b.x)]) == gen, bar);
      __builtin_amdgcn_fence(__ATOMIC_ACQUIRE, "agent");
      asm volatile("s_waitcnt vmcnt(0)" ::: "memory");
    }
  }
  __syncthreads();
}

#define GRID_BARRIER() xcd_barrier(xb)
#define REP(k) for (int rep_ = 0; rep_ < (DUP == (k) ? 2 : 1); ++rep_)

__global__ void __launch_bounds__(256, 2) mega_kernel(Params p) {
  __shared__ __attribute__((aligned(16))) char smem[SMEM_BYTES];
  cg::grid_group grid = cg::this_grid();
  const int G = gridDim.x, bid = blockIdx.x;
  __shared__ uint4 xb_words;
  if (tid_now() == 0) xb_words = make_uint4(0u, 0u, 0u, 0u);
  if (bid == 0) for (int i = tid_now(); i < XCD_BAR_WORDS; i += 256) p.bar[i] = 0u;
  REP(1) for (int it = bid; it < MODP_ITEMS + CONVT_ITEMS + CONVS_ITEMS + 1; it += G) {
    if (it < MODP_ITEMS) stage_mod_partial(p, it, smem);
    else if (it < MODP_ITEMS + CONVT_ITEMS) stage_convT(p, it - MODP_ITEMS, smem);
    else if (it < MODP_ITEMS + CONVT_ITEMS + CONVS_ITEMS) stage_convS(p, it - MODP_ITEMS - CONVT_ITEMS);
    else stage_rope(p);
  }
  grid.sync();
  XcdBarrier xb = xcd_barrier_post(p.bar, (volatile LAS unsigned*)&xb_words);
  for (int it = bid; it < MODR_ITEMS; it += G) stage_mod_reduce(p, it);
  GRID_BARRIER();
#pragma unroll 1
  for (int l = 0; l < 2; ++l) {
    REP(2) for (int it = bid; it < MTOT / 4; it += G) stage_norm(p, l, 0, it);
    GRID_BARRIER();
    {
      const int n = l == 0 ? INPROJ_ITEMS : 256 * 18 + 32 * 8;
      REP(3) for (int it = bid; it < n; it += G) {
        int item = it;
        if (it >= 256 * 18) { const int r = it - 256 * 18; item = l == 0 ? it : (256 + (r >> 3)) * 18 + 10 + (r & 7); }
        stage_inproj(p, l, item, smem);
      }
    }
    GRID_BARRIER();
    {
      const int nconv = l == 0 ? 1152 : 1024, nctx = l == 0 ? CTXATT_ITEMS : 0;
      const int n = GQA_ITEMS + NA2_ITEMS + nconv + nctx;
      REP(4) for (int it = bid; it < n; it += G) {
        if (it < GQA_ITEMS) { if (DUP != 41 && DUP != 42) stage_gqa(p, it, smem); if (DUP == 40) stage_gqa(p, it, smem); }
        else if (it < GQA_ITEMS + NA2_ITEMS) { stage_na2(p, l, it - GQA_ITEMS, smem); if (DUP == 43) stage_na2(p, l, it - GQA_ITEMS, smem); }
        else if (it < GQA_ITEMS + NA2_ITEMS + nconv) { stage_conv(p, l, it - GQA_ITEMS - NA2_ITEMS, smem); if (DUP == 44) stage_conv(p, l, it - GQA_ITEMS - NA2_ITEMS, smem); }
        else stage_ctxatt(p, it - GQA_ITEMS - NA2_ITEMS - nconv, smem);
      }
    }
    GRID_BARRIER();
    {
      const int n = (l == 0 ? 288 : 256) * 8;
      for (int it = bid; it < n; it += G) stage_outproj(p, l, it, smem);
    }
    GRID_BARRIER();
    {
      const int n = (l == 0 ? MTOT : NTOK) / 4;
      REP(6) for (int it = bid; it < n; it += G) stage_norm(p, l, 1, it);
    }
    GRID_BARRIER();
    {
      const int n = (l == 0 ? 288 : 256) * 8;
      REP(7) for (int it = bid; it < n; it += G) stage_route(p, l, it, smem);
    }
    GRID_BARRIER();
    {
      const int n = (l == 0 ? MTOT : NTOK) / 4;
      for (int it = bid; it < n; it += G) stage_gather(p, l, it);
    }
    GRID_BARRIER();
  }
  for (int it = bid; it < NTOK / 4; it += G) stage_final(p, it);
}

extern "C" void kernel_launch(void* const* d_in, const int* in_sizes, int n_in, void* d_out, int out_size, void* d_ws, size_t ws_size,
                              hipStream_t stream) {
  Params p{};
  const float** f = (const float**)&p;
  for (int i = 0; i < 22; ++i) f[i] = (const float*)d_in[i];
  p.out = (float*)d_out;
  char* w = (char*)d_ws; size_t off = 0;
  auto take = [&](size_t bytes) { char* r = w + off; off += (bytes + 255) & ~(size_t)255; return r; };
  p.win = (bf16*)take((size_t)2 * INC * D * 2);
  p.wout = (bf16*)take((size_t)2 * D * D * 2);
  p.wq = (bf16*)take((size_t)2 * 2048 * D * 2);
  p.pk = (bf16*)take(PK_N * 2);
  p.pu8 = (unsigned char*)take(PU_N);
  p.pv8 = (unsigned char*)take(PU_N);
  p.modp = (float*)take((size_t)2 * 8 * 17 * 6144 * 4);
  p.mod = (float*)take((size_t)2 * 17 * 6144 * 4);
  p.ropetab = (float*)take(64 * 16 * 2 * 4);
  p.H = (bf16*)take((size_t)MTOT * D * 2);
  p.CAT = p.H;
  p.U = (bf16*)take((size_t)MTOT * 256 * 2);
  p.QN = (bf16*)take((size_t)NB * 6 * SEQ2 * 64 * 2);
  p.KN = (bf16*)take((size_t)NB * 6 * SEQ2 * 64 * 2);
  p.VNt = (bf16*)take((size_t)NB * 6 * SEQ2 * 64 * 2);
  p.QG = (bf16*)take((size_t)NB * 6 * SEQ2 * 64 * 2);
  p.KG = (bf16*)take((size_t)NB * 2 * SEQ2 * 64 * 2);
  p.VGt = (bf16*)take((size_t)NB * 2 * SEQ2 * 64 * 2);
  p.XC = (float*)take((size_t)NCTX * D * 4);
  p.ridx = (int*)take((size_t)MTOT * 128 * 4);
  p.rg = (float*)take((size_t)MTOT * 128 * 4);
  p.bar = (unsigned*)take(XCD_BAR_WORDS * 4);
  if (off > ws_size) return;
  static int grid_blocks = 0;
  if (!grid_blocks) {
    int dev = 0, cus = 0, per_cu = 0;
    hipGetDevice(&dev);
    hipDeviceGetAttribute(&cus, hipDeviceAttributeMultiprocessorCount, dev);
    hipOccupancyMaxActiveBlocksPerMultiprocessor(&per_cu, mega_kernel, 256, 0);
    if (per_cu > 2) per_cu = 2;
    grid_blocks = cus * per_cu;
  }
  void* args[] = {&p};
  hipLaunchCooperativeKernel((void*)mega_kernel, dim3(grid_blocks), dim3(256), args, 0, stream);
}
```

```cpp
#include <hip/hip_runtime.h>
#include <stdint.h>

typedef __attribute__((ext_vector_type(8))) short bf16x8;
typedef __attribute__((ext_vector_type(16))) float f32x16;
typedef __attribute__((ext_vector_type(2))) __bf16 bf2_t;
typedef __attribute__((ext_vector_type(2))) float f2_t;
typedef unsigned short bf16;
typedef __attribute__((ext_vector_type(4))) unsigned u32x4;
typedef __attribute__((ext_vector_type(2))) unsigned u32x2;

#define DI __device__ __forceinline__
#ifndef PROBE
#define PROBE 0
#endif
#ifndef DUP
#define DUP 0
#endif
#define MFMA(a, b, c) __builtin_amdgcn_mfma_f32_32x32x16_bf16((a), (b), (c), 0, 0, 0)

constexpr int D = 1024, NB = 16, T = 2048, CL = 256;
constexpr int NTOK = NB * T;
constexpr int NCTX = NB * CL;
constexpr int MTOT = NTOK + NCTX;
constexpr int INC = 2304;
constexpr int SEQ2 = T + CL;
constexpr int NEXP = 16384;
constexpr float EPS = 1e-6f;
constexpr float L2E = 1.4426950408889634f;

struct Params {
  const float *x, *c, *ctx, *c_ctx, *norm1_g, *norm2_g, *w_ada, *b_ada, *w_in, *conv_w, *conv_b, *conv_ln_g,
      *conv_ln_b, *na_rel_bias, *gqa_q_norm, *gqa_k_norm, *w_out, *peer_w_q, *peer_keys, *peer_u, *peer_v, *final_norm_g;
  float* out;
  bf16 *win, *wout, *wq, *pk;
  unsigned char *pu8, *pv8;
  float *modp, *mod, *ropetab;
  bf16 *H, *U, *QN, *KN, *VNt, *QG, *KG, *VGt, *CAT;
  float *XC;
  int* ridx;
  float* rg;
  unsigned* bar;
};

DI int tid_now() { int t; asm volatile("v_mov_b32 %0, %1" : "=v"(t) : "v"((int)__builtin_amdgcn_workitem_id_x())); return t; }
DI unsigned pack2(float a, float b) {
  f2_t v = {a, b};
  bf2_t r = __builtin_convertvector(v, bf2_t);
  return __builtin_bit_cast(unsigned, r);
}
DI float bf_lo(unsigned u) { return __uint_as_float(u << 16); }
DI float bf_hi(unsigned u) { return __uint_as_float(u & 0xffff0000u); }
DI int crow(int e, int h) { return (e & 3) + 8 * (e >> 2) + 4 * h; }
DI float fexp2(float x) { return __builtin_amdgcn_exp2f(x); }
DI float silu_f(float x) { return x / (1.f + __expf(-x)); }
DI float sigmoid_f(float x) { return 1.f / (1.f + __expf(-x)); }
DI float gelu_tanh(float x) {
  float u = 0.7978845608028654f * (x + 0.044715f * x * x * x);
  float t = 1.f - 2.f / (1.f + __expf(2.f * u));
  return 0.5f * x * (1.f + t);
}
DI float shx(float v, int m, int lane) { return __int_as_float(__builtin_amdgcn_ds_bpermute((lane ^ m) << 2, __float_as_int(v))); }
DI int shxi(int v, int m, int lane) { return __builtin_amdgcn_ds_bpermute((lane ^ m) << 2, v); }
DI float wave_sum(float v, int lane) {
#pragma unroll
  for (int o = 32; o >= 1; o >>= 1) v += shx(v, o, lane);
  return v;
}
DI float* xres_row(const Params& p, int row) { return row < NTOK ? p.out + (size_t)row * D : p.XC + (size_t)(row - NTOK) * D; }
DI const float* xin_row(const Params& p, int layer, int row) {
  if (layer == 0) return row < NTOK ? p.x + (size_t)row * D : p.ctx + (size_t)(row - NTOK) * D;
  return xres_row(p, row);
}
DI int mod_row(int row) { return row < NTOK ? (row >> 11) : 16; }
DI int batch_of(int row) { return row < NTOK ? (row >> 11) : ((row - NTOK) >> 8); }
DI int pos_of(int row) { return row < NTOK ? (row & 2047) : (T + ((row - NTOK) & 255)); }

DI int perm_in(int n) {
  if (n >= 512) return n;
  int c = n >> 6, w = n & 63;
  return w < 32 ? 32 * c + w : 256 + 32 * c + (w - 32);
}
DI void convT_tile(const float* __restrict__ src, bf16* __restrict__ dst, int K, int N, int k0, int n0, bool perm, float* tile  ) {
  const int tx = tid_now() & 63, ty = tid_now() >> 6;
  const int ns = perm ? perm_in(n0 + tx) : n0 + tx;
#pragma unroll
  for (int i = 0; i < 16; ++i) { int k = ty + 4 * i; tile[k * 65 + tx] = src[(size_t)(k0 + k) * N + ns]; }
  __syncthreads();
#pragma unroll
  for (int i = 0; i < 16; ++i) {
    int n = ty + 4 * i;
    dst[(size_t)(n0 + n) * K + k0 + tx] = (bf16)(pack2(tile[tx * 65 + n], 0.f) & 0xffff);
  }
  __syncthreads();
}
constexpr int CONVT_ITEMS = 2 * 1344;
DI void stage_convT(const Params& p, int item, char* smem) {
  float* tile = (float*)smem;
  int l = item / 1344, r = item % 1344;
  if (r < 576) { int kt = r / 36, nt = r % 36; convT_tile(p.w_in + (size_t)l * D * INC, p.win + (size_t)l * INC * D, D, INC, kt * 64, nt * 64, true, tile); }
  else if (r < 832) { r -= 576; int kt = r / 16, nt = r % 16; convT_tile(p.w_out + (size_t)l * D * D, p.wout + (size_t)l * D * D, D, D, kt * 64, nt * 64, false, tile); }
  else { r -= 832; int kt = r / 32, nt = r % 32; convT_tile(p.peer_w_q + (size_t)l * D * 2048, p.wq + (size_t)l * 2048 * D, D, 2048, kt * 64, nt * 64, false, tile); }
}
constexpr size_t PK_N = (size_t)2 * 16 * 128 * 128, PU_N = (size_t)2 * NEXP * D;
constexpr float SU = 1024.f, SV = 64.f;
constexpr int CONVK_ITEMS = (int)(PK_N / 2048), CONVUV_ITEMS = (int)(PU_N / 4096);
constexpr int CONVS_ITEMS = CONVK_ITEMS + 2 * CONVUV_ITEMS;
DI unsigned pack_fp8x4(float4 a, float s) {
  int r = 0;
  r = __builtin_amdgcn_cvt_pk_fp8_f32(a.x * s, a.y * s, r, false);
  r = __builtin_amdgcn_cvt_pk_fp8_f32(a.z * s, a.w * s, r, true);
  return (unsigned)r;
}
DI void stage_convS(const Params& p, int item) {
  if (item < CONVK_ITEMS) {
    size_t e = (size_t)item * 2048 + tid_now() * 8;
    const float* src = p.peer_keys + e;
    float4 a = ((const float4*)src)[0], b = ((const float4*)src)[1];
    u32x4 o = {pack2(a.x, a.y), pack2(a.z, a.w), pack2(b.x, b.y), pack2(b.z, b.w)};
    *(u32x4*)(p.pk + e) = o;
    return;
  }
  item -= CONVK_ITEMS;
  const bool isv = item >= CONVUV_ITEMS;
  if (isv) item -= CONVUV_ITEMS;
  size_t e = (size_t)item * 4096 + tid_now() * 16;
  const float* src = (isv ? p.peer_v : p.peer_u) + e;
  const float s = isv ? SV : SU;
  float4 a = ((const float4*)src)[0], b = ((const float4*)src)[1], c = ((const float4*)src)[2], d = ((const float4*)src)[3];
  u32x4 o = {pack_fp8x4(a, s), pack_fp8x4(b, s), pack_fp8x4(c, s), pack_fp8x4(d, s)};
  *(u32x4*)((isv ? p.pv8 : p.pu8) + e) = o;
}
DI void stage_rope(const Params& p) {
  for (int i = tid_now(); i < 64 * 16; i += 256) {
    int pos = i >> 4, f = i & 15;
    float inv = powf(10000.f, -(float)f / 16.f);
    float ang = (float)pos * inv;
    p.ropetab[2 * i] = cosf(ang); p.ropetab[2 * i + 1] = sinf(ang);
  }
}

constexpr int MODP_ITEMS = 2 * 8 * 24;
DI void stage_mod_partial(const Params& p, int item, char* smem) {
  float* sc = (float*)smem;
  int l = item / 192, r = item % 192, kc = r / 24, nc = r % 24;
  for (int i = tid_now(); i < 17 * 128; i += 256) {
    int rr = i >> 7, k = i & 127;
    float v = rr < 16 ? p.c[rr * D + kc * 128 + k] : p.c_ctx[kc * 128 + k];
    sc[i] = silu_f(v);
  }
  __syncthreads();
  float acc[17];
#pragma unroll
  for (int i = 0; i < 17; ++i) acc[i] = 0.f;
  const int n = nc * 256 + tid_now();
  const float* w = p.w_ada + ((size_t)l * D + kc * 128) * 6144 + n;
  for (int k = 0; k < 128; ++k) {
    float wv = w[(size_t)k * 6144];
#pragma unroll
    for (int i = 0; i < 17; ++i) acc[i] += sc[i * 128 + k] * wv;
  }
#pragma unroll
  for (int i = 0; i < 17; ++i) p.modp[(((size_t)l * 8 + kc) * 17 + i) * 6144 + n] = acc[i];
  __syncthreads();
}
constexpr int MODR_ITEMS = 2 * 17 * 6144 / 256;
DI void stage_mod_reduce(const Params& p, int item) {
  int idx = item * 256 + tid_now();
  int l = idx / (17 * 6144), rem = idx % (17 * 6144), n = rem % 6144;
  float s = p.b_ada[l * 6144 + n];
#pragma unroll
  for (int kc = 0; kc < 8; ++kc) s += p.modp[((size_t)l * 8 + kc) * 17 * 6144 + rem];
  p.mod[idx] = s;
}

DI void norm_row(const Params& p, const float* __restrict__ xr, const float* __restrict__ g, const float* __restrict__ sh,
                 const float* __restrict__ sc, bf16* __restrict__ hr) {
  const int lane = tid_now() & 63;
  float4 v[4]; float ss = 0.f;
#pragma unroll
  for (int i = 0; i < 4; ++i) { v[i] = ((const float4*)xr)[lane + 64 * i]; ss += v[i].x * v[i].x + v[i].y * v[i].y + v[i].z * v[i].z + v[i].w * v[i].w; }
  ss = wave_sum(ss, lane);
  const float rstd = rsqrtf(ss * (1.f / D) + EPS);
#pragma unroll
  for (int i = 0; i < 4; ++i) {
    float4 gg = ((const float4*)g)[lane + 64 * i], s1 = ((const float4*)sh)[lane + 64 * i], s2 = ((const float4*)sc)[lane + 64 * i];
    float a = v[i].x * rstd * gg.x * (1.f + s2.x) + s1.x, b = v[i].y * rstd * gg.y * (1.f + s2.y) + s1.y;
    float c = v[i].z * rstd * gg.z * (1.f + s2.z) + s1.z, d = v[i].w * rstd * gg.w * (1.f + s2.w) + s1.w;
    u32x2 o = {pack2(a, b), pack2(c, d)};
    ((u32x2*)hr)[lane + 64 * i] = o;
  }
}
DI void stage_norm(const Params& p, int layer, int which, int item) {
  int row = item * 4 + (tid_now() >> 6);
  const float* xr = which == 0 ? xin_row(p, layer, row) : xres_row(p, row);
  const float* g = (which == 0 ? p.norm1_g : p.norm2_g) + layer * D;
  const float* m = p.mod + ((size_t)layer * 17 + mod_row(row)) * 6144 + (which == 0 ? 0 : 3072);
  norm_row(p, xr, g, m, m + D, p.H + (size_t)row * D);
}
DI void stage_final(const Params& p, int item) {
  int row = item * 4 + (tid_now() >> 6);
  const int lane = tid_now() & 63;
  const float* xr = p.out + (size_t)row * D;
  float4 v[4]; float ss = 0.f;
#pragma unroll
  for (int i = 0; i < 4; ++i) { v[i] = ((const float4*)xr)[lane + 64 * i]; ss += v[i].x * v[i].x + v[i].y * v[i].y + v[i].z * v[i].z + v[i].w * v[i].w; }
  ss = wave_sum(ss, lane);
  const float rstd = rsqrtf(ss * (1.f / D) + EPS);
#pragma unroll
  for (int i = 0; i < 4; ++i) {
    float4 gg = ((const float4*)p.final_norm_g)[lane + 64 * i];
    float4 o = {v[i].x * rstd * gg.x, v[i].y * rstd * gg.y, v[i].z * rstd * gg.z, v[i].w * rstd * gg.w};
    ((float4*)(p.out + (size_t)row * D))[lane + 64 * i] = o;
  }
}

constexpr int LROW = 144;
constexpr int LTILE = 128 * LROW;
constexpr int GEMM_SMEM = 4 * LTILE;

template <bool ORIENT_T>
DI void gemm_core(const bf16* __restrict__ A, const bf16* __restrict__ W, char* smem, f32x16 (&acc)[2][2]) {
  const int tid = tid_now(), lane = tid & 63, wave = tid >> 6;
  const int wm = wave >> 1, wn = wave & 1, l31 = lane & 31, hh = lane >> 5;
  const int lrow = tid >> 3, kc = tid & 7;
#pragma unroll
  for (int i = 0; i < 2; ++i)
#pragma unroll
    for (int j = 0; j < 2; ++j)
#pragma unroll
      for (int e = 0; e < 16; ++e) acc[i][j][e] = 0.f;
  u32x4 ra0[4], rw0[4], ra1[4], rw1[4];
  const bf16* ap = A + (size_t)lrow * D + kc * 8;
  const bf16* wp = W + (size_t)lrow * D + kc * 8;
#pragma unroll
  for (int i = 0; i < 4; ++i) { ra0[i] = *(const u32x4*)(ap + (size_t)(32 * i) * D); rw0[i] = *(const u32x4*)(wp + (size_t)(32 * i) * D); }
#pragma unroll
  for (int i = 0; i < 4; ++i) { ra1[i] = *(const u32x4*)(ap + (size_t)(32 * i) * D + 64); rw1[i] = *(const u32x4*)(wp + (size_t)(32 * i) * D + 64); }
  auto compute = [&](const char* sa, const char* sw) {
#pragma unroll
    for (int s = 0; s < 4; ++s) {
      bf16x8 af[2], wf[2];
#pragma unroll
      for (int t = 0; t < 2; ++t) {
        af[t] = *(const bf16x8*)(sa + (wm * 64 + t * 32 + l31) * LROW + (s * 16 + hh * 8) * 2);
        wf[t] = *(const bf16x8*)(sw + (wn * 64 + t * 32 + l31) * LROW + (s * 16 + hh * 8) * 2);
      }
#pragma unroll
      for (int ft = 0; ft < 2; ++ft)
#pragma unroll
        for (int tt = 0; tt < 2; ++tt)
          acc[ft][tt] = ORIENT_T ? MFMA(wf[ft], af[tt], acc[ft][tt]) : MFMA(af[tt], wf[ft], acc[ft][tt]);
    }
  };
#pragma unroll 1
  for (int kt = 0; kt < 16; kt += 2) {
    {
      char* sa = smem;
      char* sw = sa + LTILE;
#pragma unroll
      for (int i = 0; i < 4; ++i) {
        *(u32x4*)(sa + (lrow + 32 * i) * LROW + kc * 16) = ra0[i];
        *(u32x4*)(sw + (lrow + 32 * i) * LROW + kc * 16) = rw0[i];
      }
      __syncthreads();
      if (kt + 2 < 16) {
#pragma unroll
        for (int i = 0; i < 4; ++i) {
          ra0[i] = *(const u32x4*)(ap + (size_t)(32 * i) * D + (kt + 2) * 64);
          rw0[i] = *(const u32x4*)(wp + (size_t)(32 * i) * D + (kt + 2) * 64);
        }
      }
      compute(sa, sw);
    }
    {
      char* sa = smem + 2 * LTILE;
      char* sw = sa + LTILE;
#pragma unroll
      for (int i = 0; i < 4; ++i) {
        *(u32x4*)(sa + (lrow + 32 * i) * LROW + kc * 16) = ra1[i];
        *(u32x4*)(sw + (lrow + 32 * i) * LROW + kc * 16) = rw1[i];
      }
      __syncthreads();
      if (kt + 3 < 16) {
#pragma unroll
        for (int i = 0; i < 4; ++i) {
          ra1[i] = *(const u32x4*)(ap + (size_t)(32 * i) * D + (kt + 3) * 64);
          rw1[i] = *(const u32x4*)(wp + (size_t)(32 * i) * D + (kt + 3) * 64);
        }
      }
      compute(sa, sw);
    }
  }
  __syncthreads();
}

constexpr int INPROJ_ITEMS = 288 * 18;
DI void store4(bf16* dst, float a, float b, float c, float d) { u32x2 o = {pack2(a, b), pack2(c, d)}; *(u32x2*)dst = o; }

DI void stage_inproj(const Params& p, int layer, int item, char* smem) {
  const int mt = item / 18, nt = item % 18;
  if (layer == 1 && mt >= 256 && nt < 10) return;
  const int row0 = mt * 128, n0 = nt * 128;
  const bf16* A = p.H + (size_t)row0 * D;
  const bf16* W = p.win + ((size_t)layer * INC + n0) * D;
  const int lane = tid_now() & 63, wave = tid_now() >> 6, wm = wave >> 1, wn = wave & 1, l31 = lane & 31, hh = lane >> 5;
  const bool vtile = (nt >= 13 && nt <= 15) || nt == 17;
  f32x16 acc[2][2];
  const int b = batch_of(row0);
  if (vtile) {
    gemm_core<false>(A, W, smem, acc);
    bf16* base; int head;
    if (nt == 17) { head = wn; base = p.VGt + ((size_t)(b * 2 + head) * 64) * SEQ2; }
    else { head = (nt - 13) * 2 + wn; base = p.VNt + ((size_t)(b * 6 + head) * 64) * SEQ2; }
    const int pos0 = pos_of(row0) + wm * 64;
#pragma unroll
    for (int ft = 0; ft < 2; ++ft) {
      const int d = ft * 32 + l31;
#pragma unroll
      for (int tt = 0; tt < 2; ++tt)
#pragma unroll
        for (int g = 0; g < 4; ++g)
          store4(base + (size_t)d * SEQ2 + pos0 + tt * 32 + 8 * g + 4 * hh, acc[ft][tt][4 * g], acc[ft][tt][4 * g + 1], acc[ft][tt][4 * g + 2], acc[ft][tt][4 * g + 3]);
    }
    return;
  }
  gemm_core<true>(A, W, smem, acc);
  const int chunk = nt * 2 + wn;
#pragma unroll
  for (int tt = 0; tt < 2; ++tt) {
    const int row = row0 + wm * 64 + tt * 32 + l31;
    const int pos = pos_of(row);
    const bool isctx = row >= NTOK;
    if (chunk < 8) {
      bf16* dst = p.U + (size_t)row * 256 + 32 * chunk;
#pragma unroll
      for (int g = 0; g < 4; ++g) {
        float u0 = acc[0][tt][4 * g] * sigmoid_f(acc[1][tt][4 * g]), u1 = acc[0][tt][4 * g + 1] * sigmoid_f(acc[1][tt][4 * g + 1]);
        float u2 = acc[0][tt][4 * g + 2] * sigmoid_f(acc[1][tt][4 * g + 2]), u3 = acc[0][tt][4 * g + 3] * sigmoid_f(acc[1][tt][4 * g + 3]);
        store4(dst + 8 * g + 4 * hh, u0, u1, u2, u3);
      }
    } else if (chunk < 14 || (chunk >= 20 && chunk < 26)) {
      const bool isq = chunk < 14;
      const int head = isq ? chunk - 8 : chunk - 20;
      const float sc = isq ? 0.125f : 1.f;
      bf16* dst = (isq ? p.QN : p.KN) + ((size_t)(b * 6 + head) * SEQ2 + pos) * 64;
#pragma unroll
      for (int ft = 0; ft < 2; ++ft)
#pragma unroll
        for (int g = 0; g < 4; ++g)
          store4(dst + ft * 32 + 8 * g + 4 * hh, acc[ft][tt][4 * g] * sc, acc[ft][tt][4 * g + 1] * sc, acc[ft][tt][4 * g + 2] * sc, acc[ft][tt][4 * g + 3] * sc);
    } else {
      const bool isq = chunk < 20;
      const int head = isq ? chunk - 14 : chunk - 32;
      const float* gn = (isq ? p.gqa_q_norm : p.gqa_k_norm) + layer * 64;
      float ss = 0.f;
#pragma unroll
      for (int ft = 0; ft < 2; ++ft)
#pragma unroll
        for (int e = 0; e < 16; ++e) ss += acc[ft][tt][e] * acc[ft][tt][e];
      ss += shx(ss, 32, lane);
      const float rstd = rsqrtf(ss * (1.f / 64.f) + EPS) ;
      const float sc = isq ? 0.125f : 1.f;
      bf16* dst = (isq ? p.QG + ((size_t)(b * 6 + head) * SEQ2 + pos) * 64 : p.KG + ((size_t)(b * 2 + head) * SEQ2 + pos) * 64);
      const int prow = pos >> 6, pcol = pos & 63;
#pragma unroll
      for (int g = 0; g < 4; ++g) {
        float o1[4], o2[4];
#pragma unroll
        for (int j = 0; j < 4; ++j) {
          const int i = 8 * g + 4 * hh + j;
          float x1 = acc[0][tt][4 * g + j] * rstd * gn[i];
          float x2 = acc[1][tt][4 * g + j] * rstd * gn[32 + i];
          if (!isctx && PROBE != 13) {
            const int ppos = (g < 2) ? prow : pcol;
            const float2 cs = *(const float2*)(p.ropetab + 2 * (ppos * 16 + (i & 15)));
            float y1 = x1 * cs.x - x2 * cs.y, y2 = x1 * cs.y + x2 * cs.x;
            x1 = y1; x2 = y2;
          }
          o1[j] = x1 * sc; o2[j] = x2 * sc;
        }
        store4(dst + 8 * g + 4 * hh, o1[0], o1[1], o1[2], o1[3]);
        store4(dst + 32 + 8 * g + 4 * hh, o2[0], o2[1], o2[2], o2[3]);
      }
    }
  }
}

constexpr int CONV_TT = 32;
constexpr int CONV_SMEM = (CONV_TT + 30) * 512 + CONV_TT * 1024;
DI void stage_conv(const Params& p, int layer, int item, char* smem) {
  bf16* ub = (bf16*)smem;
  float* yb = (float*)(smem + (CONV_TT + 30) * 512);
  const int tid = tid_now();
  int row0, seq_lo, seq_hi;
  if (item < 1024) { row0 = item * CONV_TT; seq_lo = row0 & ~2047; seq_hi = seq_lo + 2048; }
  else { row0 = NTOK + (item - 1024) * CONV_TT; seq_lo = NTOK + (((item - 1024) * CONV_TT) & ~255); seq_hi = seq_lo + 256; }
  for (int c = tid; c < 62 * 32; c += 256) {
    int r = c >> 5, cc = c & 31;
    int row = row0 - 15 + r;
    u32x4 v = {0u, 0u, 0u, 0u};
    if (row >= seq_lo && row < seq_hi) v = *(const u32x4*)(p.U + (size_t)row * 256 + cc * 8);
    *(u32x4*)(ub + r * 256 + cc * 8) = v;
  }
  __syncthreads();
  {
    const int ch = tid;
    float w[31];
#pragma unroll
    for (int j = 0; j < 31; ++j) w[j] = p.conv_w[((size_t)layer * 31 + j) * 256 + ch];
    const float bias = p.conv_b[layer * 256 + ch];
#pragma unroll 1
    for (int t0 = 0; t0 < CONV_TT; t0 += 8) {
      float in[38];
#pragma unroll
      for (int j = 0; j < 38; ++j) in[j] = __uint_as_float((unsigned)ub[(t0 + j) * 256 + ch] << 16);
#pragma unroll
      for (int t = 0; t < 8; ++t) {
        float a = bias;
#pragma unroll
        for (int j = 0; j < 31; ++j) a += in[t + j] * w[j];
        yb[(t0 + t) * 256 + ch] = a;
      }
    }
  }
  __syncthreads();
  {
    const int wave = tid >> 6, lane = tid & 63;
    const float4 g = ((const float4*)(p.conv_ln_g + layer * 256))[lane], bb = ((const float4*)(p.conv_ln_b + layer * 256))[lane];
    for (int t = wave * 8; t < wave * 8 + 8; ++t) {
      float4 v = ((const float4*)(yb + t * 256))[lane];
      float mu = wave_sum(v.x + v.y + v.z + v.w, lane) * (1.f / 256.f);
      float dx = v.x - mu, dy = v.y - mu, dz = v.z - mu, dw = v.w - mu;
      float var = wave_sum(dx * dx + dy * dy + dz * dz + dw * dw, lane) * (1.f / 256.f);
      float rs = rsqrtf(var + EPS);
      float a = silu_f(dx * rs * g.x + bb.x), b = silu_f(dy * rs * g.y + bb.y), c = silu_f(dz * rs * g.z + bb.z), d = silu_f(dw * rs * g.w + bb.w);
      store4(p.CAT + (size_t)(row0 + t) * D + lane * 4, a, b, c, d);
    }
  }
  __syncthreads();
}

DI int kperm(int i) { return (i & 19) | ((i & 4) << 1) | ((i & 8) >> 1); }
DI int keyoff(int e, int h) { return (e & 3) + 4 * ((e >> 2) & 1) + 8 * h + 16 * (e >> 3); }
DI bf16x8 pack8(const f32x16& x, int s) {
  u32x4 r = {pack2(x[8 * s], x[8 * s + 1]), pack2(x[8 * s + 2], x[8 * s + 3]), pack2(x[8 * s + 4], x[8 * s + 5]), pack2(x[8 * s + 6], x[8 * s + 7])};
  return __builtin_bit_cast(bf16x8, r);
}

constexpr int NA_ITEMS = 6144 / 4;
DI void stage_na(const Params& p, int layer, int item) {
  const int lane = tid_now() & 63, wave = tid_now() >> 6, l31 = lane & 31, hh = lane >> 5;
  const int wi = item * 4 + wave;
  const int qhalf = wi & 1, head = (wi >> 1) % 6, br = wi / 12, r = br & 31, b = br >> 5;
  const int r0 = min(max(r - 4, 0), 24);
  const size_t hb = (size_t)(b * 6 + head);
  const bf16* Q = p.QN + (hb * SEQ2 + r * 64 + qhalf * 32 + l31) * 64;
  const bf16* Kb = p.KN + hb * SEQ2 * 64;
  const bf16* Vb = p.VNt + hb * 64 * SEQ2;
  const float* bias = p.na_rel_bias + ((size_t)layer * 6 + head) * 15 * 31;
  bf16x8 qf[4];
#pragma unroll
  for (int s = 0; s < 4; ++s) qf[s] = *(const bf16x8*)(Q + 16 * s + 8 * hh);
  f32x16 o[2];
#pragma unroll
  for (int e = 0; e < 16; ++e) { o[0][e] = 0.f; o[1][e] = 0.f; }
  float m = -1e30f, l = 0.f;
  const int qc = qhalf * 32 + l31;
  const int c0 = min(max(qc - 8, 0), 48);
  const int kp = kperm(l31);
#pragma unroll 1
  for (int t = 0; t < 24; ++t) {
    int key0, brow = 0, cs = 0;
    const bool local = t >= 8;
    if (!local) key0 = T + t * 32;
    else { brow = (t - 8) >> 1; cs = (t - 8) & 1; key0 = (r0 + brow) * 64 + cs * 32; }
    f32x16 st;
#pragma unroll
    for (int e = 0; e < 16; ++e) st[e] = 0.f;
    const bf16* kr = Kb + (size_t)(key0 + kp) * 64 + 8 * hh;
#pragma unroll
    for (int s = 0; s < 4; ++s) { bf16x8 kf = *(const bf16x8*)(kr + 16 * s); st = MFMA(kf, qf[s], st); }
    if (local) {
      const int rb = (r0 + brow) - r + 7;
#pragma unroll
      for (int e = 0; e < 16; ++e) {
        const int kc = cs * 32 + keyoff(e, hh);
        const bool valid = (kc >= c0) && (kc < c0 + 16);
        const int ci = min(max(kc - qc + 15, 0), 30);
        const float bv = (PROBE == 12) ? 0.f : bias[rb * 31 + ci];
        st[e] = valid ? st[e] + bv : -1e30f;
      }
    }
    float mx = st[0];
#pragma unroll
    for (int e = 1; e < 16; ++e) mx = fmaxf(mx, st[e]);
    mx = fmaxf(mx, shx(mx, 32, lane));
    const float mn = fmaxf(m, mx);
    const float alpha = exp2f((m - mn) * L2E);
    float ls = 0.f;
#pragma unroll
    for (int e = 0; e < 16; ++e) { st[e] = exp2f((st[e] - mn) * L2E); ls += st[e]; }
    l = l * alpha + ls; m = mn;
#pragma unroll
    for (int e = 0; e < 16; ++e) { o[0][e] *= alpha; o[1][e] *= alpha; }
    bf16x8 pf0 = pack8(st, 0), pf1 = pack8(st, 1);
#pragma unroll
    for (int dt = 0; dt < 2; ++dt) {
      const bf16* vr = Vb + (size_t)(dt * 32 + l31) * SEQ2 + key0 + 8 * hh;
      bf16x8 v0 = *(const bf16x8*)(vr), v1 = *(const bf16x8*)(vr + 16);
      o[dt] = MFMA(v0, pf0, o[dt]);
      o[dt] = MFMA(v1, pf1, o[dt]);
    }
  }
  l += shx(l, 32, lane);
  const float inv = (PROBE == 10) ? 0.f : 1.f / l;
  bf16* dst = p.CAT + (size_t)(b * T + r * 64 + qc) * D + 256 + head * 64;
#pragma unroll
  for (int dt = 0; dt < 2; ++dt)
#pragma unroll
    for (int g = 0; g < 4; ++g)
      store4(dst + dt * 32 + 8 * g + 4 * hh, o[dt][4 * g] * inv, o[dt][4 * g + 1] * inv, o[dt][4 * g + 2] * inv, o[dt][4 * g + 3] * inv);
}

constexpr int NA2_ITEMS = 16 * 6 * 16;
DI void stage_na2(const Params& p, int layer, int item, char* smem) {
  const int tid = tid_now(), lane = tid & 63, wave = tid >> 6, l31 = lane & 31, hh = lane >> 5;
  const int lrow = tid >> 3, kc8 = tid & 7;
  const int rp = item & 15, head = (item >> 4) % 6, b = item / 96;
  const int qrow = 2 * rp + (wave >> 1), qhalf = wave & 1;
  const int r0w = min(max(qrow - 4, 0), 24);
  const int rlo = min(max(2 * rp - 4, 0), 24), rhi = min(max(2 * rp - 3, 0), 24) + 7;
  const int ntile = 4 + (rhi - rlo + 1);
  const size_t hb = (size_t)(b * 6 + head);
  const bf16* K = p.KN + hb * SEQ2 * 64;
  const bf16* Vt = p.VNt + hb * 64 * SEQ2;
  float* bl = (float*)(smem + 2 * 2 * 64 * LROW);
  for (int i = tid; i < 15 * 31; i += 256) bl[i] = p.na_rel_bias[((size_t)layer * 6 + head) * 465 + i];
  bf16x8 qf[4];
  const int qc = qhalf * 32 + l31;
  const bf16* qp = p.QN + (hb * SEQ2 + qrow * 64 + qc) * 64 + 8 * hh;
#pragma unroll
  for (int s = 0; s < 4; ++s) qf[s] = *(const bf16x8*)(qp + 16 * s);
  f32x16 o[2];
#pragma unroll
  for (int e = 0; e < 16; ++e) { o[0][e] = 0.f; o[1][e] = 0.f; }
  float m = -1e30f, l = 0.f;
  const int kp = kperm(l31);
  const int c0 = min(max(qc - 8, 0), 48);
  u32x4 rk[2], rv[2];
  auto key0_of = [&](int t) { return t < 4 ? T + 64 * t : (rlo + t - 4) * 64; };
  {
    const int k0 = key0_of(0);
#pragma unroll
    for (int i = 0; i < 2; ++i) {
      rk[i] = *(const u32x4*)(K + (size_t)(k0 + lrow + 32 * i) * 64 + kc8 * 8);
      rv[i] = *(const u32x4*)(Vt + (size_t)(lrow + 32 * i) * SEQ2 + k0 + kc8 * 8);
    }
  }
#pragma unroll 1
  for (int t = 0; t < ntile; ++t) {
    char* sk = smem + (t & 1) * 2 * 64 * LROW;
    char* sv = sk + 64 * LROW;
#pragma unroll
    for (int i = 0; i < 2; ++i) {
      *(u32x4*)(sk + (lrow + 32 * i) * LROW + kc8 * 16) = rk[i];
      *(u32x4*)(sv + (lrow + 32 * i) * LROW + kc8 * 16) = rv[i];
    }
    __syncthreads();
    if (t + 1 < ntile) {
      const int k0 = key0_of(t + 1);
#pragma unroll
      for (int i = 0; i < 2; ++i) {
        rk[i] = *(const u32x4*)(K + (size_t)(k0 + lrow + 32 * i) * 64 + kc8 * 8);
        rv[i] = *(const u32x4*)(Vt + (size_t)(lrow + 32 * i) * SEQ2 + k0 + kc8 * 8);
      }
    }
    const int R = rlo + t - 4;
    const bool local = t >= 4;
    if (!local || (R >= r0w && R < r0w + 8)) {
      f32x16 st[2];
#pragma unroll
      for (int k2 = 0; k2 < 2; ++k2) {
#pragma unroll
        for (int e = 0; e < 16; ++e) st[k2][e] = 0.f;
#pragma unroll
        for (int s = 0; s < 4; ++s) {
          bf16x8 kf = *(const bf16x8*)(sk + (k2 * 32 + kp) * LROW + (16 * s + 8 * hh) * 2);
          st[k2] = MFMA(kf, qf[s], st[k2]);
        }
      }
      if (local) {
        const float* brow = bl + (R - qrow + 7) * 31 + (15 - qc);
#pragma unroll
        for (int k2 = 0; k2 < 2; ++k2)
#pragma unroll
          for (int e = 0; e < 16; ++e) {
            const int kc = k2 * 32 + keyoff(e, hh);
            const bool valid = (kc >= c0) && (kc < c0 + 16);
            const float bv = brow[valid ? kc : qc];
            st[k2][e] = valid ? st[k2][e] + bv : -1e30f;
          }
      }
      float mx = st[0][0];
#pragma unroll
      for (int e = 1; e < 16; ++e) mx = fmaxf(mx, st[0][e]);
#pragma unroll
      for (int e = 0; e < 16; ++e) mx = fmaxf(mx, st[1][e]);
      mx = fmaxf(mx, shx(mx, 32, lane));
      const float mn = fmaxf(m, mx);
      const float mnl = mn * L2E;
      const float alpha = fexp2(m * L2E - mnl);
      float ls = 0.f;
#pragma unroll
      for (int k2 = 0; k2 < 2; ++k2)
#pragma unroll
        for (int e = 0; e < 16; ++e) { st[k2][e] = fexp2(st[k2][e] * L2E - mnl); ls += st[k2][e]; }
      l = l * alpha + ls; m = mn;
#pragma unroll
      for (int e = 0; e < 16; ++e) { o[0][e] *= alpha; o[1][e] *= alpha; }
#pragma unroll
      for (int k2 = 0; k2 < 2; ++k2)
#pragma unroll
        for (int s2 = 0; s2 < 2; ++s2) {
          bf16x8 pf = pack8(st[k2], s2);
#pragma unroll
          for (int dt = 0; dt < 2; ++dt) {
            bf16x8 vf = *(const bf16x8*)(sv + (dt * 32 + l31) * LROW + (k2 * 32 + 16 * s2 + 8 * hh) * 2);
            o[dt] = MFMA(vf, pf, o[dt]);
          }
        }
    }
  }
  l += shx(l, 32, lane);
  const float inv = 1.f / l;
  bf16* dst = p.CAT + (size_t)(b * T + qrow * 64 + qc) * D + 256 + head * 64;
#pragma unroll
  for (int dt = 0; dt < 2; ++dt)
#pragma unroll
    for (int g = 0; g < 4; ++g)
      store4(dst + dt * 32 + 8 * g + 4 * hh, o[dt][4 * g] * inv, o[dt][4 * g + 1] * inv, o[dt][4 * g + 2] * inv, o[dt][4 * g + 3] * inv);
  __syncthreads();
}

constexpr int FA_SMEM = 2 * 2 * 64 * LROW;
DI void flash_block(const bf16* __restrict__ Q, const bf16* __restrict__ K, const bf16* __restrict__ Vt, int q0, int kt0, int kt1,
                    bf16* __restrict__ dst  , char* smem) {
  const int tid = tid_now(), lane = tid & 63, wave = tid >> 6, l31 = lane & 31, hh = lane >> 5;
  const int lrow = tid >> 3, kc = tid & 7;
  bf16x8 qf[4];
  const bf16* qp = Q + (size_t)(q0 + wave * 32 + l31) * 64 + 8 * hh;
#pragma unroll
  for (int s = 0; s < 4; ++s) qf[s] = *(const bf16x8*)(qp + 16 * s);
  f32x16 o[2];
#pragma unroll
  for (int e = 0; e < 16; ++e) { o[0][e] = 0.f; o[1][e] = 0.f; }
  float m = -1e30f, l = 0.f;
  const int kp = kperm(l31);
  u32x4 rk[2], rv[2];
#pragma unroll
  for (int i = 0; i < 2; ++i) {
    rk[i] = *(const u32x4*)(K + (size_t)(kt0 * 64 + lrow + 32 * i) * 64 + kc * 8);
    rv[i] = *(const u32x4*)(Vt + (size_t)(lrow + 32 * i) * SEQ2 + kt0 * 64 + kc * 8);
  }
  for (int kt = kt0; kt < kt1; ++kt) {
    char* sk = smem + ((kt - kt0) & 1) * 2 * 64 * LROW;
    char* sv = sk + 64 * LROW;
#pragma unroll
    for (int i = 0; i < 2; ++i) {
      *(u32x4*)(sk + (lrow + 32 * i) * LROW + kc * 16) = rk[i];
      *(u32x4*)(sv + (lrow + 32 * i) * LROW + kc * 16) = rv[i];
    }
    __syncthreads();
    if (kt + 1 < kt1) {
#pragma unroll
      for (int i = 0; i < 2; ++i) {
        rk[i] = *(const u32x4*)(K + (size_t)((kt + 1) * 64 + lrow + 32 * i) * 64 + kc * 8);
        rv[i] = *(const u32x4*)(Vt + (size_t)(lrow + 32 * i) * SEQ2 + (kt + 1) * 64 + kc * 8);
      }
    }
    f32x16 st[2];
#pragma unroll
    for (int k2 = 0; k2 < 2; ++k2) {
#pragma unroll
      for (int e = 0; e < 16; ++e) st[k2][e] = 0.f;
#pragma unroll
      for (int s = 0; s < 4; ++s) {
        bf16x8 kf = *(const bf16x8*)(sk + (k2 * 32 + kp) * LROW + (16 * s + 8 * hh) * 2);
        st[k2] = MFMA(kf, qf[s], st[k2]);
      }
    }
    float mx = st[0][0];
#pragma unroll
    for (int e = 1; e < 16; ++e) mx = fmaxf(mx, st[0][e]);
#pragma unroll
    for (int e = 0; e < 16; ++e) mx = fmaxf(mx, st[1][e]);
    mx = fmaxf(mx, shx(mx, 32, lane));
    const float mn = fmaxf(m, mx);
    const float mnl = mn * L2E;
    const float alpha = fexp2(m * L2E - mnl);
    float ls = 0.f;
#pragma unroll
    for (int k2 = 0; k2 < 2; ++k2)
#pragma unroll
      for (int e = 0; e < 16; ++e) { st[k2][e] = fexp2(st[k2][e] * L2E - mnl); ls += st[k2][e]; }
    l = l * alpha + ls; m = mn;
#pragma unroll
    for (int e = 0; e < 16; ++e) { o[0][e] *= alpha; o[1][e] *= alpha; }
#pragma unroll
    for (int k2 = 0; k2 < 2; ++k2)
#pragma unroll
      for (int s2 = 0; s2 < 2; ++s2) {
        bf16x8 pf = pack8(st[k2], s2);
#pragma unroll
        for (int dt = 0; dt < 2; ++dt) {
          bf16x8 vf = *(const bf16x8*)(sv + (dt * 32 + l31) * LROW + (k2 * 32 + 16 * s2 + 8 * hh) * 2);
          o[dt] = MFMA(vf, pf, o[dt]);
        }
      }
  }
  l += shx(l, 32, lane);
  const float inv = (PROBE == 11) ? 0.f : 1.f / l;
  bf16* d2 = dst + (size_t)(wave * 32 + l31) * D;
#pragma unroll
  for (int dt = 0; dt < 2; ++dt)
#pragma unroll
    for (int g = 0; g < 4; ++g)
      store4(d2 + dt * 32 + 8 * g + 4 * hh, o[dt][4 * g] * inv, o[dt][4 * g + 1] * inv, o[dt][4 * g + 2] * inv, o[dt][4 * g + 3] * inv);
  __syncthreads();
}
constexpr int GQA_ITEMS = 16 * 6 * 16;
DI void stage_gqa(const Params& p, int item, char* smem) {
  const int qt = item & 15, hq = (item >> 4) % 6, b = item / 96;
  const int kvh = hq / 3;
  flash_block(p.QG + (size_t)(b * 6 + hq) * SEQ2 * 64, p.KG + (size_t)(b * 2 + kvh) * SEQ2 * 64, p.VGt + (size_t)(b * 2 + kvh) * 64 * SEQ2,
              qt * 128, 0, 36, p.CAT + (size_t)(b * T + qt * 128) * D + 640 + hq * 64, smem);
}
constexpr int CTXATT_ITEMS = 384;
DI void stage_ctxatt(const Params& p, int item, char* smem) {
  const int qt = item & 1, head = (item >> 1) % 6, which = (item / 12) & 1, b = item / 24;
  bf16* dst = p.CAT + (size_t)(NTOK + b * CL + qt * 128) * D;
  if (which == 0)
    flash_block(p.QN + (size_t)(b * 6 + head) * SEQ2 * 64, p.KN + (size_t)(b * 6 + head) * SEQ2 * 64, p.VNt + (size_t)(b * 6 + head) * 64 * SEQ2,
                T + qt * 128, 32, 36, dst + 256 + head * 64, smem);
  else
    flash_block(p.QG + (size_t)(b * 6 + head) * SEQ2 * 64, p.KG + (size_t)(b * 2 + head / 3) * SEQ2 * 64, p.VGt + (size_t)(b * 2 + head / 3) * 64 * SEQ2,
                T + qt * 128, 32, 36, dst + 640 + head * 64, smem);
}

constexpr int OUTPROJ_ITEMS = 288 * 8;
DI void stage_outproj(const Params& p, int layer, int item, char* smem) {
  const int mt = item >> 3, nt = item & 7;
  if (layer == 1 && mt >= 256) return;
  const int row0 = mt * 128, n0 = nt * 128;
  f32x16 acc[2][2];
  gemm_core<true>(p.CAT + (size_t)row0 * D, p.wout + ((size_t)layer * D + n0) * D, smem, acc);
  const int lane = tid_now() & 63, wave = tid_now() >> 6, wm = wave >> 1, wn = wave & 1, l31 = lane & 31, hh = lane >> 5;
  const float* g1 = p.mod + ((size_t)layer * 17 + mod_row(row0)) * 6144 + 2048;
#pragma unroll
  for (int tt = 0; tt < 2; ++tt) {
    const int row = row0 + wm * 64 + tt * 32 + l31;
    const float* xr = xin_row(p, layer, row);
    float* dr = xres_row(p, row);
    float4 xv[2][4], gv[2][4];
#pragma unroll
    for (int ft = 0; ft < 2; ++ft)
#pragma unroll
      for (int g = 0; g < 4; ++g) {
        const int n = n0 + wn * 64 + ft * 32 + 8 * g + 4 * hh;
        xv[ft][g] = *(const float4*)(xr + n); gv[ft][g] = *(const float4*)(g1 + n);
        if (PROBE == 2) { gv[ft][g].x = gv[ft][g].y = gv[ft][g].z = gv[ft][g].w = 0.f; }
      }
#pragma unroll
    for (int ft = 0; ft < 2; ++ft)
#pragma unroll
      for (int g = 0; g < 4; ++g) {
        const int n = n0 + wn * 64 + ft * 32 + 8 * g + 4 * hh;
        float4 o = {xv[ft][g].x + gv[ft][g].x * acc[ft][tt][4 * g], xv[ft][g].y + gv[ft][g].y * acc[ft][tt][4 * g + 1],
                    xv[ft][g].z + gv[ft][g].z * acc[ft][tt][4 * g + 2], xv[ft][g].w + gv[ft][g].w * acc[ft][tt][4 * g + 3]};
        *(float4*)(dr + n) = o;
      }
  }
}

constexpr int ROUTE_ITEMS = 288 * 8;
constexpr int QROW = 272;
DI int to_sortable(int b) { return b ^ ((b >> 31) & 0x7fffffff); }

#define CAND_LIST(X) \
  X(0,0,0) X(1,0,1) X(2,0,2) X(3,0,3) X(4,0,4) X(5,0,5) X(6,0,6) X(7,0,7) X(8,0,8) X(9,0,9) X(10,0,10) X(11,0,11) X(12,0,12) X(13,0,13) X(14,0,14) X(15,0,15) \
  X(16,1,1) X(17,1,2) X(18,1,3) X(19,1,4) X(20,1,5) X(21,1,6) X(22,1,7) \
  X(23,2,2) X(24,2,3) X(25,2,4) \
  X(26,3,3)

DI void stage_route(const Params& p, int layer, int item, char* smem) {
  const int mt = item >> 3, head = item & 7;
  if (layer == 1 && mt >= 256) return;
  const int row0 = mt * 128;
  const int tid = tid_now(), lane = tid & 63, wave = tid >> 6, wm = wave >> 1, wn = wave & 1, l31 = lane & 31, hh = lane >> 5;
  int t0[16], tk[16];
  char* Qs = smem;
  char* Ks = smem + 2 * LTILE;
#pragma unroll 1
  for (int pp = 0; pp < 2; ++pp) {
    {
      f32x16 acc[2][2];
      gemm_core<true>(p.H + (size_t)row0 * D, p.wq + ((size_t)layer * 2048 + (head * 2 + pp) * 128) * D, smem, acc);
#pragma unroll
      for (int tt = 0; tt < 2; ++tt)
#pragma unroll
        for (int ft = 0; ft < 2; ++ft)
#pragma unroll
          for (int g = 0; g < 4; ++g) {
            const int tok = wm * 64 + tt * 32 + l31, kf = wn * 64 + ft * 32 + 8 * g + 4 * hh;
            u32x2 o = {pack2(acc[ft][tt][4 * g], acc[ft][tt][4 * g + 1]), pack2(acc[ft][tt][4 * g + 2], acc[ft][tt][4 * g + 3])};
            *(u32x2*)(Qs + tok * QROW + kf * 2) = o;
          }
    }
    const bf16* kp = p.pk + ((size_t)((layer * 8 + head) * 2 + pp) * 128) * 128;
#pragma unroll
    for (int i = 0; i < 8; ++i) {
      const int c = tid + 256 * i, n = c >> 4, kc = c & 15;
      *(u32x4*)(Ks + n * QROW + kc * 16) = *(const u32x4*)(kp + n * 128 + kc * 8);
    }
    __syncthreads();
    int key[64];
    {
      f32x16 sc[4];
#pragma unroll
      for (int nt = 0; nt < 4; ++nt)
#pragma unroll
        for (int e = 0; e < 16; ++e) sc[nt][e] = 0.f;
#pragma unroll
      for (int s = 0; s < 8; ++s) {
        bf16x8 qb = *(const bf16x8*)(Qs + (wave * 32 + l31) * QROW + (16 * s + 8 * hh) * 2);
#pragma unroll
        for (int nt = 0; nt < 4; ++nt) {
          bf16x8 ka = *(const bf16x8*)(Ks + (nt * 32 + l31) * QROW + (16 * s + 8 * hh) * 2);
          sc[nt] = MFMA(ka, qb, sc[nt]);
        }
      }
#pragma unroll
      for (int nt = 0; nt < 4; ++nt)
#pragma unroll
        for (int e = 0; e < 16; ++e) {
          const int n = nt * 32 + crow(e, hh);
          int b = (__float_as_int(sc[nt][e]) & ~127) | n;
          key[nt * 16 + e] = to_sortable(b);
        }
    }
#pragma unroll
    for (int r = 0; r < 16; ++r) {
      int mx = key[0];
#pragma unroll
      for (int i = 1; i < 64; ++i) mx = max(mx, key[i]);
      mx = max(mx, shxi(mx, 32, lane));
      tk[r] = mx;
#pragma unroll
      for (int i = 0; i < 64; ++i) key[i] = (key[i] == mx) ? (int)0x80000000 : key[i];
    }
    if (pp == 0) {
#pragma unroll
      for (int r = 0; r < 16; ++r) t0[r] = tk[r];
    }
    __syncthreads();
  }
  float av[16], bv[16]; int ai[16], bi[16];
#pragma unroll
  for (int i = 0; i < 16; ++i) {
    int k1 = to_sortable(t0[i]), k2 = to_sortable(tk[i]);
    int a = hh ? k2 : k1, b = hh ? k1 : k2;
    av[i] = __int_as_float(a & ~127); ai[i] = a & 127;
    bv[i] = __int_as_float(b & ~127); bi[i] = b & 127;
  }
  int cand[27], eid[27];
#define MKC(c, i, j) { int b = __float_as_int(av[i] + bv[j]); cand[c] = (to_sortable(b) & ~63) | (c * 2 + hh); \
                       eid[c] = hh ? (bi[j] * 128 + ai[i]) : (ai[i] * 128 + bi[j]); \
                       if (i == j && hh) cand[c] = (int)0x80000000; }
  CAND_LIST(MKC)
#undef MKC
  int win[16], weid[16];
#pragma unroll
  for (int r = 0; r < 16; ++r) {
    int mx = cand[0];
#pragma unroll
    for (int c = 1; c < 27; ++c) mx = max(mx, cand[c]);
    mx = max(mx, shxi(mx, 32, lane));
    int e = 0;
#pragma unroll
    for (int c = 0; c < 27; ++c) { const bool hit = cand[c] == mx; e = hit ? eid[c] : e; cand[c] = hit ? (int)0x80000000 : cand[c]; }
    e |= shxi(e, 32, lane);
    win[r] = mx; weid[r] = e;
  }
  float gsum = 0.f, gv[16];
  const float v0 = __int_as_float(to_sortable(win[0]) & ~63);
#pragma unroll
  for (int r = 0; r < 16; ++r) { gv[r] = __expf(__int_as_float(to_sortable(win[r]) & ~63) - v0); gsum += gv[r]; }
  const float ginv = 1.f / gsum;
  const int row = row0 + wave * 32 + l31;
  if (hh == 0) {
    int4* d = (int4*)(p.ridx + ((size_t)row * 8 + head) * 32);
#pragma unroll
    for (int q = 0; q < 4; ++q) { int4 o = {weid[4 * q], weid[4 * q + 1], weid[4 * q + 2], weid[4 * q + 3]}; d[q] = o; }
  } else {
    float4* d = (float4*)((float*)p.ridx + ((size_t)row * 8 + head) * 32 + 16);
#pragma unroll
    for (int q = 0; q < 4; ++q) { float4 o = {gv[4 * q] * ginv, gv[4 * q + 1] * ginv, gv[4 * q + 2] * ginv, gv[4 * q + 3] * ginv}; d[q] = o; }
  }
}

DI float dot2(unsigned a, unsigned b, float acc) {
  bf2_t x = __builtin_bit_cast(bf2_t, a), y = __builtin_bit_cast(bf2_t, b);
  return __builtin_amdgcn_fdot2_f32_bf16(x, y, acc, false);
}
DI float dot8(u32x4 a, u32x4 b, float acc) {
  const unsigned a0 = a[0], a1 = a[1], a2 = a[2], a3 = a[3], b0 = b[0], b1 = b[1], b2 = b[2], b3 = b[3];
  acc = dot2(a0, b0, acc); acc = dot2(a1, b1, acc); acc = dot2(a2, b2, acc); acc = dot2(a3, b3, acc);
  return acc;
}
DI void axpy8(float (&o)[8], float w, u32x4 v) {
  o[0] += w * bf_lo(v.x); o[1] += w * bf_hi(v.x); o[2] += w * bf_lo(v.y); o[3] += w * bf_hi(v.y);
  o[4] += w * bf_lo(v.z); o[5] += w * bf_hi(v.z); o[6] += w * bf_lo(v.w); o[7] += w * bf_hi(v.w);
}
constexpr int GATHER_ITEMS = MTOT / 4;
DI float dot4f8(unsigned u, unsigned hlo, unsigned hhi, float acc) {
  bf2_t a = __builtin_amdgcn_cvt_scalef32_pk_bf16_fp8((int)u, 1.0f, false);
  bf2_t b = __builtin_amdgcn_cvt_scalef32_pk_bf16_fp8((int)u, 1.0f, true);
  bf2_t x = __builtin_bit_cast(bf2_t, hlo), y = __builtin_bit_cast(bf2_t, hhi);
  acc = __builtin_amdgcn_fdot2_f32_bf16(a, x, acc, false);
  acc = __builtin_amdgcn_fdot2_f32_bf16(b, y, acc, false);
  return acc;
}
DI void axpy4f8(float& o0, float& o1, float& o2, float& o3, float w, unsigned v) {
  f2_t lo = __builtin_amdgcn_cvt_pk_f32_fp8((int)v, false), hi = __builtin_amdgcn_cvt_pk_f32_fp8((int)v, true);
  o0 += w * lo[0]; o1 += w * lo[1]; o2 += w * hi[0]; o3 += w * hi[1];
}
DI void stage_gather(const Params& p, int layer, int item) {
  const int lane = tid_now() & 63, wave = tid_now() >> 6;
  const int row = item * 4 + wave;
  if (layer == 1 && row >= NTOK) return;
  const int* rr = p.ridx + (size_t)row * 256 + (lane >> 4) * 32 + (lane & 15);
  const int idxA = rr[0], idxB = rr[128];
  const float gA = __int_as_float(rr[16]), gB = __int_as_float(rr[144]);
  const bf16* hr = p.H + (size_t)row * D + lane * 16;
  const u32x4 hA = *(const u32x4*)(hr), hB = *(const u32x4*)(hr + 8);
  const unsigned h0 = hA[0], h1 = hA[1], h2 = hA[2], h3 = hA[3], h4 = hB[0], h5 = hB[1], h6 = hB[2], h7 = hB[3];
  float o[16];
#pragma unroll
  for (int i = 0; i < 16; ++i) o[i] = 0.f;
  const __amdgpu_buffer_rsrc_t rU = __builtin_amdgcn_make_buffer_rsrc((void*)(p.pu8 + (size_t)layer * NEXP * D), 0, NEXP * D, 0x00020000);
  const __amdgpu_buffer_rsrc_t rV = __builtin_amdgcn_make_buffer_rsrc((void*)(p.pv8 + (size_t)layer * NEXP * D), 0, NEXP * D, 0x00020000);
  const int voff = lane * 16;
  u32x4 ua[16], va[16];
#pragma unroll
  for (int k = 0; k < 16; ++k) {
    const int e = __builtin_amdgcn_readlane(idxA, k);
    ua[k] = __builtin_amdgcn_raw_buffer_load_b128(rU, voff, e * D, 0);
  }
#pragma unroll
  for (int k = 0; k < 16; ++k) {
    const int e = __builtin_amdgcn_readlane(idxA, k);
    va[k] = __builtin_amdgcn_raw_buffer_load_b128(rV, voff, e * D, 0);
  }
#pragma unroll
  for (int head = 0; head < 8; ++head) {
    float part[16];
#pragma unroll
    for (int k = 0; k < 16; ++k) {
      const unsigned a0 = ua[k][0], a1 = ua[k][1], a2 = ua[k][2], a3 = ua[k][3];
      float s = dot4f8(a0, h0, h1, 0.f);
      s = dot4f8(a1, h2, h3, s); s = dot4f8(a2, h4, h5, s); s = dot4f8(a3, h6, h7, s);
      part[k] = s;
    }
    asm volatile("" ::: "memory");
    if (head < 7) {
#pragma unroll
      for (int k = 0; k < 16; ++k) {
        const int e = __builtin_amdgcn_readlane((head + 1) < 4 ? idxA : idxB, ((head + 1) & 3) * 16 + k);
        ua[k] = __builtin_amdgcn_raw_buffer_load_b128(rU, voff, e * D, 0);
      }
    }
    float r8[8], r4[4], r2[2], r1;
    {
      const bool up = lane & 32;
#pragma unroll
      for (int k = 0; k < 8; ++k) { float keep = up ? part[k + 8] : part[k], give = up ? part[k] : part[k + 8]; r8[k] = keep + shx(give, 32, lane); }
    }
    {
      const bool up = lane & 16;
#pragma unroll
      for (int k = 0; k < 4; ++k) { float keep = up ? r8[k + 4] : r8[k], give = up ? r8[k] : r8[k + 4]; r4[k] = keep + shx(give, 16, lane); }
    }
    {
      const bool up = lane & 8;
#pragma unroll
      for (int k = 0; k < 2; ++k) { float keep = up ? r4[k + 2] : r4[k], give = up ? r4[k] : r4[k + 2]; r2[k] = keep + shx(give, 8, lane); }
    }
    {
      const bool up = lane & 4;
      float keep = up ? r2[1] : r2[0], give = up ? r2[0] : r2[1];
      r1 = keep + shx(give, 4, lane);
    }
    r1 += shx(r1, 2, lane);
    r1 += shx(r1, 1, lane);
    const float myg = __int_as_float(__builtin_amdgcn_ds_bpermute(((head & 3) * 16 + ((lane >> 2) & 15)) << 2, __float_as_int(head < 4 ? gA : gB)));
    const float w = gelu_tanh(r1 * (1.f / SU)) * myg * (1.f / SV);
#pragma unroll
    for (int k = 0; k < 16; ++k) {
      const float wk = __int_as_float(__builtin_amdgcn_readlane(__float_as_int(w), k << 2));
      const unsigned a0 = va[k][0], a1 = va[k][1], a2 = va[k][2], a3 = va[k][3];
      axpy4f8(o[0], o[1], o[2], o[3], wk, a0); axpy4f8(o[4], o[5], o[6], o[7], wk, a1);
      axpy4f8(o[8], o[9], o[10], o[11], wk, a2); axpy4f8(o[12], o[13], o[14], o[15], wk, a3);
    }
    asm volatile("" ::: "memory");
    if (head < 7) {
#pragma unroll
      for (int k = 0; k < 16; ++k) {
        const int e = __builtin_amdgcn_readlane((head + 1) < 4 ? idxA : idxB, ((head + 1) & 3) * 16 + k);
        va[k] = __builtin_amdgcn_raw_buffer_load_b128(rV, voff, e * D, 0);
      }
    }
  }
  const float* g2 = p.mod + ((size_t)layer * 17 + mod_row(row)) * 6144 + 5120 + lane * 16;
  float* dr = xres_row(p, row) + lane * 16;
  float4 xv[4], gv[4];
#pragma unroll
  for (int q = 0; q < 4; ++q) { xv[q] = *(const float4*)(dr + 4 * q); gv[q] = *(const float4*)(g2 + 4 * q); }
#pragma unroll
  for (int q = 0; q < 4; ++q) {
    float4 r = {xv[q].x + gv[q].x * o[4 * q], xv[q].y + gv[q].y * o[4 * q + 1], xv[q].z + gv[q].z * o[4 * q + 2], xv[q].w + gv[q].w * o[4 * q + 3]};
    *(float4*)(dr + 4 * q) = r;
  }
}

#include <hip/hip_cooperative_groups.h>
namespace cg = cooperative_groups;
constexpr int SMEM_BYTES = GEMM_SMEM;


#define XB_TMO      128
#define XB_XCNT(j)  (256  + 64 * (j))
#define XB_XSUB(j)  (1280 + 64 * (j))
#define XB_XGEN(j)  (2304 + 64 * (j))
#define XB_TOP      3328
#define XB_TOPGEN   3392
#define XCD_BAR_WORDS 3456
#define XB_SPIN_CAP (1u << 22)
#define LAS __attribute__((address_space(3)))
DI unsigned xb_ld(unsigned* p) { return __hip_atomic_load(p, __ATOMIC_RELAXED, __HIP_MEMORY_SCOPE_AGENT); }
DI unsigned xb_add(unsigned* p, unsigned v) { return __hip_atomic_fetch_add(p, v, __ATOMIC_RELAXED, __HIP_MEMORY_SCOPE_AGENT); }
DI unsigned xb_xcc_id() { return (unsigned)__builtin_amdgcn_s_getreg((3 << 11) | 20) & 0xFu; }
#define XB_SPIN(cond, bar) do { unsigned _sp = 0; while (cond) { __builtin_amdgcn_s_sleep(1); \
    if ((++_sp & 255u) == 0u) { if (xb_ld(&(bar)[XB_TMO])) break; if (_sp > XB_SPIN_CAP) { atomicAdd(&(bar)[XB_TMO], 1u); break; } } } } while (0)
struct XcdBarrier { unsigned* bar; unsigned x; volatile LAS unsigned* st; };
DI XcdBarrier xcd_barrier_post(unsigned* bar, volatile LAS unsigned* st) {
  XcdBarrier b; b.bar = bar; b.x = xb_xcc_id(); b.st = st;
  if (tid_now() == 0) (void)xb_add(&bar[XB_XCNT(b.x)], 1u);
  return b;
}
DI void xcd_barrier_complete(unsigned* bar, unsigned x, unsigned& nloc, unsigned& nx) {
  const unsigned G = gridDim.x;
  unsigned sum, cnt, mine, sp = 0u;
  for (;;) {
    sum = 0u; cnt = 0u; mine = 0u;
#pragma unroll
    for (unsigned j = 0; j < 16; ++j) { const unsigned c = xb_ld(&bar[XB_XCNT(j)]); sum += c; cnt += (c > 0u) ? 1u : 0u; mine = (j == x) ? c : mine; }
    if (sum == G) break;
    __builtin_amdgcn_s_sleep(1);
    if ((++sp & 255u) == 0u) { if (xb_ld(&bar[XB_TMO])) break; if (sp > XB_SPIN_CAP) { atomicAdd(&bar[XB_TMO], 1u); break; } }
  }
  nloc = mine > 0u ? mine : 1u; nx = cnt > 0u ? cnt : 1u;
}
DI void xcd_barrier(const XcdBarrier& b) {
  asm volatile("s_waitcnt vmcnt(0)" ::: "memory");
  __syncthreads();
  if (tid_now() == 0) {
    unsigned* bar = b.bar;
    __builtin_amdgcn_s_waitcnt(0);
    unsigned nloc = b.st[0], nx = b.st[1];
    if (nloc == 0u) { xcd_barrier_complete(bar, b.x, nloc, nx); b.st[0] = nloc; b.st[1] = nx; }
    const unsigned old = xb_add(&bar[XB_XSUB(b.x)], 1u);
    const unsigned gen = old / nloc;
    if (old + 1u == (gen + 1u) * nloc) {
      __builtin_amdgcn_fence(__ATOMIC_RELEASE, "agent");
      asm volatile("s_waitcnt vmcnt(0)" ::: "memory");
      const unsigned og = xb_add(&bar[XB_TOP], 1u);
      const unsigned tg = og / nx;
      if (og + 1u == (tg + 1u) * nx) xb_add(&bar[XB_TOPGEN], 1u);
      else XB_SPIN(xb_ld(&bar[XB_TOPGEN]) == tg, bar);
      __builtin_amdgcn_fence(__ATOMIC_ACQUIRE, "agent");
      xb_add(&bar[XB_XGEN(b.x)], 1u);
      asm volatile("s_waitcnt vmcnt(0)" ::: "memory");
    } else {
      XB_SPIN(xb_ld(&bar[XB_XGEN(b.x)]) == gen, bar);
      __builtin_amdgcn_fence(__ATOMIC_ACQUIRE, "agent");
      asm volatile("s_waitcnt vmcnt(0)" ::: "memory");
    }
  }
  __syncthreads();
}

#define GRID_BARRIER() xcd_barrier(xb)
#define REP(k) for (int rep_ = 0; rep_ < (DUP == (k) ? 2 : 1); ++rep_)

__global__ void __launch_bounds__(256, 2) mega_kernel(Params p) {
  __shared__ __attribute__((aligned(16))) char smem[SMEM_BYTES];
  cg::grid_group grid = cg::this_grid();
  const int G = gridDim.x, bid = blockIdx.x;
  __shared__ uint4 xb_words;
  if (tid_now() == 0) xb_words = make_uint4(0u, 0u, 0u, 0u);
  if (bid == 0) for (int i = tid_now(); i < XCD_BAR_WORDS; i += 256) p.bar[i] = 0u;
  REP(1) for (int it = bid; it < MODP_ITEMS + CONVT_ITEMS + CONVS_ITEMS + 1; it += G) {
    if (it < MODP_ITEMS) stage_mod_partial(p, it, smem);
    else if (it < MODP_ITEMS + CONVT_ITEMS) stage_convT(p, it - MODP_ITEMS, smem);
    else if (it < MODP_ITEMS + CONVT_ITEMS + CONVS_ITEMS) stage_convS(p, it - MODP_ITEMS - CONVT_ITEMS);
    else stage_rope(p);
  }
  grid.sync();
  XcdBarrier xb = xcd_barrier_post(p.bar, (volatile LAS unsigned*)&xb_words);
  for (int it = bid; it < MODR_ITEMS; it += G) stage_mod_reduce(p, it);
  GRID_BARRIER();
#pragma unroll 1
  for (int l = 0; l < 2; ++l) {
    REP(2) for (int it = bid; it < MTOT / 4; it += G) stage_norm(p, l, 0, it);
    GRID_BARRIER();
    {
      const int n = l == 0 ? INPROJ_ITEMS : 256 * 18 + 32 * 8;
      REP(3) for (int it = bid; it < n; it += G) {
        int item = it;
        if (it >= 256 * 18) { const int r = it - 256 * 18; item = l == 0 ? it : (256 + (r >> 3)) * 18 + 10 + (r & 7); }
        stage_inproj(p, l, item, smem);
      }
    }
    GRID_BARRIER();
    {
      const int nconv = l == 0 ? 1152 : 1024, nctx = l == 0 ? CTXATT_ITEMS : 0;
      const int n = GQA_ITEMS + NA2_ITEMS + nconv + nctx;
      REP(4) for (int it = bid; it < n; it += G) {
        if (it < GQA_ITEMS) { if (DUP != 41 && DUP != 42) stage_gqa(p, it, smem); if (DUP == 40) stage_gqa(p, it, smem); }
        else if (it < GQA_ITEMS + NA2_ITEMS) { stage_na2(p, l, it - GQA_ITEMS, smem); if (DUP == 43) stage_na2(p, l, it - GQA_ITEMS, smem); }
        else if (it < GQA_ITEMS + NA2_ITEMS + nconv) { stage_conv(p, l, it - GQA_ITEMS - NA2_ITEMS, smem); if (DUP == 44) stage_conv(p, l, it - GQA_ITEMS - NA2_ITEMS, smem); }
        else stage_ctxatt(p, it - GQA_ITEMS - NA2_ITEMS - nconv, smem);
      }
    }
    GRID_BARRIER();
    {
      const int n = (l == 0 ? 288 : 256) * 8;
      for (int it = bid; it < n; it += G) stage_outproj(p, l, it, smem);
    }
    GRID_BARRIER();
    {
      const int n = (l == 0 ? MTOT : NTOK) / 4;
      REP(6) for (int it = bid; it < n; it += G) stage_norm(p, l, 1, it);
    }
    GRID_BARRIER();
    {
      const int n = (l == 0 ? 288 : 256) * 8;
      REP(7) for (int it = bid; it < n; it += G) stage_route(p, l, it, smem);
    }
    GRID_BARRIER();
    {
      const int n = (l == 0 ? MTOT : NTOK) / 4;
      for (int it = bid; it < n; it += G) stage_gather(p, l, it);
    }
    GRID_BARRIER();
  }
  for (int it = bid; it < NTOK / 4; it += G) stage_final(p, it);
}

extern "C" void kernel_launch(void* const* d_in, const int* in_sizes, int n_in, void* d_out, int out_size, void* d_ws, size_t ws_size,
                              hipStream_t stream) {
  Params p{};
  const float** f = (const float**)&p;
  for (int i = 0; i < 22; ++i) f[i] = (const float*)d_in[i];
  p.out = (float*)d_out;
  char* w = (char*)d_ws; size_t off = 0;
  auto take = [&](size_t bytes) { char* r = w + off; off += (bytes + 255) & ~(size_t)255; return r; };
  p.win = (bf16*)take((size_t)2 * INC * D * 2);
  p.wout = (bf16*)take((size_t)2 * D * D * 2);
  p.wq = (bf16*)take((size_t)2 * 2048 * D * 2);
  p.pk = (bf16*)take(PK_N * 2);
  p.pu8 = (unsigned char*)take(PU_N);
  p.pv8 = (unsigned char*)take(PU_N);
  p.modp = (float*)take((size_t)2 * 8 * 17 * 6144 * 4);
  p.mod = (float*)take((size_t)2 * 17 * 6144 * 4);
  p.ropetab = (float*)take(64 * 16 * 2 * 4);
  p.H = (bf16*)take((size_t)MTOT * D * 2);
  p.CAT = p.H;
  p.U = (bf16*)take((size_t)MTOT * 256 * 2);
  p.QN = (bf16*)take((size_t)NB * 6 * SEQ2 * 64 * 2);
  p.KN = (bf16*)take((size_t)NB * 6 * SEQ2 * 64 * 2);
  p.VNt = (bf16*)take((size_t)NB * 6 * SEQ2 * 64 * 2);
  p.QG = (bf16*)take((size_t)NB * 6 * SEQ2 * 64 * 2);
  p.KG = (bf16*)take((size_t)NB * 2 * SEQ2 * 64 * 2);
  p.VGt = (bf16*)take((size_t)NB * 2 * SEQ2 * 64 * 2);
  p.XC = (float*)take((size_t)NCTX * D * 4);
  p.ridx = (int*)take((size_t)MTOT * 256 * 4);
  p.rg = (float*)p.ridx;
  p.bar = (unsigned*)take(XCD_BAR_WORDS * 4);
  if (off > ws_size) return;
  static int grid_blocks = 0;
  if (!grid_blocks) {
    int dev = 0, cus = 0, per_cu = 0;
    hipGetDevice(&dev);
    hipDeviceGetAttribute(&cus, hipDeviceAttributeMultiprocessorCount, dev);
    hipOccupancyMaxActiveBlocksPerMultiprocessor(&per_cu, mega_kernel, 256, 0);
    if (per_cu > 2) per_cu = 2;
    grid_blocks = cus * per_cu;
  }
  void* args[] = {&p};
  hipLaunchCooperativeKernel((void*)mega_kernel, dim3(grid_blocks), dim3(256), args, 0, stream);
}
```

```cpp
#include <hip/hip_runtime.h>
#include <stdint.h>

typedef __attribute__((ext_vector_type(8))) short bf16x8;
typedef __attribute__((ext_vector_type(16))) float f32x16;
typedef __attribute__((ext_vector_type(2))) __bf16 bf2_t;
typedef __attribute__((ext_vector_type(2))) float f2_t;
typedef unsigned short bf16;
typedef __attribute__((ext_vector_type(2))) _Float16 h2_t;
typedef __attribute__((ext_vector_type(4))) unsigned u32x4;
typedef __attribute__((ext_vector_type(2))) unsigned u32x2;

#define DI __device__ __forceinline__
#ifndef PROBE
#define PROBE 0
#endif
#ifndef DUP
#define DUP 0
#endif
#define MFMA(a, b, c) __builtin_amdgcn_mfma_f32_32x32x16_bf16((a), (b), (c), 0, 0, 0)

constexpr int D = 1024, NB = 16, T = 2048, CL = 256;
constexpr int NTOK = NB * T;
constexpr int NCTX = NB * CL;
constexpr int MTOT = NTOK + NCTX;
constexpr int INC = 2304;
constexpr int SEQ2 = T + CL;
constexpr int NEXP = 16384;
constexpr float EPS = 1e-6f;
constexpr float L2E = 1.4426950408889634f;

struct Params {
  const float *x, *c, *ctx, *c_ctx, *norm1_g, *norm2_g, *w_ada, *b_ada, *w_in, *conv_w, *conv_b, *conv_ln_g,
      *conv_ln_b, *na_rel_bias, *gqa_q_norm, *gqa_k_norm, *w_out, *peer_w_q, *peer_keys, *peer_u, *peer_v, *final_norm_g;
  float* out;
  bf16 *win, *wout, *wq, *pk;
  unsigned char *pu8, *pv8;
  float *esc;
  float *ssq16, *hs8;
  float *cqp, *cq;
  bf16 *H2;
  signed char* hq;
  float *modp, *mod, *ropetab;
  bf16 *H, *U, *QN, *KN, *VNt, *QG, *KG, *VGt, *CAT;
  float *XC;
  int* ridx;
  float* rg;
  unsigned* bar;
  unsigned* qctr;
  int never;
  int pad_;
};

DI int tid_now() { int t; asm volatile("v_mov_b32 %0, %1" : "=v"(t) : "v"((int)__builtin_amdgcn_workitem_id_x())); return t; }
DI unsigned pack2(float a, float b) {
  f2_t v = {a, b};
  bf2_t r = __builtin_convertvector(v, bf2_t);
  return __builtin_bit_cast(unsigned, r);
}
DI float bf_lo(unsigned u) { return __uint_as_float(u << 16); }
DI float bf_hi(unsigned u) { return __uint_as_float(u & 0xffff0000u); }
DI int sidx(int r) { return (r >> 2) * 32 + (r & 3); }
DI int crow(int e, int h) { return (e & 3) + 8 * (e >> 2) + 4 * h; }
DI float fexp2(float x) { return __builtin_amdgcn_exp2f(x); }
DI float silu_f(float x) { return x / (1.f + __expf(-x)); }
DI float sigmoid_f(float x) { return 1.f / (1.f + __expf(-x)); }
DI float gelu_tanh(float x) {
  float u = 0.7978845608028654f * (x + 0.044715f * x * x * x);
  float t = 1.f - 2.f / (1.f + __expf(2.f * u));
  return 0.5f * x * (1.f + t);
}
DI float shx(float v, int m, int lane) { return __int_as_float(__builtin_amdgcn_ds_bpermute((lane ^ m) << 2, __float_as_int(v))); }
DI int shxi(int v, int m, int lane) { return __builtin_amdgcn_ds_bpermute((lane ^ m) << 2, v); }
DI float wave_sum(float v, int lane) {
#pragma unroll
  for (int o = 32; o >= 1; o >>= 1) v += shx(v, o, lane);
  return v;
}
DI float* xres_row(const Params& p, int row) { return row < NTOK ? p.out + (size_t)row * D : p.XC + (size_t)(row - NTOK) * D; }
DI const float* xin_row(const Params& p, int layer, int row) {
  if (layer == 0) return row < NTOK ? p.x + (size_t)row * D : p.ctx + (size_t)(row - NTOK) * D;
  return xres_row(p, row);
}
DI int mod_row(int row) { return row < NTOK ? (row >> 11) : 16; }
DI int batch_of(int row) { return row < NTOK ? (row >> 11) : ((row - NTOK) >> 8); }
DI int pos_of(int row) { return row < NTOK ? (row & 2047) : (T + ((row - NTOK) & 255)); }

DI int perm_in(int n) {
  if (n >= 512) return n;
  int c = n >> 6, w = n & 63;
  return w < 32 ? 32 * c + w : 256 + 32 * c + (w - 32);
}
DI size_t fm_index(int n, int k) { return ((size_t)(n >> 5) * 64 + (k >> 4)) * 512 + ((((k >> 3) & 1) * 32 + (n & 31)) * 8) + (k & 7); }
DI void convT_tile(const float* __restrict__ src, bf16* __restrict__ dst, int K, int N, int k0, int n0, bool perm, float* tile  ) {
  const int tx = tid_now() & 63, ty = tid_now() >> 6;
  const int ns = perm ? perm_in(n0 + tx) : n0 + tx;
#pragma unroll
  for (int i = 0; i < 16; ++i) { int k = ty + 4 * i; tile[k * 65 + tx] = src[(size_t)(k0 + k) * N + ns]; }
  __syncthreads();
#pragma unroll
  for (int i = 0; i < 2; ++i) {
    const int pr = tid_now() + 256 * i;
    const int n = pr & 63, kc = pr >> 6;
    const float* t = tile + (kc * 8) * 65 + n;
    u32x4 o = {pack2(t[0], t[65]), pack2(t[2 * 65], t[3 * 65]), pack2(t[4 * 65], t[5 * 65]), pack2(t[6 * 65], t[7 * 65])};
    *(u32x4*)(dst + fm_index(n0 + n, k0 + kc * 8)) = o;
  }
  __syncthreads();
}
constexpr int CONVT_ITEMS = 2 * 1344;
DI void stage_convT(const Params& p, int item, char* smem) {
  float* tile = (float*)smem;
  int l = item / 1344, r = item % 1344;
  if (r < 576) { int kt = r / 36, nt = r % 36; convT_tile(p.w_in + (size_t)l * D * INC, p.win + (size_t)l * INC * D, D, INC, kt * 64, nt * 64, true, tile); }
  else if (r < 832) { r -= 576; int kt = r / 16, nt = r % 16; convT_tile(p.w_out + (size_t)l * D * D, p.wout + (size_t)l * D * D, D, D, kt * 64, nt * 64, false, tile); }
  else { r -= 832; int kt = r / 32, nt = r % 32; convT_tile(p.peer_w_q + (size_t)l * D * 2048, p.wq + (size_t)l * 2048 * D, D, 2048, kt * 64, nt * 64, false, tile); }
}
constexpr size_t PK_N = (size_t)2 * 16 * 128 * 128, PU_N = (size_t)2 * NEXP * D;
constexpr float SU = 1024.f, SV = 64.f;
constexpr int CONVK_ITEMS = (int)(PK_N / 2048), CONVV_ITEMS = (int)(PU_N / 4096), CONVU_ITEMS = 2 * NEXP / 4;
constexpr int CONVS_ITEMS = CONVK_ITEMS + CONVV_ITEMS + CONVU_ITEMS;
DI unsigned pack_fp8x4(float4 a, float s) {
  int r = 0;
  r = __builtin_amdgcn_cvt_pk_fp8_f32(a.x * s, a.y * s, r, false);
  r = __builtin_amdgcn_cvt_pk_fp8_f32(a.z * s, a.w * s, r, true);
  return (unsigned)r;
}
DI unsigned pack_i8x4(float4 a, float s) {
  const int x = (int)rintf(a.x * s), y = (int)rintf(a.y * s), z = (int)rintf(a.z * s), w = (int)rintf(a.w * s);
  return (unsigned)(x & 255) | ((unsigned)(y & 255) << 8) | ((unsigned)(z & 255) << 16) | ((unsigned)(w & 255) << 24);
}
DI void stage_convS(const Params& p, int item) {
  if (item < CONVK_ITEMS) {
    size_t e = (size_t)item * 2048 + tid_now() * 8;
    const float* src = p.peer_keys + e;
    float4 a = ((const float4*)src)[0], b = ((const float4*)src)[1];
    u32x4 o = {pack2(a.x, a.y), pack2(a.z, a.w), pack2(b.x, b.y), pack2(b.z, b.w)};
    *(u32x4*)(p.pk + e) = o;
    return;
  }
  item -= CONVK_ITEMS;
  if (item < CONVV_ITEMS) {
    size_t e = (size_t)item * 4096 + tid_now() * 16;
    const float* src = p.peer_v + e;
    float4 a = ((const float4*)src)[0], b = ((const float4*)src)[1], c = ((const float4*)src)[2], d = ((const float4*)src)[3];
    u32x4 o = {pack_fp8x4(a, SV), pack_fp8x4(b, SV), pack_fp8x4(c, SV), pack_fp8x4(d, SV)};
    *(u32x4*)(p.pv8 + e) = o;
    return;
  }
  item -= CONVV_ITEMS;
  {
    const int lane = tid_now() & 63, wave = tid_now() >> 6;
    const int r = item * 4 + wave;
    const float* src = p.peer_u + (size_t)r * D + lane * 16;
    float4 a = ((const float4*)src)[0], b = ((const float4*)src)[1], c = ((const float4*)src)[2], d = ((const float4*)src)[3];
    float m = fmaxf(fmaxf(fmaxf(fabsf(a.x), fabsf(a.y)), fmaxf(fabsf(a.z), fabsf(a.w))), fmaxf(fmaxf(fabsf(b.x), fabsf(b.y)), fmaxf(fabsf(b.z), fabsf(b.w))));
    m = fmaxf(m, fmaxf(fmaxf(fmaxf(fabsf(c.x), fabsf(c.y)), fmaxf(fabsf(c.z), fabsf(c.w))), fmaxf(fmaxf(fabsf(d.x), fabsf(d.y)), fmaxf(fabsf(d.z), fabsf(d.w)))));
#pragma unroll
    for (int o = 32; o >= 1; o >>= 1) m = fmaxf(m, shx(m, o, lane));
    m = fmaxf(m, 1e-30f);
    const float s = 127.f / m;
    u32x4 o = {pack_i8x4(a, s), pack_i8x4(b, s), pack_i8x4(c, s), pack_i8x4(d, s)};
    *(u32x4*)(p.pu8 + (size_t)r * D + lane * 16) = o;
  }
}
DI float dotbf(unsigned a, unsigned b, float acc) {
  const bf2_t x = __builtin_bit_cast(bf2_t, a), y = __builtin_bit_cast(bf2_t, b);
  return __builtin_amdgcn_fdot2_f32_bf16(x, y, acc, false);
}
DI void stage_convU(const Params& p, int l, int f0, int f1, char* smem) {
  if (f0 >= f1) return;
  const int tid = tid_now(), lane = tid & 63, wave = tid >> 6;
  __syncthreads();
  for (int i = tid; i < 17 * 128; i += 256) {
    const int mr = i >> 7, c8 = i & 127;
    const float* sp = p.mod + ((size_t)l * 17 + mr) * 6144 + 3072 + c8 * 8;
    const float4 s0 = ((const float4*)sp)[0], s1 = ((const float4*)sp)[1];
    u32x4 o = {pack2(s0.x, s0.y), pack2(s0.z, s0.w), pack2(s1.x, s1.y), pack2(s1.z, s1.w)};
    *(u32x4*)(smem + ((mr * 2 + (c8 & 1)) * 64 + (c8 >> 1)) * 16) = o;
  }
  __syncthreads();
#pragma unroll 1
  for (int f = f0; f < f1; ++f) {
    const int r = (l * (NEXP / 4) + f) * 4 + wave;
    const float* src = p.peer_u + (size_t)r * D + lane * 16;
    float4 a = ((const float4*)src)[0], b = ((const float4*)src)[1], c = ((const float4*)src)[2], d = ((const float4*)src)[3];
    float m = fmaxf(fmaxf(fmaxf(fabsf(a.x), fabsf(a.y)), fmaxf(fabsf(a.z), fabsf(a.w))), fmaxf(fmaxf(fabsf(b.x), fabsf(b.y)), fmaxf(fabsf(b.z), fabsf(b.w))));
    m = fmaxf(m, fmaxf(fmaxf(fmaxf(fabsf(c.x), fabsf(c.y)), fmaxf(fabsf(c.z), fabsf(c.w))), fmaxf(fmaxf(fabsf(d.x), fabsf(d.y)), fmaxf(fabsf(d.z), fabsf(d.w)))));
#pragma unroll
    for (int o = 32; o >= 1; o >>= 1) m = fmaxf(m, shx(m, o, lane));
    m = fmaxf(m, 1e-30f);
    const float s = 127.f / m;
    u32x4 o = {pack_i8x4(a, s), pack_i8x4(b, s), pack_i8x4(c, s), pack_i8x4(d, s)};
    *(u32x4*)(p.pu8 + (size_t)r * D + lane * 16) = o;
    const unsigned u0 = pack2(a.x, a.y), u1 = pack2(a.z, a.w), u2 = pack2(b.x, b.y), u3 = pack2(b.z, b.w);
    const unsigned u4 = pack2(c.x, c.y), u5 = pack2(c.z, c.w), u6 = pack2(d.x, d.y), u7 = pack2(d.z, d.w);
    float tv[17];
#pragma unroll
    for (int mr = 0; mr < 17; ++mr) {
      const u32x4 sa = *(const u32x4*)(smem + ((mr * 2) * 64 + lane) * 16), sb = *(const u32x4*)(smem + ((mr * 2 + 1) * 64 + lane) * 16);
      const unsigned a0 = sa[0], a1 = sa[1], a2 = sa[2], a3 = sa[3], b0 = sb[0], b1 = sb[1], b2 = sb[2], b3 = sb[3];
      float t = dotbf(u0, a0, 0.f); t = dotbf(u1, a1, t); t = dotbf(u2, a2, t); t = dotbf(u3, a3, t);
      t = dotbf(u4, b0, t); t = dotbf(u5, b1, t); t = dotbf(u6, b2, t); t = dotbf(u7, b3, t);
      tv[mr] = t;
      if ((mr & 3) == 3) asm volatile("" ::: "memory");
    }
    const float t16 = wave_sum(tv[16], lane);
    float r8[8], r4[4], r2[2], r1;
    {
      const bool up = lane & 1;
#pragma unroll
      for (int k = 0; k < 8; ++k) { const float keep = up ? tv[k + 8] : tv[k], give = up ? tv[k] : tv[k + 8]; r8[k] = keep + shx(give, 1, lane); }
    }
    {
      const bool up = lane & 2;
#pragma unroll
      for (int k = 0; k < 4; ++k) { const float keep = up ? r8[k + 4] : r8[k], give = up ? r8[k] : r8[k + 4]; r4[k] = keep + shx(give, 2, lane); }
    }
    {
      const bool up = lane & 4;
#pragma unroll
      for (int k = 0; k < 2; ++k) { const float keep = up ? r4[k + 2] : r4[k], give = up ? r4[k] : r4[k + 2]; r2[k] = keep + shx(give, 4, lane); }
    }
    {
      const bool up = lane & 8;
      const float keep = up ? r2[1] : r2[0], give = up ? r2[0] : r2[1];
      r1 = keep + shx(give, 8, lane);
    }
    r1 += shx(r1, 16, lane);
    r1 += shx(r1, 32, lane);
    const int idx = 8 * (lane & 1) + 4 * ((lane >> 1) & 1) + 2 * ((lane >> 2) & 1) + ((lane >> 3) & 1);
    float* er = p.esc + (size_t)r * 64;
    const float2 ov = {lane < 16 ? r1 : t16, m * (1.f / 127.f)};
    if (lane < 17) *(float2*)(er + 2 * (lane < 16 ? idx : 16)) = ov;
  }
  __syncthreads();
}
constexpr int CQ_KS = 32;
constexpr int CQP_ITEMS = 2 * CQ_KS * 8;
DI void stage_cq_partial(const Params& p, int item, char* smem) {
  float* sc = (float*)smem;
  const int l = item / (CQ_KS * 8), r = item % (CQ_KS * 8), kc = r >> 3, nc = r & 7;
  for (int i = tid_now(); i < 17 * 32; i += 256) {
    const int rr = i >> 5, k = i & 31;
    sc[i] = p.mod[((size_t)l * 17 + rr) * 6144 + 3072 + kc * 32 + k];
  }
  const int n = nc * 256 + tid_now();
  const float* w = p.peer_w_q + ((size_t)l * D + kc * 32) * 2048 + n;
  float wv[32];
#pragma unroll
  for (int k = 0; k < 32; ++k) wv[k] = w[(size_t)k * 2048];
  __syncthreads();
  float acc[17];
#pragma unroll
  for (int i = 0; i < 17; ++i) acc[i] = 0.f;
#pragma unroll
  for (int k4 = 0; k4 < 8; ++k4)
#pragma unroll
    for (int i = 0; i < 17; ++i) {
      const float4 s = *(const float4*)(sc + i * 32 + k4 * 4);
      acc[i] += s.x * wv[4 * k4] + s.y * wv[4 * k4 + 1] + s.z * wv[4 * k4 + 2] + s.w * wv[4 * k4 + 3];
    }
#pragma unroll
  for (int i = 0; i < 17; ++i) p.cqp[(((size_t)l * CQ_KS + kc) * 17 + i) * 2048 + n] = acc[i];
  __syncthreads();
}
constexpr int CQR_ITEMS = 2 * 17 * 2048 / 256;
DI void stage_cq_reduce(const Params& p, int item) {
  const int idx = item * 256 + tid_now();
  const int l = idx / (17 * 2048), rem = idx % (17 * 2048);
  float v[CQ_KS];
#pragma unroll
  for (int kc = 0; kc < CQ_KS; ++kc) v[kc] = p.cqp[((size_t)l * CQ_KS + kc) * 17 * 2048 + rem];
  float s = 0.f;
#pragma unroll
  for (int kc = 0; kc < CQ_KS; ++kc) s += v[kc];
  p.cq[idx] = s;
}
DI void stage_rope(const Params& p) {
  for (int i = tid_now(); i < 64 * 16; i += 256) {
    int pos = i >> 4, f = i & 15;
    float inv = powf(10000.f, -(float)f / 16.f);
    float ang = (float)pos * inv;
    p.ropetab[2 * i] = cosf(ang); p.ropetab[2 * i + 1] = sinf(ang);
  }
}

constexpr int MODP_ITEMS = 2 * 8 * 24;
DI void stage_mod_partial(const Params& p, int item, char* smem) {
  float* sc = (float*)smem;
  int l = item / 192, r = item % 192, kc = r / 24, nc = r % 24;
  for (int i = tid_now(); i < 17 * 128; i += 256) {
    int rr = i >> 7, k = i & 127;
    float v = rr < 16 ? p.c[rr * D + kc * 128 + k] : p.c_ctx[kc * 128 + k];
    sc[i] = silu_f(v);
  }
  __syncthreads();
  float acc[17];
#pragma unroll
  for (int i = 0; i < 17; ++i) acc[i] = 0.f;
  const int n = nc * 256 + tid_now();
  const float* w = p.w_ada + ((size_t)l * D + kc * 128) * 6144 + n;
#pragma unroll 1
  for (int k0 = 0; k0 < 128; k0 += 32) {
    float wv[32];
#pragma unroll
    for (int k = 0; k < 32; ++k) wv[k] = w[(size_t)(k0 + k) * 6144];
#pragma unroll
    for (int k4 = 0; k4 < 8; ++k4)
#pragma unroll
      for (int i = 0; i < 17; ++i) {
        const float4 s = *(const float4*)(sc + i * 128 + k0 + k4 * 4);
        acc[i] += s.x * wv[4 * k4] + s.y * wv[4 * k4 + 1] + s.z * wv[4 * k4 + 2] + s.w * wv[4 * k4 + 3];
      }
  }
#pragma unroll
  for (int i = 0; i < 17; ++i) p.modp[(((size_t)l * 8 + kc) * 17 + i) * 6144 + n] = acc[i];
  __syncthreads();
}
constexpr int MODR_ITEMS = 2 * 17 * 6144 / 256;
DI void stage_mod_reduce(const Params& p, int item) {
  int idx = item * 256 + tid_now();
  int l = idx / (17 * 6144), rem = idx % (17 * 6144), n = rem % 6144;
  float s = p.b_ada[l * 6144 + n];
#pragma unroll
  for (int kc = 0; kc < 8; ++kc) s += p.modp[((size_t)l * 8 + kc) * 17 * 6144 + rem];
  p.mod[idx] = s;
}

DI void norm_row(const Params& p, const float* __restrict__ xr, const float* __restrict__ g, const float* __restrict__ sh,
                 const float* __restrict__ sc, bf16* __restrict__ hr, signed char* __restrict__ hq = nullptr, float* __restrict__ hsc = nullptr) {
  const int lane = tid_now() & 63;
  float4 v[4]; float ss = 0.f;
#pragma unroll
  for (int i = 0; i < 4; ++i) { v[i] = ((const float4*)xr)[lane + 64 * i]; ss += v[i].x * v[i].x + v[i].y * v[i].y + v[i].z * v[i].z + v[i].w * v[i].w; }
  ss = wave_sum(ss, lane);
  const float rstd = rsqrtf(ss * (1.f / D) + EPS);
#pragma unroll
  for (int i = 0; i < 4; ++i) {
    float4 gg = ((const float4*)g)[lane + 64 * i], s1 = ((const float4*)sh)[lane + 64 * i], s2 = ((const float4*)sc)[lane + 64 * i];
    float a = v[i].x * rstd * gg.x * (1.f + s2.x) + s1.x, b = v[i].y * rstd * gg.y * (1.f + s2.y) + s1.y;
    float c = v[i].z * rstd * gg.z * (1.f + s2.z) + s1.z, d = v[i].w * rstd * gg.w * (1.f + s2.w) + s1.w;
    u32x2 o = {pack2(a, b), pack2(c, d)};
    ((u32x2*)hr)[lane + 64 * i] = o;
    v[i].x = a; v[i].y = b; v[i].z = c; v[i].w = d;
  }
  if (hq != nullptr) {
    float m = 0.f;
#pragma unroll
    for (int i = 0; i < 4; ++i) m = fmaxf(m, fmaxf(fmaxf(fabsf(v[i].x), fabsf(v[i].y)), fmaxf(fabsf(v[i].z), fabsf(v[i].w))));
#pragma unroll
    for (int o = 32; o >= 1; o >>= 1) m = fmaxf(m, shx(m, o, lane));
    m = fmaxf(m, 1e-30f);
    const float s = 127.f / m;
#pragma unroll
    for (int i = 0; i < 4; ++i) ((unsigned*)hq)[lane + 64 * i] = pack_i8x4(v[i], s);
    if (lane == 0) *hsc = m * (1.f / 127.f);
  }
}
DI void stage_norm(const Params& p, int layer, int which, int item) {
  const int lane = tid_now() & 63;
  const int rowa = item * 8 + (tid_now() >> 6) * 2;
  const float* g = (which == 0 ? p.norm1_g : p.norm2_g) + layer * D;
  const float* mm = p.mod + ((size_t)layer * 17 + mod_row(rowa)) * 6144 + (which == 0 ? 0 : 3072);
  float4 v[2][4], gg[4], s1[4], s2[4];
#pragma unroll
  for (int j = 0; j < 2; ++j) {
    const float* xr = which == 0 ? xin_row(p, layer, rowa + j) : xres_row(p, rowa + j);
#pragma unroll
    for (int i = 0; i < 4; ++i) v[j][i] = ((const float4*)xr)[lane + 64 * i];
  }
#pragma unroll
  for (int i = 0; i < 4; ++i) { gg[i] = ((const float4*)g)[lane + 64 * i]; s1[i] = ((const float4*)mm)[lane + 64 * i]; s2[i] = ((const float4*)(mm + D))[lane + 64 * i]; }
#pragma unroll
  for (int j = 0; j < 2; ++j) {
    float ss = 0.f;
#pragma unroll
    for (int i = 0; i < 4; ++i) ss += v[j][i].x * v[j][i].x + v[j][i].y * v[j][i].y + v[j][i].z * v[j][i].z + v[j][i].w * v[j][i].w;
    ss = wave_sum(ss, lane);
    const float rstd = rsqrtf(ss * (1.f / D) + EPS);
    bf16* hr = p.H + (size_t)(rowa + j) * D;
#pragma unroll
    for (int i = 0; i < 4; ++i) {
      const float a = v[j][i].x * rstd * gg[i].x * (1.f + s2[i].x) + s1[i].x, b = v[j][i].y * rstd * gg[i].y * (1.f + s2[i].y) + s1[i].y;
      const float c = v[j][i].z * rstd * gg[i].z * (1.f + s2[i].z) + s1[i].z, d = v[j][i].w * rstd * gg[i].w * (1.f + s2[i].w) + s1[i].w;
      u32x2 o = {pack2(a, b), pack2(c, d)};
      ((u32x2*)hr)[lane + 64 * i] = o;
    }
  }
}
DI void stage_final(const Params& p, int item) {
  const int lane = tid_now() & 63;
  const int rowa = item * 8 + (tid_now() >> 6) * 2;
  float4 v[2][4], gg[4];
#pragma unroll
  for (int j = 0; j < 2; ++j) {
    const float* xr = p.out + (size_t)(rowa + j) * D;
#pragma unroll
    for (int i = 0; i < 4; ++i) v[j][i] = ((const float4*)xr)[lane + 64 * i];
  }
#pragma unroll
  for (int i = 0; i < 4; ++i) gg[i] = ((const float4*)p.final_norm_g)[lane + 64 * i];
#pragma unroll
  for (int j = 0; j < 2; ++j) {
    float ss = 0.f;
#pragma unroll
    for (int i = 0; i < 4; ++i) ss += v[j][i].x * v[j][i].x + v[j][i].y * v[j][i].y + v[j][i].z * v[j][i].z + v[j][i].w * v[j][i].w;
    ss = wave_sum(ss, lane);
    const float rstd = rsqrtf(ss * (1.f / D) + EPS);
#pragma unroll
    for (int i = 0; i < 4; ++i) {
      float4 o = {v[j][i].x * rstd * gg[i].x, v[j][i].y * rstd * gg[i].y, v[j][i].z * rstd * gg[i].z, v[j][i].w * rstd * gg[i].w};
      ((float4*)(p.out + (size_t)(rowa + j) * D))[lane + 64 * i] = o;
    }
  }
}

constexpr int LROW = 144;
constexpr int LTILE = 128 * LROW;
constexpr int GEMM_SMEM = 2 * LTILE;

template <bool ORIENT_T, bool PEEL = false>
DI void gemm_core(const bf16* __restrict__ A, const bf16* __restrict__ W, char* smem, f32x16 (&acc)[2][2]) {
  const int tid = tid_now(), lane = tid & 63, wave = tid >> 6;
  const int wm = wave >> 1, wn = wave & 1, l31 = lane & 31, hh = lane >> 5;
  const int lrow = tid >> 3, kc = tid & 7;
#pragma unroll
  for (int i = 0; i < 2; ++i)
#pragma unroll
    for (int j = 0; j < 2; ++j)
#pragma unroll
      for (int e = 0; e < 16; ++e) acc[i][j][e] = 0.f;
  u32x4 ra[4];
  bf16x8 wf[2][4];
  const bf16* ap = A + (size_t)lrow * D + kc * 8;
  const bf16* wp = W + (size_t)(wn * 2) * 64 * 512 + lane * 8;
#pragma unroll
  for (int i = 0; i < 4; ++i) ra[i] = *(const u32x4*)(ap + (size_t)(32 * i) * D);
  if (PEEL) {
#pragma unroll
    for (int s = 0; s < 4; ++s)
#pragma unroll
      for (int ft = 0; ft < 2; ++ft) wf[ft][s] = *(const bf16x8*)(wp + (size_t)(ft * 64 + s) * 512);
    __builtin_amdgcn_sched_barrier(0);
  } else {
#pragma unroll
    for (int ft = 0; ft < 2; ++ft)
#pragma unroll
      for (int s = 0; s < 4; ++s) wf[ft][s] = *(const bf16x8*)(wp + (size_t)(ft * 64 + s) * 512);
  }
  auto ktile = [&](const int kt, const bool more) {
    char* sa = smem + (kt & 1) * LTILE;
#pragma unroll
    for (int i = 0; i < 4; ++i) *(u32x4*)(sa + (lrow + 32 * i) * LROW + kc * 16) = ra[i];
    __syncthreads();
    if (more) {
#pragma unroll
      for (int i = 0; i < 4; ++i) ra[i] = *(const u32x4*)(ap + (size_t)(32 * i) * D + (kt + 1) * 64);
    }
    if (PEEL) __builtin_amdgcn_sched_barrier(0);
#pragma unroll
    for (int s = 0; s < 4; ++s) {
      bf16x8 af[2];
#pragma unroll
      for (int t = 0; t < 2; ++t) af[t] = *(const bf16x8*)(sa + (wm * 64 + t * 32 + l31) * LROW + (s * 16 + hh * 8) * 2);
#pragma unroll
      for (int ft = 0; ft < 2; ++ft)
#pragma unroll
        for (int tt = 0; tt < 2; ++tt)
          acc[ft][tt] = ORIENT_T ? MFMA(wf[ft][s], af[tt], acc[ft][tt]) : MFMA(af[tt], wf[ft][s], acc[ft][tt]);
      if (more) {
#pragma unroll
        for (int ft = 0; ft < 2; ++ft) wf[ft][s] = *(const bf16x8*)(wp + (size_t)(ft * 64 + (kt + 1) * 4 + s) * 512);
      }
      if (PEEL) __builtin_amdgcn_sched_barrier(0);
    }
    };
  if (PEEL) {
#pragma unroll 1
    for (int kt = 0; kt < 15; ++kt) ktile(kt, true);
    ktile(15, false);
  } else {
#pragma unroll 1
    for (int kt = 0; kt < 16; ++kt) ktile(kt, kt + 1 < 16);
  }
  __syncthreads();
}

constexpr int INPROJ_ITEMS = 288 * 18;
DI void store4(bf16* dst, float a, float b, float c, float d) { u32x2 o = {pack2(a, b), pack2(c, d)}; *(u32x2*)dst = o; }
DI void store_pair(bf16* rowbase, int hh, float a0, float a1, float a2, float a3, float b0, float b1, float b2, float b3) {
  unsigned ax = pack2(a0, a1), ay = pack2(a2, a3), bx = pack2(b0, b1), by = pack2(b2, b3);
  const auto r0 = __builtin_amdgcn_permlane32_swap(ax, bx, false, false); ax = r0[0]; bx = r0[1];
  const auto r1 = __builtin_amdgcn_permlane32_swap(ay, by, false, false); ay = r1[0]; by = r1[1];
  u32x4 o = {ax, ay, bx, by};
  *(u32x4*)(rowbase + hh * 8) = o;
}

DI void stage_inproj(const Params& p, int layer, int item, char* smem) {
  const int mt = item / 18, nt = item % 18;
  if (layer == 1 && mt >= 256 && nt < 10) return;
  const int row0 = mt * 128, n0 = nt * 128;
  const bf16* A = p.H + (size_t)row0 * D;
  const bf16* W = p.win + ((size_t)layer * INC + n0) * D;
  const int lane = tid_now() & 63, wave = tid_now() >> 6, wm = wave >> 1, wn = wave & 1, l31 = lane & 31, hh = lane >> 5;
  const bool vtile = (nt >= 13 && nt <= 15) || nt == 17;
  f32x16 acc[2][2];
  const int b = batch_of(row0);
  if (vtile) {
    gemm_core<false, true>(A, W, smem, acc);
    bf16* base; int head;
    if (nt == 17) { head = wn; base = p.VGt + ((size_t)(b * 2 + head) * 64) * SEQ2; }
    else { head = (nt - 13) * 2 + wn; base = p.VNt + ((size_t)(b * 6 + head) * 64) * SEQ2; }
    const int pos0 = pos_of(row0) + wm * 64;
#pragma unroll
    for (int ft = 0; ft < 2; ++ft) {
      const int d = ft * 32 + l31;
#pragma unroll
      for (int tt = 0; tt < 2; ++tt)
#pragma unroll
        for (int g = 0; g < 4; g += 2)
          store_pair(base + (size_t)d * SEQ2 + pos0 + tt * 32 + 8 * g, hh, acc[ft][tt][4 * g], acc[ft][tt][4 * g + 1], acc[ft][tt][4 * g + 2], acc[ft][tt][4 * g + 3],
                     acc[ft][tt][4 * g + 4], acc[ft][tt][4 * g + 5], acc[ft][tt][4 * g + 6], acc[ft][tt][4 * g + 7]);
    }
    return;
  }
  gemm_core<true, true>(A, W, smem, acc);
  const int chunk = nt * 2 + wn;
#pragma unroll
  for (int tt = 0; tt < 2; ++tt) {
    const int row = row0 + wm * 64 + tt * 32 + l31;
    const int pos = pos_of(row);
    const bool isctx = row >= NTOK;
    if (chunk < 8) {
      bf16* dst = p.U + (size_t)row * 256 + 32 * chunk;
#pragma unroll
      for (int g = 0; g < 4; g += 2) {
        float u[8];
#pragma unroll
        for (int j = 0; j < 8; ++j) u[j] = acc[0][tt][4 * g + j] * sigmoid_f(acc[1][tt][4 * g + j]);
        store_pair(dst + 8 * g, hh, u[0], u[1], u[2], u[3], u[4], u[5], u[6], u[7]);
      }
    } else if (chunk < 14 || (chunk >= 20 && chunk < 26)) {
      const bool isq = chunk < 14;
      const int head = isq ? chunk - 8 : chunk - 20;
      const float sc = isq ? 0.125f : 1.f;
      bf16* dst = (isq ? p.QN : p.KN) + ((size_t)(b * 6 + head) * SEQ2 + pos) * 64;
#pragma unroll
      for (int ft = 0; ft < 2; ++ft)
#pragma unroll
        for (int g = 0; g < 4; g += 2)
          store_pair(dst + ft * 32 + 8 * g, hh, acc[ft][tt][4 * g] * sc, acc[ft][tt][4 * g + 1] * sc, acc[ft][tt][4 * g + 2] * sc, acc[ft][tt][4 * g + 3] * sc,
                     acc[ft][tt][4 * g + 4] * sc, acc[ft][tt][4 * g + 5] * sc, acc[ft][tt][4 * g + 6] * sc, acc[ft][tt][4 * g + 7] * sc);
    } else {
      const bool isq = chunk < 20;
      const int head = isq ? chunk - 14 : chunk - 32;
      const float* gn = (isq ? p.gqa_q_norm : p.gqa_k_norm) + layer * 64;
      float ss = 0.f;
#pragma unroll
      for (int ft = 0; ft < 2; ++ft)
#pragma unroll
        for (int e = 0; e < 16; ++e) ss += acc[ft][tt][e] * acc[ft][tt][e];
      ss += shx(ss, 32, lane);
      const float rstd = rsqrtf(ss * (1.f / 64.f) + EPS) ;
      const float sc = isq ? 0.125f : 1.f;
      bf16* dst = (isq ? p.QG + ((size_t)(b * 6 + head) * SEQ2 + pos) * 64 : p.KG + ((size_t)(b * 2 + head) * SEQ2 + pos) * 64);
      const int prow = pos >> 6, pcol = pos & 63;
#pragma unroll
      for (int g = 0; g < 4; g += 2) {
        float o1[8], o2[8];
#pragma unroll
        for (int j = 0; j < 8; ++j) {
          const int gg = g + (j >> 2);
          const int i = 8 * gg + 4 * hh + (j & 3);
          float x1 = acc[0][tt][4 * g + j] * rstd * gn[i];
          float x2 = acc[1][tt][4 * g + j] * rstd * gn[32 + i];
          if (!isctx && PROBE != 13) {
            const int ppos = (gg < 2) ? prow : pcol;
            const float2 cs = *(const float2*)(p.ropetab + 2 * (ppos * 16 + (i & 15)));
            float y1 = x1 * cs.x - x2 * cs.y, y2 = x1 * cs.y + x2 * cs.x;
            x1 = y1; x2 = y2;
          }
          o1[j] = x1 * sc; o2[j] = x2 * sc;
        }
        store_pair(dst + 8 * g, hh, o1[0], o1[1], o1[2], o1[3], o1[4], o1[5], o1[6], o1[7]);
        store_pair(dst + 32 + 8 * g, hh, o2[0], o2[1], o2[2], o2[3], o2[4], o2[5], o2[6], o2[7]);
      }
    }
  }
}

constexpr int CONV_TT = 16;
constexpr int CONV_SMEM = (CONV_TT + 30) * 512 + CONV_TT * 1024;
DI void stage_conv(const Params& p, int layer, int item, char* smem) {
  bf16* ub = (bf16*)smem;
  float* yb = (float*)(smem + (CONV_TT + 30) * 512);
  const int tid = tid_now();
  int row0, seq_lo, seq_hi;
  constexpr int NLAT = NTOK / CONV_TT;
  if (item < NLAT) { row0 = item * CONV_TT; seq_lo = row0 & ~2047; seq_hi = seq_lo + 2048; }
  else { row0 = NTOK + (item - NLAT) * CONV_TT; seq_lo = NTOK + (((item - NLAT) * CONV_TT) & ~255); seq_hi = seq_lo + 256; }
  for (int c = tid; c < (CONV_TT + 30) * 32; c += 256) {
    int r = c >> 5, cc = c & 31;
    int row = row0 - 15 + r;
    u32x4 v = {0u, 0u, 0u, 0u};
    if (row >= seq_lo && row < seq_hi) v = *(const u32x4*)(p.U + (size_t)row * 256 + cc * 8);
    *(u32x4*)(ub + r * 256 + cc * 8) = v;
  }
  __syncthreads();
  {
    const int ch = tid;
    float w[31];
#pragma unroll
    for (int j = 0; j < 31; ++j) w[j] = p.conv_w[((size_t)layer * 31 + j) * 256 + ch];
    const float bias = p.conv_b[layer * 256 + ch];
#pragma unroll 1
    for (int t0 = 0; t0 < CONV_TT; t0 += 8) {
      float in[38];
#pragma unroll
      for (int j = 0; j < 38; ++j) in[j] = __uint_as_float((unsigned)ub[(t0 + j) * 256 + ch] << 16);
#pragma unroll
      for (int t = 0; t < 8; ++t) {
        float a = bias;
#pragma unroll
        for (int j = 0; j < 31; ++j) a += in[t + j] * w[j];
        yb[(t0 + t) * 256 + ch] = a;
      }
    }
  }
  __syncthreads();
  {
    const int wave = tid >> 6, lane = tid & 63;
    const float4 g = ((const float4*)(p.conv_ln_g + layer * 256))[lane], bb = ((const float4*)(p.conv_ln_b + layer * 256))[lane];
    for (int t = wave * (CONV_TT / 4); t < (wave + 1) * (CONV_TT / 4); ++t) {
      float4 v = ((const float4*)(yb + t * 256))[lane];
      float mu = wave_sum(v.x + v.y + v.z + v.w, lane) * (1.f / 256.f);
      float dx = v.x - mu, dy = v.y - mu, dz = v.z - mu, dw = v.w - mu;
      float var = wave_sum(dx * dx + dy * dy + dz * dz + dw * dw, lane) * (1.f / 256.f);
      float rs = rsqrtf(var + EPS);
      float a = silu_f(dx * rs * g.x + bb.x), b = silu_f(dy * rs * g.y + bb.y), c = silu_f(dz * rs * g.z + bb.z), d = silu_f(dw * rs * g.w + bb.w);
      store4(p.CAT + (size_t)(row0 + t) * D + lane * 4, a, b, c, d);
    }
  }
  __syncthreads();
}

DI int kperm(int i) { return (i & 19) | ((i & 4) << 1) | ((i & 8) >> 1); }
DI int keyoff(int e, int h) { return (e & 3) + 4 * ((e >> 2) & 1) + 8 * h + 16 * (e >> 3); }
DI bf16x8 pack8(const f32x16& x, int s) {
  u32x4 r = {pack2(x[8 * s], x[8 * s + 1]), pack2(x[8 * s + 2], x[8 * s + 3]), pack2(x[8 * s + 4], x[8 * s + 5]), pack2(x[8 * s + 6], x[8 * s + 7])};
  return __builtin_bit_cast(bf16x8, r);
}

constexpr int NA_ITEMS = 6144 / 4;
DI void stage_na(const Params& p, int layer, int item) {
  const int lane = tid_now() & 63, wave = tid_now() >> 6, l31 = lane & 31, hh = lane >> 5;
  const int wi = item * 4 + wave;
  const int qhalf = wi & 1, head = (wi >> 1) % 6, br = wi / 12, r = br & 31, b = br >> 5;
  const int r0 = min(max(r - 4, 0), 24);
  const size_t hb = (size_t)(b * 6 + head);
  const bf16* Q = p.QN + (hb * SEQ2 + r * 64 + qhalf * 32 + l31) * 64;
  const bf16* Kb = p.KN + hb * SEQ2 * 64;
  const bf16* Vb = p.VNt + hb * 64 * SEQ2;
  const float* bias = p.na_rel_bias + ((size_t)layer * 6 + head) * 15 * 31;
  bf16x8 qf[4];
#pragma unroll
  for (int s = 0; s < 4; ++s) qf[s] = *(const bf16x8*)(Q + 16 * s + 8 * hh);
  f32x16 o[2];
#pragma unroll
  for (int e = 0; e < 16; ++e) { o[0][e] = 0.f; o[1][e] = 0.f; }
  float m = -1e30f, l = 0.f;
  const int qc = qhalf * 32 + l31;
  const int c0 = min(max(qc - 8, 0), 48);
  const int kp = kperm(l31);
#pragma unroll 1
  for (int t = 0; t < 24; ++t) {
    int key0, brow = 0, cs = 0;
    const bool local = t >= 8;
    if (!local) key0 = T + t * 32;
    else { brow = (t - 8) >> 1; cs = (t - 8) & 1; key0 = (r0 + brow) * 64 + cs * 32; }
    f32x16 st;
#pragma unroll
    for (int e = 0; e < 16; ++e) st[e] = 0.f;
    const bf16* kr = Kb + (size_t)(key0 + kp) * 64 + 8 * hh;
#pragma unroll
    for (int s = 0; s < 4; ++s) { bf16x8 kf = *(const bf16x8*)(kr + 16 * s); st = MFMA(kf, qf[s], st); }
    if (local) {
      const int rb = (r0 + brow) - r + 7;
#pragma unroll
      for (int e = 0; e < 16; ++e) {
        const int kc = cs * 32 + keyoff(e, hh);
        const bool valid = (kc >= c0) && (kc < c0 + 16);
        const int ci = min(max(kc - qc + 15, 0), 30);
        const float bv = (PROBE == 12) ? 0.f : bias[rb * 31 + ci];
        st[e] = valid ? st[e] + bv : -1e30f;
      }
    }
    float mx = st[0];
#pragma unroll
    for (int e = 1; e < 16; ++e) mx = fmaxf(mx, st[e]);
    mx = fmaxf(mx, shx(mx, 32, lane));
    const float mn = fmaxf(m, mx);
    const float alpha = exp2f((m - mn) * L2E);
    float ls = 0.f;
#pragma unroll
    for (int e = 0; e < 16; ++e) { st[e] = exp2f((st[e] - mn) * L2E); ls += st[e]; }
    l = l * alpha + ls; m = mn;
#pragma unroll
    for (int e = 0; e < 16; ++e) { o[0][e] *= alpha; o[1][e] *= alpha; }
    bf16x8 pf0 = pack8(st, 0), pf1 = pack8(st, 1);
#pragma unroll
    for (int dt = 0; dt < 2; ++dt) {
      const bf16* vr = Vb + (size_t)(dt * 32 + l31) * SEQ2 + key0 + 8 * hh;
      bf16x8 v0 = *(const bf16x8*)(vr), v1 = *(const bf16x8*)(vr + 16);
      o[dt] = MFMA(v0, pf0, o[dt]);
      o[dt] = MFMA(v1, pf1, o[dt]);
    }
  }
  l += shx(l, 32, lane);
  const float inv = (PROBE == 10) ? 0.f : 1.f / l;
  bf16* dst = p.CAT + (size_t)(b * T + r * 64 + qc) * D + 256 + head * 64;
#pragma unroll
  for (int dt = 0; dt < 2; ++dt)
#pragma unroll
    for (int g = 0; g < 4; g += 2)
      store_pair(dst + dt * 32 + 8 * g, hh, o[dt][4 * g] * inv, o[dt][4 * g + 1] * inv, o[dt][4 * g + 2] * inv, o[dt][4 * g + 3] * inv,
                 o[dt][4 * g + 4] * inv, o[dt][4 * g + 5] * inv, o[dt][4 * g + 6] * inv, o[dt][4 * g + 7] * inv);
}

constexpr int NA2_ITEMS = 16 * 6 * 16;
DI void stage_na2(const Params& p, int layer, int item, char* smem) {
  const int tid = tid_now(), lane = tid & 63, wave = tid >> 6, l31 = lane & 31, hh = lane >> 5;
  const int lrow = tid >> 3, kc8 = tid & 7;
  const int rp = item & 15, head = (item >> 4) % 6, b = item / 96;
  const int qrow = 2 * rp + ((lane >> 4) & 1), qc = wave * 16 + (lane & 15);
  const int r0w = min(max(qrow - 4, 0), 24);
  const int rlo = min(max(2 * rp - 4, 0), 24), rhi = min(max(2 * rp - 3, 0), 24) + 7;
  const int ntile = 4 + (rhi - rlo + 1);
  const size_t hb = (size_t)(b * 6 + head);
  const bf16* K = p.KN + hb * SEQ2 * 64;
  const bf16* Vt = p.VNt + hb * 64 * SEQ2;
  float* bl = (float*)(smem + 2 * 2 * 64 * LROW);
  for (int i = tid; i < 15 * 31; i += 256) bl[i] = p.na_rel_bias[((size_t)layer * 6 + head) * 465 + i];
  bf16x8 qf[4];
  const bf16* qp = p.QN + (hb * SEQ2 + qrow * 64 + qc) * 64 + 8 * hh;
#pragma unroll
  for (int s = 0; s < 4; ++s) qf[s] = *(const bf16x8*)(qp + 16 * s);
  f32x16 o[2];
#pragma unroll
  for (int e = 0; e < 16; ++e) { o[0][e] = 0.f; o[1][e] = 0.f; }
  float m = -1e30f, l = 0.f;
  const int kp = kperm(l31);
  const int c0 = min(max(qc - 8, 0), 48);
  const int kb = min(max(wave * 16 - 8, 0), 32);
  u32x4 rk[2], rv[2];
  auto key0_of = [&](int t) { return t < 4 ? T + 64 * t : (rlo + t - 4) * 64; };
  {
    const int k0 = key0_of(0);
#pragma unroll
    for (int i = 0; i < 2; ++i) {
      rk[i] = *(const u32x4*)(K + (size_t)(k0 + lrow + 32 * i) * 64 + kc8 * 8);
      rv[i] = *(const u32x4*)(Vt + (size_t)(lrow + 32 * i) * SEQ2 + k0 + kc8 * 8);
    }
  }
#pragma unroll 1
  for (int t = 0; t < ntile; ++t) {
    char* sk = smem + (t & 1) * 2 * 64 * LROW;
    char* sv = sk + 64 * LROW;
#pragma unroll
    for (int i = 0; i < 2; ++i) {
      *(u32x4*)(sk + (lrow + 32 * i) * LROW + kc8 * 16) = rk[i];
      *(u32x4*)(sv + (lrow + 32 * i) * LROW + kc8 * 16) = rv[i];
    }
    __syncthreads();
    if (t + 1 < ntile) {
      const int k0 = key0_of(t + 1);
#pragma unroll
      for (int i = 0; i < 2; ++i) {
        rk[i] = *(const u32x4*)(K + (size_t)(k0 + lrow + 32 * i) * 64 + kc8 * 8);
        rv[i] = *(const u32x4*)(Vt + (size_t)(lrow + 32 * i) * SEQ2 + k0 + kc8 * 8);
      }
    }
    const int R = rlo + t - 4;
    const bool local = t >= 4;
    const int nsub = local ? 1 : 2;
#pragma unroll 1
    for (int si = 0; si < nsub; ++si) {
      const int kbase = local ? kb : 32 * si;
      const bool loc = local;
      f32x16 st;
      bf16x8 lf[4];
      __builtin_amdgcn_sched_barrier(0);
#pragma unroll
      for (int s = 0; s < 4; ++s) lf[s] = *(const bf16x8*)(sk + (kbase + kp) * LROW + (16 * s + 8 * hh) * 2);
      __builtin_amdgcn_sched_barrier(0);
#pragma unroll
      for (int e = 0; e < 16; ++e) st[e] = 0.f;
#pragma unroll
      for (int s = 0; s < 4; ++s) st = MFMA(lf[s], qf[s], st);
      __builtin_amdgcn_sched_barrier(0);
#pragma unroll
      for (int s2 = 0; s2 < 2; ++s2)
#pragma unroll
        for (int dt = 0; dt < 2; ++dt) lf[s2 * 2 + dt] = *(const bf16x8*)(sv + (dt * 32 + l31) * LROW + (kbase + 16 * s2 + 8 * hh) * 2);
      __builtin_amdgcn_sched_barrier(0);
      if (loc) {
        const int c0e = ((unsigned)(R - r0w) < 8u) ? c0 : 4096;
        const float* brow = bl + (R - qrow + 7) * 31 + (15 - qc);
#pragma unroll
        for (int e = 0; e < 16; ++e) {
          const int kc = kbase + keyoff(e, hh);
          const bool valid = (unsigned)(kc - c0e) < 16u;
          const float bv = brow[kc];
          st[e] = valid ? st[e] + bv : -1e30f;
        }
      }
      float mx = st[0];
#pragma unroll
      for (int e = 1; e < 16; ++e) mx = fmaxf(mx, st[e]);
      mx = fmaxf(mx, shx(mx, 32, lane));
      const float mn = fmaxf(m, mx);
      const float mnl = mn * L2E;
      const float alpha = fexp2(m * L2E - mnl);
      f2_t ls2 = {0.f, 0.f};
#pragma unroll
      for (int e = 0; e < 16; e += 2) {
        const float p0 = fexp2(st[e] * L2E - mnl), p1 = fexp2(st[e + 1] * L2E - mnl);
        st[e] = p0; st[e + 1] = p1;
        const f2_t pp = {p0, p1};
        ls2 += pp;
      }
      l = l * alpha + (ls2[0] + ls2[1]); m = mn;
      const f2_t al2 = {alpha, alpha};
#pragma unroll
      for (int e = 0; e < 16; e += 2) {
        f2_t a0 = {o[0][e], o[0][e + 1]}, a1 = {o[1][e], o[1][e + 1]};
        a0 *= al2; a1 *= al2;
        o[0][e] = a0[0]; o[0][e + 1] = a0[1]; o[1][e] = a1[0]; o[1][e + 1] = a1[1];
      }
#pragma unroll
      for (int s2 = 0; s2 < 2; ++s2) {
        bf16x8 pf = pack8(st, s2);
#pragma unroll
        for (int dt = 0; dt < 2; ++dt) o[dt] = MFMA(lf[s2 * 2 + dt], pf, o[dt]);
      }
    }
  }
  l += shx(l, 32, lane);
  const float inv = 1.f / l;
  bf16* dst = p.CAT + (size_t)(b * T + qrow * 64 + qc) * D + 256 + head * 64;
#pragma unroll
  for (int dt = 0; dt < 2; ++dt)
#pragma unroll
    for (int g = 0; g < 4; g += 2)
      store_pair(dst + dt * 32 + 8 * g, hh, o[dt][4 * g] * inv, o[dt][4 * g + 1] * inv, o[dt][4 * g + 2] * inv, o[dt][4 * g + 3] * inv,
                 o[dt][4 * g + 4] * inv, o[dt][4 * g + 5] * inv, o[dt][4 * g + 6] * inv, o[dt][4 * g + 7] * inv);
  __syncthreads();
}

template <int MODE>
DI void flash_block(const bf16* __restrict__ Q, const bf16* __restrict__ K, const bf16* __restrict__ Vt, int q0, int kt0, int kt1,
                    bf16* __restrict__ dst  , char* smem, float smax = 0.f) {
  const int tid = tid_now(), lane = tid & 63, wave = tid >> 6, l31 = lane & 31, hh = lane >> 5;
  const int lrow = tid >> 3, kc = tid & 7;
  bf16x8 qf[4];
  const bf16* qp = Q + (size_t)(q0 + wave * 32 + l31) * 64 + 8 * hh;
#pragma unroll
  for (int s = 0; s < 4; ++s) qf[s] = *(const bf16x8*)(qp + 16 * s);
  constexpr bool BOUNDED = MODE != 0;
  if (MODE == 2) {
#pragma unroll
    for (int s = 0; s < 4; ++s) {
      u32x4 w = __builtin_bit_cast(u32x4, qf[s]);
      const unsigned w0 = w[0], w1 = w[1], w2 = w[2], w3 = w[3];
      u32x4 o = {pack2(bf_lo(w0) * L2E, bf_hi(w0) * L2E), pack2(bf_lo(w1) * L2E, bf_hi(w1) * L2E),
                 pack2(bf_lo(w2) * L2E, bf_hi(w2) * L2E), pack2(bf_lo(w3) * L2E, bf_hi(w3) * L2E)};
      qf[s] = __builtin_bit_cast(bf16x8, o);
    }
  }
  f32x16 o[2];
#pragma unroll
  for (int e = 0; e < 16; ++e) { o[0][e] = 0.f; o[1][e] = 0.f; }
  float m = -1e30f, l = 0.f;
  f2_t l2 = {0.f, 0.f};
  const int kp = kperm(l31);
  u32x4 rk[2], rv[2];
#pragma unroll
  for (int i = 0; i < 2; ++i) {
    rk[i] = *(const u32x4*)(K + (size_t)(kt0 * 64 + lrow + 32 * i) * 64 + kc * 8);
    rv[i] = *(const u32x4*)(Vt + (size_t)(lrow + 32 * i) * SEQ2 + kt0 * 64 + kc * 8);
  }
#pragma unroll 1
  for (int kt = kt0; kt < kt1; ++kt) {
    char* sk = smem + ((kt - kt0) & 1) * 2 * 64 * LROW;
    char* sv = sk + 64 * LROW;
#pragma unroll
    for (int i = 0; i < 2; ++i) {
      *(u32x4*)(sk + (lrow + 32 * i) * LROW + kc * 16) = rk[i];
      *(u32x4*)(sv + (lrow + 32 * i) * LROW + kc * 16) = rv[i];
    }
    __syncthreads();
    if (kt + 1 < kt1) {
#pragma unroll
      for (int i = 0; i < 2; ++i) {
        rk[i] = *(const u32x4*)(K + (size_t)((kt + 1) * 64 + lrow + 32 * i) * 64 + kc * 8);
        rv[i] = *(const u32x4*)(Vt + (size_t)(lrow + 32 * i) * SEQ2 + (kt + 1) * 64 + kc * 8);
      }
    }
    f32x16 st[2];
    bf16x8 lf[8];
    __builtin_amdgcn_sched_barrier(0);
#pragma unroll
    for (int k2 = 0; k2 < 2; ++k2)
#pragma unroll
      for (int s = 0; s < 4; ++s) lf[k2 * 4 + s] = *(const bf16x8*)(sk + (k2 * 32 + kp) * LROW + (16 * s + 8 * hh) * 2);
    __builtin_amdgcn_sched_barrier(0);
#pragma unroll
    for (int k2 = 0; k2 < 2; ++k2) {
#pragma unroll
      for (int e = 0; e < 16; ++e) st[k2][e] = 0.f;
#pragma unroll
      for (int s = 0; s < 4; ++s) st[k2] = MFMA(lf[k2 * 4 + s], qf[s], st[k2]);
    }
    __builtin_amdgcn_sched_barrier(0);
#pragma unroll
    for (int k2 = 0; k2 < 2; ++k2)
#pragma unroll
      for (int s2 = 0; s2 < 2; ++s2)
#pragma unroll
        for (int dt = 0; dt < 2; ++dt)
          lf[(k2 * 2 + s2) * 2 + dt] = *(const bf16x8*)(sv + (dt * 32 + l31) * LROW + (k2 * 32 + 16 * s2 + 8 * hh) * 2);
    __builtin_amdgcn_sched_barrier(0);
    if (BOUNDED) {
      const float mnl = smax * L2E;
#pragma unroll
      for (int k2 = 0; k2 < 2; ++k2)
#pragma unroll
        for (int e = 0; e < 16; e += 2) {
          const float p0 = MODE == 2 ? fexp2(st[k2][e]) : fexp2(st[k2][e] * L2E - mnl), p1 = MODE == 2 ? fexp2(st[k2][e + 1]) : fexp2(st[k2][e + 1] * L2E - mnl);
          st[k2][e] = p0; st[k2][e + 1] = p1;
          const f2_t pp = {p0, p1};
          l2 += pp;
        }
    } else {
      float mx = st[0][0];
  #pragma unroll
      for (int e = 1; e < 16; ++e) mx = fmaxf(mx, st[0][e]);
  #pragma unroll
      for (int e = 0; e < 16; ++e) mx = fmaxf(mx, st[1][e]);
      mx = fmaxf(mx, shx(mx, 32, lane));
      const float mn = fmaxf(m, mx);
      const float mnl = mn * L2E;
      const float alpha = fexp2(m * L2E - mnl);
      float ls = 0.f;
  #pragma unroll
      for (int k2 = 0; k2 < 2; ++k2)
  #pragma unroll
        for (int e = 0; e < 16; ++e) { st[k2][e] = fexp2(st[k2][e] * L2E - mnl); ls += st[k2][e]; }
      l = l * alpha + ls; m = mn;
  #pragma unroll
      for (int e = 0; e < 16; ++e) { o[0][e] *= alpha; o[1][e] *= alpha; }
    }
#pragma unroll
    for (int k2 = 0; k2 < 2; ++k2)
#pragma unroll
      for (int s2 = 0; s2 < 2; ++s2) {
        bf16x8 pf = pack8(st[k2], s2);
#pragma unroll
        for (int dt = 0; dt < 2; ++dt) o[dt] = MFMA(lf[(k2 * 2 + s2) * 2 + dt], pf, o[dt]);
      }
  }
  l += l2[0] + l2[1];
  l += shx(l, 32, lane);
  const float inv = (PROBE == 11) ? 0.f : 1.f / l;
  bf16* d2 = dst + (size_t)(wave * 32 + l31) * D;
#pragma unroll
  for (int dt = 0; dt < 2; ++dt)
#pragma unroll
    for (int g = 0; g < 4; g += 2)
      store_pair(d2 + dt * 32 + 8 * g, hh, o[dt][4 * g] * inv, o[dt][4 * g + 1] * inv, o[dt][4 * g + 2] * inv, o[dt][4 * g + 3] * inv,
                 o[dt][4 * g + 4] * inv, o[dt][4 * g + 5] * inv, o[dt][4 * g + 6] * inv, o[dt][4 * g + 7] * inv);
  __syncthreads();
}
constexpr int GQA_ITEMS = 16 * 6 * 16;
DI float gqa_score_bound(const Params& p, int layer) {
  const int lane = tid_now() & 63;
  float a = fabsf(p.gqa_q_norm[layer * 64 + lane]), b = fabsf(p.gqa_k_norm[layer * 64 + lane]);
#pragma unroll
  for (int o = 32; o >= 1; o >>= 1) { a = fmaxf(a, shx(a, o, lane)); b = fmaxf(b, shx(b, o, lane)); }
  return 8.f * a * b * 1.0001f + 1e-3f;
}
DI void stage_gqa(const Params& p, int layer, int item, char* smem) {
  const int qt = item & 15, hq = (item >> 4) % 6, b = item / 96;
  const int kvh = hq / 3;
  const float bound = __int_as_float(__builtin_amdgcn_readfirstlane(__float_as_int(gqa_score_bound(p, layer))));
  const bf16* Q = p.QG + (size_t)(b * 6 + hq) * SEQ2 * 64; const bf16* K = p.KG + (size_t)(b * 2 + kvh) * SEQ2 * 64; const bf16* Vt = p.VGt + (size_t)(b * 2 + kvh) * 64 * SEQ2;
  bf16* dst = p.CAT + (size_t)(b * T + qt * 128) * D + 640 + hq * 64;
  if (bound * L2E < 100.f) flash_block<2>(Q, K, Vt, qt * 128, 0, 36, dst, smem, bound);
  else flash_block<1>(Q, K, Vt, qt * 128, 0, 36, dst, smem, bound);
}
constexpr int CTXATT_ITEMS = 384;
DI void stage_ctxatt(const Params& p, int item, char* smem) {
  const int qt = item & 1, head = (item >> 1) % 6, which = (item / 12) & 1, b = item / 24;
  bf16* dst = p.CAT + (size_t)(NTOK + b * CL + qt * 128) * D + (which == 0 ? 256 : 640) + head * 64;
  const int kvh = which == 0 ? b * 6 + head : b * 2 + head / 3;
  const bf16* Q = (which == 0 ? p.QN : p.QG) + (size_t)(b * 6 + head) * SEQ2 * 64;
  const bf16* K = (which == 0 ? p.KN : p.KG) + (size_t)kvh * SEQ2 * 64;
  const bf16* Vt = (which == 0 ? p.VNt : p.VGt) + (size_t)kvh * 64 * SEQ2;
  flash_block<0>(Q, K, Vt, T + qt * 128, 32, 36, dst, smem);
}

constexpr int OUTPROJ_ITEMS = 288 * 8;
DI void stage_outproj(const Params& p, int layer, int item, char* smem) {
  const int mt = item >> 3, nt = item & 7;
  if (layer == 1 && mt >= 256) return;
  const int row0 = mt * 128, n0 = nt * 128;
  f32x16 acc[2][2];
  gemm_core<true, true>(p.CAT + (size_t)row0 * D, p.wout + ((size_t)layer * D + n0) * D, smem, acc);
  const int lane = tid_now() & 63, wave = tid_now() >> 6, wm = wave >> 1, wn = wave & 1, l31 = lane & 31, hh = lane >> 5;
  const float* mrow = p.mod + ((size_t)layer * 17 + mod_row(row0)) * 6144;
  const float* g1 = mrow + 2048;
  const float* sc2 = mrow + 4096;
  const float* n2g = p.norm2_g + layer * D;
  float* amx = (float*)(smem + GEMM_SMEM);
  float amv[2];
#pragma unroll
  for (int tt = 0; tt < 2; ++tt) {
    const int row = row0 + wm * 64 + tt * 32 + l31;
    const float* xr = xin_row(p, layer, row);
    float* dr = xres_row(p, row);
    float ss = 0.f, am = 0.f;
#pragma unroll
    for (int ft = 0; ft < 2; ++ft)
#pragma unroll
      for (int gp = 0; gp < 4; gp += 2) {
        float4 xv[2], gv[2], gg[2], sv[2];
#pragma unroll
        for (int g = 0; g < 2; ++g) {
          const int n = n0 + wn * 64 + ft * 32 + 8 * (gp + g) + 4 * hh;
          xv[g] = *(const float4*)(xr + n); gv[g] = *(const float4*)(g1 + n);
          gg[g] = *(const float4*)(n2g + n); sv[g] = *(const float4*)(sc2 + n);
          if (PROBE == 2) { gv[g].x = gv[g].y = gv[g].z = gv[g].w = 0.f; }
        }
#pragma unroll
        for (int g = 0; g < 2; ++g) {
          const int n = n0 + wn * 64 + ft * 32 + 8 * (gp + g) + 4 * hh, e = 4 * (gp + g);
          float4 o = {xv[g].x + gv[g].x * acc[ft][tt][e], xv[g].y + gv[g].y * acc[ft][tt][e + 1],
                      xv[g].z + gv[g].z * acc[ft][tt][e + 2], xv[g].w + gv[g].w * acc[ft][tt][e + 3]};
          *(float4*)(dr + n) = o;
          ss += o.x * o.x + o.y * o.y + o.z * o.z + o.w * o.w;
          o.x *= gg[g].x * (1.f + sv[g].x); o.y *= gg[g].y * (1.f + sv[g].y); o.z *= gg[g].z * (1.f + sv[g].z); o.w *= gg[g].w * (1.f + sv[g].w);
          acc[ft][tt][e] = o.x; acc[ft][tt][e + 1] = o.y; acc[ft][tt][e + 2] = o.z; acc[ft][tt][e + 3] = o.w;
          am = fmaxf(am, fmaxf(fmaxf(fabsf(o.x), fabsf(o.y)), fmaxf(fabsf(o.z), fabsf(o.w))));
        }
      }
    ss += shx(ss, 32, lane);
    am = fmaxf(am, shx(am, 32, lane));
    if (hh == 0) { p.ssq16[(size_t)(nt * 2 + wn) * MTOT + row] = ss; amx[((wm * 2 + tt) * 32 + l31) * 2 + wn] = am; }
    amv[tt] = am;
    asm volatile("" ::: "memory");
  }
  __syncthreads();
#pragma unroll
  for (int tt = 0; tt < 2; ++tt) {
    const int row = row0 + wm * 64 + tt * 32 + l31;
    const float am = fmaxf(fmaxf(amv[tt], amx[((wm * 2 + tt) * 32 + l31) * 2 + (wn ^ 1)]), 1e-30f);
    const float qs = 127.f / am;
    if (hh == 0 && wn == 0) p.hs8[(size_t)nt * MTOT + row] = am * (1.f / 127.f);
    bf16* hrow = p.H2 + (size_t)row * D + n0 + wn * 64;
    signed char* qrow = p.hq + (size_t)row * D + n0 + wn * 64;
#pragma unroll
    for (int ft = 0; ft < 2; ++ft)
#pragma unroll
      for (int g = 0; g < 4; g += 2) {
        store_pair(hrow + ft * 32 + 8 * g, hh, acc[ft][tt][4 * g], acc[ft][tt][4 * g + 1], acc[ft][tt][4 * g + 2], acc[ft][tt][4 * g + 3],
                   acc[ft][tt][4 * g + 4], acc[ft][tt][4 * g + 5], acc[ft][tt][4 * g + 6], acc[ft][tt][4 * g + 7]);
        float4 va = {acc[ft][tt][4 * g], acc[ft][tt][4 * g + 1], acc[ft][tt][4 * g + 2], acc[ft][tt][4 * g + 3]};
        float4 vb = {acc[ft][tt][4 * g + 4], acc[ft][tt][4 * g + 5], acc[ft][tt][4 * g + 6], acc[ft][tt][4 * g + 7]};
        unsigned qa = pack_i8x4(va, qs), qb = pack_i8x4(vb, qs);
        const auto rq = __builtin_amdgcn_permlane32_swap(qa, qb, false, false);
        u32x2 o8 = {rq[0], rq[1]};
        *(u32x2*)(qrow + ft * 32 + 8 * g + hh * 8) = o8;
      }
  }
}

constexpr int ROUTE_ITEMS = 288 * 8;
constexpr int QROW = 272;
DI int to_sortable(int b) { return b ^ ((b >> 31) & 0x7fffffff); }

#define CAND_LIST(X) \
  X(0,0,0) X(1,0,1) X(2,0,2) X(3,0,3) X(4,0,4) X(5,0,5) X(6,0,6) X(7,0,7) X(8,0,8) X(9,0,9) X(10,0,10) X(11,0,11) X(12,0,12) X(13,0,13) X(14,0,14) X(15,0,15) \
  X(16,1,1) X(17,1,2) X(18,1,3) X(19,1,4) X(20,1,5) X(21,1,6) X(22,1,7) \
  X(23,2,2) X(24,2,3) X(25,2,4) \
  X(26,3,3)


DI void ce_desc(int& a, int& b) { const int hi = max(a, b), lo = min(a, b); a = hi; b = lo; }
DI void bitonic_sort16_desc(int (&v)[16]) {
#pragma unroll
  for (int k = 2; k <= 16; k <<= 1)
#pragma unroll
    for (int j = k >> 1; j > 0; j >>= 1)
#pragma unroll
      for (int i = 0; i < 16; ++i) {
        const int l = i ^ j;
        if (l > i) { if ((i & k) == 0) ce_desc(v[i], v[l]); else ce_desc(v[l], v[i]); }
      }
}
DI void bitonic_merge16_desc(int (&v)[16]) {
#pragma unroll
  for (int j = 8; j > 0; j >>= 1)
#pragma unroll
    for (int i = 0; i < 16; ++i) { const int l = i ^ j; if (l > i) ce_desc(v[i], v[l]); }
}
DI void merge_top16(int (&a)[16], const int (&b)[16]) {
#pragma unroll
  for (int i = 0; i < 16; ++i) a[i] = max(a[i], b[15 - i]);
  bitonic_merge16_desc(a);
}
DI void stage_route(const Params& p, int layer, int item, char* smem) {
  const int mt = item >> 3, head = item & 7;
  if (layer == 1 && mt >= 256) return;
  const int row0 = mt * 128;
  const int tid = tid_now(), lane = tid & 63, wave = tid >> 6, wm = wave >> 1, wn = wave & 1, l31 = lane & 31, hh = lane >> 5;
  int t0[16], tk[16];
  char* Qs = smem;
  float* rs = (float*)(smem + GEMM_SMEM);
  if (tid < 128) {
    float sv[16];
#pragma unroll
    for (int s = 0; s < 16; ++s) sv[s] = p.ssq16[(size_t)s * MTOT + row0 + tid];
    float ssum = 0.f;
#pragma unroll
    for (int s = 0; s < 16; ++s) ssum += sv[s];
    rs[tid] = rsqrtf(ssum * (1.f / D) + EPS);
  }
#pragma unroll 1
  for (int pp = 0; pp < 2; ++pp) {
    {
      f32x16 acc[2][2];
      gemm_core<true, true>(p.H2 + (size_t)row0 * D, p.wq + ((size_t)layer * 2048 + (head * 2 + pp) * 128) * D, smem, acc);
      {
        const float* cqr = p.cq + ((size_t)layer * 17 + mod_row(row0)) * 2048 + (head * 2 + pp) * 128 + wn * 64 + 4 * hh;
#pragma unroll
        for (int tt = 0; tt < 2; ++tt) {
          const float rsd = rs[wm * 64 + tt * 32 + l31];
#pragma unroll
          for (int ft = 0; ft < 2; ++ft)
#pragma unroll
            for (int g = 0; g < 4; ++g) {
              const float4 cv = *(const float4*)(cqr + ft * 32 + 8 * g);
              acc[ft][tt][4 * g] = acc[ft][tt][4 * g] * rsd + cv.x; acc[ft][tt][4 * g + 1] = acc[ft][tt][4 * g + 1] * rsd + cv.y;
              acc[ft][tt][4 * g + 2] = acc[ft][tt][4 * g + 2] * rsd + cv.z; acc[ft][tt][4 * g + 3] = acc[ft][tt][4 * g + 3] * rsd + cv.w;
            }
        }
      }
#pragma unroll
      for (int tt = 0; tt < 2; ++tt)
#pragma unroll
        for (int ft = 0; ft < 2; ++ft)
#pragma unroll
          for (int g = 0; g < 4; ++g) {
            const int tok = wm * 64 + tt * 32 + l31, kf = wn * 64 + ft * 32 + 8 * g + 4 * hh;
            u32x2 o = {pack2(acc[ft][tt][4 * g], acc[ft][tt][4 * g + 1]), pack2(acc[ft][tt][4 * g + 2], acc[ft][tt][4 * g + 3])};
            *(u32x2*)(Qs + tok * QROW + kf * 2) = o;
          }
    }
    const __amdgpu_buffer_rsrc_t rK = __builtin_amdgcn_make_buffer_rsrc((void*)p.pk, 0, (unsigned)(PK_N * 2), 0x00020000);
    const int kso = (((layer * 8 + head) * 2 + pp) * 128) * 256;
    u32x4 ka[8];
#pragma unroll
    for (int s = 0; s < 8; ++s) ka[s] = __builtin_amdgcn_raw_buffer_load_b128(rK, (l31 * 128 + 8 * hh) * 2 + 32 * s, kso, 0);
    __syncthreads();
    {
#pragma unroll
      for (int r = 0; r < 16; ++r) tk[r] = (int)0x80000000;
#pragma unroll 1
      for (int nt = 0; nt < 4; ++nt) {
        int cur[16];
        {
          f32x16 sc;
#pragma unroll
          for (int e = 0; e < 16; ++e) sc[e] = 0.f;
#pragma unroll
          for (int s = 0; s < 8; ++s) {
            bf16x8 qb = *(const bf16x8*)(Qs + (wave * 32 + l31) * QROW + (16 * s + 8 * hh) * 2);
            sc = MFMA(__builtin_bit_cast(bf16x8, ka[s]), qb, sc);
          }
          {
            const int nn = nt < 3 ? nt + 1 : 3;
#pragma unroll
            for (int s = 0; s < 8; ++s) ka[s] = __builtin_amdgcn_raw_buffer_load_b128(rK, ((nn * 32 + l31) * 128 + 8 * hh) * 2 + 32 * s, kso, 0);
          }
#pragma unroll
          for (int e = 0; e < 16; ++e) {
            const int n = nt * 32 + crow(e, hh);
            int b = (__float_as_int(sc[e]) & ~127) | n;
            cur[e] = to_sortable(b);
          }
        }
        bitonic_sort16_desc(cur);
        merge_top16(tk, cur);
      }
      int pb[16];
#pragma unroll
      for (int i = 0; i < 16; ++i) pb[i] = shxi(tk[i], 32, lane);
      merge_top16(tk, pb);
    }
    if (pp == 0) {
#pragma unroll
      for (int r = 0; r < 16; ++r) t0[r] = tk[r];
    }
    __syncthreads();
  }
  char* recs = Qs + (tid_now() >> 6) * 32 * QROW;
  int cand[27];
  {
    float av[16], bv[16];
    unsigned pa[4] = {0u, 0u, 0u, 0u}, pbb[4] = {0u, 0u, 0u, 0u};
#pragma unroll
    for (int i = 0; i < 16; ++i) {
      int k1 = to_sortable(t0[i]), k2 = to_sortable(tk[i]);
      int a = hh ? k2 : k1, b = hh ? k1 : k2;
      av[i] = __int_as_float(a & ~127); bv[i] = __int_as_float(b & ~127);
      pa[i >> 2] |= (unsigned)(a & 127) << (8 * (i & 3));
      pbb[i >> 2] |= (unsigned)(b & 127) << (8 * (i & 3));
    }
    u32x4 ra_ = {pa[0], pa[1], pa[2], pa[3]}, rb_ = {pbb[0], pbb[1], pbb[2], pbb[3]};
    *(u32x4*)(recs + lane * 32) = ra_;
    *(u32x4*)(recs + lane * 32 + 16) = rb_;
#define MKC(c, i, j) { int b = __float_as_int(av[i] + bv[j]); cand[c] = (to_sortable(b) & ~63) | (c * 2 + hh); \
                       if (i == j && hh) cand[c] = (int)0x80000000; }
    CAND_LIST(MKC)
#undef MKC
  }
  int win[16], weid[16];
#pragma unroll
  for (int r = 0; r < 16; ++r) {
    int mx = cand[0];
#pragma unroll
    for (int c = 1; c < 27; ++c) mx = max(mx, cand[c]);
    mx = max(mx, shxi(mx, 32, lane));
#pragma unroll
    for (int c = 0; c < 27; ++c) cand[c] = (cand[c] == mx) ? (int)0x80000000 : cand[c];
    win[r] = mx;
  }
#pragma unroll
  for (int r = 0; r < 16; ++r) {
    const int code = win[r] & 63, c = code >> 1, hw = code & 1;
    const int i = (c >= 16) + (c >= 23) + (c >= 26);
    const int j = c - (i == 0 ? 0 : i == 1 ? 15 : i == 2 ? 21 : 23);
    const unsigned char* orec = (const unsigned char*)(recs + (l31 + 32 * hw) * 32);
    const int aiv = orec[i], biv = orec[16 + j];
    weid[r] = hw ? (biv * 128 + aiv) : (aiv * 128 + biv);
  }
  float gsum = 0.f, gv[16];
  const float v0 = __int_as_float(to_sortable(win[0]) & ~63);
#pragma unroll
  for (int r = 0; r < 16; ++r) { gv[r] = __expf(__int_as_float(to_sortable(win[r]) & ~63) - v0); gsum += gv[r]; }
  const float ginv = 1.f / gsum;
  const int row = row0 + (tid_now() >> 6) * 32 + (tid_now() & 31);
  if (hh == 0) {
    int4* d = (int4*)(p.ridx + ((size_t)row * 8 + head) * 32);
#pragma unroll
    for (int q = 0; q < 4; ++q) { int4 o = {weid[4 * q], weid[4 * q + 1], weid[4 * q + 2], weid[4 * q + 3]}; d[q] = o; }
  } else {
    float4* d = (float4*)((float*)p.ridx + ((size_t)row * 8 + head) * 32 + 16);
#pragma unroll
    for (int q = 0; q < 4; ++q) { float4 o = {gv[4 * q] * ginv, gv[4 * q + 1] * ginv, gv[4 * q + 2] * ginv, gv[4 * q + 3] * ginv}; d[q] = o; }
  }
  __syncthreads();
}

DI float dot2(unsigned a, unsigned b, float acc) {
  bf2_t x = __builtin_bit_cast(bf2_t, a), y = __builtin_bit_cast(bf2_t, b);
  return __builtin_amdgcn_fdot2_f32_bf16(x, y, acc, false);
}
DI float dot8(u32x4 a, u32x4 b, float acc) {
  const unsigned a0 = a[0], a1 = a[1], a2 = a[2], a3 = a[3], b0 = b[0], b1 = b[1], b2 = b[2], b3 = b[3];
  acc = dot2(a0, b0, acc); acc = dot2(a1, b1, acc); acc = dot2(a2, b2, acc); acc = dot2(a3, b3, acc);
  return acc;
}
DI void axpy8(float (&o)[8], float w, u32x4 v) {
  o[0] += w * bf_lo(v.x); o[1] += w * bf_hi(v.x); o[2] += w * bf_lo(v.y); o[3] += w * bf_hi(v.y);
  o[4] += w * bf_lo(v.z); o[5] += w * bf_hi(v.z); o[6] += w * bf_lo(v.w); o[7] += w * bf_hi(v.w);
}
constexpr int GATHER_ITEMS = MTOT / 4;
DI float dot4f8(unsigned u, unsigned hlo, unsigned hhi, float acc) {
  bf2_t a = __builtin_amdgcn_cvt_scalef32_pk_bf16_fp8((int)u, 1.0f, false);
  bf2_t b = __builtin_amdgcn_cvt_scalef32_pk_bf16_fp8((int)u, 1.0f, true);
  bf2_t x = __builtin_bit_cast(bf2_t, hlo), y = __builtin_bit_cast(bf2_t, hhi);
  acc = __builtin_amdgcn_fdot2_f32_bf16(a, x, acc, false);
  acc = __builtin_amdgcn_fdot2_f32_bf16(b, y, acc, false);
  return acc;
}
DI void axpy4f8(float& o0, float& o1, float& o2, float& o3, float w, unsigned v) {
  f2_t lo = __builtin_amdgcn_cvt_pk_f32_fp8((int)v, false), hi = __builtin_amdgcn_cvt_pk_f32_fp8((int)v, true);
  o0 += w * lo[0]; o1 += w * lo[1]; o2 += w * hi[0]; o3 += w * hi[1];
}
DI void stage_gather(const Params& p, int layer, int item) {
  const int lane = tid_now() & 63, wave = tid_now() >> 6;
  const int row = item * 4 + wave;
  if (layer == 1 && row >= NTOK) return;
  const int* rr = p.ridx + (size_t)row * 256 + (lane >> 4) * 32 + (lane & 15);
  const int idxA = rr[0], idxB = rr[128];
  const float gA = __int_as_float(rr[16]), gB = __int_as_float(rr[144]);
  const bf16* hr = p.H + (size_t)row * D + lane * 16;
  const u32x4 hA = *(const u32x4*)(hr), hB = *(const u32x4*)(hr + 8);
  const unsigned h0 = hA[0], h1 = hA[1], h2 = hA[2], h3 = hA[3], h4 = hB[0], h5 = hB[1], h6 = hB[2], h7 = hB[3];
  float o[16];
#pragma unroll
  for (int i = 0; i < 16; ++i) o[i] = 0.f;
  const __amdgpu_buffer_rsrc_t rU = __builtin_amdgcn_make_buffer_rsrc((void*)(p.pu8 + (size_t)layer * NEXP * D), 0, NEXP * D, 0x00020000);
  const __amdgpu_buffer_rsrc_t rV = __builtin_amdgcn_make_buffer_rsrc((void*)(p.pv8 + (size_t)layer * NEXP * D), 0, NEXP * D, 0x00020000);
  const int voff = lane * 16;
  u32x4 ua[16], va[16];
#pragma unroll
  for (int k = 0; k < 16; ++k) {
    const int e = __builtin_amdgcn_readlane(idxA, k);
    ua[k] = __builtin_amdgcn_raw_buffer_load_b128(rU, voff, e * D, 0);
  }
#pragma unroll
  for (int k = 0; k < 16; ++k) {
    const int e = __builtin_amdgcn_readlane(idxA, k);
    va[k] = __builtin_amdgcn_raw_buffer_load_b128(rV, voff, e * D, 0);
  }
#pragma unroll
  for (int head = 0; head < 8; ++head) {
    float part[16];
#pragma unroll
    for (int k = 0; k < 16; ++k) {
      const unsigned a0 = ua[k][0], a1 = ua[k][1], a2 = ua[k][2], a3 = ua[k][3];
      float s = dot4f8(a0, h0, h1, 0.f);
      s = dot4f8(a1, h2, h3, s); s = dot4f8(a2, h4, h5, s); s = dot4f8(a3, h6, h7, s);
      part[k] = s;
    }
    asm volatile("" ::: "memory");
    if (head < 7) {
#pragma unroll
      for (int k = 0; k < 16; ++k) {
        const int e = __builtin_amdgcn_readlane((head + 1) < 4 ? idxA : idxB, ((head + 1) & 3) * 16 + k);
        ua[k] = __builtin_amdgcn_raw_buffer_load_b128(rU, voff, e * D, 0);
      }
    }
    float r8[8], r4[4], r2[2], r1;
    {
      const bool up = lane & 32;
#pragma unroll
      for (int k = 0; k < 8; ++k) { float keep = up ? part[k + 8] : part[k], give = up ? part[k] : part[k + 8]; r8[k] = keep + shx(give, 32, lane); }
    }
    {
      const bool up = lane & 16;
#pragma unroll
      for (int k = 0; k < 4; ++k) { float keep = up ? r8[k + 4] : r8[k], give = up ? r8[k] : r8[k + 4]; r4[k] = keep + shx(give, 16, lane); }
    }
    {
      const bool up = lane & 8;
#pragma unroll
      for (int k = 0; k < 2; ++k) { float keep = up ? r4[k + 2] : r4[k], give = up ? r4[k] : r4[k + 2]; r2[k] = keep + shx(give, 8, lane); }
    }
    {
      const bool up = lane & 4;
      float keep = up ? r2[1] : r2[0], give = up ? r2[0] : r2[1];
      r1 = keep + shx(give, 4, lane);
    }
    r1 += shx(r1, 2, lane);
    r1 += shx(r1, 1, lane);
    const float myg = __int_as_float(__builtin_amdgcn_ds_bpermute(((head & 3) * 16 + ((lane >> 2) & 15)) << 2, __float_as_int(head < 4 ? gA : gB)));
    const float w = gelu_tanh(r1 * (1.f / SU)) * myg * (1.f / SV);
#pragma unroll
    for (int k = 0; k < 16; ++k) {
      const float wk = __int_as_float(__builtin_amdgcn_readlane(__float_as_int(w), k << 2));
      const unsigned a0 = va[k][0], a1 = va[k][1], a2 = va[k][2], a3 = va[k][3];
      axpy4f8(o[0], o[1], o[2], o[3], wk, a0); axpy4f8(o[4], o[5], o[6], o[7], wk, a1);
      axpy4f8(o[8], o[9], o[10], o[11], wk, a2); axpy4f8(o[12], o[13], o[14], o[15], wk, a3);
    }
    asm volatile("" ::: "memory");
    if (head < 7) {
#pragma unroll
      for (int k = 0; k < 16; ++k) {
        const int e = __builtin_amdgcn_readlane((head + 1) < 4 ? idxA : idxB, ((head + 1) & 3) * 16 + k);
        va[k] = __builtin_amdgcn_raw_buffer_load_b128(rV, voff, e * D, 0);
      }
    }
  }
  const float* g2 = p.mod + ((size_t)layer * 17 + mod_row(row)) * 6144 + 5120 + lane * 16;
  float* dr = xres_row(p, row) + lane * 16;
  float4 xv[4], gv[4];
#pragma unroll
  for (int q = 0; q < 4; ++q) { xv[q] = *(const float4*)(dr + 4 * q); gv[q] = *(const float4*)(g2 + 4 * q); }
#pragma unroll
  for (int q = 0; q < 4; ++q) {
    float4 r = {xv[q].x + gv[q].x * o[4 * q], xv[q].y + gv[q].y * o[4 * q + 1], xv[q].z + gv[q].z * o[4 * q + 2], xv[q].w + gv[q].w * o[4 * q + 3]};
    *(float4*)(dr + 4 * q) = r;
  }
}

constexpr int PEER_TPW = 8;
constexpr int PEER_TPI = 4 * PEER_TPW;
DI float bperm_f(float v, int src_lane) { return __int_as_float(__builtin_amdgcn_ds_bpermute(src_lane << 2, __float_as_int(v))); }
DI int bperm_i(int v, int src_lane) { return __builtin_amdgcn_ds_bpermute(src_lane << 2, v); }

DI __amdgpu_buffer_rsrc_t mk_rsrc(const void* ptr, unsigned bytes) { return __builtin_amdgcn_make_buffer_rsrc((void*)ptr, 0, bytes, 0x00020000); }
DI void stage_peer_u(const Params& p, int layer, int q, int tile, _Float16* __restrict__ partial) {
  const int tid = tid_now(), lane = tid & 63, g = lane >> 3, c = lane & 7;
  const int wave = __builtin_amdgcn_readfirstlane(tid >> 6);
  const int row_base = tile * PEER_TPI + wave * PEER_TPW;
  const __amdgpu_buffer_rsrc_t rU = mk_rsrc(p.pu8 + (size_t)layer * NEXP * D, NEXP * D);
  const __amdgpu_buffer_rsrc_t rRec = mk_rsrc(p.ridx, (unsigned)((size_t)MTOT * 1024));
  const __amdgpu_buffer_rsrc_t rH = mk_rsrc(p.hq, (unsigned)((size_t)MTOT * D));
  const __amdgpu_buffer_rsrc_t rP = mk_rsrc(partial, (unsigned)((size_t)8 * MTOT * 256));
  const int coff = q * 128 + c * 16;
  const int rec_v = ((lane >> 4) * 32 + (lane & 15)) * 4;
  const int i0 = 4 * (c & 1) + 2 * ((c >> 1) & 1) + ((c >> 2) & 1);
  const int pv0 = (8 * i0 + g) * 4;
  int idA[3], idB[3];
  u32x4 d[2][8]; u32x4 hv[2];
  auto load_idx = [&](int t, int slot) {
    const int so = (row_base + t) * 1024;
    idA[slot] = __builtin_amdgcn_raw_buffer_load_b32(rRec, rec_v, so, 0);
    idB[slot] = __builtin_amdgcn_raw_buffer_load_b32(rRec, rec_v + 512, so, 0);
  };
  auto issue = [&](int u) {
    const int t = u >> 1, hf = u & 1, slot = t % 3, buf = u & 1;
    if (hf == 0) hv[t & 1] = __builtin_amdgcn_raw_buffer_load_b128(rH, coff, (row_base + t) * D, 0);
#pragma unroll
    for (int i = 0; i < 8; ++i) {
      const int e = bperm_i(hf ? idB[slot] : idA[slot], (8 * i + g) & 63);
      d[buf][i] = __builtin_amdgcn_raw_buffer_load_b128(rU, e * D + coff, 0, 0);
    }
  };
  load_idx(0, 0); load_idx(1, 1);
  issue(0);
  int r[16];
#pragma unroll
  for (int u = 0; u < 2 * PEER_TPW; ++u) {
    const int t = u >> 1, hf = u & 1, buf = u & 1;
    asm volatile("" ::: "memory");
    if (hf == 0 && t + 2 < PEER_TPW) load_idx(t + 2, (t + 2) % 3);
    if (u + 1 < 2 * PEER_TPW) issue(u + 1);
    const int h0 = (int)hv[t & 1][0], h1 = (int)hv[t & 1][1], h2 = (int)hv[t & 1][2], h3 = (int)hv[t & 1][3];
#pragma unroll
    for (int i = 0; i < 8; ++i) {
      const int a0 = (int)d[buf][i][0], a1 = (int)d[buf][i][1], a2 = (int)d[buf][i][2], a3 = (int)d[buf][i][3];
      int s = __builtin_amdgcn_sdot4(a0, h0, 0, false);
      s = __builtin_amdgcn_sdot4(a1, h1, s, false); s = __builtin_amdgcn_sdot4(a2, h2, s, false); s = __builtin_amdgcn_sdot4(a3, h3, s, false);
      r[8 * hf + i] = s;
    }
    if (hf == 0) continue;
    asm volatile("" ::: "memory");
    int r8[8], r4[4], r2[2];
    {
      const bool up = c & 1;
#pragma unroll
      for (int b3 = 0; b3 < 2; ++b3)
#pragma unroll
        for (int m = 0; m < 4; ++m) { int lo = r[8 * b3 + m], hi = r[8 * b3 + 4 + m]; int keep = up ? hi : lo, give = up ? lo : hi; r8[4 * b3 + m] = keep + bperm_i(give, lane ^ 1); }
    }
    {
      const bool up = c & 2;
#pragma unroll
      for (int b3 = 0; b3 < 2; ++b3)
#pragma unroll
        for (int m = 0; m < 2; ++m) { int lo = r8[4 * b3 + m], hi = r8[4 * b3 + 2 + m]; int keep = up ? hi : lo, give = up ? lo : hi; r4[2 * b3 + m] = keep + bperm_i(give, lane ^ 2); }
    }
    {
      const bool up = c & 4;
#pragma unroll
      for (int b3 = 0; b3 < 2; ++b3) { int lo = r4[2 * b3], hi = r4[2 * b3 + 1]; int keep = up ? hi : lo, give = up ? lo : hi; r2[b3] = keep + bperm_i(give, lane ^ 4); }
    }
    const int so = (q * MTOT + row_base + t) * 256;
    const h2_t ph = {(_Float16)((float)r2[0] * (1.f / 64.f)), (_Float16)((float)r2[1] * (1.f / 64.f))};
    __builtin_amdgcn_raw_buffer_store_b32(__builtin_bit_cast(int, ph), rP, pv0, so, 0);
  }
}

constexpr int PEERC_RPW = 2;
DI void stage_peer_combine(const Params& p, int layer, int item, const _Float16* __restrict__ partial) {
  const int lane = tid_now() & 63, wave = tid_now() >> 6;
  const int rbase = (item * 4 + wave) * PEERC_RPW;
  const int mr = mod_row(rbase);
  int e0[PEERC_RPW], e1[PEERC_RPW];
  float g0[PEERC_RPW], g1[PEERC_RPW], ssum[PEERC_RPW];
  unsigned pab[PEERC_RPW][8];
  float hq[PEERC_RPW][8];
#pragma unroll
  for (int j = 0; j < PEERC_RPW; ++j) {
    const int* reci = p.ridx + (size_t)(rbase + j) * 256 + (lane >> 4) * 32 + (lane & 15);
    e0[j] = reci[0]; e1[j] = reci[128];
  }
#pragma unroll
  for (int j = 0; j < PEERC_RPW; ++j) {
    const int row = rbase + j;
#pragma unroll
    for (int q = 0; q < 8; ++q) {
      pab[j][q] = ((const unsigned*)partial)[((size_t)q * MTOT + row) * 64 + lane];
      hq[j][q] = p.hs8[(size_t)q * MTOT + row] * 64.f;
    }
    const int* reci = p.ridx + (size_t)row * 256 + (lane >> 4) * 32 + (lane & 15);
    g0[j] = __int_as_float(reci[16]); g1[j] = __int_as_float(reci[144]);
    ssum[j] = p.ssq16[(size_t)(lane & 15) * MTOT + row];
  }
  float2 er0[PEERC_RPW], er1[PEERC_RPW];
#pragma unroll
  for (int j = 0; j < PEERC_RPW; ++j) {
    er0[j] = *(const float2*)(p.esc + ((size_t)layer * NEXP + e0[j]) * 64 + 2 * mr);
    er1[j] = *(const float2*)(p.esc + ((size_t)layer * NEXP + e1[j]) * 64 + 2 * mr);
  }
#pragma unroll
  for (int j = 0; j < PEERC_RPW; ++j) {
    const int row = rbase + j;
    float s0 = 0.f, s1 = 0.f;
#pragma unroll
    for (int q = 0; q < 8; ++q) { const h2_t pv = __builtin_bit_cast(h2_t, pab[j][q]); s0 += (float)pv[0] * hq[j][q]; s1 += (float)pv[1] * hq[j][q]; }
    float t = ssum[j];
    t += shx(t, 1, lane); t += shx(t, 2, lane); t += shx(t, 4, lane); t += shx(t, 8, lane);
    const float rstd = rsqrtf(t * (1.f / D) + EPS);
    float* rec = (float*)(p.ridx + (size_t)row * 256 + (lane >> 4) * 32 + (lane & 15)) + 16;
    const _Float16 w0 = (_Float16)(gelu_tanh(s0 * er0[j].y * rstd + er0[j].x) * g0[j]), w1 = (_Float16)(gelu_tanh(s1 * er1[j].y * rstd + er1[j].x) * g1[j]);
    const h2_t w0p = {w0, w0}, w1p = {w1, w1};
    rec[0] = __builtin_bit_cast(float, w0p);
    rec[128] = __builtin_bit_cast(float, w1p);
  }
}

DI void axpy4f8_pk(f2_t& o01, f2_t& o23, f2_t w2, unsigned v) {
  f2_t lo = __builtin_amdgcn_cvt_pk_f32_fp8((int)v, false), hi = __builtin_amdgcn_cvt_pk_f32_fp8((int)v, true);
  o01 = __builtin_elementwise_fma(w2, lo, o01); o23 = __builtin_elementwise_fma(w2, hi, o23);
}
DI void stage_peer_v(const Params& p, int layer, int q, int tile, float dry = 1.f) {
  const int tid = tid_now(), lane = tid & 63, g = lane >> 3, c = lane & 7;
  const int wave = __builtin_amdgcn_readfirstlane(tid >> 6);
  const int row_base = tile * PEER_TPI + wave * PEER_TPW;
  const __amdgpu_buffer_rsrc_t rV = mk_rsrc(p.pv8 + (size_t)layer * NEXP * D, NEXP * D);
  const __amdgpu_buffer_rsrc_t rRec = mk_rsrc(p.ridx, (unsigned)((size_t)MTOT * 1024));
  const bool isctx = row_base >= NTOK;
  const __amdgpu_buffer_rsrc_t rX = isctx ? mk_rsrc(p.XC, (unsigned)((size_t)NCTX * D * 4)) : mk_rsrc(p.out, (unsigned)((size_t)NTOK * D * 4));
  const int xrow0 = isctx ? row_base - NTOK : row_base;
  const int coff = q * 128 + c * 16;
  const int rec_v = ((lane >> 4) * 32 + (lane & 15)) * 4;
  int idA[3], idB[3]; float wA[3], wB[3];
  u32x4 d[2][8];
  auto load_idx = [&](int t, int slot) {
    const int so = (row_base + t) * 1024;
    idA[slot] = __builtin_amdgcn_raw_buffer_load_b32(rRec, rec_v, so, 0);
    idB[slot] = __builtin_amdgcn_raw_buffer_load_b32(rRec, rec_v + 512, so, 0);
    wA[slot] = __int_as_float(__builtin_amdgcn_raw_buffer_load_b32(rRec, rec_v + 64, so, 0));
    wB[slot] = __int_as_float(__builtin_amdgcn_raw_buffer_load_b32(rRec, rec_v + 576, so, 0));
  };
  const int dl = coff + 8 * (g & 1) + 4 * ((g >> 1) & 1) + 2 * ((g >> 2) & 1);
  u32x2 xvb[2];
  auto issue = [&](int u) {
    const int t = u >> 1, hf = u & 1, slot = t % 3, buf = u & 1;
#pragma unroll
    for (int i = 0; i < 8; ++i) {
      const int e = bperm_i(hf ? idB[slot] : idA[slot], (8 * i + g) & 63);
      d[buf][i] = __builtin_amdgcn_raw_buffer_load_b128(rV, e * D + coff, 0, 0);
    }
    if (hf == 1) xvb[t & 1] = __builtin_amdgcn_raw_buffer_load_b64(rX, dl * 4, (xrow0 + t) * (D * 4), 0);
  };
  const float2 g2v = *(const float2*)(p.mod + ((size_t)layer * 17 + mod_row(row_base)) * 6144 + 5120 + dl);
  load_idx(0, 0); load_idx(1, 1);
  issue(0);
  h2_t oh[8];
#pragma unroll
  for (int u = 0; u < 2 * PEER_TPW; ++u) {
    const int t = u >> 1, hf = u & 1, buf = u & 1, slot = t % 3;
    asm volatile("" ::: "memory");
    if (hf == 0 && t + 2 < PEER_TPW) load_idx(t + 2, (t + 2) % 3);
    if (u + 1 < 2 * PEER_TPW) issue(u + 1);
#pragma unroll
    for (int i = 0; i < 8; ++i) {
      const h2_t w2 = __builtin_bit_cast(h2_t, bperm_f(hf ? wB[slot] : wA[slot], (8 * i + g) & 63));
#pragma unroll
      for (int j = 0; j < 4; ++j) {
        const int av = (int)d[buf][i][j];
        const h2_t lo = __builtin_amdgcn_cvt_scalef32_pk_f16_fp8(av, 1.0f, false), hi = __builtin_amdgcn_cvt_scalef32_pk_f16_fp8(av, 1.0f, true);
        if (hf == 0 && i == 0) { oh[2 * j] = w2 * lo; oh[2 * j + 1] = w2 * hi; }
        else { oh[2 * j] = __builtin_elementwise_fma(w2, lo, oh[2 * j]); oh[2 * j + 1] = __builtin_elementwise_fma(w2, hi, oh[2 * j + 1]); }
      }
    }
    if (hf == 0) continue;
    asm volatile("" ::: "memory");
    h2_t q4[4], q2[2], q1;
    {
      const bool up = g & 1;
#pragma unroll
      for (int k = 0; k < 4; ++k) {
        const h2_t keep = up ? oh[k + 4] : oh[k], give = up ? oh[k] : oh[k + 4];
        q4[k] = keep + __builtin_bit_cast(h2_t, bperm_i(__builtin_bit_cast(int, give), lane ^ 8));
      }
    }
    {
      const bool up = g & 2;
#pragma unroll
      for (int k = 0; k < 2; ++k) {
        const h2_t keep = up ? q4[k + 2] : q4[k], give = up ? q4[k] : q4[k + 2];
        q2[k] = keep + __builtin_bit_cast(h2_t, bperm_i(__builtin_bit_cast(int, give), lane ^ 16));
      }
    }
    {
      const auto sw = __builtin_amdgcn_permlane32_swap(__builtin_bit_cast(unsigned, q2[0]), __builtin_bit_cast(unsigned, q2[1]), false, false);
      const unsigned sa = sw[0], sb = sw[1];
      q1 = __builtin_bit_cast(h2_t, sa) + __builtin_bit_cast(h2_t, sb);
    }
    float r2[2] = {(float)q1[0] * (1.f / SV), (float)q1[1] * (1.f / SV)};
    const int so = (xrow0 + t) * (D * 4);
    const u32x2 xv = xvb[t & 1];
    const float x0 = __uint_as_float(xv[0]), x1 = __uint_as_float(xv[1]);
    u32x2 ov = {__float_as_uint(x0 + dry * g2v.x * r2[0]), __float_as_uint(x1 + dry * g2v.y * r2[1])};
    __builtin_amdgcn_raw_buffer_store_b64(ov, rX, dl * 4, so, 0);
  }
}

#include <hip/hip_cooperative_groups.h>
namespace cg = cooperative_groups;
constexpr int SMEM_BYTES = 40960;


#define XB_TMO      128
#define XB_XCNT(j)  (256  + 64 * (j))
#define XB_XSUB(j)  (1280 + 64 * (j))
#define XB_XGEN(j)  (2304 + 64 * (j))
#define XB_TOP      3328
#define XB_TOPGEN   3392
#define XCD_BAR_WORDS 3456
#define XB_SPIN_CAP (1u << 22)
#define LAS __attribute__((address_space(3)))
DI unsigned xb_ld(unsigned* p) { return __hip_atomic_load(p, __ATOMIC_RELAXED, __HIP_MEMORY_SCOPE_AGENT); }
DI unsigned xb_add(unsigned* p, unsigned v) { return __hip_atomic_fetch_add(p, v, __ATOMIC_RELAXED, __HIP_MEMORY_SCOPE_AGENT); }
DI unsigned xb_xcc_id() { unsigned x; asm volatile("s_getreg_b32 %0, hwreg(HW_REG_XCC_ID, 0, 4)" : "=s"(x)); return x & 0xFu; }
#define XB_SPIN(cond, bar) do { unsigned _sp = 0; while (cond) { __builtin_amdgcn_s_sleep(1); \
    if ((++_sp & 255u) == 0u) { if (xb_ld(&(bar)[XB_TMO])) break; if (_sp > XB_SPIN_CAP) { atomicAdd(&(bar)[XB_TMO], 1u); break; } } } } while (0)
struct XcdBarrier { unsigned* bar; volatile LAS unsigned* st; };
DI XcdBarrier xcd_barrier_post(unsigned* bar, volatile LAS unsigned* st) {
  XcdBarrier b; b.bar = bar; b.st = st;
  if (tid_now() == 0) (void)xb_add(&bar[XB_XCNT(xb_xcc_id())], 1u);
  return b;
}
DI void xcd_barrier_complete(unsigned* bar, unsigned x, unsigned& nloc, unsigned& nx) {
  const unsigned G = gridDim.x;
  unsigned sum, cnt, mine, sp = 0u;
  for (;;) {
    sum = 0u; cnt = 0u; mine = 0u;
#pragma unroll
    for (unsigned j = 0; j < 16; ++j) { const unsigned c = xb_ld(&bar[XB_XCNT(j)]); sum += c; cnt += (c > 0u) ? 1u : 0u; mine = (j == x) ? c : mine; }
    if (sum == G) break;
    __builtin_amdgcn_s_sleep(1);
    if ((++sp & 255u) == 0u) { if (xb_ld(&bar[XB_TMO])) break; if (sp > XB_SPIN_CAP) { atomicAdd(&bar[XB_TMO], 1u); break; } }
  }
  nloc = mine > 0u ? mine : 1u; nx = cnt > 0u ? cnt : 1u;
}
DI void xcd_barrier(const XcdBarrier& b) {
  asm volatile("s_waitcnt vmcnt(0)" ::: "memory");
  __syncthreads();
  if (tid_now() == 0) {
    unsigned* bar = b.bar;
    const unsigned bx = xb_xcc_id();
    __builtin_amdgcn_s_waitcnt(0);
    unsigned nloc = b.st[0], nx = b.st[1];
    if (nloc == 0u) { xcd_barrier_complete(bar, bx, nloc, nx); b.st[0] = nloc; b.st[1] = nx; }
    const unsigned old = xb_add(&bar[XB_XSUB(bx)], 1u);
    const unsigned gen = old / nloc;
    if (old + 1u == (gen + 1u) * nloc) {
      __builtin_amdgcn_s_sleep(64);
      __builtin_amdgcn_fence(__ATOMIC_RELEASE, "agent");
      asm volatile("s_waitcnt vmcnt(0)" ::: "memory");
      const unsigned og = xb_add(&bar[XB_TOP], 1u);
      const unsigned tg = og / nx;
      if (og + 1u == (tg + 1u) * nx) xb_add(&bar[XB_TOPGEN], 1u);
      else XB_SPIN(xb_ld(&bar[XB_TOPGEN]) == tg, bar);
      __builtin_amdgcn_fence(__ATOMIC_ACQUIRE, "agent");
      xb_add(&bar[XB_XGEN(bx)], 1u);
      asm volatile("s_waitcnt vmcnt(0)" ::: "memory");
    } else {
      XB_SPIN(xb_ld(&bar[XB_XGEN(bx)]) == gen, bar);
      __builtin_amdgcn_fence(__ATOMIC_ACQUIRE, "agent");
      asm volatile("s_waitcnt vmcnt(0)" ::: "memory");
    }
  }
  __syncthreads();
}

constexpr int QCTR_STRIDE = 32;
constexpr int QCTR_WORDS = 16 * 8 * QCTR_STRIDE;
DI int q_pop(unsigned* ctr, volatile LAS int* slot) {
  __syncthreads();
  if (tid_now() == 0) *slot = (int)__hip_atomic_fetch_add(ctr, 1u, __ATOMIC_RELAXED, __HIP_MEMORY_SCOPE_AGENT);
  __syncthreads();
  return *slot;
}
template <class NF, class BF>
DI void run_queues(unsigned* ctr, int myx, volatile LAS int* slot, NF nitems_of_q, BF body) {
#pragma unroll 1
  for (int s = 0; s < 8; ++s) {
    const int q = (myx + s) & 7;
    const int n = nitems_of_q(q);
#pragma unroll 1
    for (;;) {
      const int idx = q_pop(ctr + q * QCTR_STRIDE, slot);
      if (idx >= n) break;
      body(q, idx);
    }
  }
}

#define GRID_BARRIER() xcd_barrier(xb)
#define REP(k) for (int rep_ = 0; rep_ < (DUP == (k) ? 2 : 1); ++rep_)

__global__ void __launch_bounds__(256, 3) mega_kernel(Params p) {
  __shared__ __attribute__((aligned(16))) char smem[SMEM_BYTES];
  cg::grid_group grid = cg::this_grid();
  const int G = gridDim.x, bid = blockIdx.x;
  uint4* xbw = (uint4*)(smem + SMEM_BYTES - 16);
  if (tid_now() == 0) *xbw = make_uint4(0u, 0u, 0u, 0u);
  volatile LAS int* qslot = (volatile LAS int*)xbw + 2;
  XcdBarrier xb = xcd_barrier_post(p.bar, (volatile LAS unsigned*)xbw);
  if (p.never) grid.sync();
  REP(1) for (int it = bid; it < MODP_ITEMS + CONVT_ITEMS + CONVK_ITEMS + 1; it += G) {
    if (it < MODP_ITEMS) stage_mod_partial(p, it, smem);
    else if (it < MODP_ITEMS + CONVT_ITEMS) stage_convT(p, it - MODP_ITEMS, smem);
    else if (it < MODP_ITEMS + CONVT_ITEMS + CONVK_ITEMS) stage_convS(p, it - MODP_ITEMS - CONVT_ITEMS);
    else stage_rope(p);
  }
  GRID_BARRIER();
  for (int it = bid; it < MODR_ITEMS; it += G) stage_mod_reduce(p, it);
  GRID_BARRIER();
#pragma unroll 1
  for (int l = 0; l < 2; ++l) {
    REP(2) for (int it = bid; it < MTOT / 8; it += G) stage_norm(p, l, 0, it);
    if (l == 0) for (int it = bid; it < CQP_ITEMS; it += G) stage_cq_partial(p, it, smem);
    GRID_BARRIER();
    {
      const int myx = xb_xcc_id() & 7;
      unsigned* ctr = p.qctr + (l * 8 + 0) * 8 * QCTR_STRIDE;
      const int nlat = l == 0 ? 288 : 256;
      run_queues(ctr, myx, qslot,
        [&](int q) { return nlat * (q < 2 ? 3 : 2) + (l == 0 ? 0 : 32); },
        [&](int q, int idx) {
          const int nN = q < 2 ? 3 : 2;
          int mt, nt;
          if (idx < nlat * nN) { mt = idx / nN; nt = q + 8 * (idx - mt * nN); }
          else { mt = 256 + (idx - nlat * nN); nt = q < 2 ? q + 16 : q + 8; }
          stage_inproj(p, l, mt * 18 + nt, smem);
          if (DUP == 3) stage_inproj(p, l, mt * 18 + nt, smem);
        });
    }
    if (l == 0) for (int it = bid; it < CQR_ITEMS; it += G) stage_cq_reduce(p, it);
    GRID_BARRIER();
    {
      const int myx = xb_xcc_id() & 7;
      run_queues(p.qctr + (l * 8 + 1) * 8 * QCTR_STRIDE, myx, qslot, [&](int) { return 192; },
        [&](int q, int idx) {
          const int b = q + 8 * (idx / 96), r = idx % 96;
          stage_gqa(p, l, b * 96 + r, smem);
          if (DUP == 40) stage_gqa(p, l, b * 96 + r, smem);
          constexpr int NV = CONVV_ITEMS / 2;
          const int g = q * 192 + idx;
          for (int f = g * NV / 1536; f < (g + 1) * NV / 1536; ++f) stage_convS(p, CONVK_ITEMS + l * NV + f);
          const int ncv = (l == 0 ? MTOT : NTOK) / CONV_TT;
          const int c0 = g * ncv / 1536, c1 = (g + 1) * ncv / 1536;
          if (c0 < c1) {
            __syncthreads();
            for (int f = c0; f < c1; ++f) { stage_conv(p, l, f, smem); if (DUP == 44) stage_conv(p, l, f, smem); }
          }
        });
      run_queues(p.qctr + (l * 8 + 2) * 8 * QCTR_STRIDE, myx, qslot, [&](int) { return 192; },
        [&](int q, int idx) {
          const int b = q + 8 * (idx / 96), r = idx % 96;
          stage_na2(p, l, b * 96 + r, smem);
          if (DUP == 43) stage_na2(p, l, b * 96 + r, smem);
          constexpr int NU = CONVU_ITEMS / 2;
          const int g = q * 192 + idx;
          stage_convU(p, l, g * NU / 1536, (g + 1) * NU / 1536, smem);
        });
      const int nctx = l == 0 ? CTXATT_ITEMS : 0;
      for (int it = bid; it < nctx; it += G) stage_ctxatt(p, it, smem);
    }
    GRID_BARRIER();
    {
      const int myx = xb_xcc_id() & 7, nlat = l == 0 ? 288 : 256;
      run_queues(p.qctr + (l * 8 + 3) * 8 * QCTR_STRIDE, myx, qslot, [&](int) { return nlat; },
        [&](int q, int idx) { stage_outproj(p, l, idx * 8 + q, smem); });
    }
    GRID_BARRIER();
    {
      const int myx = xb_xcc_id() & 7, nlat = l == 0 ? 288 : 256;
      run_queues(p.qctr + (l * 8 + 4) * 8 * QCTR_STRIDE, myx, qslot, [&](int) { return nlat; },
        [&](int q, int idx) { stage_route(p, l, idx * 8 + q, smem); if (DUP == 7) stage_route(p, l, idx * 8 + q, smem); });
    }
    GRID_BARRIER();
    {
      const int myx = xb_xcc_id() & 7;
      const int ntile = (l == 0 ? MTOT : NTOK) / PEER_TPI;
      _Float16* partial = (_Float16*)p.U;
      run_queues(p.qctr + (l * 8 + 5) * 8 * QCTR_STRIDE, myx, qslot, [&](int) { return ntile; },
        [&](int q, int idx) { stage_peer_u(p, l, q, idx, partial); if (DUP == 50) stage_peer_u(p, l, q, idx, partial); });
      GRID_BARRIER();
      for (int it = bid; it < (l == 0 ? MTOT : NTOK) / (4 * PEERC_RPW); it += G) stage_peer_combine(p, l, it, partial);
      GRID_BARRIER();
      run_queues(p.qctr + (l * 8 + 6) * 8 * QCTR_STRIDE, myx, qslot, [&](int) { return ntile; },
        [&](int q, int idx) { if (DUP == 51) stage_peer_v(p, l, q, idx, 0.f); stage_peer_v(p, l, q, idx); });
    }
    GRID_BARRIER();
  }
  for (int it = bid; it < NTOK / 8; it += G) stage_final(p, it);
}

extern "C" void kernel_launch(void* const* d_in, const int* in_sizes, int n_in, void* d_out, int out_size, void* d_ws, size_t ws_size,
                              hipStream_t stream) {
  Params p{};
  const float** f = (const float**)&p;
  for (int i = 0; i < 22; ++i) f[i] = (const float*)d_in[i];
  p.out = (float*)d_out;
  char* w = (char*)d_ws; size_t off = 0;
  auto take = [&](size_t bytes) { char* r = w + off; off += (bytes + 255) & ~(size_t)255; return r; };
  p.win = (bf16*)take((size_t)2 * INC * D * 2);
  p.wout = (bf16*)take((size_t)2 * D * D * 2);
  p.wq = (bf16*)take((size_t)2 * 2048 * D * 2);
  p.pk = (bf16*)take(PK_N * 2);
  p.pu8 = (unsigned char*)take(PU_N);
  p.pv8 = (unsigned char*)take(PU_N);
  p.esc = (float*)take((size_t)2 * NEXP * 64 * 4);
  p.ssq16 = (float*)take((size_t)16 * MTOT * 4);
  p.hs8 = (float*)take((size_t)8 * MTOT * 4);
  p.cqp = (float*)take((size_t)CQ_KS * 2 * 17 * 2048 * 4);
  p.cq = (float*)take((size_t)2 * 17 * 2048 * 4);
  p.H2 = (bf16*)take((size_t)MTOT * D * 2);
  p.hq = (signed char*)take((size_t)MTOT * D);
  p.modp = (float*)take((size_t)2 * 8 * 17 * 6144 * 4);
  p.mod = (float*)take((size_t)2 * 17 * 6144 * 4);
  p.ropetab = (float*)take(64 * 16 * 2 * 4);
  p.H = (bf16*)take((size_t)MTOT * D * 2);
  p.CAT = p.H;
  p.U = (bf16*)take((size_t)MTOT * 256 * 2);
  p.QN = (bf16*)take((size_t)NB * 6 * SEQ2 * 64 * 2);
  p.KN = (bf16*)take((size_t)NB * 6 * SEQ2 * 64 * 2);
  p.VNt = (bf16*)take((size_t)NB * 6 * SEQ2 * 64 * 2);
  p.QG = (bf16*)take((size_t)NB * 6 * SEQ2 * 64 * 2);
  p.KG = (bf16*)take((size_t)NB * 2 * SEQ2 * 64 * 2);
  p.VGt = (bf16*)take((size_t)NB * 2 * SEQ2 * 64 * 2);
  p.XC = (float*)take((size_t)NCTX * D * 4);
  p.ridx = (int*)take((size_t)MTOT * 256 * 4);
  p.rg = (float*)p.ridx;
  p.bar = (unsigned*)take(XCD_BAR_WORDS * 4);
  p.qctr = (unsigned*)take(QCTR_WORDS * 4);
  if (off > ws_size) return;
  static int grid_blocks = 0;
  if (!grid_blocks) {
    int dev = 0, cus = 0, per_cu = 0;
    hipGetDevice(&dev);
    hipDeviceGetAttribute(&cus, hipDeviceAttributeMultiprocessorCount, dev);
    hipOccupancyMaxActiveBlocksPerMultiprocessor(&per_cu, mega_kernel, 256, 0);
    if (per_cu > 3) per_cu = 3;
    grid_blocks = cus * per_cu;
  }
  void* args[] = {&p};
  hipMemsetAsync(p.bar, 0, (size_t)(XCD_BAR_WORDS + QCTR_WORDS) * 4, stream);
  hipLaunchCooperativeKernel((void*)mega_kernel, dim3(grid_blocks), dim3(256), args, 0, stream);
}
```

```cpp
#include <hip/hip_runtime.h>
#include <stdint.h>

typedef __attribute__((ext_vector_type(8))) short bf16x8;
typedef __attribute__((ext_vector_type(16))) float f32x16;
typedef __attribute__((ext_vector_type(2))) __bf16 bf2_t;
typedef __attribute__((ext_vector_type(2))) float f2_t;
typedef unsigned short bf16;
typedef __attribute__((ext_vector_type(2))) _Float16 h2_t;
typedef __attribute__((ext_vector_type(4))) unsigned u32x4;
typedef __attribute__((ext_vector_type(2))) unsigned u32x2;

#define DI __device__ __forceinline__
#ifndef PROBE
#define PROBE 0
#endif
#ifndef DUP
#define DUP 0
#endif
#define MFMA(a, b, c) __builtin_amdgcn_mfma_f32_32x32x16_bf16((a), (b), (c), 0, 0, 0)

constexpr int D = 1024, NB = 16, T = 2048, CL = 256;
constexpr int NTOK = NB * T;
constexpr int NCTX = NB * CL;
constexpr int MTOT = NTOK + NCTX;
constexpr int INC = 2304;
constexpr int SEQ2 = T + CL;
constexpr int NEXP = 16384;
constexpr float EPS = 1e-6f;
constexpr float L2E = 1.4426950408889634f;

struct Params {
  const float *x, *c, *ctx, *c_ctx, *norm1_g, *norm2_g, *w_ada, *b_ada, *w_in, *conv_w, *conv_b, *conv_ln_g,
      *conv_ln_b, *na_rel_bias, *gqa_q_norm, *gqa_k_norm, *w_out, *peer_w_q, *peer_keys, *peer_u, *peer_v, *final_norm_g;
  float* out;
  bf16 *win, *wout, *wq, *pk;
  unsigned char *pu8, *pv8;
  float *esc;
  float *ssq16, *hs8;
  float *cqp, *cq;
  bf16 *H2;
  signed char* hq;
  float *modp, *mod, *ropetab;
  bf16 *H, *U, *QN, *KN, *VNt, *QG, *KG, *VGt, *CAT;
  float *XC;
  int* ridx;
  float* rg;
  unsigned* bar;
  unsigned* qctr;
  int never;
  int pad_;
};

DI int tid_now() { int t; asm volatile("v_mov_b32 %0, %1" : "=v"(t) : "v"((int)__builtin_amdgcn_workitem_id_x())); return t; }
DI unsigned pack2(float a, float b) {
  f2_t v = {a, b};
  bf2_t r = __builtin_convertvector(v, bf2_t);
  return __builtin_bit_cast(unsigned, r);
}
DI float bf_lo(unsigned u) { return __uint_as_float(u << 16); }
DI float bf_hi(unsigned u) { return __uint_as_float(u & 0xffff0000u); }
DI int sidx(int r) { return (r >> 2) * 32 + (r & 3); }
DI int crow(int e, int h) { return (e & 3) + 8 * (e >> 2) + 4 * h; }
DI float fexp2(float x) { return __builtin_amdgcn_exp2f(x); }
DI float silu_f(float x) { return x / (1.f + __expf(-x)); }
DI float sigmoid_f(float x) { return 1.f / (1.f + __expf(-x)); }
DI float gelu_tanh(float x) {
  float u = 0.7978845608028654f * (x + 0.044715f * x * x * x);
  float t = 1.f - 2.f / (1.f + __expf(2.f * u));
  return 0.5f * x * (1.f + t);
}
DI float shx(float v, int m, int lane) { return __int_as_float(__builtin_amdgcn_ds_bpermute((lane ^ m) << 2, __float_as_int(v))); }
DI int shxi(int v, int m, int lane) { return __builtin_amdgcn_ds_bpermute((lane ^ m) << 2, v); }
DI float wave_sum(float v, int lane) {
#pragma unroll
  for (int o = 32; o >= 1; o >>= 1) v += shx(v, o, lane);
  return v;
}
DI float* xres_row(const Params& p, int row) { return row < NTOK ? p.out + (size_t)row * D : p.XC + (size_t)(row - NTOK) * D; }
DI const float* xin_row(const Params& p, int layer, int row) {
  if (layer == 0) return row < NTOK ? p.x + (size_t)row * D : p.ctx + (size_t)(row - NTOK) * D;
  return xres_row(p, row);
}
DI int mod_row(int row) { return row < NTOK ? (row >> 11) : 16; }
DI int batch_of(int row) { return row < NTOK ? (row >> 11) : ((row - NTOK) >> 8); }
DI int pos_of(int row) { return row < NTOK ? (row & 2047) : (T + ((row - NTOK) & 255)); }

DI int perm_in(int n) {
  if (n >= 512) return n;
  int c = n >> 6, w = n & 63;
  return w < 32 ? 32 * c + w : 256 + 32 * c + (w - 32);
}
DI size_t fm_index(int n, int k) { return ((size_t)(n >> 5) * 64 + (k >> 4)) * 512 + ((((k >> 3) & 1) * 32 + (n & 31)) * 8) + (k & 7); }
DI void convT_tile(const float* __restrict__ src, bf16* __restrict__ dst, int K, int N, int k0, int n0, bool perm, float* tile  ) {
  const int tx = tid_now() & 63, ty = tid_now() >> 6;
  const int ns = perm ? perm_in(n0 + tx) : n0 + tx;
#pragma unroll
  for (int i = 0; i < 16; ++i) { int k = ty + 4 * i; tile[k * 65 + tx] = src[(size_t)(k0 + k) * N + ns]; }
  __syncthreads();
#pragma unroll
  for (int i = 0; i < 2; ++i) {
    const int pr = tid_now() + 256 * i;
    const int n = pr & 63, kc = pr >> 6;
    const float* t = tile + (kc * 8) * 65 + n;
    u32x4 o = {pack2(t[0], t[65]), pack2(t[2 * 65], t[3 * 65]), pack2(t[4 * 65], t[5 * 65]), pack2(t[6 * 65], t[7 * 65])};
    *(u32x4*)(dst + fm_index(n0 + n, k0 + kc * 8)) = o;
  }
  __syncthreads();
}
constexpr int CONVT_ITEMS = 2 * 1344;
DI void stage_convT(const Params& p, int item, char* smem) {
  float* tile = (float*)smem;
  int l = item / 1344, r = item % 1344;
  if (r < 576) { int kt = r / 36, nt = r % 36; convT_tile(p.w_in + (size_t)l * D * INC, p.win + (size_t)l * INC * D, D, INC, kt * 64, nt * 64, true, tile); }
  else if (r < 832) { r -= 576; int kt = r / 16, nt = r % 16; convT_tile(p.w_out + (size_t)l * D * D, p.wout + (size_t)l * D * D, D, D, kt * 64, nt * 64, false, tile); }
  else { r -= 832; int kt = r / 32, nt = r % 32; convT_tile(p.peer_w_q + (size_t)l * D * 2048, p.wq + (size_t)l * 2048 * D, D, 2048, kt * 64, nt * 64, false, tile); }
}
constexpr size_t PK_N = (size_t)2 * 16 * 128 * 128, PU_N = (size_t)2 * NEXP * D;
constexpr float SU = 1024.f, SV = 64.f;
constexpr int CONVK_ITEMS = (int)(PK_N / 2048), CONVV_ITEMS = (int)(PU_N / 4096), CONVU_ITEMS = 2 * NEXP / 4;
constexpr int CONVS_ITEMS = CONVK_ITEMS + CONVV_ITEMS + CONVU_ITEMS;
DI unsigned pack_fp8x4(float4 a, float s) {
  int r = 0;
  r = __builtin_amdgcn_cvt_pk_fp8_f32(a.x * s, a.y * s, r, false);
  r = __builtin_amdgcn_cvt_pk_fp8_f32(a.z * s, a.w * s, r, true);
  return (unsigned)r;
}
DI unsigned pack_i8x4(float4 a, float s) {
  const int x = (int)rintf(a.x * s), y = (int)rintf(a.y * s), z = (int)rintf(a.z * s), w = (int)rintf(a.w * s);
  return (unsigned)(x & 255) | ((unsigned)(y & 255) << 8) | ((unsigned)(z & 255) << 16) | ((unsigned)(w & 255) << 24);
}
DI void stage_convS(const Params& p, int item) {
  if (item < CONVK_ITEMS) {
    size_t e = (size_t)item * 2048 + tid_now() * 8;
    const float* src = p.peer_keys + e;
    float4 a = ((const float4*)src)[0], b = ((const float4*)src)[1];
    u32x4 o = {pack2(a.x, a.y), pack2(a.z, a.w), pack2(b.x, b.y), pack2(b.z, b.w)};
    *(u32x4*)(p.pk + e) = o;
    return;
  }
  item -= CONVK_ITEMS;
  if (item < CONVV_ITEMS) {
    size_t e = (size_t)item * 4096 + tid_now() * 16;
    const float* src = p.peer_v + e;
    float4 a = ((const float4*)src)[0], b = ((const float4*)src)[1], c = ((const float4*)src)[2], d = ((const float4*)src)[3];
    u32x4 o = {pack_fp8x4(a, SV), pack_fp8x4(b, SV), pack_fp8x4(c, SV), pack_fp8x4(d, SV)};
    *(u32x4*)(p.pv8 + e) = o;
    return;
  }
  item -= CONVV_ITEMS;
  {
    const int lane = tid_now() & 63, wave = tid_now() >> 6;
    const int r = item * 4 + wave;
    const float* src = p.peer_u + (size_t)r * D + lane * 16;
    float4 a = ((const float4*)src)[0], b = ((const float4*)src)[1], c = ((const float4*)src)[2], d = ((const float4*)src)[3];
    float m = fmaxf(fmaxf(fmaxf(fabsf(a.x), fabsf(a.y)), fmaxf(fabsf(a.z), fabsf(a.w))), fmaxf(fmaxf(fabsf(b.x), fabsf(b.y)), fmaxf(fabsf(b.z), fabsf(b.w))));
    m = fmaxf(m, fmaxf(fmaxf(fmaxf(fabsf(c.x), fabsf(c.y)), fmaxf(fabsf(c.z), fabsf(c.w))), fmaxf(fmaxf(fabsf(d.x), fabsf(d.y)), fmaxf(fabsf(d.z), fabsf(d.w)))));
#pragma unroll
    for (int o = 32; o >= 1; o >>= 1) m = fmaxf(m, shx(m, o, lane));
    m = fmaxf(m, 1e-30f);
    const float s = 127.f / m;
    u32x4 o = {pack_i8x4(a, s), pack_i8x4(b, s), pack_i8x4(c, s), pack_i8x4(d, s)};
    *(u32x4*)(p.pu8 + (size_t)r * D + lane * 16) = o;
  }
}
DI float dotbf(unsigned a, unsigned b, float acc) {
  const bf2_t x = __builtin_bit_cast(bf2_t, a), y = __builtin_bit_cast(bf2_t, b);
  return __builtin_amdgcn_fdot2_f32_bf16(x, y, acc, false);
}
DI void stage_convU(const Params& p, int l, int f0, int f1, char* smem) {
  if (f0 >= f1) return;
  const int tid = tid_now(), lane = tid & 63, wave = tid >> 6;
  __syncthreads();
  for (int i = tid; i < 17 * 128; i += 256) {
    const int mr = i >> 7, c8 = i & 127;
    const float* sp = p.mod + ((size_t)l * 17 + mr) * 6144 + 3072 + c8 * 8;
    const float4 s0 = ((const float4*)sp)[0], s1 = ((const float4*)sp)[1];
    u32x4 o = {pack2(s0.x, s0.y), pack2(s0.z, s0.w), pack2(s1.x, s1.y), pack2(s1.z, s1.w)};
    *(u32x4*)(smem + ((mr * 2 + (c8 & 1)) * 64 + (c8 >> 1)) * 16) = o;
  }
  __syncthreads();
#pragma unroll 1
  for (int f = f0; f < f1; ++f) {
    const int r = (l * (NEXP / 4) + f) * 4 + wave;
    const float* src = p.peer_u + (size_t)r * D + lane * 16;
    float4 a = ((const float4*)src)[0], b = ((const float4*)src)[1], c = ((const float4*)src)[2], d = ((const float4*)src)[3];
    float m = fmaxf(fmaxf(fmaxf(fabsf(a.x), fabsf(a.y)), fmaxf(fabsf(a.z), fabsf(a.w))), fmaxf(fmaxf(fabsf(b.x), fabsf(b.y)), fmaxf(fabsf(b.z), fabsf(b.w))));
    m = fmaxf(m, fmaxf(fmaxf(fmaxf(fabsf(c.x), fabsf(c.y)), fmaxf(fabsf(c.z), fabsf(c.w))), fmaxf(fmaxf(fabsf(d.x), fabsf(d.y)), fmaxf(fabsf(d.z), fabsf(d.w)))));
#pragma unroll
    for (int o = 32; o >= 1; o >>= 1) m = fmaxf(m, shx(m, o, lane));
    m = fmaxf(m, 1e-30f);
    const float s = 127.f / m;
    u32x4 o = {pack_i8x4(a, s), pack_i8x4(b, s), pack_i8x4(c, s), pack_i8x4(d, s)};
    *(u32x4*)(p.pu8 + (size_t)r * D + lane * 16) = o;
    const unsigned u0 = pack2(a.x, a.y), u1 = pack2(a.z, a.w), u2 = pack2(b.x, b.y), u3 = pack2(b.z, b.w);
    const unsigned u4 = pack2(c.x, c.y), u5 = pack2(c.z, c.w), u6 = pack2(d.x, d.y), u7 = pack2(d.z, d.w);
    float tv[17];
#pragma unroll
    for (int mr = 0; mr < 17; ++mr) {
      const u32x4 sa = *(const u32x4*)(smem + ((mr * 2) * 64 + lane) * 16), sb = *(const u32x4*)(smem + ((mr * 2 + 1) * 64 + lane) * 16);
      const unsigned a0 = sa[0], a1 = sa[1], a2 = sa[2], a3 = sa[3], b0 = sb[0], b1 = sb[1], b2 = sb[2], b3 = sb[3];
      float t = dotbf(u0, a0, 0.f); t = dotbf(u1, a1, t); t = dotbf(u2, a2, t); t = dotbf(u3, a3, t);
      t = dotbf(u4, b0, t); t = dotbf(u5, b1, t); t = dotbf(u6, b2, t); t = dotbf(u7, b3, t);
      tv[mr] = t;
      if ((mr & 3) == 3) asm volatile("" ::: "memory");
    }
    const float t16 = wave_sum(tv[16], lane);
    float r8[8], r4[4], r2[2], r1;
    {
      const bool up = lane & 1;
#pragma unroll
      for (int k = 0; k < 8; ++k) { const float keep = up ? tv[k + 8] : tv[k], give = up ? tv[k] : tv[k + 8]; r8[k] = keep + shx(give, 1, lane); }
    }
    {
      const bool up = lane & 2;
#pragma unroll
      for (int k = 0; k < 4; ++k) { const float keep = up ? r8[k + 4] : r8[k], give = up ? r8[k] : r8[k + 4]; r4[k] = keep + shx(give, 2, lane); }
    }
    {
      const bool up = lane & 4;
#pragma unroll
      for (int k = 0; k < 2; ++k) { const float keep = up ? r4[k + 2] : r4[k], give = up ? r4[k] : r4[k + 2]; r2[k] = keep + shx(give, 4, lane); }
    }
    {
      const bool up = lane & 8;
      const float keep = up ? r2[1] : r2[0], give = up ? r2[0] : r2[1];
      r1 = keep + shx(give, 8, lane);
    }
    r1 += shx(r1, 16, lane);
    r1 += shx(r1, 32, lane);
    const int idx = 8 * (lane & 1) + 4 * ((lane >> 1) & 1) + 2 * ((lane >> 2) & 1) + ((lane >> 3) & 1);
    float* er = p.esc + (size_t)r * 64;
    const float2 ov = {lane < 16 ? r1 : t16, m * (1.f / 127.f)};
    if (lane < 17) *(float2*)(er + 2 * (lane < 16 ? idx : 16)) = ov;
  }
  __syncthreads();
}
constexpr int CQ_KS = 32;
constexpr int CQP_ITEMS = 2 * CQ_KS * 8;
DI void stage_cq_partial(const Params& p, int item, char* smem) {
  float* sc = (float*)smem;
  const int l = item / (CQ_KS * 8), r = item % (CQ_KS * 8), kc = r >> 3, nc = r & 7;
  for (int i = tid_now(); i < 17 * 32; i += 256) {
    const int rr = i >> 5, k = i & 31;
    sc[i] = p.mod[((size_t)l * 17 + rr) * 6144 + 3072 + kc * 32 + k];
  }
  const int n = nc * 256 + tid_now();
  const float* w = p.peer_w_q + ((size_t)l * D + kc * 32) * 2048 + n;
  float wv[32];
#pragma unroll
  for (int k = 0; k < 32; ++k) wv[k] = w[(size_t)k * 2048];
  __syncthreads();
  float acc[17];
#pragma unroll
  for (int i = 0; i < 17; ++i) acc[i] = 0.f;
#pragma unroll
  for (int k4 = 0; k4 < 8; ++k4)
#pragma unroll
    for (int i = 0; i < 17; ++i) {
      const float4 s = *(const float4*)(sc + i * 32 + k4 * 4);
      acc[i] += s.x * wv[4 * k4] + s.y * wv[4 * k4 + 1] + s.z * wv[4 * k4 + 2] + s.w * wv[4 * k4 + 3];
    }
#pragma unroll
  for (int i = 0; i < 17; ++i) p.cqp[(((size_t)l * CQ_KS + kc) * 17 + i) * 2048 + n] = acc[i];
  __syncthreads();
}
constexpr int CQR_ITEMS = 2 * 17 * 2048 / 256;
DI void stage_cq_reduce(const Params& p, int item) {
  const int idx = item * 256 + tid_now();
  const int l = idx / (17 * 2048), rem = idx % (17 * 2048);
  float v[CQ_KS];
#pragma unroll
  for (int kc = 0; kc < CQ_KS; ++kc) v[kc] = p.cqp[((size_t)l * CQ_KS + kc) * 17 * 2048 + rem];
  float s = 0.f;
#pragma unroll
  for (int kc = 0; kc < CQ_KS; ++kc) s += v[kc];
  p.cq[idx] = s;
}
DI void stage_rope(const Params& p) {
  for (int i = tid_now(); i < 64 * 16; i += 256) {
    int pos = i >> 4, f = i & 15;
    float inv = powf(10000.f, -(float)f / 16.f);
    float ang = (float)pos * inv;
    p.ropetab[2 * i] = cosf(ang); p.ropetab[2 * i + 1] = sinf(ang);
  }
}

constexpr int MODP_ITEMS = 2 * 8 * 24;
DI void stage_mod_partial(const Params& p, int item, char* smem) {
  float* sc = (float*)smem;
  int l = item / 192, r = item % 192, kc = r / 24, nc = r % 24;
  for (int i = tid_now(); i < 17 * 128; i += 256) {
    int rr = i >> 7, k = i & 127;
    float v = rr < 16 ? p.c[rr * D + kc * 128 + k] : p.c_ctx[kc * 128 + k];
    sc[i] = silu_f(v);
  }
  __syncthreads();
  float acc[17];
#pragma unroll
  for (int i = 0; i < 17; ++i) acc[i] = 0.f;
  const int n = nc * 256 + tid_now();
  const float* w = p.w_ada + ((size_t)l * D + kc * 128) * 6144 + n;
#pragma unroll 1
  for (int k0 = 0; k0 < 128; k0 += 32) {
    float wv[32];
#pragma unroll
    for (int k = 0; k < 32; ++k) wv[k] = w[(size_t)(k0 + k) * 6144];
#pragma unroll
    for (int k4 = 0; k4 < 8; ++k4)
#pragma unroll
      for (int i = 0; i < 17; ++i) {
        const float4 s = *(const float4*)(sc + i * 128 + k0 + k4 * 4);
        acc[i] += s.x * wv[4 * k4] + s.y * wv[4 * k4 + 1] + s.z * wv[4 * k4 + 2] + s.w * wv[4 * k4 + 3];
      }
  }
#pragma unroll
  for (int i = 0; i < 17; ++i) p.modp[(((size_t)l * 8 + kc) * 17 + i) * 6144 + n] = acc[i];
  __syncthreads();
}
constexpr int MODR_ITEMS = 2 * 17 * 6144 / 256;
DI void stage_mod_reduce(const Params& p, int item) {
  int idx = item * 256 + tid_now();
  int l = idx / (17 * 6144), rem = idx % (17 * 6144), n = rem % 6144;
  float s = p.b_ada[l * 6144 + n];
#pragma unroll
  for (int kc = 0; kc < 8; ++kc) s += p.modp[((size_t)l * 8 + kc) * 17 * 6144 + rem];
  p.mod[idx] = s;
}

DI void norm_row(const Params& p, const float* __restrict__ xr, const float* __restrict__ g, const float* __restrict__ sh,
                 const float* __restrict__ sc, bf16* __restrict__ hr, signed char* __restrict__ hq = nullptr, float* __restrict__ hsc = nullptr) {
  const int lane = tid_now() & 63;
  float4 v[4]; float ss = 0.f;
#pragma unroll
  for (int i = 0; i < 4; ++i) { v[i] = ((const float4*)xr)[lane + 64 * i]; ss += v[i].x * v[i].x + v[i].y * v[i].y + v[i].z * v[i].z + v[i].w * v[i].w; }
  ss = wave_sum(ss, lane);
  const float rstd = rsqrtf(ss * (1.f / D) + EPS);
#pragma unroll
  for (int i = 0; i < 4; ++i) {
    float4 gg = ((const float4*)g)[lane + 64 * i], s1 = ((const float4*)sh)[lane + 64 * i], s2 = ((const float4*)sc)[lane + 64 * i];
    float a = v[i].x * rstd * gg.x * (1.f + s2.x) + s1.x, b = v[i].y * rstd * gg.y * (1.f + s2.y) + s1.y;
    float c = v[i].z * rstd * gg.z * (1.f + s2.z) + s1.z, d = v[i].w * rstd * gg.w * (1.f + s2.w) + s1.w;
    u32x2 o = {pack2(a, b), pack2(c, d)};
    ((u32x2*)hr)[lane + 64 * i] = o;
    v[i].x = a; v[i].y = b; v[i].z = c; v[i].w = d;
  }
  if (hq != nullptr) {
    float m = 0.f;
#pragma unroll
    for (int i = 0; i < 4; ++i) m = fmaxf(m, fmaxf(fmaxf(fabsf(v[i].x), fabsf(v[i].y)), fmaxf(fabsf(v[i].z), fabsf(v[i].w))));
#pragma unroll
    for (int o = 32; o >= 1; o >>= 1) m = fmaxf(m, shx(m, o, lane));
    m = fmaxf(m, 1e-30f);
    const float s = 127.f / m;
#pragma unroll
    for (int i = 0; i < 4; ++i) ((unsigned*)hq)[lane + 64 * i] = pack_i8x4(v[i], s);
    if (lane == 0) *hsc = m * (1.f / 127.f);
  }
}
DI void stage_norm(const Params& p, int layer, int which, int item) {
  const int lane = tid_now() & 63;
  const int rowa = item * 8 + (tid_now() >> 6) * 2;
  const float* g = (which == 0 ? p.norm1_g : p.norm2_g) + layer * D;
  const float* mm = p.mod + ((size_t)layer * 17 + mod_row(rowa)) * 6144 + (which == 0 ? 0 : 3072);
  float4 v[2][4], gg[4], s1[4], s2[4];
#pragma unroll
  for (int j = 0; j < 2; ++j) {
    const float* xr = which == 0 ? xin_row(p, layer, rowa + j) : xres_row(p, rowa + j);
#pragma unroll
    for (int i = 0; i < 4; ++i) v[j][i] = ((const float4*)xr)[lane + 64 * i];
  }
#pragma unroll
  for (int i = 0; i < 4; ++i) { gg[i] = ((const float4*)g)[lane + 64 * i]; s1[i] = ((const float4*)mm)[lane + 64 * i]; s2[i] = ((const float4*)(mm + D))[lane + 64 * i]; }
#pragma unroll
  for (int j = 0; j < 2; ++j) {
    float ss = 0.f;
#pragma unroll
    for (int i = 0; i < 4; ++i) ss += v[j][i].x * v[j][i].x + v[j][i].y * v[j][i].y + v[j][i].z * v[j][i].z + v[j][i].w * v[j][i].w;
    ss = wave_sum(ss, lane);
    const float rstd = rsqrtf(ss * (1.f / D) + EPS);
    bf16* hr = p.H + (size_t)(rowa + j) * D;
#pragma unroll
    for (int i = 0; i < 4; ++i) {
      const float a = v[j][i].x * rstd * gg[i].x * (1.f + s2[i].x) + s1[i].x, b = v[j][i].y * rstd * gg[i].y * (1.f + s2[i].y) + s1[i].y;
      const float c = v[j][i].z * rstd * gg[i].z * (1.f + s2[i].z) + s1[i].z, d = v[j][i].w * rstd * gg[i].w * (1.f + s2[i].w) + s1[i].w;
      u32x2 o = {pack2(a, b), pack2(c, d)};
      ((u32x2*)hr)[lane + 64 * i] = o;
    }
  }
}
DI void stage_final(const Params& p, int item) {
  const int lane = tid_now() & 63;
  const int rowa = item * 8 + (tid_now() >> 6) * 2;
  float4 v[2][4], gg[4];
#pragma unroll
  for (int j = 0; j < 2; ++j) {
    const float* xr = p.out + (size_t)(rowa + j) * D;
#pragma unroll
    for (int i = 0; i < 4; ++i) v[j][i] = ((const float4*)xr)[lane + 64 * i];
  }
#pragma unroll
  for (int i = 0; i < 4; ++i) gg[i] = ((const float4*)p.final_norm_g)[lane + 64 * i];
#pragma unroll
  for (int j = 0; j < 2; ++j) {
    float ss = 0.f;
#pragma unroll
    for (int i = 0; i < 4; ++i) ss += v[j][i].x * v[j][i].x + v[j][i].y * v[j][i].y + v[j][i].z * v[j][i].z + v[j][i].w * v[j][i].w;
    ss = wave_sum(ss, lane);
    const float rstd = rsqrtf(ss * (1.f / D) + EPS);
#pragma unroll
    for (int i = 0; i < 4; ++i) {
      float4 o = {v[j][i].x * rstd * gg[i].x, v[j][i].y * rstd * gg[i].y, v[j][i].z * rstd * gg[i].z, v[j][i].w * rstd * gg[i].w};
      ((float4*)(p.out + (size_t)(rowa + j) * D))[lane + 64 * i] = o;
    }
  }
}

constexpr int LROW = 144;
constexpr int LTILE = 128 * LROW;
constexpr int GEMM_SMEM = 2 * LTILE;

template <bool ORIENT_T, bool PEEL = false>
DI void gemm_core(const bf16* __restrict__ A, const bf16* __restrict__ W, char* smem, f32x16 (&acc)[2][2]) {
  const int tid = tid_now(), lane = tid & 63, wave = tid >> 6;
  const int wm = wave >> 1, wn = wave & 1, l31 = lane & 31, hh = lane >> 5;
  const int lrow = tid >> 3, kc = tid & 7;
#pragma unroll
  for (int i = 0; i < 2; ++i)
#pragma unroll
    for (int j = 0; j < 2; ++j)
#pragma unroll
      for (int e = 0; e < 16; ++e) acc[i][j][e] = 0.f;
  u32x4 ra[4];
  bf16x8 wf[2][4];
  const bf16* ap = A + (size_t)lrow * D + kc * 8;
  const bf16* wp = W + (size_t)(wn * 2) * 64 * 512 + lane * 8;
#pragma unroll
  for (int i = 0; i < 4; ++i) ra[i] = *(const u32x4*)(ap + (size_t)(32 * i) * D);
  if (PEEL) {
#pragma unroll
    for (int s = 0; s < 4; ++s)
#pragma unroll
      for (int ft = 0; ft < 2; ++ft) wf[ft][s] = *(const bf16x8*)(wp + (size_t)(ft * 64 + s) * 512);
    __builtin_amdgcn_sched_barrier(0);
  } else {
#pragma unroll
    for (int ft = 0; ft < 2; ++ft)
#pragma unroll
      for (int s = 0; s < 4; ++s) wf[ft][s] = *(const bf16x8*)(wp + (size_t)(ft * 64 + s) * 512);
  }
  auto ktile = [&](const int kt, const bool more) {
    char* sa = smem + (kt & 1) * LTILE;
#pragma unroll
    for (int i = 0; i < 4; ++i) *(u32x4*)(sa + (lrow + 32 * i) * LROW + kc * 16) = ra[i];
    __syncthreads();
    if (more) {
#pragma unroll
      for (int i = 0; i < 4; ++i) ra[i] = *(const u32x4*)(ap + (size_t)(32 * i) * D + (kt + 1) * 64);
    }
    if (PEEL) __builtin_amdgcn_sched_barrier(0);
#pragma unroll
    for (int s = 0; s < 4; ++s) {
      bf16x8 af[2];
#pragma unroll
      for (int t = 0; t < 2; ++t) af[t] = *(const bf16x8*)(sa + (wm * 64 + t * 32 + l31) * LROW + (s * 16 + hh * 8) * 2);
#pragma unroll
      for (int ft = 0; ft < 2; ++ft)
#pragma unroll
        for (int tt = 0; tt < 2; ++tt)
          acc[ft][tt] = ORIENT_T ? MFMA(wf[ft][s], af[tt], acc[ft][tt]) : MFMA(af[tt], wf[ft][s], acc[ft][tt]);
      if (more) {
#pragma unroll
        for (int ft = 0; ft < 2; ++ft) wf[ft][s] = *(const bf16x8*)(wp + (size_t)(ft * 64 + (kt + 1) * 4 + s) * 512);
      }
      if (PEEL) __builtin_amdgcn_sched_barrier(0);
    }
    };
  if (PEEL) {
#pragma unroll 1
    for (int kt = 0; kt < 15; ++kt) ktile(kt, true);
    ktile(15, false);
  } else {
#pragma unroll 1
    for (int kt = 0; kt < 16; ++kt) ktile(kt, kt + 1 < 16);
  }
  __syncthreads();
}

constexpr int INPROJ_ITEMS = 288 * 18;
DI void store4(bf16* dst, float a, float b, float c, float d) { u32x2 o = {pack2(a, b), pack2(c, d)}; *(u32x2*)dst = o; }
DI void store_pair(bf16* rowbase, int hh, float a0, float a1, float a2, float a3, float b0, float b1, float b2, float b3) {
  unsigned ax = pack2(a0, a1), ay = pack2(a2, a3), bx = pack2(b0, b1), by = pack2(b2, b3);
  const auto r0 = __builtin_amdgcn_permlane32_swap(ax, bx, false, false); ax = r0[0]; bx = r0[1];
  const auto r1 = __builtin_amdgcn_permlane32_swap(ay, by, false, false); ay = r1[0]; by = r1[1];
  u32x4 o = {ax, ay, bx, by};
  *(u32x4*)(rowbase + hh * 8) = o;
}

DI void stage_inproj(const Params& p, int layer, int item, char* smem) {
  const int mt = item / 18, nt = item % 18;
  if (layer == 1 && mt >= 256 && nt < 10) return;
  const int row0 = mt * 128, n0 = nt * 128;
  const bf16* A = p.H + (size_t)row0 * D;
  const bf16* W = p.win + ((size_t)layer * INC + n0) * D;
  const int lane = tid_now() & 63, wave = tid_now() >> 6, wm = wave >> 1, wn = wave & 1, l31 = lane & 31, hh = lane >> 5;
  const bool vtile = (nt >= 13 && nt <= 15) || nt == 17;
  f32x16 acc[2][2];
  const int b = batch_of(row0);
  if (vtile) {
    gemm_core<false, true>(A, W, smem, acc);
    bf16* base; int head;
    if (nt == 17) { head = wn; base = p.VGt + ((size_t)(b * 2 + head) * 64) * SEQ2; }
    else { head = (nt - 13) * 2 + wn; base = p.VNt + ((size_t)(b * 6 + head) * 64) * SEQ2; }
    const int pos0 = pos_of(row0) + wm * 64;
#pragma unroll
    for (int ft = 0; ft < 2; ++ft) {
      const int d = ft * 32 + l31;
#pragma unroll
      for (int tt = 0; tt < 2; ++tt)
#pragma unroll
        for (int g = 0; g < 4; g += 2)
          store_pair(base + (size_t)d * SEQ2 + pos0 + tt * 32 + 8 * g, hh, acc[ft][tt][4 * g], acc[ft][tt][4 * g + 1], acc[ft][tt][4 * g + 2], acc[ft][tt][4 * g + 3],
                     acc[ft][tt][4 * g + 4], acc[ft][tt][4 * g + 5], acc[ft][tt][4 * g + 6], acc[ft][tt][4 * g + 7]);
    }
    return;
  }
  gemm_core<true, true>(A, W, smem, acc);
  const int chunk = nt * 2 + wn;
#pragma unroll
  for (int tt = 0; tt < 2; ++tt) {
    const int row = row0 + wm * 64 + tt * 32 + l31;
    const int pos = pos_of(row);
    const bool isctx = row >= NTOK;
    if (chunk < 8) {
      bf16* dst = p.U + (size_t)row * 256 + 32 * chunk;
#pragma unroll
      for (int g = 0; g < 4; g += 2) {
        float u[8];
#pragma unroll
        for (int j = 0; j < 8; ++j) u[j] = acc[0][tt][4 * g + j] * sigmoid_f(acc[1][tt][4 * g + j]);
        store_pair(dst + 8 * g, hh, u[0], u[1], u[2], u[3], u[4], u[5], u[6], u[7]);
      }
    } else if (chunk < 14 || (chunk >= 20 && chunk < 26)) {
      const bool isq = chunk < 14;
      const int head = isq ? chunk - 8 : chunk - 20;
      const float sc = isq ? 0.125f : 1.f;
      bf16* dst = (isq ? p.QN : p.KN) + ((size_t)(b * 6 + head) * SEQ2 + pos) * 64;
#pragma unroll
      for (int ft = 0; ft < 2; ++ft)
#pragma unroll
        for (int g = 0; g < 4; g += 2)
          store_pair(dst + ft * 32 + 8 * g, hh, acc[ft][tt][4 * g] * sc, acc[ft][tt][4 * g + 1] * sc, acc[ft][tt][4 * g + 2] * sc, acc[ft][tt][4 * g + 3] * sc,
                     acc[ft][tt][4 * g + 4] * sc, acc[ft][tt][4 * g + 5] * sc, acc[ft][tt][4 * g + 6] * sc, acc[ft][tt][4 * g + 7] * sc);
    } else {
      const bool isq = chunk < 20;
      const int head = isq ? chunk - 14 : chunk - 32;
      const float* gn = (isq ? p.gqa_q_norm : p.gqa_k_norm) + layer * 64;
      float ss = 0.f;
#pragma unroll
      for (int ft = 0; ft < 2; ++ft)
#pragma unroll
        for (int e = 0; e < 16; ++e) ss += acc[ft][tt][e] * acc[ft][tt][e];
      ss += shx(ss, 32, lane);
      const float rstd = rsqrtf(ss * (1.f / 64.f) + EPS) ;
      const float sc = isq ? 0.125f : 1.f;
      bf16* dst = (isq ? p.QG + ((size_t)(b * 6 + head) * SEQ2 + pos) * 64 : p.KG + ((size_t)(b * 2 + head) * SEQ2 + pos) * 64);
      const int prow = pos >> 6, pcol = pos & 63;
#pragma unroll
      for (int g = 0; g < 4; g += 2) {
        float o1[8], o2[8];
#pragma unroll
        for (int j = 0; j < 8; ++j) {
          const int gg = g + (j >> 2);
          const int i = 8 * gg + 4 * hh + (j & 3);
          float x1 = acc[0][tt][4 * g + j] * rstd * gn[i];
          float x2 = acc[1][tt][4 * g + j] * rstd * gn[32 + i];
          if (!isctx && PROBE != 13) {
            const int ppos = (gg < 2) ? prow : pcol;
            const float2 cs = *(const float2*)(p.ropetab + 2 * (ppos * 16 + (i & 15)));
            float y1 = x1 * cs.x - x2 * cs.y, y2 = x1 * cs.y + x2 * cs.x;
            x1 = y1; x2 = y2;
          }
          o1[j] = x1 * sc; o2[j] = x2 * sc;
        }
        store_pair(dst + 8 * g, hh, o1[0], o1[1], o1[2], o1[3], o1[4], o1[5], o1[6], o1[7]);
        store_pair(dst + 32 + 8 * g, hh, o2[0], o2[1], o2[2], o2[3], o2[4], o2[5], o2[6], o2[7]);
      }
    }
  }
}

constexpr int CONV_TT = 16;
constexpr int CONV_SMEM = (CONV_TT + 30) * 512 + CONV_TT * 1024;
DI void stage_conv(const Params& p, int layer, int item, char* smem) {
  bf16* ub = (bf16*)smem;
  float* yb = (float*)(smem + (CONV_TT + 30) * 512);
  const int tid = tid_now();
  int row0, seq_lo, seq_hi;
  constexpr int NLAT = NTOK / CONV_TT;
  if (item < NLAT) { row0 = item * CONV_TT; seq_lo = row0 & ~2047; seq_hi = seq_lo + 2048; }
  else { row0 = NTOK + (item - NLAT) * CONV_TT; seq_lo = NTOK + (((item - NLAT) * CONV_TT) & ~255); seq_hi = seq_lo + 256; }
  for (int c = tid; c < (CONV_TT + 30) * 32; c += 256) {
    int r = c >> 5, cc = c & 31;
    int row = row0 - 15 + r;
    u32x4 v = {0u, 0u, 0u, 0u};
    if (row >= seq_lo && row < seq_hi) v = *(const u32x4*)(p.U + (size_t)row * 256 + cc * 8);
    *(u32x4*)(ub + r * 256 + cc * 8) = v;
  }
  __syncthreads();
  {
    const int ch = tid;
    float w[31];
#pragma unroll
    for (int j = 0; j < 31; ++j) w[j] = p.conv_w[((size_t)layer * 31 + j) * 256 + ch];
    const float bias = p.conv_b[layer * 256 + ch];
#pragma unroll 1
    for (int t0 = 0; t0 < CONV_TT; t0 += 8) {
      float in[38];
#pragma unroll
      for (int j = 0; j < 38; ++j) in[j] = __uint_as_float((unsigned)ub[(t0 + j) * 256 + ch] << 16);
#pragma unroll
      for (int t = 0; t < 8; ++t) {
        float a = bias;
#pragma unroll
        for (int j = 0; j < 31; ++j) a += in[t + j] * w[j];
        yb[(t0 + t) * 256 + ch] = a;
      }
    }
  }
  __syncthreads();
  {
    const int wave = tid >> 6, lane = tid & 63;
    const float4 g = ((const float4*)(p.conv_ln_g + layer * 256))[lane], bb = ((const float4*)(p.conv_ln_b + layer * 256))[lane];
    for (int t = wave * (CONV_TT / 4); t < (wave + 1) * (CONV_TT / 4); ++t) {
      float4 v = ((const float4*)(yb + t * 256))[lane];
      float mu = wave_sum(v.x + v.y + v.z + v.w, lane) * (1.f / 256.f);
      float dx = v.x - mu, dy = v.y - mu, dz = v.z - mu, dw = v.w - mu;
      float var = wave_sum(dx * dx + dy * dy + dz * dz + dw * dw, lane) * (1.f / 256.f);
      float rs = rsqrtf(var + EPS);
      float a = silu_f(dx * rs * g.x + bb.x), b = silu_f(dy * rs * g.y + bb.y), c = silu_f(dz * rs * g.z + bb.z), d = silu_f(dw * rs * g.w + bb.w);
      store4(p.CAT + (size_t)(row0 + t) * D + lane * 4, a, b, c, d);
    }
  }
  __syncthreads();
}

DI int kperm(int i) { return (i & 19) | ((i & 4) << 1) | ((i & 8) >> 1); }
DI int keyoff(int e, int h) { return (e & 3) + 4 * ((e >> 2) & 1) + 8 * h + 16 * (e >> 3); }
DI bf16x8 pack8(const f32x16& x, int s) {
  u32x4 r = {pack2(x[8 * s], x[8 * s + 1]), pack2(x[8 * s + 2], x[8 * s + 3]), pack2(x[8 * s + 4], x[8 * s + 5]), pack2(x[8 * s + 6], x[8 * s + 7])};
  return __builtin_bit_cast(bf16x8, r);
}

constexpr int NA_ITEMS = 6144 / 4;
DI void stage_na(const Params& p, int layer, int item) {
  const int lane = tid_now() & 63, wave = tid_now() >> 6, l31 = lane & 31, hh = lane >> 5;
  const int wi = item * 4 + wave;
  const int qhalf = wi & 1, head = (wi >> 1) % 6, br = wi / 12, r = br & 31, b = br >> 5;
  const int r0 = min(max(r - 4, 0), 24);
  const size_t hb = (size_t)(b * 6 + head);
  const bf16* Q = p.QN + (hb * SEQ2 + r * 64 + qhalf * 32 + l31) * 64;
  const bf16* Kb = p.KN + hb * SEQ2 * 64;
  const bf16* Vb = p.VNt + hb * 64 * SEQ2;
  const float* bias = p.na_rel_bias + ((size_t)layer * 6 + head) * 15 * 31;
  bf16x8 qf[4];
#pragma unroll
  for (int s = 0; s < 4; ++s) qf[s] = *(const bf16x8*)(Q + 16 * s + 8 * hh);
  f32x16 o[2];
#pragma unroll
  for (int e = 0; e < 16; ++e) { o[0][e] = 0.f; o[1][e] = 0.f; }
  float m = -1e30f, l = 0.f;
  const int qc = qhalf * 32 + l31;
  const int c0 = min(max(qc - 8, 0), 48);
  const int kp = kperm(l31);
#pragma unroll 1
  for (int t = 0; t < 24; ++t) {
    int key0, brow = 0, cs = 0;
    const bool local = t >= 8;
    if (!local) key0 = T + t * 32;
    else { brow = (t - 8) >> 1; cs = (t - 8) & 1; key0 = (r0 + brow) * 64 + cs * 32; }
    f32x16 st;
#pragma unroll
    for (int e = 0; e < 16; ++e) st[e] = 0.f;
    const bf16* kr = Kb + (size_t)(key0 + kp) * 64 + 8 * hh;
#pragma unroll
    for (int s = 0; s < 4; ++s) { bf16x8 kf = *(const bf16x8*)(kr + 16 * s); st = MFMA(kf, qf[s], st); }
    if (local) {
      const int rb = (r0 + brow) - r + 7;
#pragma unroll
      for (int e = 0; e < 16; ++e) {
        const int kc = cs * 32 + keyoff(e, hh);
        const bool valid = (kc >= c0) && (kc < c0 + 16);
        const int ci = min(max(kc - qc + 15, 0), 30);
        const float bv = (PROBE == 12) ? 0.f : bias[rb * 31 + ci];
        st[e] = valid ? st[e] + bv : -1e30f;
      }
    }
    float mx = st[0];
#pragma unroll
    for (int e = 1; e < 16; ++e) mx = fmaxf(mx, st[e]);
    mx = fmaxf(mx, shx(mx, 32, lane));
    const float mn = fmaxf(m, mx);
    const float alpha = exp2f((m - mn) * L2E);
    float ls = 0.f;
#pragma unroll
    for (int e = 0; e < 16; ++e) { st[e] = exp2f((st[e] - mn) * L2E); ls += st[e]; }
    l = l * alpha + ls; m = mn;
#pragma unroll
    for (int e = 0; e < 16; ++e) { o[0][e] *= alpha; o[1][e] *= alpha; }
    bf16x8 pf0 = pack8(st, 0), pf1 = pack8(st, 1);
#pragma unroll
    for (int dt = 0; dt < 2; ++dt) {
      const bf16* vr = Vb + (size_t)(dt * 32 + l31) * SEQ2 + key0 + 8 * hh;
      bf16x8 v0 = *(const bf16x8*)(vr), v1 = *(const bf16x8*)(vr + 16);
      o[dt] = MFMA(v0, pf0, o[dt]);
      o[dt] = MFMA(v1, pf1, o[dt]);
    }
  }
  l += shx(l, 32, lane);
  const float inv = (PROBE == 10) ? 0.f : 1.f / l;
  bf16* dst = p.CAT + (size_t)(b * T + r * 64 + qc) * D + 256 + head * 64;
#pragma unroll
  for (int dt = 0; dt < 2; ++dt)
#pragma unroll
    for (int g = 0; g < 4; g += 2)
      store_pair(dst + dt * 32 + 8 * g, hh, o[dt][4 * g] * inv, o[dt][4 * g + 1] * inv, o[dt][4 * g + 2] * inv, o[dt][4 * g + 3] * inv,
                 o[dt][4 * g + 4] * inv, o[dt][4 * g + 5] * inv, o[dt][4 * g + 6] * inv, o[dt][4 * g + 7] * inv);
}

constexpr int NA2_ITEMS = 16 * 6 * 16;
DI void stage_na2(const Params& p, int layer, int item, char* smem) {
  const int tid = tid_now(), lane = tid & 63, wave = tid >> 6, l31 = lane & 31, hh = lane >> 5;
  const int lrow = tid >> 3, kc8 = tid & 7;
  const int rp = item & 15, head = (item >> 4) % 6, b = item / 96;
  const int qrow = 2 * rp + ((lane >> 4) & 1), qc = wave * 16 + (lane & 15);
  const int r0w = min(max(qrow - 4, 0), 24);
  const int rlo = min(max(2 * rp - 4, 0), 24), rhi = min(max(2 * rp - 3, 0), 24) + 7;
  const int ntile = 4 + (rhi - rlo + 1);
  const size_t hb = (size_t)(b * 6 + head);
  const bf16* K = p.KN + hb * SEQ2 * 64;
  const bf16* Vt = p.VNt + hb * 64 * SEQ2;
  float* bl = (float*)(smem + 2 * 2 * 64 * LROW);
  for (int i = tid; i < 15 * 31; i += 256) bl[i] = p.na_rel_bias[((size_t)layer * 6 + head) * 465 + i];
  bf16x8 qf[4];
  const bf16* qp = p.QN + (hb * SEQ2 + qrow * 64 + qc) * 64 + 8 * hh;
#pragma unroll
  for (int s = 0; s < 4; ++s) qf[s] = *(const bf16x8*)(qp + 16 * s);
  f32x16 o[2];
#pragma unroll
  for (int e = 0; e < 16; ++e) { o[0][e] = 0.f; o[1][e] = 0.f; }
  float m = -1e30f, l = 0.f;
  const int kp = kperm(l31);
  const int c0 = min(max(qc - 8, 0), 48);
  const int kb = min(max(wave * 16 - 8, 0), 32);
  u32x4 rk[2], rv[2];
  auto key0_of = [&](int t) { return t < 4 ? T + 64 * t : (rlo + t - 4) * 64; };
  {
    const int k0 = key0_of(0);
#pragma unroll
    for (int i = 0; i < 2; ++i) {
      rk[i] = *(const u32x4*)(K + (size_t)(k0 + lrow + 32 * i) * 64 + kc8 * 8);
      rv[i] = *(const u32x4*)(Vt + (size_t)(lrow + 32 * i) * SEQ2 + k0 + kc8 * 8);
    }
  }
#pragma unroll 1
  for (int t = 0; t < ntile; ++t) {
    char* sk = smem + (t & 1) * 2 * 64 * LROW;
    char* sv = sk + 64 * LROW;
#pragma unroll
    for (int i = 0; i < 2; ++i) {
      *(u32x4*)(sk + (lrow + 32 * i) * LROW + kc8 * 16) = rk[i];
      *(u32x4*)(sv + (lrow + 32 * i) * LROW + kc8 * 16) = rv[i];
    }
    __syncthreads();
    if (t + 1 < ntile) {
      const int k0 = key0_of(t + 1);
#pragma unroll
      for (int i = 0; i < 2; ++i) {
        rk[i] = *(const u32x4*)(K + (size_t)(k0 + lrow + 32 * i) * 64 + kc8 * 8);
        rv[i] = *(const u32x4*)(Vt + (size_t)(lrow + 32 * i) * SEQ2 + k0 + kc8 * 8);
      }
    }
    const int R = rlo + t - 4;
    const bool local = t >= 4;
    const int nsub = local ? 1 : 2;
#pragma unroll 1
    for (int si = 0; si < nsub; ++si) {
      const int kbase = local ? kb : 32 * si;
      const bool loc = local;
      f32x16 st;
      bf16x8 lf[4];
      __builtin_amdgcn_sched_barrier(0);
#pragma unroll
      for (int s = 0; s < 4; ++s) lf[s] = *(const bf16x8*)(sk + (kbase + kp) * LROW + (16 * s + 8 * hh) * 2);
      __builtin_amdgcn_sched_barrier(0);
#pragma unroll
      for (int e = 0; e < 16; ++e) st[e] = 0.f;
#pragma unroll
      for (int s = 0; s < 4; ++s) st = MFMA(lf[s], qf[s], st);
      __builtin_amdgcn_sched_barrier(0);
#pragma unroll
      for (int s2 = 0; s2 < 2; ++s2)
#pragma unroll
        for (int dt = 0; dt < 2; ++dt) lf[s2 * 2 + dt] = *(const bf16x8*)(sv + (dt * 32 + l31) * LROW + (kbase + 16 * s2 + 8 * hh) * 2);
      __builtin_amdgcn_sched_barrier(0);
      if (loc) {
        const int c0e = ((unsigned)(R - r0w) < 8u) ? c0 : 4096;
        const float* brow = bl + (R - qrow + 7) * 31 + (15 - qc);
#pragma unroll
        for (int e = 0; e < 16; ++e) {
          const int kc = kbase + keyoff(e, hh);
          const bool valid = (unsigned)(kc - c0e) < 16u;
          const float bv = brow[kc];
          st[e] = valid ? st[e] + bv : -1e30f;
        }
      }
      float mx = st[0];
#pragma unroll
      for (int e = 1; e < 16; ++e) mx = fmaxf(mx, st[e]);
      mx = fmaxf(mx, shx(mx, 32, lane));
      const float mn = fmaxf(m, mx);
      const float mnl = mn * L2E;
      const float alpha = fexp2(m * L2E - mnl);
      f2_t ls2 = {0.f, 0.f};
#pragma unroll
      for (int e = 0; e < 16; e += 2) {
        const float p0 = fexp2(st[e] * L2E - mnl), p1 = fexp2(st[e + 1] * L2E - mnl);
        st[e] = p0; st[e + 1] = p1;
        const f2_t pp = {p0, p1};
        ls2 += pp;
      }
      l = l * alpha + (ls2[0] + ls2[1]); m = mn;
      const f2_t al2 = {alpha, alpha};
#pragma unroll
      for (int e = 0; e < 16; e += 2) {
        f2_t a0 = {o[0][e], o[0][e + 1]}, a1 = {o[1][e], o[1][e + 1]};
        a0 *= al2; a1 *= al2;
        o[0][e] = a0[0]; o[0][e + 1] = a0[1]; o[1][e] = a1[0]; o[1][e + 1] = a1[1];
      }
#pragma unroll
      for (int s2 = 0; s2 < 2; ++s2) {
        bf16x8 pf = pack8(st, s2);
#pragma unroll
        for (int dt = 0; dt < 2; ++dt) o[dt] = MFMA(lf[s2 * 2 + dt], pf, o[dt]);
      }
    }
  }
  l += shx(l, 32, lane);
  const float inv = 1.f / l;
  bf16* dst = p.CAT + (size_t)(b * T + qrow * 64 + qc) * D + 256 + head * 64;
#pragma unroll
  for (int dt = 0; dt < 2; ++dt)
#pragma unroll
    for (int g = 0; g < 4; g += 2)
      store_pair(dst + dt * 32 + 8 * g, hh, o[dt][4 * g] * inv, o[dt][4 * g + 1] * inv, o[dt][4 * g + 2] * inv, o[dt][4 * g + 3] * inv,
                 o[dt][4 * g + 4] * inv, o[dt][4 * g + 5] * inv, o[dt][4 * g + 6] * inv, o[dt][4 * g + 7] * inv);
  __syncthreads();
}

template <int MODE>
DI void flash_block(const bf16* __restrict__ Q, const bf16* __restrict__ K, const bf16* __restrict__ Vt, int q0, int kt0, int kt1,
                    bf16* __restrict__ dst  , char* smem, float smax = 0.f) {
  const int tid = tid_now(), lane = tid & 63, wave = tid >> 6, l31 = lane & 31, hh = lane >> 5;
  const int lrow = tid >> 3, kc = tid & 7;
  bf16x8 qf[4];
  const bf16* qp = Q + (size_t)(q0 + wave * 32 + l31) * 64 + 8 * hh;
#pragma unroll
  for (int s = 0; s < 4; ++s) qf[s] = *(const bf16x8*)(qp + 16 * s);
  constexpr bool BOUNDED = MODE != 0;
  if (MODE == 2) {
#pragma unroll
    for (int s = 0; s < 4; ++s) {
      u32x4 w = __builtin_bit_cast(u32x4, qf[s]);
      const unsigned w0 = w[0], w1 = w[1], w2 = w[2], w3 = w[3];
      u32x4 o = {pack2(bf_lo(w0) * L2E, bf_hi(w0) * L2E), pack2(bf_lo(w1) * L2E, bf_hi(w1) * L2E),
                 pack2(bf_lo(w2) * L2E, bf_hi(w2) * L2E), pack2(bf_lo(w3) * L2E, bf_hi(w3) * L2E)};
      qf[s] = __builtin_bit_cast(bf16x8, o);
    }
  }
  f32x16 o[2];
#pragma unroll
  for (int e = 0; e < 16; ++e) { o[0][e] = 0.f; o[1][e] = 0.f; }
  float m = -1e30f, l = 0.f;
  f2_t l2 = {0.f, 0.f};
  const int kp = kperm(l31);
  u32x4 rk[2], rv[2];
#pragma unroll
  for (int i = 0; i < 2; ++i) {
    rk[i] = *(const u32x4*)(K + (size_t)(kt0 * 64 + lrow + 32 * i) * 64 + kc * 8);
    rv[i] = *(const u32x4*)(Vt + (size_t)(lrow + 32 * i) * SEQ2 + kt0 * 64 + kc * 8);
  }
#pragma unroll 1
  for (int kt = kt0; kt < kt1; ++kt) {
    char* sk = smem + ((kt - kt0) & 1) * 2 * 64 * LROW;
    char* sv = sk + 64 * LROW;
#pragma unroll
    for (int i = 0; i < 2; ++i) {
      *(u32x4*)(sk + (lrow + 32 * i) * LROW + kc * 16) = rk[i];
      *(u32x4*)(sv + (lrow + 32 * i) * LROW + kc * 16) = rv[i];
    }
    __syncthreads();
    if (kt + 1 < kt1) {
#pragma unroll
      for (int i = 0; i < 2; ++i) {
        rk[i] = *(const u32x4*)(K + (size_t)((kt + 1) * 64 + lrow + 32 * i) * 64 + kc * 8);
        rv[i] = *(const u32x4*)(Vt + (size_t)(lrow + 32 * i) * SEQ2 + (kt + 1) * 64 + kc * 8);
      }
    }
    f32x16 st[2];
    bf16x8 lf[8];
    __builtin_amdgcn_sched_barrier(0);
#pragma unroll
    for (int k2 = 0; k2 < 2; ++k2)
#pragma unroll
      for (int s = 0; s < 4; ++s) lf[k2 * 4 + s] = *(const bf16x8*)(sk + (k2 * 32 + kp) * LROW + (16 * s + 8 * hh) * 2);
    __builtin_amdgcn_sched_barrier(0);
#pragma unroll
    for (int k2 = 0; k2 < 2; ++k2) {
#pragma unroll
      for (int e = 0; e < 16; ++e) st[k2][e] = 0.f;
#pragma unroll
      for (int s = 0; s < 4; ++s) st[k2] = MFMA(lf[k2 * 4 + s], qf[s], st[k2]);
    }
    __builtin_amdgcn_sched_barrier(0);
#pragma unroll
    for (int k2 = 0; k2 < 2; ++k2)
#pragma unroll
      for (int s2 = 0; s2 < 2; ++s2)
#pragma unroll
        for (int dt = 0; dt < 2; ++dt)
          lf[(k2 * 2 + s2) * 2 + dt] = *(const bf16x8*)(sv + (dt * 32 + l31) * LROW + (k2 * 32 + 16 * s2 + 8 * hh) * 2);
    __builtin_amdgcn_sched_barrier(0);
    if (BOUNDED) {
      const float mnl = smax * L2E;
#pragma unroll
      for (int k2 = 0; k2 < 2; ++k2)
#pragma unroll
        for (int e = 0; e < 16; e += 2) {
          const float p0 = MODE == 2 ? fexp2(st[k2][e]) : fexp2(st[k2][e] * L2E - mnl), p1 = MODE == 2 ? fexp2(st[k2][e + 1]) : fexp2(st[k2][e + 1] * L2E - mnl);
          st[k2][e] = p0; st[k2][e + 1] = p1;
          const f2_t pp = {p0, p1};
          l2 += pp;
        }
    } else {
      float mx = st[0][0];
  #pragma unroll
      for (int e = 1; e < 16; ++e) mx = fmaxf(mx, st[0][e]);
  #pragma unroll
      for (int e = 0; e < 16; ++e) mx = fmaxf(mx, st[1][e]);
      mx = fmaxf(mx, shx(mx, 32, lane));
      const float mn = fmaxf(m, mx);
      const float mnl = mn * L2E;
      const float alpha = fexp2(m * L2E - mnl);
      float ls = 0.f;
  #pragma unroll
      for (int k2 = 0; k2 < 2; ++k2)
  #pragma unroll
        for (int e = 0; e < 16; ++e) { st[k2][e] = fexp2(st[k2][e] * L2E - mnl); ls += st[k2][e]; }
      l = l * alpha + ls; m = mn;
  #pragma unroll
      for (int e = 0; e < 16; ++e) { o[0][e] *= alpha; o[1][e] *= alpha; }
    }
#pragma unroll
    for (int k2 = 0; k2 < 2; ++k2)
#pragma unroll
      for (int s2 = 0; s2 < 2; ++s2) {
        bf16x8 pf = pack8(st[k2], s2);
#pragma unroll
        for (int dt = 0; dt < 2; ++dt) o[dt] = MFMA(lf[(k2 * 2 + s2) * 2 + dt], pf, o[dt]);
      }
  }
  l += l2[0] + l2[1];
  l += shx(l, 32, lane);
  const float inv = (PROBE == 11) ? 0.f : 1.f / l;
  bf16* d2 = dst + (size_t)(wave * 32 + l31) * D;
#pragma unroll
  for (int dt = 0; dt < 2; ++dt)
#pragma unroll
    for (int g = 0; g < 4; g += 2)
      store_pair(d2 + dt * 32 + 8 * g, hh, o[dt][4 * g] * inv, o[dt][4 * g + 1] * inv, o[dt][4 * g + 2] * inv, o[dt][4 * g + 3] * inv,
                 o[dt][4 * g + 4] * inv, o[dt][4 * g + 5] * inv, o[dt][4 * g + 6] * inv, o[dt][4 * g + 7] * inv);
  __syncthreads();
}
constexpr int GQA_ITEMS = 16 * 6 * 16;
DI float gqa_score_bound(const Params& p, int layer) {
  const int lane = tid_now() & 63;
  float a = fabsf(p.gqa_q_norm[layer * 64 + lane]), b = fabsf(p.gqa_k_norm[layer * 64 + lane]);
#pragma unroll
  for (int o = 32; o >= 1; o >>= 1) { a = fmaxf(a, shx(a, o, lane)); b = fmaxf(b, shx(b, o, lane)); }
  return 8.f * a * b * 1.0001f + 1e-3f;
}
DI void stage_gqa(const Params& p, int layer, int item, char* smem) {
  const int qt = item & 15, hq = (item >> 4) % 6, b = item / 96;
  const int kvh = hq / 3;
  const float bound = __int_as_float(__builtin_amdgcn_readfirstlane(__float_as_int(gqa_score_bound(p, layer))));
  const bf16* Q = p.QG + (size_t)(b * 6 + hq) * SEQ2 * 64; const bf16* K = p.KG + (size_t)(b * 2 + kvh) * SEQ2 * 64; const bf16* Vt = p.VGt + (size_t)(b * 2 + kvh) * 64 * SEQ2;
  bf16* dst = p.CAT + (size_t)(b * T + qt * 128) * D + 640 + hq * 64;
  if (bound * L2E < 100.f) flash_block<2>(Q, K, Vt, qt * 128, 0, 36, dst, smem, bound);
  else flash_block<1>(Q, K, Vt, qt * 128, 0, 36, dst, smem, bound);
}
constexpr int CTXATT_ITEMS = 384;
DI void stage_ctxatt(const Params& p, int item, char* smem) {
  const int qt = item & 1, head = (item >> 1) % 6, which = (item / 12) & 1, b = item / 24;
  bf16* dst = p.CAT + (size_t)(NTOK + b * CL + qt * 128) * D + (which == 0 ? 256 : 640) + head * 64;
  const int kvh = which == 0 ? b * 6 + head : b * 2 + head / 3;
  const bf16* Q = (which == 0 ? p.QN : p.QG) + (size_t)(b * 6 + head) * SEQ2 * 64;
  const bf16* K = (which == 0 ? p.KN : p.KG) + (size_t)kvh * SEQ2 * 64;
  const bf16* Vt = (which == 0 ? p.VNt : p.VGt) + (size_t)kvh * 64 * SEQ2;
  flash_block<0>(Q, K, Vt, T + qt * 128, 32, 36, dst, smem);
}

constexpr int OUTPROJ_ITEMS = 288 * 8;
DI void stage_outproj(const Params& p, int layer, int item, char* smem) {
  const int mt = item >> 3, nt = item & 7;
  if (layer == 1 && mt >= 256) return;
  const int row0 = mt * 128, n0 = nt * 128;
  f32x16 acc[2][2];
  gemm_core<true, true>(p.CAT + (size_t)row0 * D, p.wout + ((size_t)layer * D + n0) * D, smem, acc);
  const int lane = tid_now() & 63, wave = tid_now() >> 6, wm = wave >> 1, wn = wave & 1, l31 = lane & 31, hh = lane >> 5;
  const float* mrow = p.mod + ((size_t)layer * 17 + mod_row(row0)) * 6144;
  const float* g1 = mrow + 2048;
  const float* sc2 = mrow + 4096;
  const float* n2g = p.norm2_g + layer * D;
  float* amx = (float*)(smem + GEMM_SMEM);
  float amv[2];
#pragma unroll
  for (int tt = 0; tt < 2; ++tt) {
    const int row = row0 + wm * 64 + tt * 32 + l31;
    const float* xr = xin_row(p, layer, row);
    float* dr = xres_row(p, row);
    float ss = 0.f, am = 0.f;
#pragma unroll
    for (int ft = 0; ft < 2; ++ft)
#pragma unroll
      for (int gp = 0; gp < 4; gp += 2) {
        float4 xv[2], gv[2], gg[2], sv[2];
#pragma unroll
        for (int g = 0; g < 2; ++g) {
          const int n = n0 + wn * 64 + ft * 32 + 8 * (gp + g) + 4 * hh;
          xv[g] = *(const float4*)(xr + n); gv[g] = *(const float4*)(g1 + n);
          gg[g] = *(const float4*)(n2g + n); sv[g] = *(const float4*)(sc2 + n);
          if (PROBE == 2) { gv[g].x = gv[g].y = gv[g].z = gv[g].w = 0.f; }
        }
#pragma unroll
        for (int g = 0; g < 2; ++g) {
          const int n = n0 + wn * 64 + ft * 32 + 8 * (gp + g) + 4 * hh, e = 4 * (gp + g);
          float4 o = {xv[g].x + gv[g].x * acc[ft][tt][e], xv[g].y + gv[g].y * acc[ft][tt][e + 1],
                      xv[g].z + gv[g].z * acc[ft][tt][e + 2], xv[g].w + gv[g].w * acc[ft][tt][e + 3]};
          *(float4*)(dr + n) = o;
          ss += o.x * o.x + o.y * o.y + o.z * o.z + o.w * o.w;
          o.x *= gg[g].x * (1.f + sv[g].x); o.y *= gg[g].y * (1.f + sv[g].y); o.z *= gg[g].z * (1.f + sv[g].z); o.w *= gg[g].w * (1.f + sv[g].w);
          acc[ft][tt][e] = o.x; acc[ft][tt][e + 1] = o.y; acc[ft][tt][e + 2] = o.z; acc[ft][tt][e + 3] = o.w;
          am = fmaxf(am, fmaxf(fmaxf(fabsf(o.x), fabsf(o.y)), fmaxf(fabsf(o.z), fabsf(o.w))));
        }
      }
    ss += shx(ss, 32, lane);
    am = fmaxf(am, shx(am, 32, lane));
    if (hh == 0) { p.ssq16[(size_t)(nt * 2 + wn) * MTOT + row] = ss; amx[((wm * 2 + tt) * 32 + l31) * 2 + wn] = am; }
    amv[tt] = am;
    asm volatile("" ::: "memory");
  }
  __syncthreads();
#pragma unroll
  for (int tt = 0; tt < 2; ++tt) {
    const int row = row0 + wm * 64 + tt * 32 + l31;
    const float am = fmaxf(fmaxf(amv[tt], amx[((wm * 2 + tt) * 32 + l31) * 2 + (wn ^ 1)]), 1e-30f);
    const float qs = 127.f / am;
    if (hh == 0 && wn == 0) p.hs8[(size_t)nt * MTOT + row] = am * (1.f / 127.f);
    bf16* hrow = p.H2 + (size_t)row * D + n0 + wn * 64;
    signed char* qrow = p.hq + (size_t)row * D + n0 + wn * 64;
#pragma unroll
    for (int ft = 0; ft < 2; ++ft)
#pragma unroll
      for (int g = 0; g < 4; g += 2) {
        store_pair(hrow + ft * 32 + 8 * g, hh, acc[ft][tt][4 * g], acc[ft][tt][4 * g + 1], acc[ft][tt][4 * g + 2], acc[ft][tt][4 * g + 3],
                   acc[ft][tt][4 * g + 4], acc[ft][tt][4 * g + 5], acc[ft][tt][4 * g + 6], acc[ft][tt][4 * g + 7]);
        float4 va = {acc[ft][tt][4 * g], acc[ft][tt][4 * g + 1], acc[ft][tt][4 * g + 2], acc[ft][tt][4 * g + 3]};
        float4 vb = {acc[ft][tt][4 * g + 4], acc[ft][tt][4 * g + 5], acc[ft][tt][4 * g + 6], acc[ft][tt][4 * g + 7]};
        unsigned qa = pack_i8x4(va, qs), qb = pack_i8x4(vb, qs);
        const auto rq = __builtin_amdgcn_permlane32_swap(qa, qb, false, false);
        u32x2 o8 = {rq[0], rq[1]};
        *(u32x2*)(qrow + ft * 32 + 8 * g + hh * 8) = o8;
      }
  }
}

constexpr int ROUTE_ITEMS = 288 * 8;
constexpr int QROW = 272;
DI int to_sortable(int b) { return b ^ ((b >> 31) & 0x7fffffff); }

#define CAND_LIST(X) \
  X(0,0,0) X(1,0,1) X(2,0,2) X(3,0,3) X(4,0,4) X(5,0,5) X(6,0,6) X(7,0,7) X(8,0,8) X(9,0,9) X(10,0,10) X(11,0,11) X(12,0,12) X(13,0,13) X(14,0,14) X(15,0,15) \
  X(16,1,1) X(17,1,2) X(18,1,3) X(19,1,4) X(20,1,5) X(21,1,6) X(22,1,7) \
  X(23,2,2) X(24,2,3) X(25,2,4) \
  X(26,3,3)


DI void ce_desc(int& a, int& b) { const int hi = max(a, b), lo = min(a, b); a = hi; b = lo; }
DI void bitonic_sort16_desc(int (&v)[16]) {
#pragma unroll
  for (int k = 2; k <= 16; k <<= 1)
#pragma unroll
    for (int j = k >> 1; j > 0; j >>= 1)
#pragma unroll
      for (int i = 0; i < 16; ++i) {
        const int l = i ^ j;
        if (l > i) { if ((i & k) == 0) ce_desc(v[i], v[l]); else ce_desc(v[l], v[i]); }
      }
}
DI void bitonic_merge16_desc(int (&v)[16]) {
#pragma unroll
  for (int j = 8; j > 0; j >>= 1)
#pragma unroll
    for (int i = 0; i < 16; ++i) { const int l = i ^ j; if (l > i) ce_desc(v[i], v[l]); }
}
DI void merge_top16(int (&a)[16], const int (&b)[16]) {
#pragma unroll
  for (int i = 0; i < 16; ++i) a[i] = max(a[i], b[15 - i]);
  bitonic_merge16_desc(a);
}
DI void stage_route(const Params& p, int layer, int item, char* smem) {
  const int mt = item >> 3, head = item & 7;
  if (layer == 1 && mt >= 256) return;
  const int row0 = mt * 128;
  const int tid = tid_now(), lane = tid & 63, wave = tid >> 6, wm = wave >> 1, wn = wave & 1, l31 = lane & 31, hh = lane >> 5;
  int t0[16], tk[16];
  char* Qs = smem;
  float* rs = (float*)(smem + GEMM_SMEM);
  if (tid < 128) {
    float sv[16];
#pragma unroll
    for (int s = 0; s < 16; ++s) sv[s] = p.ssq16[(size_t)s * MTOT + row0 + tid];
    float ssum = 0.f;
#pragma unroll
    for (int s = 0; s < 16; ++s) ssum += sv[s];
    rs[tid] = rsqrtf(ssum * (1.f / D) + EPS);
  }
#pragma unroll 1
  for (int pp = 0; pp < 2; ++pp) {
    {
      f32x16 acc[2][2];
      gemm_core<true, true>(p.H2 + (size_t)row0 * D, p.wq + ((size_t)layer * 2048 + (head * 2 + pp) * 128) * D, smem, acc);
      {
        const float* cqr = p.cq + ((size_t)layer * 17 + mod_row(row0)) * 2048 + (head * 2 + pp) * 128 + wn * 64 + 4 * hh;
#pragma unroll
        for (int tt = 0; tt < 2; ++tt) {
          const float rsd = rs[wm * 64 + tt * 32 + l31];
#pragma unroll
          for (int ft = 0; ft < 2; ++ft)
#pragma unroll
            for (int g = 0; g < 4; ++g) {
              const float4 cv = *(const float4*)(cqr + ft * 32 + 8 * g);
              acc[ft][tt][4 * g] = acc[ft][tt][4 * g] * rsd + cv.x; acc[ft][tt][4 * g + 1] = acc[ft][tt][4 * g + 1] * rsd + cv.y;
              acc[ft][tt][4 * g + 2] = acc[ft][tt][4 * g + 2] * rsd + cv.z; acc[ft][tt][4 * g + 3] = acc[ft][tt][4 * g + 3] * rsd + cv.w;
            }
        }
      }
#pragma unroll
      for (int tt = 0; tt < 2; ++tt)
#pragma unroll
        for (int ft = 0; ft < 2; ++ft)
#pragma unroll
          for (int g = 0; g < 4; ++g) {
            const int tok = wm * 64 + tt * 32 + l31, kf = wn * 64 + ft * 32 + 8 * g + 4 * hh;
            u32x2 o = {pack2(acc[ft][tt][4 * g], acc[ft][tt][4 * g + 1]), pack2(acc[ft][tt][4 * g + 2], acc[ft][tt][4 * g + 3])};
            *(u32x2*)(Qs + tok * QROW + kf * 2) = o;
          }
    }
    const __amdgpu_buffer_rsrc_t rK = __builtin_amdgcn_make_buffer_rsrc((void*)p.pk, 0, (unsigned)(PK_N * 2), 0x00020000);
    const int kso = (((layer * 8 + head) * 2 + pp) * 128) * 256;
    u32x4 ka[8];
#pragma unroll
    for (int s = 0; s < 8; ++s) ka[s] = __builtin_amdgcn_raw_buffer_load_b128(rK, (l31 * 128 + 8 * hh) * 2 + 32 * s, kso, 0);
    __syncthreads();
    {
#pragma unroll
      for (int r = 0; r < 16; ++r) tk[r] = (int)0x80000000;
#pragma unroll 1
      for (int nt = 0; nt < 4; ++nt) {
        int cur[16];
        {
          f32x16 sc;
#pragma unroll
          for (int e = 0; e < 16; ++e) sc[e] = 0.f;
#pragma unroll
          for (int s = 0; s < 8; ++s) {
            bf16x8 qb = *(const bf16x8*)(Qs + (wave * 32 + l31) * QROW + (16 * s + 8 * hh) * 2);
            sc = MFMA(__builtin_bit_cast(bf16x8, ka[s]), qb, sc);
          }
          {
            const int nn = nt < 3 ? nt + 1 : 3;
#pragma unroll
            for (int s = 0; s < 8; ++s) ka[s] = __builtin_amdgcn_raw_buffer_load_b128(rK, ((nn * 32 + l31) * 128 + 8 * hh) * 2 + 32 * s, kso, 0);
          }
#pragma unroll
          for (int e = 0; e < 16; ++e) {
            const int n = nt * 32 + crow(e, hh);
            int b = (__float_as_int(sc[e]) & ~127) | n;
            cur[e] = to_sortable(b);
          }
        }
        bitonic_sort16_desc(cur);
        merge_top16(tk, cur);
      }
      int pb[16];
#pragma unroll
      for (int i = 0; i < 16; ++i) pb[i] = shxi(tk[i], 32, lane);
      merge_top16(tk, pb);
    }
    if (pp == 0) {
#pragma unroll
      for (int r = 0; r < 16; ++r) t0[r] = tk[r];
    }
    __syncthreads();
  }
  char* recs = Qs + (tid_now() >> 6) * 32 * QROW;
  int cand[27];
  {
    float av[16], bv[16];
    unsigned pa[4] = {0u, 0u, 0u, 0u}, pbb[4] = {0u, 0u, 0u, 0u};
#pragma unroll
    for (int i = 0; i < 16; ++i) {
      int k1 = to_sortable(t0[i]), k2 = to_sortable(tk[i]);
      int a = hh ? k2 : k1, b = hh ? k1 : k2;
      av[i] = __int_as_float(a & ~127); bv[i] = __int_as_float(b & ~127);
      pa[i >> 2] |= (unsigned)(a & 127) << (8 * (i & 3));
      pbb[i >> 2] |= (unsigned)(b & 127) << (8 * (i & 3));
    }
    u32x4 ra_ = {pa[0], pa[1], pa[2], pa[3]}, rb_ = {pbb[0], pbb[1], pbb[2], pbb[3]};
    *(u32x4*)(recs + lane * 32) = ra_;
    *(u32x4*)(recs + lane * 32 + 16) = rb_;
#define MKC(c, i, j) { int b = __float_as_int(av[i] + bv[j]); cand[c] = (to_sortable(b) & ~63) | (c * 2 + hh); \
                       if (i == j && hh) cand[c] = (int)0x80000000; }
    CAND_LIST(MKC)
#undef MKC
  }
  int win[16], weid[16];
#pragma unroll
  for (int r = 0; r < 16; ++r) {
    int mx = cand[0];
#pragma unroll
    for (int c = 1; c < 27; ++c) mx = max(mx, cand[c]);
    mx = max(mx, shxi(mx, 32, lane));
#pragma unroll
    for (int c = 0; c < 27; ++c) cand[c] = (cand[c] == mx) ? (int)0x80000000 : cand[c];
    win[r] = mx;
  }
#pragma unroll
  for (int r = 0; r < 16; ++r) {
    const int code = win[r] & 63, c = code >> 1, hw = code & 1;
    const int i = (c >= 16) + (c >= 23) + (c >= 26);
    const int j = c - (i == 0 ? 0 : i == 1 ? 15 : i == 2 ? 21 : 23);
    const unsigned char* orec = (const unsigned char*)(recs + (l31 + 32 * hw) * 32);
    const int aiv = orec[i], biv = orec[16 + j];
    weid[r] = hw ? (biv * 128 + aiv) : (aiv * 128 + biv);
  }
  float gsum = 0.f, gv[16];
  const float v0 = __int_as_float(to_sortable(win[0]) & ~63);
#pragma unroll
  for (int r = 0; r < 16; ++r) { gv[r] = __expf(__int_as_float(to_sortable(win[r]) & ~63) - v0); gsum += gv[r]; }
  const float ginv = 1.f / gsum;
  const int row = row0 + (tid_now() >> 6) * 32 + (tid_now() & 31);
  if (hh == 0) {
    int4* d = (int4*)(p.ridx + ((size_t)row * 8 + head) * 32);
#pragma unroll
    for (int q = 0; q < 4; ++q) { int4 o = {weid[4 * q], weid[4 * q + 1], weid[4 * q + 2], weid[4 * q + 3]}; d[q] = o; }
  } else {
    float4* d = (float4*)((float*)p.ridx + ((size_t)row * 8 + head) * 32 + 16);
#pragma unroll
    for (int q = 0; q < 4; ++q) { float4 o = {gv[4 * q] * ginv, gv[4 * q + 1] * ginv, gv[4 * q + 2] * ginv, gv[4 * q + 3] * ginv}; d[q] = o; }
  }
  __syncthreads();
}

DI float dot2(unsigned a, unsigned b, float acc) {
  bf2_t x = __builtin_bit_cast(bf2_t, a), y = __builtin_bit_cast(bf2_t, b);
  return __builtin_amdgcn_fdot2_f32_bf16(x, y, acc, false);
}
DI float dot8(u32x4 a, u32x4 b, float acc) {
  const unsigned a0 = a[0], a1 = a[1], a2 = a[2], a3 = a[3], b0 = b[0], b1 = b[1], b2 = b[2], b3 = b[3];
  acc = dot2(a0, b0, acc); acc = dot2(a1, b1, acc); acc = dot2(a2, b2, acc); acc = dot2(a3, b3, acc);
  return acc;
}
DI void axpy8(float (&o)[8], float w, u32x4 v) {
  o[0] += w * bf_lo(v.x); o[1] += w * bf_hi(v.x); o[2] += w * bf_lo(v.y); o[3] += w * bf_hi(v.y);
  o[4] += w * bf_lo(v.z); o[5] += w * bf_hi(v.z); o[6] += w * bf_lo(v.w); o[7] += w * bf_hi(v.w);
}
constexpr int GATHER_ITEMS = MTOT / 4;
DI float dot4f8(unsigned u, unsigned hlo, unsigned hhi, float acc) {
  bf2_t a = __builtin_amdgcn_cvt_scalef32_pk_bf16_fp8((int)u, 1.0f, false);
  bf2_t b = __builtin_amdgcn_cvt_scalef32_pk_bf16_fp8((int)u, 1.0f, true);
  bf2_t x = __builtin_bit_cast(bf2_t, hlo), y = __builtin_bit_cast(bf2_t, hhi);
  acc = __builtin_amdgcn_fdot2_f32_bf16(a, x, acc, false);
  acc = __builtin_amdgcn_fdot2_f32_bf16(b, y, acc, false);
  return acc;
}
DI void axpy4f8(float& o0, float& o1, float& o2, float& o3, float w, unsigned v) {
  f2_t lo = __builtin_amdgcn_cvt_pk_f32_fp8((int)v, false), hi = __builtin_amdgcn_cvt_pk_f32_fp8((int)v, true);
  o0 += w * lo[0]; o1 += w * lo[1]; o2 += w * hi[0]; o3 += w * hi[1];
}
DI void stage_gather(const Params& p, int layer, int item) {
  const int lane = tid_now() & 63, wave = tid_now() >> 6;
  const int row = item * 4 + wave;
  if (layer == 1 && row >= NTOK) return;
  const int* rr = p.ridx + (size_t)row * 256 + (lane >> 4) * 32 + (lane & 15);
  const int idxA = rr[0], idxB = rr[128];
  const float gA = __int_as_float(rr[16]), gB = __int_as_float(rr[144]);
  const bf16* hr = p.H + (size_t)row * D + lane * 16;
  const u32x4 hA = *(const u32x4*)(hr), hB = *(const u32x4*)(hr + 8);
  const unsigned h0 = hA[0], h1 = hA[1], h2 = hA[2], h3 = hA[3], h4 = hB[0], h5 = hB[1], h6 = hB[2], h7 = hB[3];
  float o[16];
#pragma unroll
  for (int i = 0; i < 16; ++i) o[i] = 0.f;
  const __amdgpu_buffer_rsrc_t rU = __builtin_amdgcn_make_buffer_rsrc((void*)(p.pu8 + (size_t)layer * NEXP * D), 0, NEXP * D, 0x00020000);
  const __amdgpu_buffer_rsrc_t rV = __builtin_amdgcn_make_buffer_rsrc((void*)(p.pv8 + (size_t)layer * NEXP * D), 0, NEXP * D, 0x00020000);
  const int voff = lane * 16;
  u32x4 ua[16], va[16];
#pragma unroll
  for (int k = 0; k < 16; ++k) {
    const int e = __builtin_amdgcn_readlane(idxA, k);
    ua[k] = __builtin_amdgcn_raw_buffer_load_b128(rU, voff, e * D, 0);
  }
#pragma unroll
  for (int k = 0; k < 16; ++k) {
    const int e = __builtin_amdgcn_readlane(idxA, k);
    va[k] = __builtin_amdgcn_raw_buffer_load_b128(rV, voff, e * D, 0);
  }
#pragma unroll
  for (int head = 0; head < 8; ++head) {
    float part[16];
#pragma unroll
    for (int k = 0; k < 16; ++k) {
      const unsigned a0 = ua[k][0], a1 = ua[k][1], a2 = ua[k][2], a3 = ua[k][3];
      float s = dot4f8(a0, h0, h1, 0.f);
      s = dot4f8(a1, h2, h3, s); s = dot4f8(a2, h4, h5, s); s = dot4f8(a3, h6, h7, s);
      part[k] = s;
    }
    asm volatile("" ::: "memory");
    if (head < 7) {
#pragma unroll
      for (int k = 0; k < 16; ++k) {
        const int e = __builtin_amdgcn_readlane((head + 1) < 4 ? idxA : idxB, ((head + 1) & 3) * 16 + k);
        ua[k] = __builtin_amdgcn_raw_buffer_load_b128(rU, voff, e * D, 0);
      }
    }
    float r8[8], r4[4], r2[2], r1;
    {
      const bool up = lane & 32;
#pragma unroll
      for (int k = 0; k < 8; ++k) { float keep = up ? part[k + 8] : part[k], give = up ? part[k] : part[k + 8]; r8[k] = keep + shx(give, 32, lane); }
    }
    {
      const bool up = lane & 16;
#pragma unroll
      for (int k = 0; k < 4; ++k) { float keep = up ? r8[k + 4] : r8[k], give = up ? r8[k] : r8[k + 4]; r4[k] = keep + shx(give, 16, lane); }
    }
    {
      const bool up = lane & 8;
#pragma unroll
      for (int k = 0; k < 2; ++k) { float keep = up ? r4[k + 2] : r4[k], give = up ? r4[k] : r4[k + 2]; r2[k] = keep + shx(give, 8, lane); }
    }
    {
      const bool up = lane & 4;
      float keep = up ? r2[1] : r2[0], give = up ? r2[0] : r2[1];
      r1 = keep + shx(give, 4, lane);
    }
    r1 += shx(r1, 2, lane);
    r1 += shx(r1, 1, lane);
    const float myg = __int_as_float(__builtin_amdgcn_ds_bpermute(((head & 3) * 16 + ((lane >> 2) & 15)) << 2, __float_as_int(head < 4 ? gA : gB)));
    const float w = gelu_tanh(r1 * (1.f / SU)) * myg * (1.f / SV);
#pragma unroll
    for (int k = 0; k < 16; ++k) {
      const float wk = __int_as_float(__builtin_amdgcn_readlane(__float_as_int(w), k << 2));
      const unsigned a0 = va[k][0], a1 = va[k][1], a2 = va[k][2], a3 = va[k][3];
      axpy4f8(o[0], o[1], o[2], o[3], wk, a0); axpy4f8(o[4], o[5], o[6], o[7], wk, a1);
      axpy4f8(o[8], o[9], o[10], o[11], wk, a2); axpy4f8(o[12], o[13], o[14], o[15], wk, a3);
    }
    asm volatile("" ::: "memory");
    if (head < 7) {
#pragma unroll
      for (int k = 0; k < 16; ++k) {
        const int e = __builtin_amdgcn_readlane((head + 1) < 4 ? idxA : idxB, ((head + 1) & 3) * 16 + k);
        va[k] = __builtin_amdgcn_raw_buffer_load_b128(rV, voff, e * D, 0);
      }
    }
  }
  const float* g2 = p.mod + ((size_t)layer * 17 + mod_row(row)) * 6144 + 5120 + lane * 16;
  float* dr = xres_row(p, row) + lane * 16;
  float4 xv[4], gv[4];
#pragma unroll
  for (int q = 0; q < 4; ++q) { xv[q] = *(const float4*)(dr + 4 * q); gv[q] = *(const float4*)(g2 + 4 * q); }
#pragma unroll
  for (int q = 0; q < 4; ++q) {
    float4 r = {xv[q].x + gv[q].x * o[4 * q], xv[q].y + gv[q].y * o[4 * q + 1], xv[q].z + gv[q].z * o[4 * q + 2], xv[q].w + gv[q].w * o[4 * q + 3]};
    *(float4*)(dr + 4 * q) = r;
  }
}

constexpr int PEER_TPW = 4;
constexpr int PEER_TPI = 4 * PEER_TPW;
DI float bperm_f(float v, int src_lane) { return __int_as_float(__builtin_amdgcn_ds_bpermute(src_lane << 2, __float_as_int(v))); }
DI int bperm_i(int v, int src_lane) { return __builtin_amdgcn_ds_bpermute(src_lane << 2, v); }

DI __amdgpu_buffer_rsrc_t mk_rsrc(const void* ptr, unsigned bytes) { return __builtin_amdgcn_make_buffer_rsrc((void*)ptr, 0, bytes, 0x00020000); }
DI void stage_peer_u(const Params& p, int layer, int q, int tile, _Float16* __restrict__ partial) {
  const int tid = tid_now(), lane = tid & 63, g = lane >> 3, c = lane & 7;
  const int wave = __builtin_amdgcn_readfirstlane(tid >> 6);
  const int row_base = tile * PEER_TPI + wave * PEER_TPW;
  const __amdgpu_buffer_rsrc_t rU = mk_rsrc(p.pu8 + (size_t)layer * NEXP * D, NEXP * D);
  const __amdgpu_buffer_rsrc_t rRec = mk_rsrc(p.ridx, (unsigned)((size_t)MTOT * 1024));
  const __amdgpu_buffer_rsrc_t rH = mk_rsrc(p.hq, (unsigned)((size_t)MTOT * D));
  const __amdgpu_buffer_rsrc_t rP = mk_rsrc(partial, (unsigned)((size_t)8 * MTOT * 256));
  const int coff = q * 128 + c * 16;
  const int rec_v = ((lane >> 4) * 32 + (lane & 15)) * 4;
  const int i0 = 4 * (c & 1) + 2 * ((c >> 1) & 1) + ((c >> 2) & 1);
  const int pv0 = (8 * i0 + g) * 4;
  int idA[3], idB[3];
  u32x4 d[2][8]; u32x4 hv[2];
  auto load_idx = [&](int t, int slot) {
    const int so = (row_base + t) * 1024;
    idA[slot] = __builtin_amdgcn_raw_buffer_load_b32(rRec, rec_v, so, 0);
    idB[slot] = __builtin_amdgcn_raw_buffer_load_b32(rRec, rec_v + 512, so, 0);
  };
  auto issue = [&](int u) {
    const int t = u >> 1, hf = u & 1, slot = t % 3, buf = u & 1;
    if (hf == 0) hv[t & 1] = __builtin_amdgcn_raw_buffer_load_b128(rH, coff, (row_base + t) * D, 0);
#pragma unroll
    for (int i = 0; i < 8; ++i) {
      const int e = bperm_i(hf ? idB[slot] : idA[slot], (8 * i + g) & 63);
      d[buf][i] = __builtin_amdgcn_raw_buffer_load_b128(rU, e * D + coff, 0, 0);
    }
  };
  load_idx(0, 0); load_idx(1, 1);
  issue(0);
  int r[16];
#pragma unroll
  for (int u = 0; u < 2 * PEER_TPW; ++u) {
    const int t = u >> 1, hf = u & 1, buf = u & 1;
    asm volatile("" ::: "memory");
    if (hf == 0 && t + 2 < PEER_TPW) load_idx(t + 2, (t + 2) % 3);
    if (u + 1 < 2 * PEER_TPW) issue(u + 1);
    const int h0 = (int)hv[t & 1][0], h1 = (int)hv[t & 1][1], h2 = (int)hv[t & 1][2], h3 = (int)hv[t & 1][3];
#pragma unroll
    for (int i = 0; i < 8; ++i) {
      const int a0 = (int)d[buf][i][0], a1 = (int)d[buf][i][1], a2 = (int)d[buf][i][2], a3 = (int)d[buf][i][3];
      int s = __builtin_amdgcn_sdot4(a0, h0, 0, false);
      s = __builtin_amdgcn_sdot4(a1, h1, s, false); s = __builtin_amdgcn_sdot4(a2, h2, s, false); s = __builtin_amdgcn_sdot4(a3, h3, s, false);
      r[8 * hf + i] = s;
    }
    if (hf == 0) continue;
    asm volatile("" ::: "memory");
    int r8[8], r4[4], r2[2];
    {
      const bool up = c & 1;
#pragma unroll
      for (int b3 = 0; b3 < 2; ++b3)
#pragma unroll
        for (int m = 0; m < 4; ++m) { int lo = r[8 * b3 + m], hi = r[8 * b3 + 4 + m]; int keep = up ? hi : lo, give = up ? lo : hi; r8[4 * b3 + m] = keep + bperm_i(give, lane ^ 1); }
    }
    {
      const bool up = c & 2;
#pragma unroll
      for (int b3 = 0; b3 < 2; ++b3)
#pragma unroll
        for (int m = 0; m < 2; ++m) { int lo = r8[4 * b3 + m], hi = r8[4 * b3 + 2 + m]; int keep = up ? hi : lo, give = up ? lo : hi; r4[2 * b3 + m] = keep + bperm_i(give, lane ^ 2); }
    }
    {
      const bool up = c & 4;
#pragma unroll
      for (int b3 = 0; b3 < 2; ++b3) { int lo = r4[2 * b3], hi = r4[2 * b3 + 1]; int keep = up ? hi : lo, give = up ? lo : hi; r2[b3] = keep + bperm_i(give, lane ^ 4); }
    }
    const int so = (q * MTOT + row_base + t) * 256;
    const h2_t ph = {(_Float16)((float)r2[0] * (1.f / 64.f)), (_Float16)((float)r2[1] * (1.f / 64.f))};
    __builtin_amdgcn_raw_buffer_store_b32(__builtin_bit_cast(int, ph), rP, pv0, so, 0);
  }
}

constexpr int PEERC_RPW = 2;
DI void stage_peer_combine(const Params& p, int layer, int item, const _Float16* __restrict__ partial) {
  const int lane = tid_now() & 63, wave = tid_now() >> 6;
  const int rbase = (item * 4 + wave) * PEERC_RPW;
  const int mr = mod_row(rbase);
  int e0[PEERC_RPW], e1[PEERC_RPW];
  float g0[PEERC_RPW], g1[PEERC_RPW], ssum[PEERC_RPW];
  unsigned pab[PEERC_RPW][8];
  float hq[PEERC_RPW][8];
#pragma unroll
  for (int j = 0; j < PEERC_RPW; ++j) {
    const int* reci = p.ridx + (size_t)(rbase + j) * 256 + (lane >> 4) * 32 + (lane & 15);
    e0[j] = reci[0]; e1[j] = reci[128];
  }
#pragma unroll
  for (int j = 0; j < PEERC_RPW; ++j) {
    const int row = rbase + j;
#pragma unroll
    for (int q = 0; q < 8; ++q) {
      pab[j][q] = ((const unsigned*)partial)[((size_t)q * MTOT + row) * 64 + lane];
      hq[j][q] = p.hs8[(size_t)q * MTOT + row] * 64.f;
    }
    const int* reci = p.ridx + (size_t)row * 256 + (lane >> 4) * 32 + (lane & 15);
    g0[j] = __int_as_float(reci[16]); g1[j] = __int_as_float(reci[144]);
    ssum[j] = p.ssq16[(size_t)(lane & 15) * MTOT + row];
  }
  float2 er0[PEERC_RPW], er1[PEERC_RPW];
#pragma unroll
  for (int j = 0; j < PEERC_RPW; ++j) {
    er0[j] = *(const float2*)(p.esc + ((size_t)layer * NEXP + e0[j]) * 64 + 2 * mr);
    er1[j] = *(const float2*)(p.esc + ((size_t)layer * NEXP + e1[j]) * 64 + 2 * mr);
  }
#pragma unroll
  for (int j = 0; j < PEERC_RPW; ++j) {
    const int row = rbase + j;
    float s0 = 0.f, s1 = 0.f;
#pragma unroll
    for (int q = 0; q < 8; ++q) { const h2_t pv = __builtin_bit_cast(h2_t, pab[j][q]); s0 += (float)pv[0] * hq[j][q]; s1 += (float)pv[1] * hq[j][q]; }
    float t = ssum[j];
    t += shx(t, 1, lane); t += shx(t, 2, lane); t += shx(t, 4, lane); t += shx(t, 8, lane);
    const float rstd = rsqrtf(t * (1.f / D) + EPS);
    float* rec = (float*)(p.ridx + (size_t)row * 256 + (lane >> 4) * 32 + (lane & 15)) + 16;
    const _Float16 w0 = (_Float16)(gelu_tanh(s0 * er0[j].y * rstd + er0[j].x) * g0[j]), w1 = (_Float16)(gelu_tanh(s1 * er1[j].y * rstd + er1[j].x) * g1[j]);
    const h2_t w0p = {w0, w0}, w1p = {w1, w1};
    rec[0] = __builtin_bit_cast(float, w0p);
    rec[128] = __builtin_bit_cast(float, w1p);
  }
}

DI void axpy4f8_pk(f2_t& o01, f2_t& o23, f2_t w2, unsigned v) {
  f2_t lo = __builtin_amdgcn_cvt_pk_f32_fp8((int)v, false), hi = __builtin_amdgcn_cvt_pk_f32_fp8((int)v, true);
  o01 = __builtin_elementwise_fma(w2, lo, o01); o23 = __builtin_elementwise_fma(w2, hi, o23);
}
DI void stage_peer_v(const Params& p, int layer, int q, int tile, float dry = 1.f) {
  const int tid = tid_now(), lane = tid & 63, g = lane >> 3, c = lane & 7;
  const int wave = __builtin_amdgcn_readfirstlane(tid >> 6);
  const int row_base = tile * PEER_TPI + wave * PEER_TPW;
  const __amdgpu_buffer_rsrc_t rV = mk_rsrc(p.pv8 + (size_t)layer * NEXP * D, NEXP * D);
  const __amdgpu_buffer_rsrc_t rRec = mk_rsrc(p.ridx, (unsigned)((size_t)MTOT * 1024));
  const bool isctx = row_base >= NTOK;
  const __amdgpu_buffer_rsrc_t rX = isctx ? mk_rsrc(p.XC, (unsigned)((size_t)NCTX * D * 4)) : mk_rsrc(p.out, (unsigned)((size_t)NTOK * D * 4));
  const int xrow0 = isctx ? row_base - NTOK : row_base;
  const int coff = q * 128 + c * 16;
  const int rec_v = ((lane >> 4) * 32 + (lane & 15)) * 4;
  int idA[3], idB[3]; float wA[3], wB[3];
  u32x4 d[2][8];
  auto load_idx = [&](int t, int slot) {
    const int so = (row_base + t) * 1024;
    idA[slot] = __builtin_amdgcn_raw_buffer_load_b32(rRec, rec_v, so, 0);
    idB[slot] = __builtin_amdgcn_raw_buffer_load_b32(rRec, rec_v + 512, so, 0);
    wA[slot] = __int_as_float(__builtin_amdgcn_raw_buffer_load_b32(rRec, rec_v + 64, so, 0));
    wB[slot] = __int_as_float(__builtin_amdgcn_raw_buffer_load_b32(rRec, rec_v + 576, so, 0));
  };
  const int dl = coff + 8 * (g & 1) + 4 * ((g >> 1) & 1) + 2 * ((g >> 2) & 1);
  u32x2 xvb[2];
  auto issue = [&](int u) {
    const int t = u >> 1, hf = u & 1, slot = t % 3, buf = u & 1;
#pragma unroll
    for (int i = 0; i < 8; ++i) {
      const int e = bperm_i(hf ? idB[slot] : idA[slot], (8 * i + g) & 63);
      d[buf][i] = __builtin_amdgcn_raw_buffer_load_b128(rV, e * D + coff, 0, 0);
    }
    if (hf == 1) xvb[t & 1] = __builtin_amdgcn_raw_buffer_load_b64(rX, dl * 4, (xrow0 + t) * (D * 4), 0);
  };
  const float2 g2v = *(const float2*)(p.mod + ((size_t)layer * 17 + mod_row(row_base)) * 6144 + 5120 + dl);
  load_idx(0, 0); load_idx(1, 1);
  issue(0);
  h2_t oh[8];
#pragma unroll
  for (int u = 0; u < 2 * PEER_TPW; ++u) {
    const int t = u >> 1, hf = u & 1, buf = u & 1, slot = t % 3;
    asm volatile("" ::: "memory");
    if (hf == 0 && t + 2 < PEER_TPW) load_idx(t + 2, (t + 2) % 3);
    if (u + 1 < 2 * PEER_TPW) issue(u + 1);
#pragma unroll
    for (int i = 0; i < 8; ++i) {
      const h2_t w2 = __builtin_bit_cast(h2_t, bperm_f(hf ? wB[slot] : wA[slot], (8 * i + g) & 63));
#pragma unroll
      for (int j = 0; j < 4; ++j) {
        const int av = (int)d[buf][i][j];
        const h2_t lo = __builtin_amdgcn_cvt_scalef32_pk_f16_fp8(av, 1.0f, false), hi = __builtin_amdgcn_cvt_scalef32_pk_f16_fp8(av, 1.0f, true);
        if (hf == 0 && i == 0) { oh[2 * j] = w2 * lo; oh[2 * j + 1] = w2 * hi; }
        else { oh[2 * j] = __builtin_elementwise_fma(w2, lo, oh[2 * j]); oh[2 * j + 1] = __builtin_elementwise_fma(w2, hi, oh[2 * j + 1]); }
      }
    }
    if (hf == 0) continue;
    asm volatile("" ::: "memory");
    h2_t q4[4], q2[2], q1;
    {
      const bool up = g & 1;
#pragma unroll
      for (int k = 0; k < 4; ++k) {
        const h2_t keep = up ? oh[k + 4] : oh[k], give = up ? oh[k] : oh[k + 4];
        q4[k] = keep + __builtin_bit_cast(h2_t, bperm_i(__builtin_bit_cast(int, give), lane ^ 8));
      }
    }
    {
      const bool up = g & 2;
#pragma unroll
      for (int k = 0; k < 2; ++k) {
        const h2_t keep = up ? q4[k + 2] : q4[k], give = up ? q4[k] : q4[k + 2];
        q2[k] = keep + __builtin_bit_cast(h2_t, bperm_i(__builtin_bit_cast(int, give), lane ^ 16));
      }
    }
    {
      const auto sw = __builtin_amdgcn_permlane32_swap(__builtin_bit_cast(unsigned, q2[0]), __builtin_bit_cast(unsigned, q2[1]), false, false);
      const unsigned sa = sw[0], sb = sw[1];
      q1 = __builtin_bit_cast(h2_t, sa) + __builtin_bit_cast(h2_t, sb);
    }
    float r2[2] = {(float)q1[0] * (1.f / SV), (float)q1[1] * (1.f / SV)};
    const int so = (xrow0 + t) * (D * 4);
    const u32x2 xv = xvb[t & 1];
    const float x0 = __uint_as_float(xv[0]), x1 = __uint_as_float(xv[1]);
    u32x2 ov = {__float_as_uint(x0 + dry * g2v.x * r2[0]), __float_as_uint(x1 + dry * g2v.y * r2[1])};
    __builtin_amdgcn_raw_buffer_store_b64(ov, rX, dl * 4, so, 0);
  }
}

#include <hip/hip_cooperative_groups.h>
namespace cg = cooperative_groups;
constexpr int SMEM_BYTES = 40960;


#define XB_TMO      128
#define XB_XCNT(j)  (256  + 64 * (j))
#define XB_XSUB(j)  (1280 + 64 * (j))
#define XB_XGEN(j)  (2304 + 64 * (j))
#define XB_TOP      3328
#define XB_TOPGEN   3392
#define XCD_BAR_WORDS 3456
#define XB_SPIN_CAP (1u << 22)
#define LAS __attribute__((address_space(3)))
DI unsigned xb_ld(unsigned* p) { return __hip_atomic_load(p, __ATOMIC_RELAXED, __HIP_MEMORY_SCOPE_AGENT); }
DI unsigned xb_add(unsigned* p, unsigned v) { return __hip_atomic_fetch_add(p, v, __ATOMIC_RELAXED, __HIP_MEMORY_SCOPE_AGENT); }
DI unsigned xb_xcc_id() { unsigned x; asm volatile("s_getreg_b32 %0, hwreg(HW_REG_XCC_ID, 0, 4)" : "=s"(x)); return x & 0xFu; }
#define XB_SPIN(cond, bar) do { unsigned _sp = 0; while (cond) { __builtin_amdgcn_s_sleep(1); \
    if ((++_sp & 255u) == 0u) { if (xb_ld(&(bar)[XB_TMO])) break; if (_sp > XB_SPIN_CAP) { atomicAdd(&(bar)[XB_TMO], 1u); break; } } } } while (0)
struct XcdBarrier { unsigned* bar; volatile LAS unsigned* st; };
DI XcdBarrier xcd_barrier_post(unsigned* bar, volatile LAS unsigned* st) {
  XcdBarrier b; b.bar = bar; b.st = st;
  if (tid_now() == 0) (void)xb_add(&bar[XB_XCNT(xb_xcc_id())], 1u);
  return b;
}
DI void xcd_barrier_complete(unsigned* bar, unsigned x, unsigned& nloc, unsigned& nx) {
  const unsigned G = gridDim.x;
  unsigned sum, cnt, mine, sp = 0u;
  for (;;) {
    sum = 0u; cnt = 0u; mine = 0u;
#pragma unroll
    for (unsigned j = 0; j < 16; ++j) { const unsigned c = xb_ld(&bar[XB_XCNT(j)]); sum += c; cnt += (c > 0u) ? 1u : 0u; mine = (j == x) ? c : mine; }
    if (sum == G) break;
    __builtin_amdgcn_s_sleep(1);
    if ((++sp & 255u) == 0u) { if (xb_ld(&bar[XB_TMO])) break; if (sp > XB_SPIN_CAP) { atomicAdd(&bar[XB_TMO], 1u); break; } }
  }
  nloc = mine > 0u ? mine : 1u; nx = cnt > 0u ? cnt : 1u;
}
DI void xcd_barrier(const XcdBarrier& b) {
  asm volatile("s_waitcnt vmcnt(0)" ::: "memory");
  __syncthreads();
  if (tid_now() == 0) {
    unsigned* bar = b.bar;
    const unsigned bx = xb_xcc_id();
    __builtin_amdgcn_s_waitcnt(0);
    unsigned nloc = b.st[0], nx = b.st[1];
    if (nloc == 0u) { xcd_barrier_complete(bar, bx, nloc, nx); b.st[0] = nloc; b.st[1] = nx; }
    const unsigned old = xb_add(&bar[XB_XSUB(bx)], 1u);
    const unsigned gen = old / nloc;
    if (old + 1u == (gen + 1u) * nloc) {
      __builtin_amdgcn_s_sleep(64);
      __builtin_amdgcn_fence(__ATOMIC_RELEASE, "agent");
      asm volatile("s_waitcnt vmcnt(0)" ::: "memory");
      const unsigned og = xb_add(&bar[XB_TOP], 1u);
      const unsigned tg = og / nx;
      if (og + 1u == (tg + 1u) * nx) xb_add(&bar[XB_TOPGEN], 1u);
      else XB_SPIN(xb_ld(&bar[XB_TOPGEN]) == tg, bar);
      __builtin_amdgcn_fence(__ATOMIC_ACQUIRE, "agent");
      xb_add(&bar[XB_XGEN(bx)], 1u);
      asm volatile("s_waitcnt vmcnt(0)" ::: "memory");
    } else {
      XB_SPIN(xb_ld(&bar[XB_XGEN(bx)]) == gen, bar);
      __builtin_amdgcn_fence(__ATOMIC_ACQUIRE, "agent");
      asm volatile("s_waitcnt vmcnt(0)" ::: "memory");
    }
  }
  __syncthreads();
}

constexpr int QCTR_STRIDE = 32;
constexpr int QCTR_WORDS = 16 * 8 * QCTR_STRIDE;
DI int q_pop(unsigned* ctr, volatile LAS int* slot) {
  __syncthreads();
  if (tid_now() == 0) *slot = (int)__hip_atomic_fetch_add(ctr, 1u, __ATOMIC_RELAXED, __HIP_MEMORY_SCOPE_AGENT);
  __syncthreads();
  return *slot;
}
template <class NF, class BF>
DI void run_queues(unsigned* ctr, int myx, volatile LAS int* slot, NF nitems_of_q, BF body) {
#pragma unroll 1
  for (int s = 0; s < 8; ++s) {
    const int q = (myx + s) & 7;
    const int n = nitems_of_q(q);
#pragma unroll 1
    for (;;) {
      const int idx = q_pop(ctr + q * QCTR_STRIDE, slot);
      if (idx >= n) break;
      body(q, idx);
    }
  }
}

#define GRID_BARRIER() xcd_barrier(xb)
#define REP(k) for (int rep_ = 0; rep_ < (DUP == (k) ? 2 : 1); ++rep_)

__global__ void __launch_bounds__(256, 3) mega_kernel(Params p) {
  __shared__ __attribute__((aligned(16))) char smem[SMEM_BYTES];
  cg::grid_group grid = cg::this_grid();
  const int G = gridDim.x, bid = blockIdx.x;
  uint4* xbw = (uint4*)(smem + SMEM_BYTES - 16);
  if (tid_now() == 0) *xbw = make_uint4(0u, 0u, 0u, 0u);
  volatile LAS int* qslot = (volatile LAS int*)xbw + 2;
  XcdBarrier xb = xcd_barrier_post(p.bar, (volatile LAS unsigned*)xbw);
  if (p.never) grid.sync();
  REP(1) for (int it = bid; it < MODP_ITEMS + CONVT_ITEMS + CONVK_ITEMS + 1; it += G) {
    if (it < MODP_ITEMS) stage_mod_partial(p, it, smem);
    else if (it < MODP_ITEMS + CONVT_ITEMS) stage_convT(p, it - MODP_ITEMS, smem);
    else if (it < MODP_ITEMS + CONVT_ITEMS + CONVK_ITEMS) stage_convS(p, it - MODP_ITEMS - CONVT_ITEMS);
    else stage_rope(p);
  }
  GRID_BARRIER();
  for (int it = bid; it < MODR_ITEMS; it += G) stage_mod_reduce(p, it);
  GRID_BARRIER();
#pragma unroll 1
  for (int l = 0; l < 2; ++l) {
    REP(2) for (int it = bid; it < MTOT / 8; it += G) stage_norm(p, l, 0, it);
    if (l == 0) for (int it = bid; it < CQP_ITEMS; it += G) stage_cq_partial(p, it, smem);
    GRID_BARRIER();
    {
      const int myx = xb_xcc_id() & 7;
      unsigned* ctr = p.qctr + (l * 8 + 0) * 8 * QCTR_STRIDE;
      const int nlat = l == 0 ? 288 : 256;
      run_queues(ctr, myx, qslot,
        [&](int q) { return nlat * (q < 2 ? 3 : 2) + (l == 0 ? 0 : 32); },
        [&](int q, int idx) {
          const int nN = q < 2 ? 3 : 2;
          int mt, nt;
          if (idx < nlat * nN) { mt = idx / nN; nt = q + 8 * (idx - mt * nN); }
          else { mt = 256 + (idx - nlat * nN); nt = q < 2 ? q + 16 : q + 8; }
          stage_inproj(p, l, mt * 18 + nt, smem);
          if (DUP == 3) stage_inproj(p, l, mt * 18 + nt, smem);
        });
    }
    if (l == 0) for (int it = bid; it < CQR_ITEMS; it += G) stage_cq_reduce(p, it);
    GRID_BARRIER();
    {
      const int myx = xb_xcc_id() & 7;
      run_queues(p.qctr + (l * 8 + 1) * 8 * QCTR_STRIDE, myx, qslot, [&](int) { return 192; },
        [&](int q, int idx) {
          const int b = q + 8 * (idx / 96), r = idx % 96;
          stage_gqa(p, l, b * 96 + r, smem);
          if (DUP == 40) stage_gqa(p, l, b * 96 + r, smem);
          constexpr int NV = CONVV_ITEMS / 2;
          const int g = q * 192 + idx;
          for (int f = g * NV / 1536; f < (g + 1) * NV / 1536; ++f) stage_convS(p, CONVK_ITEMS + l * NV + f);
          const int ncv = (l == 0 ? MTOT : NTOK) / CONV_TT;
          const int c0 = g * ncv / 1536, c1 = (g + 1) * ncv / 1536;
          if (c0 < c1) {
            __syncthreads();
            for (int f = c0; f < c1; ++f) { stage_conv(p, l, f, smem); if (DUP == 44) stage_conv(p, l, f, smem); }
          }
        });
      run_queues(p.qctr + (l * 8 + 2) * 8 * QCTR_STRIDE, myx, qslot, [&](int) { return 192; },
        [&](int q, int idx) {
          const int b = q + 8 * (idx / 96), r = idx % 96;
          stage_na2(p, l, b * 96 + r, smem);
          if (DUP == 43) stage_na2(p, l, b * 96 + r, smem);
          constexpr int NU = CONVU_ITEMS / 2;
          const int g = q * 192 + idx;
          stage_convU(p, l, g * NU / 1536, (g + 1) * NU / 1536, smem);
        });
      const int nctx = l == 0 ? CTXATT_ITEMS : 0;
      for (int it = bid; it < nctx; it += G) stage_ctxatt(p, it, smem);
    }
    GRID_BARRIER();
    {
      const int myx = xb_xcc_id() & 7, nlat = l == 0 ? 288 : 256;
      run_queues(p.qctr + (l * 8 + 3) * 8 * QCTR_STRIDE, myx, qslot, [&](int) { return nlat; },
        [&](int q, int idx) { stage_outproj(p, l, idx * 8 + q, smem); });
    }
    GRID_BARRIER();
    {
      const int myx = xb_xcc_id() & 7, nlat = l == 0 ? 288 : 256;
      run_queues(p.qctr + (l * 8 + 4) * 8 * QCTR_STRIDE, myx, qslot, [&](int) { return nlat; },
        [&](int q, int idx) { stage_route(p, l, idx * 8 + q, smem); if (DUP == 7) stage_route(p, l, idx * 8 + q, smem); });
    }
    GRID_BARRIER();
    {
      const int myx = xb_xcc_id() & 7;
      const int ntile = (l == 0 ? MTOT : NTOK) / PEER_TPI;
      _Float16* partial = (_Float16*)p.U;
      run_queues(p.qctr + (l * 8 + 5) * 8 * QCTR_STRIDE, myx, qslot, [&](int) { return ntile; },
        [&](int q, int idx) { stage_peer_u(p, l, q, idx, partial); if (DUP == 50) stage_peer_u(p, l, q, idx, partial); });
      GRID_BARRIER();
      for (int it = bid; it < (l == 0 ? MTOT : NTOK) / (4 * PEERC_RPW); it += G) stage_peer_combine(p, l, it, partial);
      GRID_BARRIER();
      run_queues(p.qctr + (l * 8 + 6) * 8 * QCTR_STRIDE, myx, qslot, [&](int) { return ntile; },
        [&](int q, int idx) { if (DUP == 51) stage_peer_v(p, l, q, idx, 0.f); stage_peer_v(p, l, q, idx); });
    }
    GRID_BARRIER();
  }
  for (int it = bid; it < NTOK / 8; it += G) stage_final(p, it);
}

extern "C" void kernel_launch(void* const* d_in, const int* in_sizes, int n_in, void* d_out, int out_size, void* d_ws, size_t ws_size,
                              hipStream_t stream) {
  Params p{};
  const float** f = (const float**)&p;
  for (int i = 0; i < 22; ++i) f[i] = (const float*)d_in[i];
  p.out = (float*)d_out;
  char* w = (char*)d_ws; size_t off = 0;
  auto take = [&](size_t bytes) { char* r = w + off; off += (bytes + 255) & ~(size_t)255; return r; };
  p.win = (bf16*)take((size_t)2 * INC * D * 2);
  p.wout = (bf16*)take((size_t)2 * D * D * 2);
  p.wq = (bf16*)take((size_t)2 * 2048 * D * 2);
  p.pk = (bf16*)take(PK_N * 2);
  p.pu8 = (unsigned char*)take(PU_N);
  p.pv8 = (unsigned char*)take(PU_N);
  p.esc = (float*)take((size_t)2 * NEXP * 64 * 4);
  p.ssq16 = (float*)take((size_t)16 * MTOT * 4);
  p.hs8 = (float*)take((size_t)8 * MTOT * 4);
  p.cqp = (float*)take((size_t)CQ_KS * 2 * 17 * 2048 * 4);
  p.cq = (float*)take((size_t)2 * 17 * 2048 * 4);
  p.H2 = (bf16*)take((size_t)MTOT * D * 2);
  p.hq = (signed char*)take((size_t)MTOT * D);
  p.modp = (float*)take((size_t)2 * 8 * 17 * 6144 * 4);
  p.mod = (float*)take((size_t)2 * 17 * 6144 * 4);
  p.ropetab = (float*)take(64 * 16 * 2 * 4);
  p.H = (bf16*)take((size_t)MTOT * D * 2);
  p.CAT = p.H;
  p.U = (bf16*)take((size_t)MTOT * 256 * 2);
  p.QN = (bf16*)take((size_t)NB * 6 * SEQ2 * 64 * 2);
  p.KN = (bf16*)take((size_t)NB * 6 * SEQ2 * 64 * 2);
  p.VNt = (bf16*)take((size_t)NB * 6 * SEQ2 * 64 * 2);
  p.QG = (bf16*)take((size_t)NB * 6 * SEQ2 * 64 * 2);
  p.KG = (bf16*)take((size_t)NB * 2 * SEQ2 * 64 * 2);
  p.VGt = (bf16*)take((size_t)NB * 2 * SEQ2 * 64 * 2);
  p.XC = (float*)take((size_t)NCTX * D * 4);
  p.ridx = (int*)take((size_t)MTOT * 256 * 4);
  p.rg = (float*)p.ridx;
  p.bar = (unsigned*)take(XCD_BAR_WORDS * 4);
  p.qctr = (unsigned*)take(QCTR_WORDS * 4);
  if (off > ws_size) return;
  static int grid_blocks = 0;
  if (!grid_blocks) {
    int dev = 0, cus = 0, per_cu = 0;
    hipGetDevice(&dev);
    hipDeviceGetAttribute(&cus, hipDeviceAttributeMultiprocessorCount, dev);
    hipOccupancyMaxActiveBlocksPerMultiprocessor(&per_cu, mega_kernel, 256, 0);
    if (per_cu > 3) per_cu = 3;
    grid_blocks = cus * per_cu;
  }
  void* args[] = {&p};
  hipMemsetAsync(p.bar, 0, (size_t)(XCD_BAR_WORDS + QCTR_WORDS) * 4, stream);
  hipLaunchCooperativeKernel((void*)mega_kernel, dim3(grid_blocks), dim3(256), args, 0, stream);
}
```

```cpp
#include <hip/hip_runtime.h>
#include <stdint.h>

typedef __attribute__((ext_vector_type(8))) short bf16x8;
typedef __attribute__((ext_vector_type(16))) float f32x16;
typedef __attribute__((ext_vector_type(2))) __bf16 bf2_t;
typedef __attribute__((ext_vector_type(2))) float f2_t;
typedef unsigned short bf16;
typedef __attribute__((ext_vector_type(2))) _Float16 h2_t;
typedef __attribute__((ext_vector_type(4))) unsigned u32x4;
typedef __attribute__((ext_vector_type(2))) unsigned u32x2;

#define DI __device__ __forceinline__
#ifndef PROBE
#define PROBE 0
#endif
#ifndef DUP
#define DUP 0
#endif
#define MFMA(a, b, c) __builtin_amdgcn_mfma_f32_32x32x16_bf16((a), (b), (c), 0, 0, 0)

constexpr int D = 1024, NB = 16, T = 2048, CL = 256;
constexpr int NTOK = NB * T;
constexpr int NCTX = NB * CL;
constexpr int MTOT = NTOK + NCTX;
constexpr int INC = 2304;
constexpr int SEQ2 = T + CL;
constexpr int NEXP = 16384;
constexpr float EPS = 1e-6f;
constexpr float L2E = 1.4426950408889634f;

struct Params {
  const float *x, *c, *ctx, *c_ctx, *norm1_g, *norm2_g, *w_ada, *b_ada, *w_in, *conv_w, *conv_b, *conv_ln_g,
      *conv_ln_b, *na_rel_bias, *gqa_q_norm, *gqa_k_norm, *w_out, *peer_w_q, *peer_keys, *peer_u, *peer_v, *final_norm_g;
  float* out;
  bf16 *win, *wout, *wq, *pk;
  unsigned char *pu8, *pv8;
  float *esc;
  float *ssq16, *hs8;
  bf16 *XB;
  float *cqp, *cq;
  bf16 *H2;
  signed char* hq;
  float *modp, *mod, *ropetab;
  bf16 *H, *U, *QN, *KN, *VNt, *QG, *KG, *VGt, *CAT;
  float *XC;
  int* ridx;
  float* rg;
  unsigned* bar;
  unsigned* qctr;
  int never;
  int pad_;
};

DI int tid_now() { int t; asm volatile("v_mov_b32 %0, %1" : "=v"(t) : "v"((int)__builtin_amdgcn_workitem_id_x())); return t; }
DI unsigned pack2(float a, float b) {
  f2_t v = {a, b};
  bf2_t r = __builtin_convertvector(v, bf2_t);
  return __builtin_bit_cast(unsigned, r);
}
DI float bf_lo(unsigned u) { return __uint_as_float(u << 16); }
DI float bf_hi(unsigned u) { return __uint_as_float(u & 0xffff0000u); }
DI int sidx(int r) { return (r >> 2) * 32 + (r & 3); }
DI int crow(int e, int h) { return (e & 3) + 8 * (e >> 2) + 4 * h; }
DI float fexp2(float x) { return __builtin_amdgcn_exp2f(x); }
DI float silu_f(float x) { return x / (1.f + __expf(-x)); }
DI float sigmoid_f(float x) { return 1.f / (1.f + __expf(-x)); }
DI float gelu_tanh(float x) {
  float u = 0.7978845608028654f * (x + 0.044715f * x * x * x);
  float t = 1.f - 2.f / (1.f + __expf(2.f * u));
  return 0.5f * x * (1.f + t);
}
DI float shx(float v, int m, int lane) { return __int_as_float(__builtin_amdgcn_ds_bpermute((lane ^ m) << 2, __float_as_int(v))); }
DI int shxi(int v, int m, int lane) { return __builtin_amdgcn_ds_bpermute((lane ^ m) << 2, v); }
DI float wave_sum(float v, int lane) {
#pragma unroll
  for (int o = 32; o >= 1; o >>= 1) v += shx(v, o, lane);
  return v;
}
DI float* xres_row(const Params& p, int row) { return row < NTOK ? p.out + (size_t)row * D : p.XC + (size_t)(row - NTOK) * D; }
DI const float* xin_row(const Params& p, int layer, int row) {
  if (layer == 0) return row < NTOK ? p.x + (size_t)row * D : p.ctx + (size_t)(row - NTOK) * D;
  return xres_row(p, row);
}
DI int mod_row(int row) { return row < NTOK ? (row >> 11) : 16; }
DI int batch_of(int row) { return row < NTOK ? (row >> 11) : ((row - NTOK) >> 8); }
DI int pos_of(int row) { return row < NTOK ? (row & 2047) : (T + ((row - NTOK) & 255)); }

DI int perm_in(int n) {
  if (n >= 512) return n;
  int c = n >> 6, w = n & 63;
  return w < 32 ? 32 * c + w : 256 + 32 * c + (w - 32);
}
DI size_t fm_index(int n, int k) { return ((size_t)(n >> 5) * 64 + (k >> 4)) * 512 + ((((k >> 3) & 1) * 32 + (n & 31)) * 8) + (k & 7); }
DI void convT_tile(const float* __restrict__ src, bf16* __restrict__ dst, int K, int N, int k0, int n0, bool perm, float* tile  ) {
  const int tx = tid_now() & 63, ty = tid_now() >> 6;
  const int ns = perm ? perm_in(n0 + tx) : n0 + tx;
#pragma unroll
  for (int i = 0; i < 16; ++i) { int k = ty + 4 * i; tile[k * 65 + tx] = src[(size_t)(k0 + k) * N + ns]; }
  __syncthreads();
#pragma unroll
  for (int i = 0; i < 2; ++i) {
    const int pr = tid_now() + 256 * i;
    const int n = pr & 63, kc = pr >> 6;
    const float* t = tile + (kc * 8) * 65 + n;
    u32x4 o = {pack2(t[0], t[65]), pack2(t[2 * 65], t[3 * 65]), pack2(t[4 * 65], t[5 * 65]), pack2(t[6 * 65], t[7 * 65])};
    *(u32x4*)(dst + fm_index(n0 + n, k0 + kc * 8)) = o;
  }
  __syncthreads();
}
constexpr int CONVT_ITEMS = 2 * 1344;
DI void stage_convT(const Params& p, int item, char* smem) {
  float* tile = (float*)smem;
  int l = item / 1344, r = item % 1344;
  if (r < 576) { int kt = r / 36, nt = r % 36; convT_tile(p.w_in + (size_t)l * D * INC, p.win + (size_t)l * INC * D, D, INC, kt * 64, nt * 64, true, tile); }
  else if (r < 832) { r -= 576; int kt = r / 16, nt = r % 16; convT_tile(p.w_out + (size_t)l * D * D, p.wout + (size_t)l * D * D, D, D, kt * 64, nt * 64, false, tile); }
  else { r -= 832; int kt = r / 32, nt = r % 32; convT_tile(p.peer_w_q + (size_t)l * D * 2048, p.wq + (size_t)l * 2048 * D, D, 2048, kt * 64, nt * 64, false, tile); }
}
constexpr size_t PK_N = (size_t)2 * 16 * 128 * 128, PU_N = (size_t)2 * NEXP * D;
constexpr float SU = 1024.f, SV = 64.f;
constexpr int CONVK_ITEMS = (int)(PK_N / 2048), CONVV_ITEMS = (int)(PU_N / 4096), CONVU_ITEMS = 2 * NEXP / 4;
constexpr int CONVS_ITEMS = CONVK_ITEMS + CONVV_ITEMS + CONVU_ITEMS;
DI unsigned pack_fp8x4(float4 a, float s) {
  int r = 0;
  r = __builtin_amdgcn_cvt_pk_fp8_f32(a.x * s, a.y * s, r, false);
  r = __builtin_amdgcn_cvt_pk_fp8_f32(a.z * s, a.w * s, r, true);
  return (unsigned)r;
}
DI unsigned pack_i8x4(float4 a, float s) {
  const int x = (int)rintf(a.x * s), y = (int)rintf(a.y * s), z = (int)rintf(a.z * s), w = (int)rintf(a.w * s);
  return (unsigned)(x & 255) | ((unsigned)(y & 255) << 8) | ((unsigned)(z & 255) << 16) | ((unsigned)(w & 255) << 24);
}
DI void stage_convS(const Params& p, int item) {
  if (item < CONVK_ITEMS) {
    size_t e = (size_t)item * 2048 + tid_now() * 8;
    const float* src = p.peer_keys + e;
    float4 a = ((const float4*)src)[0], b = ((const float4*)src)[1];
    u32x4 o = {pack2(a.x, a.y), pack2(a.z, a.w), pack2(b.x, b.y), pack2(b.z, b.w)};
    *(u32x4*)(p.pk + e) = o;
    return;
  }
  item -= CONVK_ITEMS;
  if (item < CONVV_ITEMS) {
    size_t e = (size_t)item * 4096 + tid_now() * 16;
    const float* src = p.peer_v + e;
    float4 a = ((const float4*)src)[0], b = ((const float4*)src)[1], c = ((const float4*)src)[2], d = ((const float4*)src)[3];
    u32x4 o = {pack_fp8x4(a, SV), pack_fp8x4(b, SV), pack_fp8x4(c, SV), pack_fp8x4(d, SV)};
    *(u32x4*)(p.pv8 + e) = o;
    return;
  }
  item -= CONVV_ITEMS;
  {
    const int lane = tid_now() & 63, wave = tid_now() >> 6;
    const int r = item * 4 + wave;
    const float* src = p.peer_u + (size_t)r * D + lane * 16;
    float4 a = ((const float4*)src)[0], b = ((const float4*)src)[1], c = ((const float4*)src)[2], d = ((const float4*)src)[3];
    float m = fmaxf(fmaxf(fmaxf(fabsf(a.x), fabsf(a.y)), fmaxf(fabsf(a.z), fabsf(a.w))), fmaxf(fmaxf(fabsf(b.x), fabsf(b.y)), fmaxf(fabsf(b.z), fabsf(b.w))));
    m = fmaxf(m, fmaxf(fmaxf(fmaxf(fabsf(c.x), fabsf(c.y)), fmaxf(fabsf(c.z), fabsf(c.w))), fmaxf(fmaxf(fabsf(d.x), fabsf(d.y)), fmaxf(fabsf(d.z), fabsf(d.w)))));
#pragma unroll
    for (int o = 32; o >= 1; o >>= 1) m = fmaxf(m, shx(m, o, lane));
    m = fmaxf(m, 1e-30f);
    const float s = 127.f / m;
    u32x4 o = {pack_i8x4(a, s), pack_i8x4(b, s), pack_i8x4(c, s), pack_i8x4(d, s)};
    *(u32x4*)(p.pu8 + (size_t)r * D + lane * 16) = o;
  }
}
DI float dotbf(unsigned a, unsigned b, float acc) {
  const bf2_t x = __builtin_bit_cast(bf2_t, a), y = __builtin_bit_cast(bf2_t, b);
  return __builtin_amdgcn_fdot2_f32_bf16(x, y, acc, false);
}
DI void stage_convU(const Params& p, int l, int f0, int f1, char* smem) {
  if (f0 >= f1) return;
  const int tid = tid_now(), lane = tid & 63, wave = tid >> 6;
  __syncthreads();
  for (int i = tid; i < 17 * 128; i += 256) {
    const int mr = i >> 7, c8 = i & 127;
    const float* sp = p.mod + ((size_t)l * 17 + mr) * 6144 + 3072 + c8 * 8;
    const float4 s0 = ((const float4*)sp)[0], s1 = ((const float4*)sp)[1];
    u32x4 o = {pack2(s0.x, s0.y), pack2(s0.z, s0.w), pack2(s1.x, s1.y), pack2(s1.z, s1.w)};
    *(u32x4*)(smem + ((mr * 2 + (c8 & 1)) * 64 + (c8 >> 1)) * 16) = o;
  }
  __syncthreads();
#pragma unroll 1
  for (int f = f0; f < f1; ++f) {
    const int r = (l * (NEXP / 4) + f) * 4 + wave;
    const float* src = p.peer_u + (size_t)r * D + lane * 16;
    float4 a = ((const float4*)src)[0], b = ((const float4*)src)[1], c = ((const float4*)src)[2], d = ((const float4*)src)[3];
    float m = fmaxf(fmaxf(fmaxf(fabsf(a.x), fabsf(a.y)), fmaxf(fabsf(a.z), fabsf(a.w))), fmaxf(fmaxf(fabsf(b.x), fabsf(b.y)), fmaxf(fabsf(b.z), fabsf(b.w))));
    m = fmaxf(m, fmaxf(fmaxf(fmaxf(fabsf(c.x), fabsf(c.y)), fmaxf(fabsf(c.z), fabsf(c.w))), fmaxf(fmaxf(fabsf(d.x), fabsf(d.y)), fmaxf(fabsf(d.z), fabsf(d.w)))));
#pragma unroll
    for (int o = 32; o >= 1; o >>= 1) m = fmaxf(m, shx(m, o, lane));
    m = fmaxf(m, 1e-30f);
    const float s = 127.f / m;
    u32x4 o = {pack_i8x4(a, s), pack_i8x4(b, s), pack_i8x4(c, s), pack_i8x4(d, s)};
    *(u32x4*)(p.pu8 + (size_t)r * D + lane * 16) = o;
    const unsigned u0 = pack2(a.x, a.y), u1 = pack2(a.z, a.w), u2 = pack2(b.x, b.y), u3 = pack2(b.z, b.w);
    const unsigned u4 = pack2(c.x, c.y), u5 = pack2(c.z, c.w), u6 = pack2(d.x, d.y), u7 = pack2(d.z, d.w);
    float tv[17];
#pragma unroll
    for (int mr = 0; mr < 17; ++mr) {
      const u32x4 sa = *(const u32x4*)(smem + ((mr * 2) * 64 + lane) * 16), sb = *(const u32x4*)(smem + ((mr * 2 + 1) * 64 + lane) * 16);
      const unsigned a0 = sa[0], a1 = sa[1], a2 = sa[2], a3 = sa[3], b0 = sb[0], b1 = sb[1], b2 = sb[2], b3 = sb[3];
      float t = dotbf(u0, a0, 0.f); t = dotbf(u1, a1, t); t = dotbf(u2, a2, t); t = dotbf(u3, a3, t);
      t = dotbf(u4, b0, t); t = dotbf(u5, b1, t); t = dotbf(u6, b2, t); t = dotbf(u7, b3, t);
      tv[mr] = t;
      if ((mr & 3) == 3) asm volatile("" ::: "memory");
    }
    const float t16 = wave_sum(tv[16], lane);
    float r8[8], r4[4], r2[2], r1;
    {
      const bool up = lane & 1;
#pragma unroll
      for (int k = 0; k < 8; ++k) { const float keep = up ? tv[k + 8] : tv[k], give = up ? tv[k] : tv[k + 8]; r8[k] = keep + shx(give, 1, lane); }
    }
    {
      const bool up = lane & 2;
#pragma unroll
      for (int k = 0; k < 4; ++k) { const float keep = up ? r8[k + 4] : r8[k], give = up ? r8[k] : r8[k + 4]; r4[k] = keep + shx(give, 2, lane); }
    }
    {
      const bool up = lane & 4;
#pragma unroll
      for (int k = 0; k < 2; ++k) { const float keep = up ? r4[k + 2] : r4[k], give = up ? r4[k] : r4[k + 2]; r2[k] = keep + shx(give, 4, lane); }
    }
    {
      const bool up = lane & 8;
      const float keep = up ? r2[1] : r2[0], give = up ? r2[0] : r2[1];
      r1 = keep + shx(give, 8, lane);
    }
    r1 += shx(r1, 16, lane);
    r1 += shx(r1, 32, lane);
    const int idx = 8 * (lane & 1) + 4 * ((lane >> 1) & 1) + 2 * ((lane >> 2) & 1) + ((lane >> 3) & 1);
    float* er = p.esc + (size_t)r * 64;
    const float2 ov = {lane < 16 ? r1 : t16, m * (1.f / 127.f)};
    if (lane < 17) *(float2*)(er + 2 * (lane < 16 ? idx : 16)) = ov;
  }
  __syncthreads();
}
constexpr int CQ_KS = 32;
constexpr int CQP_ITEMS = 2 * CQ_KS * 8;
DI void stage_cq_partial(const Params& p, int item, char* smem) {
  float* sc = (float*)smem;
  const int l = item / (CQ_KS * 8), r = item % (CQ_KS * 8), kc = r >> 3, nc = r & 7;
  for (int i = tid_now(); i < 17 * 32; i += 256) {
    const int rr = i >> 5, k = i & 31;
    sc[i] = p.mod[((size_t)l * 17 + rr) * 6144 + 3072 + kc * 32 + k];
  }
  const int n = nc * 256 + tid_now();
  const float* w = p.peer_w_q + ((size_t)l * D + kc * 32) * 2048 + n;
  float wv[32];
#pragma unroll
  for (int k = 0; k < 32; ++k) wv[k] = w[(size_t)k * 2048];
  __syncthreads();
  float acc[17];
#pragma unroll
  for (int i = 0; i < 17; ++i) acc[i] = 0.f;
#pragma unroll
  for (int k4 = 0; k4 < 8; ++k4)
#pragma unroll
    for (int i = 0; i < 17; ++i) {
      const float4 s = *(const float4*)(sc + i * 32 + k4 * 4);
      acc[i] += s.x * wv[4 * k4] + s.y * wv[4 * k4 + 1] + s.z * wv[4 * k4 + 2] + s.w * wv[4 * k4 + 3];
    }
#pragma unroll
  for (int i = 0; i < 17; ++i) p.cqp[(((size_t)l * CQ_KS + kc) * 17 + i) * 2048 + n] = acc[i];
  __syncthreads();
}
constexpr int CQR_ITEMS = 2 * 17 * 2048 / 256;
DI void stage_cq_reduce(const Params& p, int item) {
  const int idx = item * 256 + tid_now();
  const int l = idx / (17 * 2048), rem = idx % (17 * 2048);
  float v[CQ_KS];
#pragma unroll
  for (int kc = 0; kc < CQ_KS; ++kc) v[kc] = p.cqp[((size_t)l * CQ_KS + kc) * 17 * 2048 + rem];
  float s = 0.f;
#pragma unroll
  for (int kc = 0; kc < CQ_KS; ++kc) s += v[kc];
  p.cq[idx] = s;
}
DI void stage_rope(const Params& p) {
  for (int i = tid_now(); i < 64 * 16; i += 256) {
    int pos = i >> 4, f = i & 15;
    float inv = powf(10000.f, -(float)f / 16.f);
    float ang = (float)pos * inv;
    p.ropetab[2 * i] = cosf(ang); p.ropetab[2 * i + 1] = sinf(ang);
  }
}

constexpr int MODP_ITEMS = 2 * 8 * 24;
DI void stage_mod_partial(const Params& p, int item, char* smem) {
  float* sc = (float*)smem;
  int l = item / 192, r = item % 192, kc = r / 24, nc = r % 24;
  for (int i = tid_now(); i < 17 * 128; i += 256) {
    int rr = i >> 7, k = i & 127;
    float v = rr < 16 ? p.c[rr * D + kc * 128 + k] : p.c_ctx[kc * 128 + k];
    sc[i] = silu_f(v);
  }
  __syncthreads();
  float acc[17];
#pragma unroll
  for (int i = 0; i < 17; ++i) acc[i] = 0.f;
  const int n = nc * 256 + tid_now();
  const float* w = p.w_ada + ((size_t)l * D + kc * 128) * 6144 + n;
#pragma unroll 1
  for (int k0 = 0; k0 < 128; k0 += 32) {
    float wv[32];
#pragma unroll
    for (int k = 0; k < 32; ++k) wv[k] = w[(size_t)(k0 + k) * 6144];
#pragma unroll
    for (int k4 = 0; k4 < 8; ++k4)
#pragma unroll
      for (int i = 0; i < 17; ++i) {
        const float4 s = *(const float4*)(sc + i * 128 + k0 + k4 * 4);
        acc[i] += s.x * wv[4 * k4] + s.y * wv[4 * k4 + 1] + s.z * wv[4 * k4 + 2] + s.w * wv[4 * k4 + 3];
      }
  }
#pragma unroll
  for (int i = 0; i < 17; ++i) p.modp[(((size_t)l * 8 + kc) * 17 + i) * 6144 + n] = acc[i];
  __syncthreads();
}
constexpr int MODR_ITEMS = 2 * 17 * 6144 / 256;
DI void stage_mod_reduce(const Params& p, int item) {
  int idx = item * 256 + tid_now();
  int l = idx / (17 * 6144), rem = idx % (17 * 6144), n = rem % 6144;
  float s = p.b_ada[l * 6144 + n];
#pragma unroll
  for (int kc = 0; kc < 8; ++kc) s += p.modp[((size_t)l * 8 + kc) * 17 * 6144 + rem];
  p.mod[idx] = s;
}

DI void norm_row(const Params& p, const float* __restrict__ xr, const float* __restrict__ g, const float* __restrict__ sh,
                 const float* __restrict__ sc, bf16* __restrict__ hr, signed char* __restrict__ hq = nullptr, float* __restrict__ hsc = nullptr) {
  const int lane = tid_now() & 63;
  float4 v[4]; float ss = 0.f;
#pragma unroll
  for (int i = 0; i < 4; ++i) { v[i] = ((const float4*)xr)[lane + 64 * i]; ss += v[i].x * v[i].x + v[i].y * v[i].y + v[i].z * v[i].z + v[i].w * v[i].w; }
  ss = wave_sum(ss, lane);
  const float rstd = rsqrtf(ss * (1.f / D) + EPS);
#pragma unroll
  for (int i = 0; i < 4; ++i) {
    float4 gg = ((const float4*)g)[lane + 64 * i], s1 = ((const float4*)sh)[lane + 64 * i], s2 = ((const float4*)sc)[lane + 64 * i];
    float a = v[i].x * rstd * gg.x * (1.f + s2.x) + s1.x, b = v[i].y * rstd * gg.y * (1.f + s2.y) + s1.y;
    float c = v[i].z * rstd * gg.z * (1.f + s2.z) + s1.z, d = v[i].w * rstd * gg.w * (1.f + s2.w) + s1.w;
    u32x2 o = {pack2(a, b), pack2(c, d)};
    ((u32x2*)hr)[lane + 64 * i] = o;
    v[i].x = a; v[i].y = b; v[i].z = c; v[i].w = d;
  }
  if (hq != nullptr) {
    float m = 0.f;
#pragma unroll
    for (int i = 0; i < 4; ++i) m = fmaxf(m, fmaxf(fmaxf(fabsf(v[i].x), fabsf(v[i].y)), fmaxf(fabsf(v[i].z), fabsf(v[i].w))));
#pragma unroll
    for (int o = 32; o >= 1; o >>= 1) m = fmaxf(m, shx(m, o, lane));
    m = fmaxf(m, 1e-30f);
    const float s = 127.f / m;
#pragma unroll
    for (int i = 0; i < 4; ++i) ((unsigned*)hq)[lane + 64 * i] = pack_i8x4(v[i], s);
    if (lane == 0) *hsc = m * (1.f / 127.f);
  }
}
DI void stage_norm(const Params& p, int layer, int which, int item) {
  const int lane = tid_now() & 63;
  const int rowa = item * 8 + (tid_now() >> 6) * 2;
  const float* g = (which == 0 ? p.norm1_g : p.norm2_g) + layer * D;
  const float* mm = p.mod + ((size_t)layer * 17 + mod_row(rowa)) * 6144 + (which == 0 ? 0 : 3072);
  float4 v[2][4], gg[4], s1[4], s2[4];
#pragma unroll
  for (int j = 0; j < 2; ++j) {
    if (layer == 0) {
      const float* xr = xin_row(p, 0, rowa + j);
      u32x2* xw = (u32x2*)(p.XB + (size_t)(rowa + j) * D);
#pragma unroll
      for (int i = 0; i < 4; ++i) {
        v[j][i] = ((const float4*)xr)[lane + 64 * i];
        u32x2 o = {pack2(v[j][i].x, v[j][i].y), pack2(v[j][i].z, v[j][i].w)};
        xw[lane + 64 * i] = o;
      }
    } else {
      const u32x2* xr = (const u32x2*)(p.XB + (size_t)(rowa + j) * D);
#pragma unroll
      for (int i = 0; i < 4; ++i) { const u32x2 t = xr[lane + 64 * i]; const unsigned t0 = t[0], t1 = t[1]; v[j][i] = float4{bf_lo(t0), bf_hi(t0), bf_lo(t1), bf_hi(t1)}; }
    }
  }
#pragma unroll
  for (int i = 0; i < 4; ++i) { gg[i] = ((const float4*)g)[lane + 64 * i]; s1[i] = ((const float4*)mm)[lane + 64 * i]; s2[i] = ((const float4*)(mm + D))[lane + 64 * i]; }
#pragma unroll
  for (int j = 0; j < 2; ++j) {
    float ss = 0.f;
#pragma unroll
    for (int i = 0; i < 4; ++i) ss += v[j][i].x * v[j][i].x + v[j][i].y * v[j][i].y + v[j][i].z * v[j][i].z + v[j][i].w * v[j][i].w;
    ss = wave_sum(ss, lane);
    const float rstd = rsqrtf(ss * (1.f / D) + EPS);
    bf16* hr = p.H + (size_t)(rowa + j) * D;
#pragma unroll
    for (int i = 0; i < 4; ++i) {
      const float a = v[j][i].x * rstd * gg[i].x * (1.f + s2[i].x) + s1[i].x, b = v[j][i].y * rstd * gg[i].y * (1.f + s2[i].y) + s1[i].y;
      const float c = v[j][i].z * rstd * gg[i].z * (1.f + s2[i].z) + s1[i].z, d = v[j][i].w * rstd * gg[i].w * (1.f + s2[i].w) + s1[i].w;
      u32x2 o = {pack2(a, b), pack2(c, d)};
      ((u32x2*)hr)[lane + 64 * i] = o;
    }
  }
}
DI void stage_final(const Params& p, int item) {
  const int lane = tid_now() & 63;
  const int rowa = item * 8 + (tid_now() >> 6) * 2;
  float4 v[2][4], gg[4];
#pragma unroll
  for (int j = 0; j < 2; ++j) {
    const u32x2* xr = (const u32x2*)(p.XB + (size_t)(rowa + j) * D);
#pragma unroll
    for (int i = 0; i < 4; ++i) { const u32x2 t = xr[lane + 64 * i]; const unsigned t0 = t[0], t1 = t[1]; v[j][i] = float4{bf_lo(t0), bf_hi(t0), bf_lo(t1), bf_hi(t1)}; }
  }
#pragma unroll
  for (int i = 0; i < 4; ++i) gg[i] = ((const float4*)p.final_norm_g)[lane + 64 * i];
#pragma unroll
  for (int j = 0; j < 2; ++j) {
    float ss = 0.f;
#pragma unroll
    for (int i = 0; i < 4; ++i) ss += v[j][i].x * v[j][i].x + v[j][i].y * v[j][i].y + v[j][i].z * v[j][i].z + v[j][i].w * v[j][i].w;
    ss = wave_sum(ss, lane);
    const float rstd = rsqrtf(ss * (1.f / D) + EPS);
#pragma unroll
    for (int i = 0; i < 4; ++i) {
      float4 o = {v[j][i].x * rstd * gg[i].x, v[j][i].y * rstd * gg[i].y, v[j][i].z * rstd * gg[i].z, v[j][i].w * rstd * gg[i].w};
      ((float4*)(p.out + (size_t)(rowa + j) * D))[lane + 64 * i] = o;
    }
  }
}

constexpr int LROW = 144;
constexpr int LTILE = 128 * LROW;
constexpr int GEMM_SMEM = 2 * LTILE;

template <bool ORIENT_T, bool PEEL = false>
DI void gemm_core(const bf16* __restrict__ A, const bf16* __restrict__ W, char* smem, f32x16 (&acc)[2][2]) {
  const int tid = tid_now(), lane = tid & 63, wave = tid >> 6;
  const int wm = wave >> 1, wn = wave & 1, l31 = lane & 31, hh = lane >> 5;
  const int lrow = tid >> 3, kc = tid & 7;
#pragma unroll
  for (int i = 0; i < 2; ++i)
#pragma unroll
    for (int j = 0; j < 2; ++j)
#pragma unroll
      for (int e = 0; e < 16; ++e) acc[i][j][e] = 0.f;
  u32x4 ra[4];
  bf16x8 wf[2][4];
  const bf16* ap = A + (size_t)lrow * D + kc * 8;
  const bf16* wp = W + (size_t)(wn * 2) * 64 * 512 + lane * 8;
#pragma unroll
  for (int i = 0; i < 4; ++i) ra[i] = *(const u32x4*)(ap + (size_t)(32 * i) * D);
  if (PEEL) {
#pragma unroll
    for (int s = 0; s < 4; ++s)
#pragma unroll
      for (int ft = 0; ft < 2; ++ft) wf[ft][s] = *(const bf16x8*)(wp + (size_t)(ft * 64 + s) * 512);
    __builtin_amdgcn_sched_barrier(0);
  } else {
#pragma unroll
    for (int ft = 0; ft < 2; ++ft)
#pragma unroll
      for (int s = 0; s < 4; ++s) wf[ft][s] = *(const bf16x8*)(wp + (size_t)(ft * 64 + s) * 512);
  }
  auto ktile = [&](const int kt, const bool more) {
    char* sa = smem + (kt & 1) * LTILE;
#pragma unroll
    for (int i = 0; i < 4; ++i) *(u32x4*)(sa + (lrow + 32 * i) * LROW + kc * 16) = ra[i];
    __syncthreads();
    if (more) {
#pragma unroll
      for (int i = 0; i < 4; ++i) ra[i] = *(const u32x4*)(ap + (size_t)(32 * i) * D + (kt + 1) * 64);
    }
    if (PEEL) __builtin_amdgcn_sched_barrier(0);
#pragma unroll
    for (int s = 0; s < 4; ++s) {
      bf16x8 af[2];
#pragma unroll
      for (int t = 0; t < 2; ++t) af[t] = *(const bf16x8*)(sa + (wm * 64 + t * 32 + l31) * LROW + (s * 16 + hh * 8) * 2);
#pragma unroll
      for (int ft = 0; ft < 2; ++ft)
#pragma unroll
        for (int tt = 0; tt < 2; ++tt)
          acc[ft][tt] = ORIENT_T ? MFMA(wf[ft][s], af[tt], acc[ft][tt]) : MFMA(af[tt], wf[ft][s], acc[ft][tt]);
      if (more) {
#pragma unroll
        for (int ft = 0; ft < 2; ++ft) wf[ft][s] = *(const bf16x8*)(wp + (size_t)(ft * 64 + (kt + 1) * 4 + s) * 512);
      }
      if (PEEL) __builtin_amdgcn_sched_barrier(0);
    }
    };
  if (PEEL) {
#pragma unroll 1
    for (int kt = 0; kt < 15; ++kt) ktile(kt, true);
    ktile(15, false);
  } else {
#pragma unroll 1
    for (int kt = 0; kt < 16; ++kt) ktile(kt, kt + 1 < 16);
  }
  __syncthreads();
}

constexpr int INPROJ_ITEMS = 288 * 18;
DI void store4(bf16* dst, float a, float b, float c, float d) { u32x2 o = {pack2(a, b), pack2(c, d)}; *(u32x2*)dst = o; }
DI void store_pair(bf16* rowbase, int hh, float a0, float a1, float a2, float a3, float b0, float b1, float b2, float b3) {
  unsigned ax = pack2(a0, a1), ay = pack2(a2, a3), bx = pack2(b0, b1), by = pack2(b2, b3);
  const auto r0 = __builtin_amdgcn_permlane32_swap(ax, bx, false, false); ax = r0[0]; bx = r0[1];
  const auto r1 = __builtin_amdgcn_permlane32_swap(ay, by, false, false); ay = r1[0]; by = r1[1];
  u32x4 o = {ax, ay, bx, by};
  *(u32x4*)(rowbase + hh * 8) = o;
}

DI void stage_inproj(const Params& p, int layer, int item, char* smem) {
  const int mt = item / 18, nt = item % 18;
  if (layer == 1 && mt >= 256 && nt < 10) return;
  const int row0 = mt * 128, n0 = nt * 128;
  const bf16* A = p.H + (size_t)row0 * D;
  const bf16* W = p.win + ((size_t)layer * INC + n0) * D;
  const int lane = tid_now() & 63, wave = tid_now() >> 6, wm = wave >> 1, wn = wave & 1, l31 = lane & 31, hh = lane >> 5;
  const bool vtile = (nt >= 13 && nt <= 15) || nt == 17;
  f32x16 acc[2][2];
  const int b = batch_of(row0);
  if (vtile) {
    gemm_core<false, true>(A, W, smem, acc);
    bf16* base; int head;
    if (nt == 17) { head = wn; base = p.VGt + ((size_t)(b * 2 + head) * 64) * SEQ2; }
    else { head = (nt - 13) * 2 + wn; base = p.VNt + ((size_t)(b * 6 + head) * 64) * SEQ2; }
    const int pos0 = pos_of(row0) + wm * 64;
#pragma unroll
    for (int ft = 0; ft < 2; ++ft) {
      const int d = ft * 32 + l31;
#pragma unroll
      for (int tt = 0; tt < 2; ++tt)
#pragma unroll
        for (int g = 0; g < 4; g += 2)
          store_pair(base + (size_t)d * SEQ2 + pos0 + tt * 32 + 8 * g, hh, acc[ft][tt][4 * g], acc[ft][tt][4 * g + 1], acc[ft][tt][4 * g + 2], acc[ft][tt][4 * g + 3],
                     acc[ft][tt][4 * g + 4], acc[ft][tt][4 * g + 5], acc[ft][tt][4 * g + 6], acc[ft][tt][4 * g + 7]);
    }
    return;
  }
  gemm_core<true, true>(A, W, smem, acc);
  const int chunk = nt * 2 + wn;
#pragma unroll
  for (int tt = 0; tt < 2; ++tt) {
    const int row = row0 + wm * 64 + tt * 32 + l31;
    const int pos = pos_of(row);
    const bool isctx = row >= NTOK;
    if (chunk < 8) {
      bf16* dst = p.U + (size_t)row * 256 + 32 * chunk;
#pragma unroll
      for (int g = 0; g < 4; g += 2) {
        float u[8];
#pragma unroll
        for (int j = 0; j < 8; ++j) u[j] = acc[0][tt][4 * g + j] * sigmoid_f(acc[1][tt][4 * g + j]);
        store_pair(dst + 8 * g, hh, u[0], u[1], u[2], u[3], u[4], u[5], u[6], u[7]);
      }
    } else if (chunk < 14 || (chunk >= 20 && chunk < 26)) {
      const bool isq = chunk < 14;
      const int head = isq ? chunk - 8 : chunk - 20;
      const float sc = isq ? 0.125f : 1.f;
      bf16* dst = (isq ? p.QN : p.KN) + ((size_t)(b * 6 + head) * SEQ2 + pos) * 64;
#pragma unroll
      for (int ft = 0; ft < 2; ++ft)
#pragma unroll
        for (int g = 0; g < 4; g += 2)
          store_pair(dst + ft * 32 + 8 * g, hh, acc[ft][tt][4 * g] * sc, acc[ft][tt][4 * g + 1] * sc, acc[ft][tt][4 * g + 2] * sc, acc[ft][tt][4 * g + 3] * sc,
                     acc[ft][tt][4 * g + 4] * sc, acc[ft][tt][4 * g + 5] * sc, acc[ft][tt][4 * g + 6] * sc, acc[ft][tt][4 * g + 7] * sc);
    } else {
      const bool isq = chunk < 20;
      const int head = isq ? chunk - 14 : chunk - 32;
      const float* gn = (isq ? p.gqa_q_norm : p.gqa_k_norm) + layer * 64;
      float ss = 0.f;
#pragma unroll
      for (int ft = 0; ft < 2; ++ft)
#pragma unroll
        for (int e = 0; e < 16; ++e) ss += acc[ft][tt][e] * acc[ft][tt][e];
      ss += shx(ss, 32, lane);
      const float rstd = rsqrtf(ss * (1.f / 64.f) + EPS) ;
      const float sc = isq ? 0.125f : 1.f;
      bf16* dst = (isq ? p.QG + ((size_t)(b * 6 + head) * SEQ2 + pos) * 64 : p.KG + ((size_t)(b * 2 + head) * SEQ2 + pos) * 64);
      const int prow = pos >> 6, pcol = pos & 63;
#pragma unroll
      for (int g = 0; g < 4; g += 2) {
        float o1[8], o2[8];
#pragma unroll
        for (int j = 0; j < 8; ++j) {
          const int gg = g + (j >> 2);
          const int i = 8 * gg + 4 * hh + (j & 3);
          float x1 = acc[0][tt][4 * g + j] * rstd * gn[i];
          float x2 = acc[1][tt][4 * g + j] * rstd * gn[32 + i];
          if (!isctx && PROBE != 13) {
            const int ppos = (gg < 2) ? prow : pcol;
            const float2 cs = *(const float2*)(p.ropetab + 2 * (ppos * 16 + (i & 15)));
            float y1 = x1 * cs.x - x2 * cs.y, y2 = x1 * cs.y + x2 * cs.x;
            x1 = y1; x2 = y2;
          }
          o1[j] = x1 * sc; o2[j] = x2 * sc;
        }
        store_pair(dst + 8 * g, hh, o1[0], o1[1], o1[2], o1[3], o1[4], o1[5], o1[6], o1[7]);
        store_pair(dst + 32 + 8 * g, hh, o2[0], o2[1], o2[2], o2[3], o2[4], o2[5], o2[6], o2[7]);
      }
    }
  }
}

constexpr int CONV_TT = 16;
constexpr int CONV_SMEM = (CONV_TT + 30) * 512 + CONV_TT * 1024;
DI void stage_conv(const Params& p, int layer, int item, char* smem) {
  bf16* ub = (bf16*)smem;
  float* yb = (float*)(smem + (CONV_TT + 30) * 512);
  const int tid = tid_now();
  int row0, seq_lo, seq_hi;
  constexpr int NLAT = NTOK / CONV_TT;
  if (item < NLAT) { row0 = item * CONV_TT; seq_lo = row0 & ~2047; seq_hi = seq_lo + 2048; }
  else { row0 = NTOK + (item - NLAT) * CONV_TT; seq_lo = NTOK + (((item - NLAT) * CONV_TT) & ~255); seq_hi = seq_lo + 256; }
  for (int c = tid; c < (CONV_TT + 30) * 32; c += 256) {
    int r = c >> 5, cc = c & 31;
    int row = row0 - 15 + r;
    u32x4 v = {0u, 0u, 0u, 0u};
    if (row >= seq_lo && row < seq_hi) v = *(const u32x4*)(p.U + (size_t)row * 256 + cc * 8);
    *(u32x4*)(ub + r * 256 + cc * 8) = v;
  }
  __syncthreads();
  {
    const int ch = tid;
    float w[31];
#pragma unroll
    for (int j = 0; j < 31; ++j) w[j] = p.conv_w[((size_t)layer * 31 + j) * 256 + ch];
    const float bias = p.conv_b[layer * 256 + ch];
#pragma unroll 1
    for (int t0 = 0; t0 < CONV_TT; t0 += 8) {
      float in[38];
#pragma unroll
      for (int j = 0; j < 38; ++j) in[j] = __uint_as_float((unsigned)ub[(t0 + j) * 256 + ch] << 16);
#pragma unroll
      for (int t = 0; t < 8; ++t) {
        float a = bias;
#pragma unroll
        for (int j = 0; j < 31; ++j) a += in[t + j] * w[j];
        yb[(t0 + t) * 256 + ch] = a;
      }
    }
  }
  __syncthreads();
  {
    const int wave = tid >> 6, lane = tid & 63;
    const float4 g = ((const float4*)(p.conv_ln_g + layer * 256))[lane], bb = ((const float4*)(p.conv_ln_b + layer * 256))[lane];
    for (int t = wave * (CONV_TT / 4); t < (wave + 1) * (CONV_TT / 4); ++t) {
      float4 v = ((const float4*)(yb + t * 256))[lane];
      float mu = wave_sum(v.x + v.y + v.z + v.w, lane) * (1.f / 256.f);
      float dx = v.x - mu, dy = v.y - mu, dz = v.z - mu, dw = v.w - mu;
      float var = wave_sum(dx * dx + dy * dy + dz * dz + dw * dw, lane) * (1.f / 256.f);
      float rs = rsqrtf(var + EPS);
      float a = silu_f(dx * rs * g.x + bb.x), b = silu_f(dy * rs * g.y + bb.y), c = silu_f(dz * rs * g.z + bb.z), d = silu_f(dw * rs * g.w + bb.w);
      store4(p.CAT + (size_t)(row0 + t) * D + lane * 4, a, b, c, d);
    }
  }
  __syncthreads();
}

DI int kperm(int i) { return (i & 19) | ((i & 4) << 1) | ((i & 8) >> 1); }
DI int keyoff(int e, int h) { return (e & 3) + 4 * ((e >> 2) & 1) + 8 * h + 16 * (e >> 3); }
DI bf16x8 pack8(const f32x16& x, int s) {
  u32x4 r = {pack2(x[8 * s], x[8 * s + 1]), pack2(x[8 * s + 2], x[8 * s + 3]), pack2(x[8 * s + 4], x[8 * s + 5]), pack2(x[8 * s + 6], x[8 * s + 7])};
  return __builtin_bit_cast(bf16x8, r);
}

constexpr int NA_ITEMS = 6144 / 4;
DI void stage_na(const Params& p, int layer, int item) {
  const int lane = tid_now() & 63, wave = tid_now() >> 6, l31 = lane & 31, hh = lane >> 5;
  const int wi = item * 4 + wave;
  const int qhalf = wi & 1, head = (wi >> 1) % 6, br = wi / 12, r = br & 31, b = br >> 5;
  const int r0 = min(max(r - 4, 0), 24);
  const size_t hb = (size_t)(b * 6 + head);
  const bf16* Q = p.QN + (hb * SEQ2 + r * 64 + qhalf * 32 + l31) * 64;
  const bf16* Kb = p.KN + hb * SEQ2 * 64;
  const bf16* Vb = p.VNt + hb * 64 * SEQ2;
  const float* bias = p.na_rel_bias + ((size_t)layer * 6 + head) * 15 * 31;
  bf16x8 qf[4];
#pragma unroll
  for (int s = 0; s < 4; ++s) qf[s] = *(const bf16x8*)(Q + 16 * s + 8 * hh);
  f32x16 o[2];
#pragma unroll
  for (int e = 0; e < 16; ++e) { o[0][e] = 0.f; o[1][e] = 0.f; }
  float m = -1e30f, l = 0.f;
  const int qc = qhalf * 32 + l31;
  const int c0 = min(max(qc - 8, 0), 48);
  const int kp = kperm(l31);
#pragma unroll 1
  for (int t = 0; t < 24; ++t) {
    int key0, brow = 0, cs = 0;
    const bool local = t >= 8;
    if (!local) key0 = T + t * 32;
    else { brow = (t - 8) >> 1; cs = (t - 8) & 1; key0 = (r0 + brow) * 64 + cs * 32; }
    f32x16 st;
#pragma unroll
    for (int e = 0; e < 16; ++e) st[e] = 0.f;
    const bf16* kr = Kb + (size_t)(key0 + kp) * 64 + 8 * hh;
#pragma unroll
    for (int s = 0; s < 4; ++s) { bf16x8 kf = *(const bf16x8*)(kr + 16 * s); st = MFMA(kf, qf[s], st); }
    if (local) {
      const int rb = (r0 + brow) - r + 7;
#pragma unroll
      for (int e = 0; e < 16; ++e) {
        const int kc = cs * 32 + keyoff(e, hh);
        const bool valid = (kc >= c0) && (kc < c0 + 16);
        const int ci = min(max(kc - qc + 15, 0), 30);
        const float bv = (PROBE == 12) ? 0.f : bias[rb * 31 + ci];
        st[e] = valid ? st[e] + bv : -1e30f;
      }
    }
    float mx = st[0];
#pragma unroll
    for (int e = 1; e < 16; ++e) mx = fmaxf(mx, st[e]);
    mx = fmaxf(mx, shx(mx, 32, lane));
    const float mn = fmaxf(m, mx);
    const float alpha = exp2f((m - mn) * L2E);
    float ls = 0.f;
#pragma unroll
    for (int e = 0; e < 16; ++e) { st[e] = exp2f((st[e] - mn) * L2E); ls += st[e]; }
    l = l * alpha + ls; m = mn;
#pragma unroll
    for (int e = 0; e < 16; ++e) { o[0][e] *= alpha; o[1][e] *= alpha; }
    bf16x8 pf0 = pack8(st, 0), pf1 = pack8(st, 1);
#pragma unroll
    for (int dt = 0; dt < 2; ++dt) {
      const bf16* vr = Vb + (size_t)(dt * 32 + l31) * SEQ2 + key0 + 8 * hh;
      bf16x8 v0 = *(const bf16x8*)(vr), v1 = *(const bf16x8*)(vr + 16);
      o[dt] = MFMA(v0, pf0, o[dt]);
      o[dt] = MFMA(v1, pf1, o[dt]);
    }
  }
  l += shx(l, 32, lane);
  const float inv = (PROBE == 10) ? 0.f : 1.f / l;
  bf16* dst = p.CAT + (size_t)(b * T + r * 64 + qc) * D + 256 + head * 64;
#pragma unroll
  for (int dt = 0; dt < 2; ++dt)
#pragma unroll
    for (int g = 0; g < 4; g += 2)
      store_pair(dst + dt * 32 + 8 * g, hh, o[dt][4 * g] * inv, o[dt][4 * g + 1] * inv, o[dt][4 * g + 2] * inv, o[dt][4 * g + 3] * inv,
                 o[dt][4 * g + 4] * inv, o[dt][4 * g + 5] * inv, o[dt][4 * g + 6] * inv, o[dt][4 * g + 7] * inv);
}

constexpr int NA2_ITEMS = 16 * 6 * 16;
DI void stage_na2(const Params& p, int layer, int item, char* smem) {
  const int tid = tid_now(), lane = tid & 63, wave = tid >> 6, l31 = lane & 31, hh = lane >> 5;
  const int lrow = tid >> 3, kc8 = tid & 7;
  const int rp = item & 15, head = (item >> 4) % 6, b = item / 96;
  const int qrow = 2 * rp + ((lane >> 4) & 1), qc = wave * 16 + (lane & 15);
  const int r0w = min(max(qrow - 4, 0), 24);
  const int rlo = min(max(2 * rp - 4, 0), 24), rhi = min(max(2 * rp - 3, 0), 24) + 7;
  const int ntile = 4 + (rhi - rlo + 1);
  const size_t hb = (size_t)(b * 6 + head);
  const bf16* K = p.KN + hb * SEQ2 * 64;
  const bf16* Vt = p.VNt + hb * 64 * SEQ2;
  float* bl = (float*)(smem + 2 * 2 * 64 * LROW);
  for (int i = tid; i < 15 * 31; i += 256) bl[i] = p.na_rel_bias[((size_t)layer * 6 + head) * 465 + i];
  bf16x8 qf[4];
  const bf16* qp = p.QN + (hb * SEQ2 + qrow * 64 + qc) * 64 + 8 * hh;
#pragma unroll
  for (int s = 0; s < 4; ++s) qf[s] = *(const bf16x8*)(qp + 16 * s);
  f32x16 o[2];
#pragma unroll
  for (int e = 0; e < 16; ++e) { o[0][e] = 0.f; o[1][e] = 0.f; }
  float m = -1e30f, l = 0.f;
  const int kp = kperm(l31);
  const int c0 = min(max(qc - 8, 0), 48);
  const int kb = min(max(wave * 16 - 8, 0), 32);
  u32x4 rk[2], rv[2];
  auto key0_of = [&](int t) { return t < 4 ? T + 64 * t : (rlo + t - 4) * 64; };
  {
    const int k0 = key0_of(0);
#pragma unroll
    for (int i = 0; i < 2; ++i) {
      rk[i] = *(const u32x4*)(K + (size_t)(k0 + lrow + 32 * i) * 64 + kc8 * 8);
      rv[i] = *(const u32x4*)(Vt + (size_t)(lrow + 32 * i) * SEQ2 + k0 + kc8 * 8);
    }
  }
#pragma unroll 1
  for (int t = 0; t < ntile; ++t) {
    char* sk = smem + (t & 1) * 2 * 64 * LROW;
    char* sv = sk + 64 * LROW;
#pragma unroll
    for (int i = 0; i < 2; ++i) {
      *(u32x4*)(sk + (lrow + 32 * i) * LROW + kc8 * 16) = rk[i];
      *(u32x4*)(sv + (lrow + 32 * i) * LROW + kc8 * 16) = rv[i];
    }
    __syncthreads();
    if (t + 1 < ntile) {
      const int k0 = key0_of(t + 1);
#pragma unroll
      for (int i = 0; i < 2; ++i) {
        rk[i] = *(const u32x4*)(K + (size_t)(k0 + lrow + 32 * i) * 64 + kc8 * 8);
        rv[i] = *(const u32x4*)(Vt + (size_t)(lrow + 32 * i) * SEQ2 + k0 + kc8 * 8);
      }
    }
    const int R = rlo + t - 4;
    const bool local = t >= 4;
    const int nsub = local ? 1 : 2;
#pragma unroll 1
    for (int si = 0; si < nsub; ++si) {
      const int kbase = local ? kb : 32 * si;
      const bool loc = local;
      f32x16 st;
      bf16x8 lf[4];
      __builtin_amdgcn_sched_barrier(0);
#pragma unroll
      for (int s = 0; s < 4; ++s) lf[s] = *(const bf16x8*)(sk + (kbase + kp) * LROW + (16 * s + 8 * hh) * 2);
      __builtin_amdgcn_sched_barrier(0);
#pragma unroll
      for (int e = 0; e < 16; ++e) st[e] = 0.f;
#pragma unroll
      for (int s = 0; s < 4; ++s) st = MFMA(lf[s], qf[s], st);
      __builtin_amdgcn_sched_barrier(0);
#pragma unroll
      for (int s2 = 0; s2 < 2; ++s2)
#pragma unroll
        for (int dt = 0; dt < 2; ++dt) lf[s2 * 2 + dt] = *(const bf16x8*)(sv + (dt * 32 + l31) * LROW + (kbase + 16 * s2 + 8 * hh) * 2);
      __builtin_amdgcn_sched_barrier(0);
      if (loc) {
        const int c0e = ((unsigned)(R - r0w) < 8u) ? c0 : 4096;
        const float* brow = bl + (R - qrow + 7) * 31 + (15 - qc);
#pragma unroll
        for (int e = 0; e < 16; ++e) {
          const int kc = kbase + keyoff(e, hh);
          const bool valid = (unsigned)(kc - c0e) < 16u;
          const float bv = brow[kc];
          st[e] = valid ? st[e] + bv : -1e30f;
        }
      }
      float mx = st[0];
#pragma unroll
      for (int e = 1; e < 16; ++e) mx = fmaxf(mx, st[e]);
      mx = fmaxf(mx, shx(mx, 32, lane));
      const float mn = fmaxf(m, mx);
      const float mnl = mn * L2E;
      const float alpha = fexp2(m * L2E - mnl);
      f2_t ls2 = {0.f, 0.f};
#pragma unroll
      for (int e = 0; e < 16; e += 2) {
        const float p0 = fexp2(st[e] * L2E - mnl), p1 = fexp2(st[e + 1] * L2E - mnl);
        st[e] = p0; st[e + 1] = p1;
        const f2_t pp = {p0, p1};
        ls2 += pp;
      }
      l = l * alpha + (ls2[0] + ls2[1]); m = mn;
      const f2_t al2 = {alpha, alpha};
#pragma unroll
      for (int e = 0; e < 16; e += 2) {
        f2_t a0 = {o[0][e], o[0][e + 1]}, a1 = {o[1][e], o[1][e + 1]};
        a0 *= al2; a1 *= al2;
        o[0][e] = a0[0]; o[0][e + 1] = a0[1]; o[1][e] = a1[0]; o[1][e + 1] = a1[1];
      }
#pragma unroll
      for (int s2 = 0; s2 < 2; ++s2) {
        bf16x8 pf = pack8(st, s2);
#pragma unroll
        for (int dt = 0; dt < 2; ++dt) o[dt] = MFMA(lf[s2 * 2 + dt], pf, o[dt]);
      }
    }
  }
  l += shx(l, 32, lane);
  const float inv = 1.f / l;
  bf16* dst = p.CAT + (size_t)(b * T + qrow * 64 + qc) * D + 256 + head * 64;
#pragma unroll
  for (int dt = 0; dt < 2; ++dt)
#pragma unroll
    for (int g = 0; g < 4; g += 2)
      store_pair(dst + dt * 32 + 8 * g, hh, o[dt][4 * g] * inv, o[dt][4 * g + 1] * inv, o[dt][4 * g + 2] * inv, o[dt][4 * g + 3] * inv,
                 o[dt][4 * g + 4] * inv, o[dt][4 * g + 5] * inv, o[dt][4 * g + 6] * inv, o[dt][4 * g + 7] * inv);
  __syncthreads();
}

template <int MODE>
DI void flash_block(const bf16* __restrict__ Q, const bf16* __restrict__ K, const bf16* __restrict__ Vt, int q0, int kt0, int kt1,
                    bf16* __restrict__ dst  , char* smem, float smax = 0.f) {
  const int tid = tid_now(), lane = tid & 63, wave = tid >> 6, l31 = lane & 31, hh = lane >> 5;
  const int lrow = tid >> 3, kc = tid & 7;
  bf16x8 qf[4];
  const bf16* qp = Q + (size_t)(q0 + wave * 32 + l31) * 64 + 8 * hh;
#pragma unroll
  for (int s = 0; s < 4; ++s) qf[s] = *(const bf16x8*)(qp + 16 * s);
  constexpr bool BOUNDED = MODE != 0;
  if (MODE == 2) {
#pragma unroll
    for (int s = 0; s < 4; ++s) {
      u32x4 w = __builtin_bit_cast(u32x4, qf[s]);
      const unsigned w0 = w[0], w1 = w[1], w2 = w[2], w3 = w[3];
      u32x4 o = {pack2(bf_lo(w0) * L2E, bf_hi(w0) * L2E), pack2(bf_lo(w1) * L2E, bf_hi(w1) * L2E),
                 pack2(bf_lo(w2) * L2E, bf_hi(w2) * L2E), pack2(bf_lo(w3) * L2E, bf_hi(w3) * L2E)};
      qf[s] = __builtin_bit_cast(bf16x8, o);
    }
  }
  f32x16 o[2];
#pragma unroll
  for (int e = 0; e < 16; ++e) { o[0][e] = 0.f; o[1][e] = 0.f; }
  float m = -1e30f, l = 0.f;
  f2_t l2 = {0.f, 0.f};
  const int kp = kperm(l31);
  u32x4 rk[2], rv[2];
#pragma unroll
  for (int i = 0; i < 2; ++i) {
    rk[i] = *(const u32x4*)(K + (size_t)(kt0 * 64 + lrow + 32 * i) * 64 + kc * 8);
    rv[i] = *(const u32x4*)(Vt + (size_t)(lrow + 32 * i) * SEQ2 + kt0 * 64 + kc * 8);
  }
#pragma unroll 1
  for (int kt = kt0; kt < kt1; ++kt) {
    char* sk = smem + ((kt - kt0) & 1) * 2 * 64 * LROW;
    char* sv = sk + 64 * LROW;
#pragma unroll
    for (int i = 0; i < 2; ++i) {
      *(u32x4*)(sk + (lrow + 32 * i) * LROW + kc * 16) = rk[i];
      *(u32x4*)(sv + (lrow + 32 * i) * LROW + kc * 16) = rv[i];
    }
    __syncthreads();
    if (kt + 1 < kt1) {
#pragma unroll
      for (int i = 0; i < 2; ++i) {
        rk[i] = *(const u32x4*)(K + (size_t)((kt + 1) * 64 + lrow + 32 * i) * 64 + kc * 8);
        rv[i] = *(const u32x4*)(Vt + (size_t)(lrow + 32 * i) * SEQ2 + (kt + 1) * 64 + kc * 8);
      }
    }
    f32x16 st[2];
    bf16x8 lf[8];
    __builtin_amdgcn_sched_barrier(0);
#pragma unroll
    for (int k2 = 0; k2 < 2; ++k2)
#pragma unroll
      for (int s = 0; s < 4; ++s) lf[k2 * 4 + s] = *(const bf16x8*)(sk + (k2 * 32 + kp) * LROW + (16 * s + 8 * hh) * 2);
    __builtin_amdgcn_sched_barrier(0);
#pragma unroll
    for (int k2 = 0; k2 < 2; ++k2) {
#pragma unroll
      for (int e = 0; e < 16; ++e) st[k2][e] = 0.f;
#pragma unroll
      for (int s = 0; s < 4; ++s) st[k2] = MFMA(lf[k2 * 4 + s], qf[s], st[k2]);
    }
    __builtin_amdgcn_sched_barrier(0);
#pragma unroll
    for (int k2 = 0; k2 < 2; ++k2)
#pragma unroll
      for (int s2 = 0; s2 < 2; ++s2)
#pragma unroll
        for (int dt = 0; dt < 2; ++dt)
          lf[(k2 * 2 + s2) * 2 + dt] = *(const bf16x8*)(sv + (dt * 32 + l31) * LROW + (k2 * 32 + 16 * s2 + 8 * hh) * 2);
    __builtin_amdgcn_sched_barrier(0);
    if (BOUNDED) {
      const float mnl = smax * L2E;
#pragma unroll
      for (int k2 = 0; k2 < 2; ++k2)
#pragma unroll
        for (int e = 0; e < 16; e += 2) {
          const float p0 = MODE == 2 ? fexp2(st[k2][e]) : fexp2(st[k2][e] * L2E - mnl), p1 = MODE == 2 ? fexp2(st[k2][e + 1]) : fexp2(st[k2][e + 1] * L2E - mnl);
          st[k2][e] = p0; st[k2][e + 1] = p1;
          const f2_t pp = {p0, p1};
          l2 += pp;
        }
    } else {
      float mx = st[0][0];
  #pragma unroll
      for (int e = 1; e < 16; ++e) mx = fmaxf(mx, st[0][e]);
  #pragma unroll
      for (int e = 0; e < 16; ++e) mx = fmaxf(mx, st[1][e]);
      mx = fmaxf(mx, shx(mx, 32, lane));
      const float mn = fmaxf(m, mx);
      const float mnl = mn * L2E;
      const float alpha = fexp2(m * L2E - mnl);
      float ls = 0.f;
  #pragma unroll
      for (int k2 = 0; k2 < 2; ++k2)
  #pragma unroll
        for (int e = 0; e < 16; ++e) { st[k2][e] = fexp2(st[k2][e] * L2E - mnl); ls += st[k2][e]; }
      l = l * alpha + ls; m = mn;
  #pragma unroll
      for (int e = 0; e < 16; ++e) { o[0][e] *= alpha; o[1][e] *= alpha; }
    }
#pragma unroll
    for (int k2 = 0; k2 < 2; ++k2)
#pragma unroll
      for (int s2 = 0; s2 < 2; ++s2) {
        bf16x8 pf = pack8(st[k2], s2);
#pragma unroll
        for (int dt = 0; dt < 2; ++dt) o[dt] = MFMA(lf[(k2 * 2 + s2) * 2 + dt], pf, o[dt]);
      }
  }
  l += l2[0] + l2[1];
  l += shx(l, 32, lane);
  const float inv = (PROBE == 11) ? 0.f : 1.f / l;
  bf16* d2 = dst + (size_t)(wave * 32 + l31) * D;
#pragma unroll
  for (int dt = 0; dt < 2; ++dt)
#pragma unroll
    for (int g = 0; g < 4; g += 2)
      store_pair(d2 + dt * 32 + 8 * g, hh, o[dt][4 * g] * inv, o[dt][4 * g + 1] * inv, o[dt][4 * g + 2] * inv, o[dt][4 * g + 3] * inv,
                 o[dt][4 * g + 4] * inv, o[dt][4 * g + 5] * inv, o[dt][4 * g + 6] * inv, o[dt][4 * g + 7] * inv);
  __syncthreads();
}
constexpr int GQA_ITEMS = 16 * 6 * 16;
DI float gqa_score_bound(const Params& p, int layer) {
  const int lane = tid_now() & 63;
  float a = fabsf(p.gqa_q_norm[layer * 64 + lane]), b = fabsf(p.gqa_k_norm[layer * 64 + lane]);
#pragma unroll
  for (int o = 32; o >= 1; o >>= 1) { a = fmaxf(a, shx(a, o, lane)); b = fmaxf(b, shx(b, o, lane)); }
  return 8.f * a * b * 1.0001f + 1e-3f;
}
DI void stage_gqa(const Params& p, int layer, int item, char* smem) {
  const int qt = item & 15, hq = (item >> 4) % 6, b = item / 96;
  const int kvh = hq / 3;
  const float bound = __int_as_float(__builtin_amdgcn_readfirstlane(__float_as_int(gqa_score_bound(p, layer))));
  const bf16* Q = p.QG + (size_t)(b * 6 + hq) * SEQ2 * 64; const bf16* K = p.KG + (size_t)(b * 2 + kvh) * SEQ2 * 64; const bf16* Vt = p.VGt + (size_t)(b * 2 + kvh) * 64 * SEQ2;
  bf16* dst = p.CAT + (size_t)(b * T + qt * 128) * D + 640 + hq * 64;
  if (bound * L2E < 100.f) flash_block<2>(Q, K, Vt, qt * 128, 0, 36, dst, smem, bound);
  else flash_block<1>(Q, K, Vt, qt * 128, 0, 36, dst, smem, bound);
}
constexpr int CTXATT_ITEMS = 384;
DI void stage_ctxatt(const Params& p, int item, char* smem) {
  const int qt = item & 1, head = (item >> 1) % 6, which = (item / 12) & 1, b = item / 24;
  bf16* dst = p.CAT + (size_t)(NTOK + b * CL + qt * 128) * D + (which == 0 ? 256 : 640) + head * 64;
  const int kvh = which == 0 ? b * 6 + head : b * 2 + head / 3;
  const bf16* Q = (which == 0 ? p.QN : p.QG) + (size_t)(b * 6 + head) * SEQ2 * 64;
  const bf16* K = (which == 0 ? p.KN : p.KG) + (size_t)kvh * SEQ2 * 64;
  const bf16* Vt = (which == 0 ? p.VNt : p.VGt) + (size_t)kvh * 64 * SEQ2;
  flash_block<0>(Q, K, Vt, T + qt * 128, 32, 36, dst, smem);
}

constexpr int OUTPROJ_ITEMS = 288 * 8;
DI void stage_outproj(const Params& p, int layer, int item, char* smem) {
  const int mt = item >> 3, nt = item & 7;
  if (layer == 1 && mt >= 256) return;
  const int row0 = mt * 128, n0 = nt * 128;
  f32x16 acc[2][2];
  gemm_core<true, true>(p.CAT + (size_t)row0 * D, p.wout + ((size_t)layer * D + n0) * D, smem, acc);
  const int lane = tid_now() & 63, wave = tid_now() >> 6, wm = wave >> 1, wn = wave & 1, l31 = lane & 31, hh = lane >> 5;
  const float* mrow = p.mod + ((size_t)layer * 17 + mod_row(row0)) * 6144;
  const float* g1 = mrow + 2048;
  const float* sc2 = mrow + 4096;
  const float* n2g = p.norm2_g + layer * D;
  float* amx = (float*)(smem + GEMM_SMEM);
  float amv[2];
#pragma unroll
  for (int tt = 0; tt < 2; ++tt) {
    const int row = row0 + wm * 64 + tt * 32 + l31;
    bf16* xb = p.XB + (size_t)row * D;
    float ss = 0.f, am = 0.f;
#pragma unroll
    for (int ft = 0; ft < 2; ++ft)
#pragma unroll
      for (int gp = 0; gp < 4; gp += 2) {
        {
          float4 xv[2], gv[2];
#pragma unroll
          for (int g = 0; g < 2; ++g) {
            const int n = n0 + wn * 64 + ft * 32 + 8 * (gp + g) + 4 * hh;
            { const u32x2 t = *(const u32x2*)(xb + n); const unsigned t0 = t[0], t1 = t[1]; xv[g] = float4{bf_lo(t0), bf_hi(t0), bf_lo(t1), bf_hi(t1)}; }
            gv[g] = *(const float4*)(g1 + n);
            if (PROBE == 2) { gv[g].x = gv[g].y = gv[g].z = gv[g].w = 0.f; }
          }
#pragma unroll
          for (int g = 0; g < 2; ++g) {
            const int e = 4 * (gp + g);
            const float4 o = {xv[g].x + gv[g].x * acc[ft][tt][e], xv[g].y + gv[g].y * acc[ft][tt][e + 1],
                              xv[g].z + gv[g].z * acc[ft][tt][e + 2], xv[g].w + gv[g].w * acc[ft][tt][e + 3]};
            ss += o.x * o.x + o.y * o.y + o.z * o.z + o.w * o.w;
            acc[ft][tt][e] = o.x; acc[ft][tt][e + 1] = o.y; acc[ft][tt][e + 2] = o.z; acc[ft][tt][e + 3] = o.w;
          }
          store_pair(xb + n0 + wn * 64 + ft * 32 + 8 * gp, hh, acc[ft][tt][4 * gp], acc[ft][tt][4 * gp + 1], acc[ft][tt][4 * gp + 2], acc[ft][tt][4 * gp + 3],
                     acc[ft][tt][4 * gp + 4], acc[ft][tt][4 * gp + 5], acc[ft][tt][4 * gp + 6], acc[ft][tt][4 * gp + 7]);
        }
        {
          float4 gg[2], sv[2];
#pragma unroll
          for (int g = 0; g < 2; ++g) {
            const int n = n0 + wn * 64 + ft * 32 + 8 * (gp + g) + 4 * hh;
            gg[g] = *(const float4*)(n2g + n); sv[g] = *(const float4*)(sc2 + n);
          }
#pragma unroll
          for (int g = 0; g < 2; ++g) {
            const int e = 4 * (gp + g);
            float4 o = {acc[ft][tt][e], acc[ft][tt][e + 1], acc[ft][tt][e + 2], acc[ft][tt][e + 3]};
            o.x *= gg[g].x * (1.f + sv[g].x); o.y *= gg[g].y * (1.f + sv[g].y); o.z *= gg[g].z * (1.f + sv[g].z); o.w *= gg[g].w * (1.f + sv[g].w);
            acc[ft][tt][e] = o.x; acc[ft][tt][e + 1] = o.y; acc[ft][tt][e + 2] = o.z; acc[ft][tt][e + 3] = o.w;
            am = fmaxf(am, fmaxf(fmaxf(fabsf(o.x), fabsf(o.y)), fmaxf(fabsf(o.z), fabsf(o.w))));
          }
        }
      }
    ss += shx(ss, 32, lane);
    am = fmaxf(am, shx(am, 32, lane));
    if (hh == 0) { p.ssq16[(size_t)(nt * 2 + wn) * MTOT + row] = ss; amx[((wm * 2 + tt) * 32 + l31) * 2 + wn] = am; }
    amv[tt] = am;
    asm volatile("" ::: "memory");
  }
  __syncthreads();
#pragma unroll
  for (int tt = 0; tt < 2; ++tt) {
    const int row = row0 + wm * 64 + tt * 32 + l31;
    const float am = fmaxf(fmaxf(amv[tt], amx[((wm * 2 + tt) * 32 + l31) * 2 + (wn ^ 1)]), 1e-30f);
    const float qs = 127.f / am;
    if (hh == 0 && wn == 0) p.hs8[(size_t)nt * MTOT + row] = am * (1.f / 127.f);
    bf16* hrow = p.H2 + (size_t)row * D + n0 + wn * 64;
    signed char* qrow = p.hq + (size_t)row * D + n0 + wn * 64;
#pragma unroll
    for (int ft = 0; ft < 2; ++ft)
#pragma unroll
      for (int g = 0; g < 4; g += 2) {
        store_pair(hrow + ft * 32 + 8 * g, hh, acc[ft][tt][4 * g], acc[ft][tt][4 * g + 1], acc[ft][tt][4 * g + 2], acc[ft][tt][4 * g + 3],
                   acc[ft][tt][4 * g + 4], acc[ft][tt][4 * g + 5], acc[ft][tt][4 * g + 6], acc[ft][tt][4 * g + 7]);
        float4 va = {acc[ft][tt][4 * g], acc[ft][tt][4 * g + 1], acc[ft][tt][4 * g + 2], acc[ft][tt][4 * g + 3]};
        float4 vb = {acc[ft][tt][4 * g + 4], acc[ft][tt][4 * g + 5], acc[ft][tt][4 * g + 6], acc[ft][tt][4 * g + 7]};
        unsigned qa = pack_i8x4(va, qs), qb = pack_i8x4(vb, qs);
        const auto rq = __builtin_amdgcn_permlane32_swap(qa, qb, false, false);
        u32x2 o8 = {rq[0], rq[1]};
        *(u32x2*)(qrow + ft * 32 + 8 * g + hh * 8) = o8;
      }
  }
}

constexpr int ROUTE_ITEMS = 288 * 8;
constexpr int QROW = 272;
DI int to_sortable(int b) { return b ^ ((b >> 31) & 0x7fffffff); }

#define CAND_LIST(X) \
  X(0,0,0) X(1,0,1) X(2,0,2) X(3,0,3) X(4,0,4) X(5,0,5) X(6,0,6) X(7,0,7) X(8,0,8) X(9,0,9) X(10,0,10) X(11,0,11) X(12,0,12) X(13,0,13) X(14,0,14) X(15,0,15) \
  X(16,1,1) X(17,1,2) X(18,1,3) X(19,1,4) X(20,1,5) X(21,1,6) X(22,1,7) \
  X(23,2,2) X(24,2,3) X(25,2,4) \
  X(26,3,3)


DI void ce_desc(int& a, int& b) { const int hi = max(a, b), lo = min(a, b); a = hi; b = lo; }
DI void bitonic_sort16_desc(int (&v)[16]) {
#pragma unroll
  for (int k = 2; k <= 16; k <<= 1)
#pragma unroll
    for (int j = k >> 1; j > 0; j >>= 1)
#pragma unroll
      for (int i = 0; i < 16; ++i) {
        const int l = i ^ j;
        if (l > i) { if ((i & k) == 0) ce_desc(v[i], v[l]); else ce_desc(v[l], v[i]); }
      }
}
DI void bitonic_merge16_desc(int (&v)[16]) {
#pragma unroll
  for (int j = 8; j > 0; j >>= 1)
#pragma unroll
    for (int i = 0; i < 16; ++i) { const int l = i ^ j; if (l > i) ce_desc(v[i], v[l]); }
}
DI void merge_top16(int (&a)[16], const int (&b)[16]) {
#pragma unroll
  for (int i = 0; i < 16; ++i) a[i] = max(a[i], b[15 - i]);
  bitonic_merge16_desc(a);
}
DI void stage_route(const Params& p, int layer, int item, char* smem) {
  const int mt = item >> 3, head = item & 7;
  if (layer == 1 && mt >= 256) return;
  const int row0 = mt * 128;
  const int tid = tid_now(), lane = tid & 63, wave = tid >> 6, wm = wave >> 1, wn = wave & 1, l31 = lane & 31, hh = lane >> 5;
  int t0[16], tk[16];
  char* Qs = smem;
  float* rs = (float*)(smem + GEMM_SMEM);
  if (tid < 128) {
    float sv[16];
#pragma unroll
    for (int s = 0; s < 16; ++s) sv[s] = p.ssq16[(size_t)s * MTOT + row0 + tid];
    float ssum = 0.f;
#pragma unroll
    for (int s = 0; s < 16; ++s) ssum += sv[s];
    rs[tid] = rsqrtf(ssum * (1.f / D) + EPS);
  }
#pragma unroll 1
  for (int pp = 0; pp < 2; ++pp) {
    {
      f32x16 acc[2][2];
      gemm_core<true, true>(p.H2 + (size_t)row0 * D, p.wq + ((size_t)layer * 2048 + (head * 2 + pp) * 128) * D, smem, acc);
      {
        const float* cqr = p.cq + ((size_t)layer * 17 + mod_row(row0)) * 2048 + (head * 2 + pp) * 128 + wn * 64 + 4 * hh;
#pragma unroll
        for (int tt = 0; tt < 2; ++tt) {
          const float rsd = rs[wm * 64 + tt * 32 + l31];
#pragma unroll
          for (int ft = 0; ft < 2; ++ft)
#pragma unroll
            for (int g = 0; g < 4; ++g) {
              const float4 cv = *(const float4*)(cqr + ft * 32 + 8 * g);
              acc[ft][tt][4 * g] = acc[ft][tt][4 * g] * rsd + cv.x; acc[ft][tt][4 * g + 1] = acc[ft][tt][4 * g + 1] * rsd + cv.y;
              acc[ft][tt][4 * g + 2] = acc[ft][tt][4 * g + 2] * rsd + cv.z; acc[ft][tt][4 * g + 3] = acc[ft][tt][4 * g + 3] * rsd + cv.w;
            }
        }
      }
#pragma unroll
      for (int tt = 0; tt < 2; ++tt)
#pragma unroll
        for (int ft = 0; ft < 2; ++ft)
#pragma unroll
          for (int g = 0; g < 4; ++g) {
            const int tok = wm * 64 + tt * 32 + l31, kf = wn * 64 + ft * 32 + 8 * g + 4 * hh;
            u32x2 o = {pack2(acc[ft][tt][4 * g], acc[ft][tt][4 * g + 1]), pack2(acc[ft][tt][4 * g + 2], acc[ft][tt][4 * g + 3])};
            *(u32x2*)(Qs + tok * QROW + kf * 2) = o;
          }
    }
    const __amdgpu_buffer_rsrc_t rK = __builtin_amdgcn_make_buffer_rsrc((void*)p.pk, 0, (unsigned)(PK_N * 2), 0x00020000);
    const int kso = (((layer * 8 + head) * 2 + pp) * 128) * 256;
    u32x4 ka[8];
#pragma unroll
    for (int s = 0; s < 8; ++s) ka[s] = __builtin_amdgcn_raw_buffer_load_b128(rK, (l31 * 128 + 8 * hh) * 2 + 32 * s, kso, 0);
    __syncthreads();
    {
#pragma unroll
      for (int r = 0; r < 16; ++r) tk[r] = (int)0x80000000;
#pragma unroll 1
      for (int nt = 0; nt < 4; ++nt) {
        int cur[16];
        {
          f32x16 sc;
#pragma unroll
          for (int e = 0; e < 16; ++e) sc[e] = 0.f;
#pragma unroll
          for (int s = 0; s < 8; ++s) {
            bf16x8 qb = *(const bf16x8*)(Qs + (wave * 32 + l31) * QROW + (16 * s + 8 * hh) * 2);
            sc = MFMA(__builtin_bit_cast(bf16x8, ka[s]), qb, sc);
          }
          {
            const int nn = nt < 3 ? nt + 1 : 3;
#pragma unroll
            for (int s = 0; s < 8; ++s) ka[s] = __builtin_amdgcn_raw_buffer_load_b128(rK, ((nn * 32 + l31) * 128 + 8 * hh) * 2 + 32 * s, kso, 0);
          }
#pragma unroll
          for (int e = 0; e < 16; ++e) {
            const int n = nt * 32 + crow(e, hh);
            int b = (__float_as_int(sc[e]) & ~127) | n;
            cur[e] = to_sortable(b);
          }
        }
        bitonic_sort16_desc(cur);
        merge_top16(tk, cur);
      }
      int pb[16];
#pragma unroll
      for (int i = 0; i < 16; ++i) pb[i] = shxi(tk[i], 32, lane);
      merge_top16(tk, pb);
    }
    if (pp == 0) {
#pragma unroll
      for (int r = 0; r < 16; ++r) t0[r] = tk[r];
    }
    __syncthreads();
  }
  char* recs = Qs + (tid_now() >> 6) * 32 * QROW;
  int cand[27];
  {
    float av[16], bv[16];
    unsigned pa[4] = {0u, 0u, 0u, 0u}, pbb[4] = {0u, 0u, 0u, 0u};
#pragma unroll
    for (int i = 0; i < 16; ++i) {
      int k1 = to_sortable(t0[i]), k2 = to_sortable(tk[i]);
      int a = hh ? k2 : k1, b = hh ? k1 : k2;
      av[i] = __int_as_float(a & ~127); bv[i] = __int_as_float(b & ~127);
      pa[i >> 2] |= (unsigned)(a & 127) << (8 * (i & 3));
      pbb[i >> 2] |= (unsigned)(b & 127) << (8 * (i & 3));
    }
    u32x4 ra_ = {pa[0], pa[1], pa[2], pa[3]}, rb_ = {pbb[0], pbb[1], pbb[2], pbb[3]};
    *(u32x4*)(recs + lane * 32) = ra_;
    *(u32x4*)(recs + lane * 32 + 16) = rb_;
#define MKC(c, i, j) { int b = __float_as_int(av[i] + bv[j]); cand[c] = (to_sortable(b) & ~63) | (c * 2 + hh); \
                       if (i == j && hh) cand[c] = (int)0x80000000; }
    CAND_LIST(MKC)
#undef MKC
  }
  int win[16], weid[16];
#pragma unroll
  for (int r = 0; r < 16; ++r) {
    int mx = cand[0];
#pragma unroll
    for (int c = 1; c < 27; ++c) mx = max(mx, cand[c]);
    mx = max(mx, shxi(mx, 32, lane));
#pragma unroll
    for (int c = 0; c < 27; ++c) cand[c] = (cand[c] == mx) ? (int)0x80000000 : cand[c];
    win[r] = mx;
  }
#pragma unroll
  for (int r = 0; r < 16; ++r) {
    const int code = win[r] & 63, c = code >> 1, hw = code & 1;
    const int i = (c >= 16) + (c >= 23) + (c >= 26);
    const int j = c - (i == 0 ? 0 : i == 1 ? 15 : i == 2 ? 21 : 23);
    const unsigned char* orec = (const unsigned char*)(recs + (l31 + 32 * hw) * 32);
    const int aiv = orec[i], biv = orec[16 + j];
    weid[r] = hw ? (biv * 128 + aiv) : (aiv * 128 + biv);
  }
  float gsum = 0.f, gv[16];
  const float v0 = __int_as_float(to_sortable(win[0]) & ~63);
#pragma unroll
  for (int r = 0; r < 16; ++r) { gv[r] = __expf(__int_as_float(to_sortable(win[r]) & ~63) - v0); gsum += gv[r]; }
  const float ginv = 1.f / gsum;
  const int row = row0 + (tid_now() >> 6) * 32 + (tid_now() & 31);
  if (hh == 0) {
    int4* d = (int4*)(p.ridx + ((size_t)row * 8 + head) * 32);
#pragma unroll
    for (int q = 0; q < 4; ++q) { int4 o = {weid[4 * q], weid[4 * q + 1], weid[4 * q + 2], weid[4 * q + 3]}; d[q] = o; }
  } else {
    float4* d = (float4*)((float*)p.ridx + ((size_t)row * 8 + head) * 32 + 16);
#pragma unroll
    for (int q = 0; q < 4; ++q) { float4 o = {gv[4 * q] * ginv, gv[4 * q + 1] * ginv, gv[4 * q + 2] * ginv, gv[4 * q + 3] * ginv}; d[q] = o; }
  }
  __syncthreads();
}

DI float dot2(unsigned a, unsigned b, float acc) {
  bf2_t x = __builtin_bit_cast(bf2_t, a), y = __builtin_bit_cast(bf2_t, b);
  return __builtin_amdgcn_fdot2_f32_bf16(x, y, acc, false);
}
DI float dot8(u32x4 a, u32x4 b, float acc) {
  const unsigned a0 = a[0], a1 = a[1], a2 = a[2], a3 = a[3], b0 = b[0], b1 = b[1], b2 = b[2], b3 = b[3];
  acc = dot2(a0, b0, acc); acc = dot2(a1, b1, acc); acc = dot2(a2, b2, acc); acc = dot2(a3, b3, acc);
  return acc;
}
DI void axpy8(float (&o)[8], float w, u32x4 v) {
  o[0] += w * bf_lo(v.x); o[1] += w * bf_hi(v.x); o[2] += w * bf_lo(v.y); o[3] += w * bf_hi(v.y);
  o[4] += w * bf_lo(v.z); o[5] += w * bf_hi(v.z); o[6] += w * bf_lo(v.w); o[7] += w * bf_hi(v.w);
}
constexpr int GATHER_ITEMS = MTOT / 4;
DI float dot4f8(unsigned u, unsigned hlo, unsigned hhi, float acc) {
  bf2_t a = __builtin_amdgcn_cvt_scalef32_pk_bf16_fp8((int)u, 1.0f, false);
  bf2_t b = __builtin_amdgcn_cvt_scalef32_pk_bf16_fp8((int)u, 1.0f, true);
  bf2_t x = __builtin_bit_cast(bf2_t, hlo), y = __builtin_bit_cast(bf2_t, hhi);
  acc = __builtin_amdgcn_fdot2_f32_bf16(a, x, acc, false);
  acc = __builtin_amdgcn_fdot2_f32_bf16(b, y, acc, false);
  return acc;
}
DI void axpy4f8(float& o0, float& o1, float& o2, float& o3, float w, unsigned v) {
  f2_t lo = __builtin_amdgcn_cvt_pk_f32_fp8((int)v, false), hi = __builtin_amdgcn_cvt_pk_f32_fp8((int)v, true);
  o0 += w * lo[0]; o1 += w * lo[1]; o2 += w * hi[0]; o3 += w * hi[1];
}
DI void stage_gather(const Params& p, int layer, int item) {
  const int lane = tid_now() & 63, wave = tid_now() >> 6;
  const int row = item * 4 + wave;
  if (layer == 1 && row >= NTOK) return;
  const int* rr = p.ridx + (size_t)row * 256 + (lane >> 4) * 32 + (lane & 15);
  const int idxA = rr[0], idxB = rr[128];
  const float gA = __int_as_float(rr[16]), gB = __int_as_float(rr[144]);
  const bf16* hr = p.H + (size_t)row * D + lane * 16;
  const u32x4 hA = *(const u32x4*)(hr), hB = *(const u32x4*)(hr + 8);
  const unsigned h0 = hA[0], h1 = hA[1], h2 = hA[2], h3 = hA[3], h4 = hB[0], h5 = hB[1], h6 = hB[2], h7 = hB[3];
  float o[16];
#pragma unroll
  for (int i = 0; i < 16; ++i) o[i] = 0.f;
  const __amdgpu_buffer_rsrc_t rU = __builtin_amdgcn_make_buffer_rsrc((void*)(p.pu8 + (size_t)layer * NEXP * D), 0, NEXP * D, 0x00020000);
  const __amdgpu_buffer_rsrc_t rV = __builtin_amdgcn_make_buffer_rsrc((void*)(p.pv8 + (size_t)layer * NEXP * D), 0, NEXP * D, 0x00020000);
  const int voff = lane * 16;
  u32x4 ua[16], va[16];
#pragma unroll
  for (int k = 0; k < 16; ++k) {
    const int e = __builtin_amdgcn_readlane(idxA, k);
    ua[k] = __builtin_amdgcn_raw_buffer_load_b128(rU, voff, e * D, 0);
  }
#pragma unroll
  for (int k = 0; k < 16; ++k) {
    const int e = __builtin_amdgcn_readlane(idxA, k);
    va[k] = __builtin_amdgcn_raw_buffer_load_b128(rV, voff, e * D, 0);
  }
#pragma unroll
  for (int head = 0; head < 8; ++head) {
    float part[16];
#pragma unroll
    for (int k = 0; k < 16; ++k) {
      const unsigned a0 = ua[k][0], a1 = ua[k][1], a2 = ua[k][2], a3 = ua[k][3];
      float s = dot4f8(a0, h0, h1, 0.f);
      s = dot4f8(a1, h2, h3, s); s = dot4f8(a2, h4, h5, s); s = dot4f8(a3, h6, h7, s);
      part[k] = s;
    }
    asm volatile("" ::: "memory");
    if (head < 7) {
#pragma unroll
      for (int k = 0; k < 16; ++k) {
        const int e = __builtin_amdgcn_readlane((head + 1) < 4 ? idxA : idxB, ((head + 1) & 3) * 16 + k);
        ua[k] = __builtin_amdgcn_raw_buffer_load_b128(rU, voff, e * D, 0);
      }
    }
    float r8[8], r4[4], r2[2], r1;
    {
      const bool up = lane & 32;
#pragma unroll
      for (int k = 0; k < 8; ++k) { float keep = up ? part[k + 8] : part[k], give = up ? part[k] : part[k + 8]; r8[k] = keep + shx(give, 32, lane); }
    }
    {
      const bool up = lane & 16;
#pragma unroll
      for (int k = 0; k < 4; ++k) { float keep = up ? r8[k + 4] : r8[k], give = up ? r8[k] : r8[k + 4]; r4[k] = keep + shx(give, 16, lane); }
    }
    {
      const bool up = lane & 8;
#pragma unroll
      for (int k = 0; k < 2; ++k) { float keep = up ? r4[k + 2] : r4[k], give = up ? r4[k] : r4[k + 2]; r2[k] = keep + shx(give, 8, lane); }
    }
    {
      const bool up = lane & 4;
      float keep = up ? r2[1] : r2[0], give = up ? r2[0] : r2[1];
      r1 = keep + shx(give, 4, lane);
    }
    r1 += shx(r1, 2, lane);
    r1 += shx(r1, 1, lane);
    const float myg = __int_as_float(__builtin_amdgcn_ds_bpermute(((head & 3) * 16 + ((lane >> 2) & 15)) << 2, __float_as_int(head < 4 ? gA : gB)));
    const float w = gelu_tanh(r1 * (1.f / SU)) * myg * (1.f / SV);
#pragma unroll
    for (int k = 0; k < 16; ++k) {
      const float wk = __int_as_float(__builtin_amdgcn_readlane(__float_as_int(w), k << 2));
      const unsigned a0 = va[k][0], a1 = va[k][1], a2 = va[k][2], a3 = va[k][3];
      axpy4f8(o[0], o[1], o[2], o[3], wk, a0); axpy4f8(o[4], o[5], o[6], o[7], wk, a1);
      axpy4f8(o[8], o[9], o[10], o[11], wk, a2); axpy4f8(o[12], o[13], o[14], o[15], wk, a3);
    }
    asm volatile("" ::: "memory");
    if (head < 7) {
#pragma unroll
      for (int k = 0; k < 16; ++k) {
        const int e = __builtin_amdgcn_readlane((head + 1) < 4 ? idxA : idxB, ((head + 1) & 3) * 16 + k);
        va[k] = __builtin_amdgcn_raw_buffer_load_b128(rV, voff, e * D, 0);
      }
    }
  }
  const float* g2 = p.mod + ((size_t)layer * 17 + mod_row(row)) * 6144 + 5120 + lane * 16;
  float* dr = xres_row(p, row) + lane * 16;
  float4 xv[4], gv[4];
#pragma unroll
  for (int q = 0; q < 4; ++q) { xv[q] = *(const float4*)(dr + 4 * q); gv[q] = *(const float4*)(g2 + 4 * q); }
#pragma unroll
  for (int q = 0; q < 4; ++q) {
    float4 r = {xv[q].x + gv[q].x * o[4 * q], xv[q].y + gv[q].y * o[4 * q + 1], xv[q].z + gv[q].z * o[4 * q + 2], xv[q].w + gv[q].w * o[4 * q + 3]};
    *(float4*)(dr + 4 * q) = r;
  }
}

constexpr int PEER_TPW = 4;
constexpr int PEER_TPI = 4 * PEER_TPW;
DI float bperm_f(float v, int src_lane) { return __int_as_float(__builtin_amdgcn_ds_bpermute(src_lane << 2, __float_as_int(v))); }
DI int bperm_i(int v, int src_lane) { return __builtin_amdgcn_ds_bpermute(src_lane << 2, v); }

DI __amdgpu_buffer_rsrc_t mk_rsrc(const void* ptr, unsigned bytes) { return __builtin_amdgcn_make_buffer_rsrc((void*)ptr, 0, bytes, 0x00020000); }
DI void stage_peer_u(const Params& p, int layer, int q, int tile, _Float16* __restrict__ partial) {
  const int tid = tid_now(), lane = tid & 63, g = lane >> 3, c = lane & 7;
  const int wave = __builtin_amdgcn_readfirstlane(tid >> 6);
  const int row_base = tile * PEER_TPI + wave * PEER_TPW;
  const __amdgpu_buffer_rsrc_t rU = mk_rsrc(p.pu8 + (size_t)layer * NEXP * D, NEXP * D);
  const __amdgpu_buffer_rsrc_t rRec = mk_rsrc(p.ridx, (unsigned)((size_t)MTOT * 1024));
  const __amdgpu_buffer_rsrc_t rH = mk_rsrc(p.hq, (unsigned)((size_t)MTOT * D));
  const __amdgpu_buffer_rsrc_t rP = mk_rsrc(partial, (unsigned)((size_t)8 * MTOT * 256));
  const int coff = q * 128 + c * 16;
  const int rec_v = ((lane >> 4) * 32 + (lane & 15)) * 4;
  const int i0 = 4 * (c & 1) + 2 * ((c >> 1) & 1) + ((c >> 2) & 1);
  const int pv0 = (8 * i0 + g) * 4;
  int idA[3], idB[3];
  u32x4 d[2][8]; u32x4 hv[2];
  auto load_idx = [&](int t, int slot) {
    const int so = (row_base + t) * 1024;
    idA[slot] = __builtin_amdgcn_raw_buffer_load_b32(rRec, rec_v, so, 0);
    idB[slot] = __builtin_amdgcn_raw_buffer_load_b32(rRec, rec_v + 512, so, 0);
  };
  auto issue = [&](int u) {
    const int t = u >> 1, hf = u & 1, slot = t % 3, buf = u & 1;
    if (hf == 0) hv[t & 1] = __builtin_amdgcn_raw_buffer_load_b128(rH, coff, (row_base + t) * D, 0);
#pragma unroll
    for (int i = 0; i < 8; ++i) {
      const int e = bperm_i(hf ? idB[slot] : idA[slot], (8 * i + g) & 63);
      d[buf][i] = __builtin_amdgcn_raw_buffer_load_b128(rU, e * D + coff, 0, 0);
    }
  };
  load_idx(0, 0); load_idx(1, 1);
  issue(0);
  int r[16];
#pragma unroll
  for (int u = 0; u < 2 * PEER_TPW; ++u) {
    const int t = u >> 1, hf = u & 1, buf = u & 1;
    asm volatile("" ::: "memory");
    if (hf == 0 && t + 2 < PEER_TPW) load_idx(t + 2, (t + 2) % 3);
    if (u + 1 < 2 * PEER_TPW) issue(u + 1);
    const int h0 = (int)hv[t & 1][0], h1 = (int)hv[t & 1][1], h2 = (int)hv[t & 1][2], h3 = (int)hv[t & 1][3];
#pragma unroll
    for (int i = 0; i < 8; ++i) {
      const int a0 = (int)d[buf][i][0], a1 = (int)d[buf][i][1], a2 = (int)d[buf][i][2], a3 = (int)d[buf][i][3];
      int s = __builtin_amdgcn_sdot4(a0, h0, 0, false);
      s = __builtin_amdgcn_sdot4(a1, h1, s, false); s = __builtin_amdgcn_sdot4(a2, h2, s, false); s = __builtin_amdgcn_sdot4(a3, h3, s, false);
      r[8 * hf + i] = s;
    }
    if (hf == 0) continue;
    asm volatile("" ::: "memory");
    int r8[8], r4[4], r2[2];
    {
      const bool up = c & 1;
#pragma unroll
      for (int b3 = 0; b3 < 2; ++b3)
#pragma unroll
        for (int m = 0; m < 4; ++m) { int lo = r[8 * b3 + m], hi = r[8 * b3 + 4 + m]; int keep = up ? hi : lo, give = up ? lo : hi; r8[4 * b3 + m] = keep + bperm_i(give, lane ^ 1); }
    }
    {
      const bool up = c & 2;
#pragma unroll
      for (int b3 = 0; b3 < 2; ++b3)
#pragma unroll
        for (int m = 0; m < 2; ++m) { int lo = r8[4 * b3 + m], hi = r8[4 * b3 + 2 + m]; int keep = up ? hi : lo, give = up ? lo : hi; r4[2 * b3 + m] = keep + bperm_i(give, lane ^ 2); }
    }
    {
      const bool up = c & 4;
#pragma unroll
      for (int b3 = 0; b3 < 2; ++b3) { int lo = r4[2 * b3], hi = r4[2 * b3 + 1]; int keep = up ? hi : lo, give = up ? lo : hi; r2[b3] = keep + bperm_i(give, lane ^ 4); }
    }
    const int so = (q * MTOT + row_base + t) * 256;
    const h2_t ph = {(_Float16)((float)r2[0] * (1.f / 64.f)), (_Float16)((float)r2[1] * (1.f / 64.f))};
    __builtin_amdgcn_raw_buffer_store_b32(__builtin_bit_cast(int, ph), rP, pv0, so, 0);
  }
}

constexpr int PEERC_RPW = 2;
DI void stage_peer_combine(const Params& p, int layer, int item, const _Float16* __restrict__ partial) {
  const int lane = tid_now() & 63, wave = tid_now() >> 6;
  const int rbase = (item * 4 + wave) * PEERC_RPW;
  const int mr = mod_row(rbase);
  int e0[PEERC_RPW], e1[PEERC_RPW];
  float g0[PEERC_RPW], g1[PEERC_RPW], ssum[PEERC_RPW];
  unsigned pab[PEERC_RPW][8];
  float hq[PEERC_RPW][8];
#pragma unroll
  for (int j = 0; j < PEERC_RPW; ++j) {
    const int* reci = p.ridx + (size_t)(rbase + j) * 256 + (lane >> 4) * 32 + (lane & 15);
    e0[j] = reci[0]; e1[j] = reci[128];
  }
#pragma unroll
  for (int j = 0; j < PEERC_RPW; ++j) {
    const int row = rbase + j;
#pragma unroll
    for (int q = 0; q < 8; ++q) {
      pab[j][q] = ((const unsigned*)partial)[((size_t)q * MTOT + row) * 64 + lane];
      hq[j][q] = p.hs8[(size_t)q * MTOT + row] * 64.f;
    }
    const int* reci = p.ridx + (size_t)row * 256 + (lane >> 4) * 32 + (lane & 15);
    g0[j] = __int_as_float(reci[16]); g1[j] = __int_as_float(reci[144]);
    ssum[j] = p.ssq16[(size_t)(lane & 15) * MTOT + row];
  }
  float2 er0[PEERC_RPW], er1[PEERC_RPW];
#pragma unroll
  for (int j = 0; j < PEERC_RPW; ++j) {
    er0[j] = *(const float2*)(p.esc + ((size_t)layer * NEXP + e0[j]) * 64 + 2 * mr);
    er1[j] = *(const float2*)(p.esc + ((size_t)layer * NEXP + e1[j]) * 64 + 2 * mr);
  }
#pragma unroll
  for (int j = 0; j < PEERC_RPW; ++j) {
    const int row = rbase + j;
    float s0 = 0.f, s1 = 0.f;
#pragma unroll
    for (int q = 0; q < 8; ++q) { const h2_t pv = __builtin_bit_cast(h2_t, pab[j][q]); s0 += (float)pv[0] * hq[j][q]; s1 += (float)pv[1] * hq[j][q]; }
    float t = ssum[j];
    t += shx(t, 1, lane); t += shx(t, 2, lane); t += shx(t, 4, lane); t += shx(t, 8, lane);
    const float rstd = rsqrtf(t * (1.f / D) + EPS);
    float* rec = (float*)(p.ridx + (size_t)row * 256 + (lane >> 4) * 32 + (lane & 15)) + 16;
    const _Float16 w0 = (_Float16)(gelu_tanh(s0 * er0[j].y * rstd + er0[j].x) * g0[j]), w1 = (_Float16)(gelu_tanh(s1 * er1[j].y * rstd + er1[j].x) * g1[j]);
    const h2_t w0p = {w0, w0}, w1p = {w1, w1};
    rec[0] = __builtin_bit_cast(float, w0p);
    rec[128] = __builtin_bit_cast(float, w1p);
  }
}

DI void axpy4f8_pk(f2_t& o01, f2_t& o23, f2_t w2, unsigned v) {
  f2_t lo = __builtin_amdgcn_cvt_pk_f32_fp8((int)v, false), hi = __builtin_amdgcn_cvt_pk_f32_fp8((int)v, true);
  o01 = __builtin_elementwise_fma(w2, lo, o01); o23 = __builtin_elementwise_fma(w2, hi, o23);
}
DI void stage_peer_v(const Params& p, int layer, int q, int tile, float dry = 1.f) {
  const int tid = tid_now(), lane = tid & 63, g = lane >> 3, c = lane & 7;
  const int wave = __builtin_amdgcn_readfirstlane(tid >> 6);
  const int row_base = tile * PEER_TPI + wave * PEER_TPW;
  const __amdgpu_buffer_rsrc_t rV = mk_rsrc(p.pv8 + (size_t)layer * NEXP * D, NEXP * D);
  const __amdgpu_buffer_rsrc_t rRec = mk_rsrc(p.ridx, (unsigned)((size_t)MTOT * 1024));
  const __amdgpu_buffer_rsrc_t rX = mk_rsrc(p.XB, (unsigned)((size_t)MTOT * D * 2));
  const int xrow0 = row_base;
  const int coff = q * 128 + c * 16;
  const int rec_v = ((lane >> 4) * 32 + (lane & 15)) * 4;
  int idA[3], idB[3]; float wA[3], wB[3];
  u32x4 d[2][8];
  auto load_idx = [&](int t, int slot) {
    const int so = (row_base + t) * 1024;
    idA[slot] = __builtin_amdgcn_raw_buffer_load_b32(rRec, rec_v, so, 0);
    idB[slot] = __builtin_amdgcn_raw_buffer_load_b32(rRec, rec_v + 512, so, 0);
    wA[slot] = __int_as_float(__builtin_amdgcn_raw_buffer_load_b32(rRec, rec_v + 64, so, 0));
    wB[slot] = __int_as_float(__builtin_amdgcn_raw_buffer_load_b32(rRec, rec_v + 576, so, 0));
  };
  const int dl = coff + 8 * (g & 1) + 4 * ((g >> 1) & 1) + 2 * ((g >> 2) & 1);
  unsigned xvb[2];
  auto issue = [&](int u) {
    const int t = u >> 1, hf = u & 1, slot = t % 3, buf = u & 1;
#pragma unroll
    for (int i = 0; i < 8; ++i) {
      const int e = bperm_i(hf ? idB[slot] : idA[slot], (8 * i + g) & 63);
      d[buf][i] = __builtin_amdgcn_raw_buffer_load_b128(rV, e * D + coff, 0, 0);
    }
    if (hf == 1) xvb[t & 1] = (unsigned)__builtin_amdgcn_raw_buffer_load_b32(rX, dl * 2, (xrow0 + t) * (D * 2), 0);
  };
  const float2 g2v = *(const float2*)(p.mod + ((size_t)layer * 17 + mod_row(row_base)) * 6144 + 5120 + dl);
  load_idx(0, 0); load_idx(1, 1);
  issue(0);
  h2_t oh[8];
#pragma unroll
  for (int u = 0; u < 2 * PEER_TPW; ++u) {
    const int t = u >> 1, hf = u & 1, buf = u & 1, slot = t % 3;
    asm volatile("" ::: "memory");
    if (hf == 0 && t + 2 < PEER_TPW) load_idx(t + 2, (t + 2) % 3);
    if (u + 1 < 2 * PEER_TPW) issue(u + 1);
#pragma unroll
    for (int i = 0; i < 8; ++i) {
      const h2_t w2 = __builtin_bit_cast(h2_t, bperm_f(hf ? wB[slot] : wA[slot], (8 * i + g) & 63));
#pragma unroll
      for (int j = 0; j < 4; ++j) {
        const int av = (int)d[buf][i][j];
        const h2_t lo = __builtin_amdgcn_cvt_scalef32_pk_f16_fp8(av, 1.0f, false), hi = __builtin_amdgcn_cvt_scalef32_pk_f16_fp8(av, 1.0f, true);
        if (hf == 0 && i == 0) { oh[2 * j] = w2 * lo; oh[2 * j + 1] = w2 * hi; }
        else { oh[2 * j] = __builtin_elementwise_fma(w2, lo, oh[2 * j]); oh[2 * j + 1] = __builtin_elementwise_fma(w2, hi, oh[2 * j + 1]); }
      }
    }
    if (hf == 0) continue;
    asm volatile("" ::: "memory");
    h2_t q4[4], q2[2], q1;
    {
      const bool up = g & 1;
#pragma unroll
      for (int k = 0; k < 4; ++k) {
        const h2_t keep = up ? oh[k + 4] : oh[k], give = up ? oh[k] : oh[k + 4];
        q4[k] = keep + __builtin_bit_cast(h2_t, bperm_i(__builtin_bit_cast(int, give), lane ^ 8));
      }
    }
    {
      const bool up = g & 2;
#pragma unroll
      for (int k = 0; k < 2; ++k) {
        const h2_t keep = up ? q4[k + 2] : q4[k], give = up ? q4[k] : q4[k + 2];
        q2[k] = keep + __builtin_bit_cast(h2_t, bperm_i(__builtin_bit_cast(int, give), lane ^ 16));
      }
    }
    {
      const auto sw = __builtin_amdgcn_permlane32_swap(__builtin_bit_cast(unsigned, q2[0]), __builtin_bit_cast(unsigned, q2[1]), false, false);
      const unsigned sa = sw[0], sb = sw[1];
      q1 = __builtin_bit_cast(h2_t, sa) + __builtin_bit_cast(h2_t, sb);
    }
    float r2[2] = {(float)q1[0] * (1.f / SV), (float)q1[1] * (1.f / SV)};
    const int so = (xrow0 + t) * (D * 2);
    const unsigned xv = xvb[t & 1];
    const float x0 = bf_lo(xv), x1 = bf_hi(xv);
    __builtin_amdgcn_raw_buffer_store_b32((int)pack2(x0 + dry * g2v.x * r2[0], x1 + dry * g2v.y * r2[1]), rX, dl * 2, so, 0);
  }
}

#include <hip/hip_cooperative_groups.h>
namespace cg = cooperative_groups;
constexpr int SMEM_BYTES = 40960;


#define XB_TMO      128
#define XB_XCNT(j)  (256  + 64 * (j))
#define XB_XSUB(j)  (1280 + 64 * (j))
#define XB_XGEN(j)  (2304 + 64 * (j))
#define XB_TOP      3328
#define XB_TOPGEN   3392
#define XCD_BAR_WORDS 3456
#define XB_SPIN_CAP (1u << 22)
#define LAS __attribute__((address_space(3)))
DI unsigned xb_ld(unsigned* p) { return __hip_atomic_load(p, __ATOMIC_RELAXED, __HIP_MEMORY_SCOPE_AGENT); }
DI unsigned xb_add(unsigned* p, unsigned v) { return __hip_atomic_fetch_add(p, v, __ATOMIC_RELAXED, __HIP_MEMORY_SCOPE_AGENT); }
DI unsigned xb_xcc_id() { unsigned x; asm volatile("s_getreg_b32 %0, hwreg(HW_REG_XCC_ID, 0, 4)" : "=s"(x)); return x & 0xFu; }
#define XB_SPIN(cond, bar) do { unsigned _sp = 0; while (cond) { __builtin_amdgcn_s_sleep(1); \
    if ((++_sp & 255u) == 0u) { if (xb_ld(&(bar)[XB_TMO])) break; if (_sp > XB_SPIN_CAP) { atomicAdd(&(bar)[XB_TMO], 1u); break; } } } } while (0)
struct XcdBarrier { unsigned* bar; volatile LAS unsigned* st; };
DI XcdBarrier xcd_barrier_post(unsigned* bar, volatile LAS unsigned* st) {
  XcdBarrier b; b.bar = bar; b.st = st;
  if (tid_now() == 0) (void)xb_add(&bar[XB_XCNT(xb_xcc_id())], 1u);
  return b;
}
DI void xcd_barrier_complete(unsigned* bar, unsigned x, unsigned& nloc, unsigned& nx) {
  const unsigned G = gridDim.x;
  unsigned sum, cnt, mine, sp = 0u;
  for (;;) {
    sum = 0u; cnt = 0u; mine = 0u;
#pragma unroll
    for (unsigned j = 0; j < 16; ++j) { const unsigned c = xb_ld(&bar[XB_XCNT(j)]); sum += c; cnt += (c > 0u) ? 1u : 0u; mine = (j == x) ? c : mine; }
    if (sum == G) break;
    __builtin_amdgcn_s_sleep(1);
    if ((++sp & 255u) == 0u) { if (xb_ld(&bar[XB_TMO])) break; if (sp > XB_SPIN_CAP) { atomicAdd(&bar[XB_TMO], 1u); break; } }
  }
  nloc = mine > 0u ? mine : 1u; nx = cnt > 0u ? cnt : 1u;
}
DI void xcd_barrier(const XcdBarrier& b) {
  asm volatile("s_waitcnt vmcnt(0)" ::: "memory");
  __syncthreads();
  if (tid_now() == 0) {
    unsigned* bar = b.bar;
    const unsigned bx = xb_xcc_id();
    __builtin_amdgcn_s_waitcnt(0);
    unsigned nloc = b.st[0], nx = b.st[1];
    if (nloc == 0u) { xcd_barrier_complete(bar, bx, nloc, nx); b.st[0] = nloc; b.st[1] = nx; }
    const unsigned old = xb_add(&bar[XB_XSUB(bx)], 1u);
    const unsigned gen = old / nloc;
    if (old + 1u == (gen + 1u) * nloc) {
      __builtin_amdgcn_s_sleep(64);
      __builtin_amdgcn_fence(__ATOMIC_RELEASE, "agent");
      asm volatile("s_waitcnt vmcnt(0)" ::: "memory");
      const unsigned og = xb_add(&bar[XB_TOP], 1u);
      const unsigned tg = og / nx;
      if (og + 1u == (tg + 1u) * nx) xb_add(&bar[XB_TOPGEN], 1u);
      else XB_SPIN(xb_ld(&bar[XB_TOPGEN]) == tg, bar);
      __builtin_amdgcn_fence(__ATOMIC_ACQUIRE, "agent");
      xb_add(&bar[XB_XGEN(bx)], 1u);
      asm volatile("s_waitcnt vmcnt(0)" ::: "memory");
    } else {
      XB_SPIN(xb_ld(&bar[XB_XGEN(bx)]) == gen, bar);
      __builtin_amdgcn_fence(__ATOMIC_ACQUIRE, "agent");
      asm volatile("s_waitcnt vmcnt(0)" ::: "memory");
    }
  }
  __syncthreads();
}

constexpr int QCTR_STRIDE = 32;
constexpr int QCTR_WORDS = 16 * 8 * QCTR_STRIDE;
DI int q_pop(unsigned* ctr, volatile LAS int* slot) {
  __syncthreads();
  if (tid_now() == 0) *slot = (int)__hip_atomic_fetch_add(ctr, 1u, __ATOMIC_RELAXED, __HIP_MEMORY_SCOPE_AGENT);
  __syncthreads();
  return *slot;
}
template <class NF, class BF>
DI void run_queues(unsigned* ctr, int myx, volatile LAS int* slot, NF nitems_of_q, BF body) {
#pragma unroll 1
  for (int s = 0; s < 8; ++s) {
    const int q = (myx + s) & 7;
    const int n = nitems_of_q(q);
#pragma unroll 1
    for (;;) {
      const int idx = q_pop(ctr + q * QCTR_STRIDE, slot);
      if (idx >= n) break;
      body(q, idx);
    }
  }
}

#define GRID_BARRIER() xcd_barrier(xb)
#define REP(k) for (int rep_ = 0; rep_ < (DUP == (k) ? 2 : 1); ++rep_)

__global__ void __launch_bounds__(256, 3) mega_kernel(Params p) {
  __shared__ __attribute__((aligned(16))) char smem[SMEM_BYTES];
  cg::grid_group grid = cg::this_grid();
  const int G = gridDim.x, bid = blockIdx.x;
  uint4* xbw = (uint4*)(smem + SMEM_BYTES - 16);
  if (tid_now() == 0) *xbw = make_uint4(0u, 0u, 0u, 0u);
  volatile LAS int* qslot = (volatile LAS int*)xbw + 2;
  XcdBarrier xb = xcd_barrier_post(p.bar, (volatile LAS unsigned*)xbw);
  if (p.never) grid.sync();
  REP(1) for (int it = bid; it < MODP_ITEMS + CONVT_ITEMS + CONVK_ITEMS + 1; it += G) {
    if (it < MODP_ITEMS) stage_mod_partial(p, it, smem);
    else if (it < MODP_ITEMS + CONVT_ITEMS) stage_convT(p, it - MODP_ITEMS, smem);
    else if (it < MODP_ITEMS + CONVT_ITEMS + CONVK_ITEMS) stage_convS(p, it - MODP_ITEMS - CONVT_ITEMS);
    else stage_rope(p);
  }
  GRID_BARRIER();
  for (int it = bid; it < MODR_ITEMS; it += G) stage_mod_reduce(p, it);
  GRID_BARRIER();
#pragma unroll 1
  for (int l = 0; l < 2; ++l) {
    REP(2) for (int it = bid; it < MTOT / 8; it += G) stage_norm(p, l, 0, it);
    if (l == 0) for (int it = bid; it < CQP_ITEMS; it += G) stage_cq_partial(p, it, smem);
    GRID_BARRIER();
    {
      const int myx = xb_xcc_id() & 7;
      unsigned* ctr = p.qctr + (l * 8 + 0) * 8 * QCTR_STRIDE;
      const int nlat = l == 0 ? 288 : 256;
      run_queues(ctr, myx, qslot,
        [&](int q) { return nlat * (q < 2 ? 3 : 2) + (l == 0 ? 0 : 32); },
        [&](int q, int idx) {
          const int nN = q < 2 ? 3 : 2;
          int mt, nt;
          if (idx < nlat * nN) { mt = idx / nN; nt = q + 8 * (idx - mt * nN); }
          else { mt = 256 + (idx - nlat * nN); nt = q < 2 ? q + 16 : q + 8; }
          stage_inproj(p, l, mt * 18 + nt, smem);
          if (DUP == 3) stage_inproj(p, l, mt * 18 + nt, smem);
        });
    }
    if (l == 0) for (int it = bid; it < CQR_ITEMS; it += G) stage_cq_reduce(p, it);
    GRID_BARRIER();
    {
      const int myx = xb_xcc_id() & 7;
      run_queues(p.qctr + (l * 8 + 1) * 8 * QCTR_STRIDE, myx, qslot, [&](int) { return 192; },
        [&](int q, int idx) {
          const int b = q + 8 * (idx / 96), r = idx % 96;
          stage_gqa(p, l, b * 96 + r, smem);
          if (DUP == 40) stage_gqa(p, l, b * 96 + r, smem);
          constexpr int NV = CONVV_ITEMS / 2;
          const int g = q * 192 + idx;
          for (int f = g * NV / 1536; f < (g + 1) * NV / 1536; ++f) stage_convS(p, CONVK_ITEMS + l * NV + f);
          const int ncv = (l == 0 ? MTOT : NTOK) / CONV_TT;
          const int c0 = g * ncv / 1536, c1 = (g + 1) * ncv / 1536;
          if (c0 < c1) {
            __syncthreads();
            for (int f = c0; f < c1; ++f) { stage_conv(p, l, f, smem); if (DUP == 44) stage_conv(p, l, f, smem); }
          }
        });
      run_queues(p.qctr + (l * 8 + 2) * 8 * QCTR_STRIDE, myx, qslot, [&](int) { return 192; },
        [&](int q, int idx) {
          const int b = q + 8 * (idx / 96), r = idx % 96;
          stage_na2(p, l, b * 96 + r, smem);
          if (DUP == 43) stage_na2(p, l, b * 96 + r, smem);
          constexpr int NU = CONVU_ITEMS / 2;
          const int g = q * 192 + idx;
          stage_convU(p, l, g * NU / 1536, (g + 1) * NU / 1536, smem);
        });
      const int nctx = l == 0 ? CTXATT_ITEMS : 0;
      for (int it = bid; it < nctx; it += G) stage_ctxatt(p, it, smem);
    }
    GRID_BARRIER();
    {
      const int myx = xb_xcc_id() & 7, nlat = l == 0 ? 288 : 256;
      run_queues(p.qctr + (l * 8 + 3) * 8 * QCTR_STRIDE, myx, qslot, [&](int) { return nlat; },
        [&](int q, int idx) { stage_outproj(p, l, idx * 8 + q, smem); });
    }
    GRID_BARRIER();
    {
      const int myx = xb_xcc_id() & 7, nlat = l == 0 ? 288 : 256;
      run_queues(p.qctr + (l * 8 + 4) * 8 * QCTR_STRIDE, myx, qslot, [&](int) { return nlat; },
        [&](int q, int idx) { stage_route(p, l, idx * 8 + q, smem); if (DUP == 7) stage_route(p, l, idx * 8 + q, smem); });
    }
    GRID_BARRIER();
    {
      const int myx = xb_xcc_id() & 7;
      const int ntile = (l == 0 ? MTOT : NTOK) / PEER_TPI;
      _Float16* partial = (_Float16*)p.U;
      run_queues(p.qctr + (l * 8 + 5) * 8 * QCTR_STRIDE, myx, qslot, [&](int) { return ntile; },
        [&](int q, int idx) { stage_peer_u(p, l, q, idx, partial); if (DUP == 50) stage_peer_u(p, l, q, idx, partial); });
      GRID_BARRIER();
      for (int it = bid; it < (l == 0 ? MTOT : NTOK) / (4 * PEERC_RPW); it += G) stage_peer_combine(p, l, it, partial);
      GRID_BARRIER();
      run_queues(p.qctr + (l * 8 + 6) * 8 * QCTR_STRIDE, myx, qslot, [&](int) { return ntile; },
        [&](int q, int idx) { if (DUP == 51) stage_peer_v(p, l, q, idx, 0.f); stage_peer_v(p, l, q, idx); });
    }
    GRID_BARRIER();
  }
  for (int it = bid; it < NTOK / 8; it += G) stage_final(p, it);
}

extern "C" void kernel_launch(void* const* d_in, const int* in_sizes, int n_in, void* d_out, int out_size, void* d_ws, size_t ws_size,
                              hipStream_t stream) {
  Params p{};
  const float** f = (const float**)&p;
  for (int i = 0; i < 22; ++i) f[i] = (const float*)d_in[i];
  p.out = (float*)d_out;
  char* w = (char*)d_ws; size_t off = 0;
  auto take = [&](size_t bytes) { char* r = w + off; off += (bytes + 255) & ~(size_t)255; return r; };
  p.win = (bf16*)take((size_t)2 * INC * D * 2);
  p.wout = (bf16*)take((size_t)2 * D * D * 2);
  p.wq = (bf16*)take((size_t)2 * 2048 * D * 2);
  p.pk = (bf16*)take(PK_N * 2);
  p.pu8 = (unsigned char*)take(PU_N);
  p.pv8 = (unsigned char*)take(PU_N);
  p.esc = (float*)take((size_t)2 * NEXP * 64 * 4);
  p.ssq16 = (float*)take((size_t)16 * MTOT * 4);
  p.hs8 = (float*)take((size_t)8 * MTOT * 4);
  p.cqp = (float*)take((size_t)CQ_KS * 2 * 17 * 2048 * 4);
  p.cq = (float*)take((size_t)2 * 17 * 2048 * 4);
  p.hq = (signed char*)take((size_t)MTOT * D);
  p.modp = (float*)take((size_t)2 * 8 * 17 * 6144 * 4);
  p.mod = (float*)take((size_t)2 * 17 * 6144 * 4);
  p.ropetab = (float*)take(64 * 16 * 2 * 4);
  p.H = (bf16*)take((size_t)MTOT * D * 2);
  p.CAT = p.H;
  p.U = (bf16*)take((size_t)MTOT * 256 * 2);
  p.QN = (bf16*)take((size_t)NB * 6 * SEQ2 * 64 * 2);
  p.KN = (bf16*)take((size_t)NB * 6 * SEQ2 * 64 * 2);
  p.VNt = (bf16*)take((size_t)NB * 6 * SEQ2 * 64 * 2);
  p.QG = (bf16*)take((size_t)NB * 6 * SEQ2 * 64 * 2);
  p.KG = (bf16*)take((size_t)NB * 2 * SEQ2 * 64 * 2);
  p.VGt = (bf16*)take((size_t)NB * 2 * SEQ2 * 64 * 2);
  p.H2 = (bf16*)((char*)p.U + (size_t)8 * MTOT * 128 * 2);
  p.XC = nullptr;
  p.XB = (bf16*)take((size_t)MTOT * D * 2);
  p.ridx = (int*)take((size_t)MTOT * 256 * 4);
  p.rg = (float*)p.ridx;
  p.bar = (unsigned*)take(XCD_BAR_WORDS * 4);
  p.qctr = (unsigned*)take(QCTR_WORDS * 4);
  if (off > ws_size) return;
  static int grid_blocks = 0;
  if (!grid_blocks) {
    int dev = 0, cus = 0, per_cu = 0;
    hipGetDevice(&dev);
    hipDeviceGetAttribute(&cus, hipDeviceAttributeMultiprocessorCount, dev);
    hipOccupancyMaxActiveBlocksPerMultiprocessor(&per_cu, mega_kernel, 256, 0);
    if (per_cu > 3) per_cu = 3;
    grid_blocks = cus * per_cu;
  }
  void* args[] = {&p};
  hipMemsetAsync(p.bar, 0, (size_t)(XCD_BAR_WORDS + QCTR_WORDS) * 4, stream);
  hipLaunchCooperativeKernel((void*)mega_kernel, dim3(grid_blocks), dim3(256), args, 0, stream);
}
```

```cpp
#include <hip/hip_runtime.h>
#include <stdint.h>

typedef __attribute__((ext_vector_type(8))) short bf16x8;
typedef __attribute__((ext_vector_type(16))) float f32x16;
typedef __attribute__((ext_vector_type(2))) __bf16 bf2_t;
typedef __attribute__((ext_vector_type(2))) float f2_t;
typedef unsigned short bf16;
typedef __attribute__((ext_vector_type(2))) _Float16 h2_t;
typedef __attribute__((ext_vector_type(4))) unsigned u32x4;
typedef __attribute__((ext_vector_type(2))) unsigned u32x2;

#define DI __device__ __forceinline__
#ifndef PROBE
#define PROBE 0
#endif
#ifndef DUP
#define DUP 0
#endif
#define MFMA(a, b, c) __builtin_amdgcn_mfma_f32_32x32x16_bf16((a), (b), (c), 0, 0, 0)

constexpr int D = 1024, NB = 16, T = 2048, CL = 256;
constexpr int NTOK = NB * T;
constexpr int NCTX = NB * CL;
constexpr int MTOT = NTOK + NCTX;
constexpr int INC = 2304;
constexpr int SEQ2 = T + CL;
constexpr int NEXP = 16384;
constexpr float EPS = 1e-6f;
constexpr float L2E = 1.4426950408889634f;

struct Params {
  const float *x, *c, *ctx, *c_ctx, *norm1_g, *norm2_g, *w_ada, *b_ada, *w_in, *conv_w, *conv_b, *conv_ln_g,
      *conv_ln_b, *na_rel_bias, *gqa_q_norm, *gqa_k_norm, *w_out, *peer_w_q, *peer_keys, *peer_u, *peer_v, *final_norm_g;
  float* out;
  bf16 *win, *wout, *wq, *pk;
  unsigned char *pu8, *pv8;
  float *esc;
  float *ssq16, *hs8;
  bf16 *XB;
  float *cqp, *cq;
  bf16 *H2;
  signed char* hq;
  float *modp, *mod, *ropetab;
  bf16 *H, *U, *QN, *KN, *VNt, *QG, *KG, *VGt, *CAT;
  float *XC;
  int* ridx;
  float* rg;
  unsigned* bar;
  unsigned* qctr;
  int never;
  int pad_;
};

DI int tid_now() { int t; asm volatile("v_mov_b32 %0, %1" : "=v"(t) : "v"((int)__builtin_amdgcn_workitem_id_x())); return t; }
DI unsigned pack2(float a, float b) {
  f2_t v = {a, b};
  bf2_t r = __builtin_convertvector(v, bf2_t);
  return __builtin_bit_cast(unsigned, r);
}
DI float bf_lo(unsigned u) { return __uint_as_float(u << 16); }
DI float bf_hi(unsigned u) { return __uint_as_float(u & 0xffff0000u); }
DI int sidx(int r) { return (r >> 2) * 32 + (r & 3); }
DI int crow(int e, int h) { return (e & 3) + 8 * (e >> 2) + 4 * h; }
DI float fexp2(float x) { return __builtin_amdgcn_exp2f(x); }
DI float silu_f(float x) { return x / (1.f + __expf(-x)); }
DI float sigmoid_f(float x) { return 1.f / (1.f + __expf(-x)); }
DI float gelu_tanh(float x) {
  float u = 0.7978845608028654f * (x + 0.044715f * x * x * x);
  float t = 1.f - 2.f / (1.f + __expf(2.f * u));
  return 0.5f * x * (1.f + t);
}
DI float shx(float v, int m, int lane) { return __int_as_float(__builtin_amdgcn_ds_bpermute((lane ^ m) << 2, __float_as_int(v))); }
DI int shxi(int v, int m, int lane) { return __builtin_amdgcn_ds_bpermute((lane ^ m) << 2, v); }
DI float wave_sum(float v, int lane) {
#pragma unroll
  for (int o = 32; o >= 1; o >>= 1) v += shx(v, o, lane);
  return v;
}
DI float* xres_row(const Params& p, int row) { return row < NTOK ? p.out + (size_t)row * D : p.XC + (size_t)(row - NTOK) * D; }
DI const float* xin_row(const Params& p, int layer, int row) {
  if (layer == 0) return row < NTOK ? p.x + (size_t)row * D : p.ctx + (size_t)(row - NTOK) * D;
  return xres_row(p, row);
}
DI int mod_row(int row) { return row < NTOK ? (row >> 11) : 16; }
DI int batch_of(int row) { return row < NTOK ? (row >> 11) : ((row - NTOK) >> 8); }
DI int pos_of(int row) { return row < NTOK ? (row & 2047) : (T + ((row - NTOK) & 255)); }

DI int perm_in(int n) {
  if (n >= 512) return n;
  int c = n >> 6, w = n & 63;
  return w < 32 ? 32 * c + w : 256 + 32 * c + (w - 32);
}
DI size_t fm_index(int n, int k) { return ((size_t)(n >> 5) * 64 + (k >> 4)) * 512 + ((((k >> 3) & 1) * 32 + (n & 31)) * 8) + (k & 7); }
DI void convT_tile(const float* __restrict__ src, bf16* __restrict__ dst, int K, int N, int k0, int n0, bool perm, float* tile  ) {
  const int tx = tid_now() & 63, ty = tid_now() >> 6;
  const int ns = perm ? perm_in(n0 + tx) : n0 + tx;
#pragma unroll
  for (int i = 0; i < 16; ++i) { int k = ty + 4 * i; tile[k * 65 + tx] = src[(size_t)(k0 + k) * N + ns]; }
  __syncthreads();
#pragma unroll
  for (int i = 0; i < 2; ++i) {
    const int pr = tid_now() + 256 * i;
    const int n = pr & 63, kc = pr >> 6;
    const float* t = tile + (kc * 8) * 65 + n;
    u32x4 o = {pack2(t[0], t[65]), pack2(t[2 * 65], t[3 * 65]), pack2(t[4 * 65], t[5 * 65]), pack2(t[6 * 65], t[7 * 65])};
    *(u32x4*)(dst + fm_index(n0 + n, k0 + kc * 8)) = o;
  }
  __syncthreads();
}
constexpr int CONVT_ITEMS = 2 * 1344;
DI void stage_convT(const Params& p, int item, char* smem) {
  float* tile = (float*)smem;
  int l = item / 1344, r = item % 1344;
  if (r < 576) { int kt = r / 36, nt = r % 36; convT_tile(p.w_in + (size_t)l * D * INC, p.win + (size_t)l * INC * D, D, INC, kt * 64, nt * 64, true, tile); }
  else if (r < 832) { r -= 576; int kt = r / 16, nt = r % 16; convT_tile(p.w_out + (size_t)l * D * D, p.wout + (size_t)l * D * D, D, D, kt * 64, nt * 64, false, tile); }
  else { r -= 832; int kt = r / 32, nt = r % 32; convT_tile(p.peer_w_q + (size_t)l * D * 2048, p.wq + (size_t)l * 2048 * D, D, 2048, kt * 64, nt * 64, false, tile); }
}
constexpr size_t PK_N = (size_t)2 * 16 * 128 * 128, PU_N = (size_t)2 * NEXP * D;
constexpr float SU = 1024.f, SV = 64.f;
constexpr int CONVK_ITEMS = (int)(PK_N / 2048), CONVV_ITEMS = (int)(PU_N / 4096), CONVU_ITEMS = 2 * NEXP / 4;
constexpr int CONVS_ITEMS = CONVK_ITEMS + CONVV_ITEMS + CONVU_ITEMS;
DI unsigned pack_fp8x4(float4 a, float s) {
  int r = 0;
  r = __builtin_amdgcn_cvt_pk_fp8_f32(a.x * s, a.y * s, r, false);
  r = __builtin_amdgcn_cvt_pk_fp8_f32(a.z * s, a.w * s, r, true);
  return (unsigned)r;
}
DI unsigned pack_i8x4(float4 a, float s) {
  const int x = (int)rintf(a.x * s), y = (int)rintf(a.y * s), z = (int)rintf(a.z * s), w = (int)rintf(a.w * s);
  return (unsigned)(x & 255) | ((unsigned)(y & 255) << 8) | ((unsigned)(z & 255) << 16) | ((unsigned)(w & 255) << 24);
}
DI void stage_convS(const Params& p, int item) {
  if (item < CONVK_ITEMS) {
    size_t e = (size_t)item * 2048 + tid_now() * 8;
    const float* src = p.peer_keys + e;
    float4 a = ((const float4*)src)[0], b = ((const float4*)src)[1];
    u32x4 o = {pack2(a.x, a.y), pack2(a.z, a.w), pack2(b.x, b.y), pack2(b.z, b.w)};
    *(u32x4*)(p.pk + e) = o;
    return;
  }
  item -= CONVK_ITEMS;
  if (item < CONVV_ITEMS) {
    size_t e = (size_t)item * 4096 + tid_now() * 16;
    const float* src = p.peer_v + e;
    float4 a = ((const float4*)src)[0], b = ((const float4*)src)[1], c = ((const float4*)src)[2], d = ((const float4*)src)[3];
    u32x4 o = {pack_fp8x4(a, SV), pack_fp8x4(b, SV), pack_fp8x4(c, SV), pack_fp8x4(d, SV)};
    *(u32x4*)(p.pv8 + e) = o;
    return;
  }
  item -= CONVV_ITEMS;
  {
    const int lane = tid_now() & 63, wave = tid_now() >> 6;
    const int r = item * 4 + wave;
    const float* src = p.peer_u + (size_t)r * D + lane * 16;
    float4 a = ((const float4*)src)[0], b = ((const float4*)src)[1], c = ((const float4*)src)[2], d = ((const float4*)src)[3];
    float m = fmaxf(fmaxf(fmaxf(fabsf(a.x), fabsf(a.y)), fmaxf(fabsf(a.z), fabsf(a.w))), fmaxf(fmaxf(fabsf(b.x), fabsf(b.y)), fmaxf(fabsf(b.z), fabsf(b.w))));
    m = fmaxf(m, fmaxf(fmaxf(fmaxf(fabsf(c.x), fabsf(c.y)), fmaxf(fabsf(c.z), fabsf(c.w))), fmaxf(fmaxf(fabsf(d.x), fabsf(d.y)), fmaxf(fabsf(d.z), fabsf(d.w)))));
#pragma unroll
    for (int o = 32; o >= 1; o >>= 1) m = fmaxf(m, shx(m, o, lane));
    m = fmaxf(m, 1e-30f);
    const float s = 127.f / m;
    u32x4 o = {pack_i8x4(a, s), pack_i8x4(b, s), pack_i8x4(c, s), pack_i8x4(d, s)};
    *(u32x4*)(p.pu8 + (size_t)r * D + lane * 16) = o;
  }
}
DI float dotbf(unsigned a, unsigned b, float acc) {
  const bf2_t x = __builtin_bit_cast(bf2_t, a), y = __builtin_bit_cast(bf2_t, b);
  return __builtin_amdgcn_fdot2_f32_bf16(x, y, acc, false);
}
DI void stage_convU(const Params& p, int l, int f0, int f1, char* smem) {
  if (f0 >= f1) return;
  const int tid = tid_now(), lane = tid & 63, wave = tid >> 6;
  __syncthreads();
  for (int i = tid; i < 17 * 128; i += 256) {
    const int mr = i >> 7, c8 = i & 127;
    const float* sp = p.mod + ((size_t)l * 17 + mr) * 6144 + 3072 + c8 * 8;
    const float4 s0 = ((const float4*)sp)[0], s1 = ((const float4*)sp)[1];
    u32x4 o = {pack2(s0.x, s0.y), pack2(s0.z, s0.w), pack2(s1.x, s1.y), pack2(s1.z, s1.w)};
    *(u32x4*)(smem + ((mr * 2 + (c8 & 1)) * 64 + (c8 >> 1)) * 16) = o;
  }
  __syncthreads();
#pragma unroll 1
  for (int f = f0; f < f1; ++f) {
    const int r = (l * (NEXP / 4) + f) * 4 + wave;
    const float* src = p.peer_u + (size_t)r * D + lane * 16;
    float4 a = ((const float4*)src)[0], b = ((const float4*)src)[1], c = ((const float4*)src)[2], d = ((const float4*)src)[3];
    float m = fmaxf(fmaxf(fmaxf(fabsf(a.x), fabsf(a.y)), fmaxf(fabsf(a.z), fabsf(a.w))), fmaxf(fmaxf(fabsf(b.x), fabsf(b.y)), fmaxf(fabsf(b.z), fabsf(b.w))));
    m = fmaxf(m, fmaxf(fmaxf(fmaxf(fabsf(c.x), fabsf(c.y)), fmaxf(fabsf(c.z), fabsf(c.w))), fmaxf(fmaxf(fabsf(d.x), fabsf(d.y)), fmaxf(fabsf(d.z), fabsf(d.w)))));
#pragma unroll
    for (int o = 32; o >= 1; o >>= 1) m = fmaxf(m, shx(m, o, lane));
    m = fmaxf(m, 1e-30f);
    const float s = 127.f / m;
    u32x4 o = {pack_i8x4(a, s), pack_i8x4(b, s), pack_i8x4(c, s), pack_i8x4(d, s)};
    *(u32x4*)(p.pu8 + (size_t)r * D + lane * 16) = o;
    const unsigned u0 = pack2(a.x, a.y), u1 = pack2(a.z, a.w), u2 = pack2(b.x, b.y), u3 = pack2(b.z, b.w);
    const unsigned u4 = pack2(c.x, c.y), u5 = pack2(c.z, c.w), u6 = pack2(d.x, d.y), u7 = pack2(d.z, d.w);
    float tv[17];
#pragma unroll
    for (int mr = 0; mr < 17; ++mr) {
      const u32x4 sa = *(const u32x4*)(smem + ((mr * 2) * 64 + lane) * 16), sb = *(const u32x4*)(smem + ((mr * 2 + 1) * 64 + lane) * 16);
      const unsigned a0 = sa[0], a1 = sa[1], a2 = sa[2], a3 = sa[3], b0 = sb[0], b1 = sb[1], b2 = sb[2], b3 = sb[3];
      float t = dotbf(u0, a0, 0.f); t = dotbf(u1, a1, t); t = dotbf(u2, a2, t); t = dotbf(u3, a3, t);
      t = dotbf(u4, b0, t); t = dotbf(u5, b1, t); t = dotbf(u6, b2, t); t = dotbf(u7, b3, t);
      tv[mr] = t;
      if ((mr & 3) == 3) asm volatile("" ::: "memory");
    }
    const float t16 = wave_sum(tv[16], lane);
    float r8[8], r4[4], r2[2], r1;
    {
      const bool up = lane & 1;
#pragma unroll
      for (int k = 0; k < 8; ++k) { const float keep = up ? tv[k + 8] : tv[k], give = up ? tv[k] : tv[k + 8]; r8[k] = keep + shx(give, 1, lane); }
    }
    {
      const bool up = lane & 2;
#pragma unroll
      for (int k = 0; k < 4; ++k) { const float keep = up ? r8[k + 4] : r8[k], give = up ? r8[k] : r8[k + 4]; r4[k] = keep + shx(give, 2, lane); }
    }
    {
      const bool up = lane & 4;
#pragma unroll
      for (int k = 0; k < 2; ++k) { const float keep = up ? r4[k + 2] : r4[k], give = up ? r4[k] : r4[k + 2]; r2[k] = keep + shx(give, 4, lane); }
    }
    {
      const bool up = lane & 8;
      const float keep = up ? r2[1] : r2[0], give = up ? r2[0] : r2[1];
      r1 = keep + shx(give, 8, lane);
    }
    r1 += shx(r1, 16, lane);
    r1 += shx(r1, 32, lane);
    const int idx = 8 * (lane & 1) + 4 * ((lane >> 1) & 1) + 2 * ((lane >> 2) & 1) + ((lane >> 3) & 1);
    float* er = p.esc + (size_t)r * 64;
    const float2 ov = {lane < 16 ? r1 : t16, m * (1.f / 127.f)};
    if (lane < 17) *(float2*)(er + 2 * (lane < 16 ? idx : 16)) = ov;
  }
  __syncthreads();
}
constexpr int CQ_KS = 32;
constexpr int CQP_ITEMS = 2 * CQ_KS * 8;
DI void stage_cq_partial(const Params& p, int item, char* smem) {
  float* sc = (float*)smem;
  const int l = item / (CQ_KS * 8), r = item % (CQ_KS * 8), kc = r >> 3, nc = r & 7;
  for (int i = tid_now(); i < 17 * 32; i += 256) {
    const int rr = i >> 5, k = i & 31;
    sc[i] = p.mod[((size_t)l * 17 + rr) * 6144 + 3072 + kc * 32 + k];
  }
  const int n = nc * 256 + tid_now();
  const float* w = p.peer_w_q + ((size_t)l * D + kc * 32) * 2048 + n;
  float wv[32];
#pragma unroll
  for (int k = 0; k < 32; ++k) wv[k] = w[(size_t)k * 2048];
  __syncthreads();
  float acc[17];
#pragma unroll
  for (int i = 0; i < 17; ++i) acc[i] = 0.f;
#pragma unroll
  for (int k4 = 0; k4 < 8; ++k4)
#pragma unroll
    for (int i = 0; i < 17; ++i) {
      const float4 s = *(const float4*)(sc + i * 32 + k4 * 4);
      acc[i] += s.x * wv[4 * k4] + s.y * wv[4 * k4 + 1] + s.z * wv[4 * k4 + 2] + s.w * wv[4 * k4 + 3];
    }
#pragma unroll
  for (int i = 0; i < 17; ++i) p.cqp[(((size_t)l * CQ_KS + kc) * 17 + i) * 2048 + n] = acc[i];
  __syncthreads();
}
constexpr int CQR_ITEMS = 2 * 17 * 2048 / 256;
DI void stage_cq_reduce(const Params& p, int item) {
  const int idx = item * 256 + tid_now();
  const int l = idx / (17 * 2048), rem = idx % (17 * 2048);
  float v[CQ_KS];
#pragma unroll
  for (int kc = 0; kc < CQ_KS; ++kc) v[kc] = p.cqp[((size_t)l * CQ_KS + kc) * 17 * 2048 + rem];
  float s = 0.f;
#pragma unroll
  for (int kc = 0; kc < CQ_KS; ++kc) s += v[kc];
  p.cq[idx] = s;
}
DI void stage_rope(const Params& p) {
  for (int i = tid_now(); i < 64 * 16; i += 256) {
    int pos = i >> 4, f = i & 15;
    float inv = powf(10000.f, -(float)f / 16.f);
    float ang = (float)pos * inv;
    p.ropetab[2 * i] = cosf(ang); p.ropetab[2 * i + 1] = sinf(ang);
  }
}

constexpr int MODP_ITEMS = 2 * 8 * 24;
DI void stage_mod_partial(const Params& p, int item, char* smem) {
  float* sc = (float*)smem;
  int l = item / 192, r = item % 192, kc = r / 24, nc = r % 24;
  for (int i = tid_now(); i < 17 * 128; i += 256) {
    int rr = i >> 7, k = i & 127;
    float v = rr < 16 ? p.c[rr * D + kc * 128 + k] : p.c_ctx[kc * 128 + k];
    sc[i] = silu_f(v);
  }
  __syncthreads();
  float acc[17];
#pragma unroll
  for (int i = 0; i < 17; ++i) acc[i] = 0.f;
  const int n = nc * 256 + tid_now();
  const float* w = p.w_ada + ((size_t)l * D + kc * 128) * 6144 + n;
#pragma unroll 1
  for (int k0 = 0; k0 < 128; k0 += 32) {
    float wv[32];
#pragma unroll
    for (int k = 0; k < 32; ++k) wv[k] = w[(size_t)(k0 + k) * 6144];
#pragma unroll
    for (int k4 = 0; k4 < 8; ++k4)
#pragma unroll
      for (int i = 0; i < 17; ++i) {
        const float4 s = *(const float4*)(sc + i * 128 + k0 + k4 * 4);
        acc[i] += s.x * wv[4 * k4] + s.y * wv[4 * k4 + 1] + s.z * wv[4 * k4 + 2] + s.w * wv[4 * k4 + 3];
      }
  }
#pragma unroll
  for (int i = 0; i < 17; ++i) p.modp[(((size_t)l * 8 + kc) * 17 + i) * 6144 + n] = acc[i];
  __syncthreads();
}
constexpr int MODR_ITEMS = 2 * 17 * 6144 / 256;
DI void stage_mod_reduce(const Params& p, int item) {
  int idx = item * 256 + tid_now();
  int l = idx / (17 * 6144), rem = idx % (17 * 6144), n = rem % 6144;
  float s = p.b_ada[l * 6144 + n];
#pragma unroll
  for (int kc = 0; kc < 8; ++kc) s += p.modp[((size_t)l * 8 + kc) * 17 * 6144 + rem];
  p.mod[idx] = s;
}

DI void norm_row(const Params& p, const float* __restrict__ xr, const float* __restrict__ g, const float* __restrict__ sh,
                 const float* __restrict__ sc, bf16* __restrict__ hr, signed char* __restrict__ hq = nullptr, float* __restrict__ hsc = nullptr) {
  const int lane = tid_now() & 63;
  float4 v[4]; float ss = 0.f;
#pragma unroll
  for (int i = 0; i < 4; ++i) { v[i] = ((const float4*)xr)[lane + 64 * i]; ss += v[i].x * v[i].x + v[i].y * v[i].y + v[i].z * v[i].z + v[i].w * v[i].w; }
  ss = wave_sum(ss, lane);
  const float rstd = rsqrtf(ss * (1.f / D) + EPS);
#pragma unroll
  for (int i = 0; i < 4; ++i) {
    float4 gg = ((const float4*)g)[lane + 64 * i], s1 = ((const float4*)sh)[lane + 64 * i], s2 = ((const float4*)sc)[lane + 64 * i];
    float a = v[i].x * rstd * gg.x * (1.f + s2.x) + s1.x, b = v[i].y * rstd * gg.y * (1.f + s2.y) + s1.y;
    float c = v[i].z * rstd * gg.z * (1.f + s2.z) + s1.z, d = v[i].w * rstd * gg.w * (1.f + s2.w) + s1.w;
    u32x2 o = {pack2(a, b), pack2(c, d)};
    ((u32x2*)hr)[lane + 64 * i] = o;
    v[i].x = a; v[i].y = b; v[i].z = c; v[i].w = d;
  }
  if (hq != nullptr) {
    float m = 0.f;
#pragma unroll
    for (int i = 0; i < 4; ++i) m = fmaxf(m, fmaxf(fmaxf(fabsf(v[i].x), fabsf(v[i].y)), fmaxf(fabsf(v[i].z), fabsf(v[i].w))));
#pragma unroll
    for (int o = 32; o >= 1; o >>= 1) m = fmaxf(m, shx(m, o, lane));
    m = fmaxf(m, 1e-30f);
    const float s = 127.f / m;
#pragma unroll
    for (int i = 0; i < 4; ++i) ((unsigned*)hq)[lane + 64 * i] = pack_i8x4(v[i], s);
    if (lane == 0) *hsc = m * (1.f / 127.f);
  }
}
DI void stage_norm(const Params& p, int layer, int which, int item) {
  const int lane = tid_now() & 63;
  const int rowa = item * 8 + (tid_now() >> 6) * 2;
  const float* g = (which == 0 ? p.norm1_g : p.norm2_g) + layer * D;
  const float* mm = p.mod + ((size_t)layer * 17 + mod_row(rowa)) * 6144 + (which == 0 ? 0 : 3072);
  float4 v[2][4], gg[4], s1[4], s2[4];
#pragma unroll
  for (int j = 0; j < 2; ++j) {
    if (layer == 0) {
      const float* xr = xin_row(p, 0, rowa + j);
      u32x2* xw = (u32x2*)(p.XB + (size_t)(rowa + j) * D);
#pragma unroll
      for (int i = 0; i < 4; ++i) {
        v[j][i] = ((const float4*)xr)[lane + 64 * i];
        u32x2 o = {pack2(v[j][i].x, v[j][i].y), pack2(v[j][i].z, v[j][i].w)};
        xw[lane + 64 * i] = o;
      }
    } else {
      const u32x2* xr = (const u32x2*)(p.XB + (size_t)(rowa + j) * D);
#pragma unroll
      for (int i = 0; i < 4; ++i) { const u32x2 t = xr[lane + 64 * i]; const unsigned t0 = t[0], t1 = t[1]; v[j][i] = float4{bf_lo(t0), bf_hi(t0), bf_lo(t1), bf_hi(t1)}; }
    }
  }
#pragma unroll
  for (int i = 0; i < 4; ++i) { gg[i] = ((const float4*)g)[lane + 64 * i]; s1[i] = ((const float4*)mm)[lane + 64 * i]; s2[i] = ((const float4*)(mm + D))[lane + 64 * i]; }
#pragma unroll
  for (int j = 0; j < 2; ++j) {
    float ss = 0.f;
#pragma unroll
    for (int i = 0; i < 4; ++i) ss += v[j][i].x * v[j][i].x + v[j][i].y * v[j][i].y + v[j][i].z * v[j][i].z + v[j][i].w * v[j][i].w;
    ss = wave_sum(ss, lane);
    const float rstd = rsqrtf(ss * (1.f / D) + EPS);
    bf16* hr = p.H + (size_t)(rowa + j) * D;
#pragma unroll
    for (int i = 0; i < 4; ++i) {
      const float a = v[j][i].x * rstd * gg[i].x * (1.f + s2[i].x) + s1[i].x, b = v[j][i].y * rstd * gg[i].y * (1.f + s2[i].y) + s1[i].y;
      const float c = v[j][i].z * rstd * gg[i].z * (1.f + s2[i].z) + s1[i].z, d = v[j][i].w * rstd * gg[i].w * (1.f + s2[i].w) + s1[i].w;
      u32x2 o = {pack2(a, b), pack2(c, d)};
      ((u32x2*)hr)[lane + 64 * i] = o;
    }
  }
}
DI void stage_final(const Params& p, int item) {
  const int lane = tid_now() & 63;
  const int rowa = item * 8 + (tid_now() >> 6) * 2;
  float4 v[2][4], gg[4];
#pragma unroll
  for (int j = 0; j < 2; ++j) {
    const u32x2* xr = (const u32x2*)(p.XB + (size_t)(rowa + j) * D);
#pragma unroll
    for (int i = 0; i < 4; ++i) { const u32x2 t = xr[lane + 64 * i]; const unsigned t0 = t[0], t1 = t[1]; v[j][i] = float4{bf_lo(t0), bf_hi(t0), bf_lo(t1), bf_hi(t1)}; }
  }
#pragma unroll
  for (int i = 0; i < 4; ++i) gg[i] = ((const float4*)p.final_norm_g)[lane + 64 * i];
#pragma unroll
  for (int j = 0; j < 2; ++j) {
    float ss = 0.f;
#pragma unroll
    for (int i = 0; i < 4; ++i) ss += v[j][i].x * v[j][i].x + v[j][i].y * v[j][i].y + v[j][i].z * v[j][i].z + v[j][i].w * v[j][i].w;
    ss = wave_sum(ss, lane);
    const float rstd = rsqrtf(ss * (1.f / D) + EPS);
#pragma unroll
    for (int i = 0; i < 4; ++i) {
      float4 o = {v[j][i].x * rstd * gg[i].x, v[j][i].y * rstd * gg[i].y, v[j][i].z * rstd * gg[i].z, v[j][i].w * rstd * gg[i].w};
      ((float4*)(p.out + (size_t)(rowa + j) * D))[lane + 64 * i] = o;
    }
  }
}

constexpr int LROW = 144;
constexpr int LTILE = 128 * LROW;
constexpr int GEMM_SMEM = 2 * LTILE;

template <bool ORIENT_T, bool PEEL = false>
DI void gemm_core(const bf16* __restrict__ A, const bf16* __restrict__ W, char* smem, f32x16 (&acc)[2][2]) {
  const int tid = tid_now(), lane = tid & 63, wave = tid >> 6;
  const int wm = wave >> 1, wn = wave & 1, l31 = lane & 31, hh = lane >> 5;
  const int lrow = tid >> 3, kc = tid & 7;
#pragma unroll
  for (int i = 0; i < 2; ++i)
#pragma unroll
    for (int j = 0; j < 2; ++j)
#pragma unroll
      for (int e = 0; e < 16; ++e) acc[i][j][e] = 0.f;
  u32x4 ra[4];
  bf16x8 wf[2][4];
  const bf16* ap = A + (size_t)lrow * D + kc * 8;
  const bf16* wp = W + (size_t)(wn * 2) * 64 * 512 + lane * 8;
#pragma unroll
  for (int i = 0; i < 4; ++i) ra[i] = *(const u32x4*)(ap + (size_t)(32 * i) * D);
  if (PEEL) {
#pragma unroll
    for (int s = 0; s < 4; ++s)
#pragma unroll
      for (int ft = 0; ft < 2; ++ft) wf[ft][s] = *(const bf16x8*)(wp + (size_t)(ft * 64 + s) * 512);
    __builtin_amdgcn_sched_barrier(0);
  } else {
#pragma unroll
    for (int ft = 0; ft < 2; ++ft)
#pragma unroll
      for (int s = 0; s < 4; ++s) wf[ft][s] = *(const bf16x8*)(wp + (size_t)(ft * 64 + s) * 512);
  }
  auto ktile = [&](const int kt, const bool more) {
    char* sa = smem + (kt & 1) * LTILE;
#pragma unroll
    for (int i = 0; i < 4; ++i) *(u32x4*)(sa + (lrow + 32 * i) * LROW + kc * 16) = ra[i];
    __syncthreads();
    if (more) {
#pragma unroll
      for (int i = 0; i < 4; ++i) ra[i] = *(const u32x4*)(ap + (size_t)(32 * i) * D + (kt + 1) * 64);
    }
    if (PEEL) __builtin_amdgcn_sched_barrier(0);
#pragma unroll
    for (int s = 0; s < 4; ++s) {
      bf16x8 af[2];
#pragma unroll
      for (int t = 0; t < 2; ++t) af[t] = *(const bf16x8*)(sa + (wm * 64 + t * 32 + l31) * LROW + (s * 16 + hh * 8) * 2);
#pragma unroll
      for (int ft = 0; ft < 2; ++ft)
#pragma unroll
        for (int tt = 0; tt < 2; ++tt)
          acc[ft][tt] = ORIENT_T ? MFMA(wf[ft][s], af[tt], acc[ft][tt]) : MFMA(af[tt], wf[ft][s], acc[ft][tt]);
      if (more) {
#pragma unroll
        for (int ft = 0; ft < 2; ++ft) wf[ft][s] = *(const bf16x8*)(wp + (size_t)(ft * 64 + (kt + 1) * 4 + s) * 512);
      }
      if (PEEL) __builtin_amdgcn_sched_barrier(0);
    }
    };
  if (PEEL) {
#pragma unroll 1
    for (int kt = 0; kt < 15; ++kt) ktile(kt, true);
    ktile(15, false);
  } else {
#pragma unroll 1
    for (int kt = 0; kt < 16; ++kt) ktile(kt, kt + 1 < 16);
  }
  __syncthreads();
}

constexpr int INPROJ_ITEMS = 288 * 18;
DI void store4(bf16* dst, float a, float b, float c, float d) { u32x2 o = {pack2(a, b), pack2(c, d)}; *(u32x2*)dst = o; }
DI void store_pair(bf16* rowbase, int hh, float a0, float a1, float a2, float a3, float b0, float b1, float b2, float b3) {
  unsigned ax = pack2(a0, a1), ay = pack2(a2, a3), bx = pack2(b0, b1), by = pack2(b2, b3);
  const auto r0 = __builtin_amdgcn_permlane32_swap(ax, bx, false, false); ax = r0[0]; bx = r0[1];
  const auto r1 = __builtin_amdgcn_permlane32_swap(ay, by, false, false); ay = r1[0]; by = r1[1];
  u32x4 o = {ax, ay, bx, by};
  *(u32x4*)(rowbase + hh * 8) = o;
}

DI void stage_inproj(const Params& p, int layer, int item, char* smem) {
  const int mt = item / 18, nt = item % 18;
  if (layer == 1 && mt >= 256 && nt < 10) return;
  const int row0 = mt * 128, n0 = nt * 128;
  const bf16* A = p.H + (size_t)row0 * D;
  const bf16* W = p.win + ((size_t)layer * INC + n0) * D;
  const int lane = tid_now() & 63, wave = tid_now() >> 6, wm = wave >> 1, wn = wave & 1, l31 = lane & 31, hh = lane >> 5;
  const bool vtile = (nt >= 13 && nt <= 15) || nt == 17;
  f32x16 acc[2][2];
  const int b = batch_of(row0);
  if (vtile) {
    gemm_core<false, true>(A, W, smem, acc);
    bf16* base; int head;
    if (nt == 17) { head = wn; base = p.VGt + ((size_t)(b * 2 + head) * 64) * SEQ2; }
    else { head = (nt - 13) * 2 + wn; base = p.VNt + ((size_t)(b * 6 + head) * 64) * SEQ2; }
    const int pos0 = pos_of(row0) + wm * 64;
#pragma unroll
    for (int ft = 0; ft < 2; ++ft) {
      const int d = ft * 32 + l31;
#pragma unroll
      for (int tt = 0; tt < 2; ++tt)
#pragma unroll
        for (int g = 0; g < 4; g += 2)
          store_pair(base + (size_t)d * SEQ2 + pos0 + tt * 32 + 8 * g, hh, acc[ft][tt][4 * g], acc[ft][tt][4 * g + 1], acc[ft][tt][4 * g + 2], acc[ft][tt][4 * g + 3],
                     acc[ft][tt][4 * g + 4], acc[ft][tt][4 * g + 5], acc[ft][tt][4 * g + 6], acc[ft][tt][4 * g + 7]);
    }
    return;
  }
  gemm_core<true, true>(A, W, smem, acc);
  const int chunk = nt * 2 + wn;
#pragma unroll
  for (int tt = 0; tt < 2; ++tt) {
    const int row = row0 + wm * 64 + tt * 32 + l31;
    const int pos = pos_of(row);
    const bool isctx = row >= NTOK;
    if (chunk < 8) {
      bf16* dst = p.U + (size_t)row * 256 + 32 * chunk;
#pragma unroll
      for (int g = 0; g < 4; g += 2) {
        float u[8];
#pragma unroll
        for (int j = 0; j < 8; ++j) u[j] = acc[0][tt][4 * g + j] * sigmoid_f(acc[1][tt][4 * g + j]);
        store_pair(dst + 8 * g, hh, u[0], u[1], u[2], u[3], u[4], u[5], u[6], u[7]);
      }
    } else if (chunk < 14 || (chunk >= 20 && chunk < 26)) {
      const bool isq = chunk < 14;
      const int head = isq ? chunk - 8 : chunk - 20;
      const float sc = isq ? 0.125f : 1.f;
      bf16* dst = (isq ? p.QN : p.KN) + ((size_t)(b * 6 + head) * SEQ2 + pos) * 64;
#pragma unroll
      for (int ft = 0; ft < 2; ++ft)
#pragma unroll
        for (int g = 0; g < 4; g += 2)
          store_pair(dst + ft * 32 + 8 * g, hh, acc[ft][tt][4 * g] * sc, acc[ft][tt][4 * g + 1] * sc, acc[ft][tt][4 * g + 2] * sc, acc[ft][tt][4 * g + 3] * sc,
                     acc[ft][tt][4 * g + 4] * sc, acc[ft][tt][4 * g + 5] * sc, acc[ft][tt][4 * g + 6] * sc, acc[ft][tt][4 * g + 7] * sc);
    } else {
      const bool isq = chunk < 20;
      const int head = isq ? chunk - 14 : chunk - 32;
      const float* gn = (isq ? p.gqa_q_norm : p.gqa_k_norm) + layer * 64;
      float ss = 0.f;
#pragma unroll
      for (int ft = 0; ft < 2; ++ft)
#pragma unroll
        for (int e = 0; e < 16; ++e) ss += acc[ft][tt][e] * acc[ft][tt][e];
      ss += shx(ss, 32, lane);
      const float rstd = rsqrtf(ss * (1.f / 64.f) + EPS) ;
      const float sc = isq ? 0.125f : 1.f;
      bf16* dst = (isq ? p.QG + ((size_t)(b * 6 + head) * SEQ2 + pos) * 64 : p.KG + ((size_t)(b * 2 + head) * SEQ2 + pos) * 64);
      const int prow = pos >> 6, pcol = pos & 63;
#pragma unroll
      for (int g = 0; g < 4; g += 2) {
        float o1[8], o2[8];
#pragma unroll
        for (int j = 0; j < 8; ++j) {
          const int gg = g + (j >> 2);
          const int i = 8 * gg + 4 * hh + (j & 3);
          float x1 = acc[0][tt][4 * g + j] * rstd * gn[i];
          float x2 = acc[1][tt][4 * g + j] * rstd * gn[32 + i];
          if (!isctx && PROBE != 13) {
            const int ppos = (gg < 2) ? prow : pcol;
            const float2 cs = *(const float2*)(p.ropetab + 2 * (ppos * 16 + (i & 15)));
            float y1 = x1 * cs.x - x2 * cs.y, y2 = x1 * cs.y + x2 * cs.x;
            x1 = y1; x2 = y2;
          }
          o1[j] = x1 * sc; o2[j] = x2 * sc;
        }
        store_pair(dst + 8 * g, hh, o1[0], o1[1], o1[2], o1[3], o1[4], o1[5], o1[6], o1[7]);
        store_pair(dst + 32 + 8 * g, hh, o2[0], o2[1], o2[2], o2[3], o2[4], o2[5], o2[6], o2[7]);
      }
    }
  }
}

constexpr int CONV_TT = 16;
constexpr int CONV_SMEM = (CONV_TT + 30) * 512 + CONV_TT * 1024;
DI void stage_conv(const Params& p, int layer, int item, char* smem) {
  bf16* ub = (bf16*)smem;
  float* yb = (float*)(smem + (CONV_TT + 30) * 512);
  const int tid = tid_now();
  int row0, seq_lo, seq_hi;
  constexpr int NLAT = NTOK / CONV_TT;
  if (item < NLAT) { row0 = item * CONV_TT; seq_lo = row0 & ~2047; seq_hi = seq_lo + 2048; }
  else { row0 = NTOK + (item - NLAT) * CONV_TT; seq_lo = NTOK + (((item - NLAT) * CONV_TT) & ~255); seq_hi = seq_lo + 256; }
  for (int c = tid; c < (CONV_TT + 30) * 32; c += 256) {
    int r = c >> 5, cc = c & 31;
    int row = row0 - 15 + r;
    u32x4 v = {0u, 0u, 0u, 0u};
    if (row >= seq_lo && row < seq_hi) v = *(const u32x4*)(p.U + (size_t)row * 256 + cc * 8);
    *(u32x4*)(ub + r * 256 + cc * 8) = v;
  }
  __syncthreads();
  {
    const int ch = tid;
    float w[31];
#pragma unroll
    for (int j = 0; j < 31; ++j) w[j] = p.conv_w[((size_t)layer * 31 + j) * 256 + ch];
    const float bias = p.conv_b[layer * 256 + ch];
#pragma unroll 1
    for (int t0 = 0; t0 < CONV_TT; t0 += 8) {
      float in[38];
#pragma unroll
      for (int j = 0; j < 38; ++j) in[j] = __uint_as_float((unsigned)ub[(t0 + j) * 256 + ch] << 16);
#pragma unroll
      for (int t = 0; t < 8; ++t) {
        float a = bias;
#pragma unroll
        for (int j = 0; j < 31; ++j) a += in[t + j] * w[j];
        yb[(t0 + t) * 256 + ch] = a;
      }
    }
  }
  __syncthreads();
  {
    const int wave = tid >> 6, lane = tid & 63;
    const float4 g = ((const float4*)(p.conv_ln_g + layer * 256))[lane], bb = ((const float4*)(p.conv_ln_b + layer * 256))[lane];
    for (int t = wave * (CONV_TT / 4); t < (wave + 1) * (CONV_TT / 4); ++t) {
      float4 v = ((const float4*)(yb + t * 256))[lane];
      float mu = wave_sum(v.x + v.y + v.z + v.w, lane) * (1.f / 256.f);
      float dx = v.x - mu, dy = v.y - mu, dz = v.z - mu, dw = v.w - mu;
      float var = wave_sum(dx * dx + dy * dy + dz * dz + dw * dw, lane) * (1.f / 256.f);
      float rs = rsqrtf(var + EPS);
      float a = silu_f(dx * rs * g.x + bb.x), b = silu_f(dy * rs * g.y + bb.y), c = silu_f(dz * rs * g.z + bb.z), d = silu_f(dw * rs * g.w + bb.w);
      store4(p.CAT + (size_t)(row0 + t) * D + lane * 4, a, b, c, d);
    }
  }
  __syncthreads();
}

DI int kperm(int i) { return (i & 19) | ((i & 4) << 1) | ((i & 8) >> 1); }
DI int keyoff(int e, int h) { return (e & 3) + 4 * ((e >> 2) & 1) + 8 * h + 16 * (e >> 3); }
DI bf16x8 pack8(const f32x16& x, int s) {
  u32x4 r = {pack2(x[8 * s], x[8 * s + 1]), pack2(x[8 * s + 2], x[8 * s + 3]), pack2(x[8 * s + 4], x[8 * s + 5]), pack2(x[8 * s + 6], x[8 * s + 7])};
  return __builtin_bit_cast(bf16x8, r);
}

constexpr int NA_ITEMS = 6144 / 4;
DI void stage_na(const Params& p, int layer, int item) {
  const int lane = tid_now() & 63, wave = tid_now() >> 6, l31 = lane & 31, hh = lane >> 5;
  const int wi = item * 4 + wave;
  const int qhalf = wi & 1, head = (wi >> 1) % 6, br = wi / 12, r = br & 31, b = br >> 5;
  const int r0 = min(max(r - 4, 0), 24);
  const size_t hb = (size_t)(b * 6 + head);
  const bf16* Q = p.QN + (hb * SEQ2 + r * 64 + qhalf * 32 + l31) * 64;
  const bf16* Kb = p.KN + hb * SEQ2 * 64;
  const bf16* Vb = p.VNt + hb * 64 * SEQ2;
  const float* bias = p.na_rel_bias + ((size_t)layer * 6 + head) * 15 * 31;
  bf16x8 qf[4];
#pragma unroll
  for (int s = 0; s < 4; ++s) qf[s] = *(const bf16x8*)(Q + 16 * s + 8 * hh);
  f32x16 o[2];
#pragma unroll
  for (int e = 0; e < 16; ++e) { o[0][e] = 0.f; o[1][e] = 0.f; }
  float m = -1e30f, l = 0.f;
  const int qc = qhalf * 32 + l31;
  const int c0 = min(max(qc - 8, 0), 48);
  const int kp = kperm(l31);
#pragma unroll 1
  for (int t = 0; t < 24; ++t) {
    int key0, brow = 0, cs = 0;
    const bool local = t >= 8;
    if (!local) key0 = T + t * 32;
    else { brow = (t - 8) >> 1; cs = (t - 8) & 1; key0 = (r0 + brow) * 64 + cs * 32; }
    f32x16 st;
#pragma unroll
    for (int e = 0; e < 16; ++e) st[e] = 0.f;
    const bf16* kr = Kb + (size_t)(key0 + kp) * 64 + 8 * hh;
#pragma unroll
    for (int s = 0; s < 4; ++s) { bf16x8 kf = *(const bf16x8*)(kr + 16 * s); st = MFMA(kf, qf[s], st); }
    if (local) {
      const int rb = (r0 + brow) - r + 7;
#pragma unroll
      for (int e = 0; e < 16; ++e) {
        const int kc = cs * 32 + keyoff(e, hh);
        const bool valid = (kc >= c0) && (kc < c0 + 16);
        const int ci = min(max(kc - qc + 15, 0), 30);
        const float bv = (PROBE == 12) ? 0.f : bias[rb * 31 + ci];
        st[e] = valid ? st[e] + bv : -1e30f;
      }
    }
    float mx = st[0];
#pragma unroll
    for (int e = 1; e < 16; ++e) mx = fmaxf(mx, st[e]);
    mx = fmaxf(mx, shx(mx, 32, lane));
    const float mn = fmaxf(m, mx);
    const float alpha = exp2f((m - mn) * L2E);
    float ls = 0.f;
#pragma unroll
    for (int e = 0; e < 16; ++e) { st[e] = exp2f((st[e] - mn) * L2E); ls += st[e]; }
    l = l * alpha + ls; m = mn;
#pragma unroll
    for (int e = 0; e < 16; ++e) { o[0][e] *= alpha; o[1][e] *= alpha; }
    bf16x8 pf0 = pack8(st, 0), pf1 = pack8(st, 1);
#pragma unroll
    for (int dt = 0; dt < 2; ++dt) {
      const bf16* vr = Vb + (size_t)(dt * 32 + l31) * SEQ2 + key0 + 8 * hh;
      bf16x8 v0 = *(const bf16x8*)(vr), v1 = *(const bf16x8*)(vr + 16);
      o[dt] = MFMA(v0, pf0, o[dt]);
      o[dt] = MFMA(v1, pf1, o[dt]);
    }
  }
  l += shx(l, 32, lane);
  const float inv = (PROBE == 10) ? 0.f : 1.f / l;
  bf16* dst = p.CAT + (size_t)(b * T + r * 64 + qc) * D + 256 + head * 64;
#pragma unroll
  for (int dt = 0; dt < 2; ++dt)
#pragma unroll
    for (int g = 0; g < 4; g += 2)
      store_pair(dst + dt * 32 + 8 * g, hh, o[dt][4 * g] * inv, o[dt][4 * g + 1] * inv, o[dt][4 * g + 2] * inv, o[dt][4 * g + 3] * inv,
                 o[dt][4 * g + 4] * inv, o[dt][4 * g + 5] * inv, o[dt][4 * g + 6] * inv, o[dt][4 * g + 7] * inv);
}

constexpr int NA2_ITEMS = 16 * 6 * 16;
DI void stage_na2(const Params& p, int layer, int item, char* smem) {
  const int tid = tid_now(), lane = tid & 63, wave = tid >> 6, l31 = lane & 31, hh = lane >> 5;
  const int lrow = tid >> 3, kc8 = tid & 7;
  const int rp = item & 15, head = (item >> 4) % 6, b = item / 96;
  const int qrow = 2 * rp + ((lane >> 4) & 1), qc = wave * 16 + (lane & 15);
  const int r0w = min(max(qrow - 4, 0), 24);
  const int rlo = min(max(2 * rp - 4, 0), 24), rhi = min(max(2 * rp - 3, 0), 24) + 7;
  const int ntile = 4 + (rhi - rlo + 1);
  const size_t hb = (size_t)(b * 6 + head);
  const bf16* K = p.KN + hb * SEQ2 * 64;
  const bf16* Vt = p.VNt + hb * 64 * SEQ2;
  float* bl = (float*)(smem + 2 * 2 * 64 * LROW);
  for (int i = tid; i < 15 * 31; i += 256) bl[i] = p.na_rel_bias[((size_t)layer * 6 + head) * 465 + i];
  bf16x8 qf[4];
  const bf16* qp = p.QN + (hb * SEQ2 + qrow * 64 + qc) * 64 + 8 * hh;
#pragma unroll
  for (int s = 0; s < 4; ++s) qf[s] = *(const bf16x8*)(qp + 16 * s);
  f32x16 o[2];
#pragma unroll
  for (int e = 0; e < 16; ++e) { o[0][e] = 0.f; o[1][e] = 0.f; }
  float m = -1e30f, l = 0.f;
  const int kp = kperm(l31);
  const int c0 = min(max(qc - 8, 0), 48);
  const int kb = min(max(wave * 16 - 8, 0), 32);
  u32x4 rk[2], rv[2];
  auto key0_of = [&](int t) { return t < 4 ? T + 64 * t : (rlo + t - 4) * 64; };
  {
    const int k0 = key0_of(0);
#pragma unroll
    for (int i = 0; i < 2; ++i) {
      rk[i] = *(const u32x4*)(K + (size_t)(k0 + lrow + 32 * i) * 64 + kc8 * 8);
      rv[i] = *(const u32x4*)(Vt + (size_t)(lrow + 32 * i) * SEQ2 + k0 + kc8 * 8);
    }
  }
#pragma unroll 1
  for (int t = 0; t < ntile; ++t) {
    char* sk = smem + (t & 1) * 2 * 64 * LROW;
    char* sv = sk + 64 * LROW;
#pragma unroll
    for (int i = 0; i < 2; ++i) {
      *(u32x4*)(sk + (lrow + 32 * i) * LROW + kc8 * 16) = rk[i];
      *(u32x4*)(sv + (lrow + 32 * i) * LROW + kc8 * 16) = rv[i];
    }
    __syncthreads();
    if (t + 1 < ntile) {
      const int k0 = key0_of(t + 1);
#pragma unroll
      for (int i = 0; i < 2; ++i) {
        rk[i] = *(const u32x4*)(K + (size_t)(k0 + lrow + 32 * i) * 64 + kc8 * 8);
        rv[i] = *(const u32x4*)(Vt + (size_t)(lrow + 32 * i) * SEQ2 + k0 + kc8 * 8);
      }
    }
    const int R = rlo + t - 4;
    const bool local = t >= 4;
    const int nsub = local ? 1 : 2;
#pragma unroll 1
    for (int si = 0; si < nsub; ++si) {
      const int kbase = local ? kb : 32 * si;
      const bool loc = local;
      f32x16 st;
      bf16x8 lf[4];
      __builtin_amdgcn_sched_barrier(0);
#pragma unroll
      for (int s = 0; s < 4; ++s) lf[s] = *(const bf16x8*)(sk + (kbase + kp) * LROW + (16 * s + 8 * hh) * 2);
      __builtin_amdgcn_sched_barrier(0);
#pragma unroll
      for (int e = 0; e < 16; ++e) st[e] = 0.f;
#pragma unroll
      for (int s = 0; s < 4; ++s) st = MFMA(lf[s], qf[s], st);
      __builtin_amdgcn_sched_barrier(0);
#pragma unroll
      for (int s2 = 0; s2 < 2; ++s2)
#pragma unroll
        for (int dt = 0; dt < 2; ++dt) lf[s2 * 2 + dt] = *(const bf16x8*)(sv + (dt * 32 + l31) * LROW + (kbase + 16 * s2 + 8 * hh) * 2);
      __builtin_amdgcn_sched_barrier(0);
      if (loc) {
        const int c0e = ((unsigned)(R - r0w) < 8u) ? c0 : 4096;
        const float* brow = bl + (R - qrow + 7) * 31 + (15 - qc);
#pragma unroll
        for (int e = 0; e < 16; ++e) {
          const int kc = kbase + keyoff(e, hh);
          const bool valid = (unsigned)(kc - c0e) < 16u;
          const float bv = brow[kc];
          st[e] = valid ? st[e] + bv : -1e30f;
        }
      }
      float mx = st[0];
#pragma unroll
      for (int e = 1; e < 16; ++e) mx = fmaxf(mx, st[e]);
      mx = fmaxf(mx, shx(mx, 32, lane));
      const float mn = fmaxf(m, mx);
      const float mnl = mn * L2E;
      const float alpha = fexp2(m * L2E - mnl);
      f2_t ls2 = {0.f, 0.f};
#pragma unroll
      for (int e = 0; e < 16; e += 2) {
        const float p0 = fexp2(st[e] * L2E - mnl), p1 = fexp2(st[e + 1] * L2E - mnl);
        st[e] = p0; st[e + 1] = p1;
        const f2_t pp = {p0, p1};
        ls2 += pp;
      }
      l = l * alpha + (ls2[0] + ls2[1]); m = mn;
      const f2_t al2 = {alpha, alpha};
#pragma unroll
      for (int e = 0; e < 16; e += 2) {
        f2_t a0 = {o[0][e], o[0][e + 1]}, a1 = {o[1][e], o[1][e + 1]};
        a0 *= al2; a1 *= al2;
        o[0][e] = a0[0]; o[0][e + 1] = a0[1]; o[1][e] = a1[0]; o[1][e + 1] = a1[1];
      }
#pragma unroll
      for (int s2 = 0; s2 < 2; ++s2) {
        bf16x8 pf = pack8(st, s2);
#pragma unroll
        for (int dt = 0; dt < 2; ++dt) o[dt] = MFMA(lf[s2 * 2 + dt], pf, o[dt]);
      }
    }
  }
  l += shx(l, 32, lane);
  const float inv = 1.f / l;
  bf16* dst = p.CAT + (size_t)(b * T + qrow * 64 + qc) * D + 256 + head * 64;
#pragma unroll
  for (int dt = 0; dt < 2; ++dt)
#pragma unroll
    for (int g = 0; g < 4; g += 2)
      store_pair(dst + dt * 32 + 8 * g, hh, o[dt][4 * g] * inv, o[dt][4 * g + 1] * inv, o[dt][4 * g + 2] * inv, o[dt][4 * g + 3] * inv,
                 o[dt][4 * g + 4] * inv, o[dt][4 * g + 5] * inv, o[dt][4 * g + 6] * inv, o[dt][4 * g + 7] * inv);
  __syncthreads();
}

template <int MODE>
DI void flash_block(const bf16* __restrict__ Q, const bf16* __restrict__ K, const bf16* __restrict__ Vt, int q0, int kt0, int kt1,
                    bf16* __restrict__ dst  , char* smem, float smax = 0.f) {
  const int tid = tid_now(), lane = tid & 63, wave = tid >> 6, l31 = lane & 31, hh = lane >> 5;
  const int lrow = tid >> 3, kc = tid & 7;
  bf16x8 qf[4];
  const bf16* qp = Q + (size_t)(q0 + wave * 32 + l31) * 64 + 8 * hh;
#pragma unroll
  for (int s = 0; s < 4; ++s) qf[s] = *(const bf16x8*)(qp + 16 * s);
  constexpr bool BOUNDED = MODE != 0;
  if (MODE == 2) {
#pragma unroll
    for (int s = 0; s < 4; ++s) {
      u32x4 w = __builtin_bit_cast(u32x4, qf[s]);
      const unsigned w0 = w[0], w1 = w[1], w2 = w[2], w3 = w[3];
      u32x4 o = {pack2(bf_lo(w0) * L2E, bf_hi(w0) * L2E), pack2(bf_lo(w1) * L2E, bf_hi(w1) * L2E),
                 pack2(bf_lo(w2) * L2E, bf_hi(w2) * L2E), pack2(bf_lo(w3) * L2E, bf_hi(w3) * L2E)};
      qf[s] = __builtin_bit_cast(bf16x8, o);
    }
  }
  f32x16 o[2];
#pragma unroll
  for (int e = 0; e < 16; ++e) { o[0][e] = 0.f; o[1][e] = 0.f; }
  float m = -1e30f, l = 0.f;
  f2_t l2 = {0.f, 0.f};
  const int kp = kperm(l31);
  u32x4 rk[2], rv[2];
#pragma unroll
  for (int i = 0; i < 2; ++i) {
    rk[i] = *(const u32x4*)(K + (size_t)(kt0 * 64 + lrow + 32 * i) * 64 + kc * 8);
    rv[i] = *(const u32x4*)(Vt + (size_t)(lrow + 32 * i) * SEQ2 + kt0 * 64 + kc * 8);
  }
#pragma unroll 1
  for (int kt = kt0; kt < kt1; ++kt) {
    char* sk = smem + ((kt - kt0) & 1) * 2 * 64 * LROW;
    char* sv = sk + 64 * LROW;
#pragma unroll
    for (int i = 0; i < 2; ++i) {
      *(u32x4*)(sk + (lrow + 32 * i) * LROW + kc * 16) = rk[i];
      *(u32x4*)(sv + (lrow + 32 * i) * LROW + kc * 16) = rv[i];
    }
    __syncthreads();
    if (kt + 1 < kt1) {
#pragma unroll
      for (int i = 0; i < 2; ++i) {
        rk[i] = *(const u32x4*)(K + (size_t)((kt + 1) * 64 + lrow + 32 * i) * 64 + kc * 8);
        rv[i] = *(const u32x4*)(Vt + (size_t)(lrow + 32 * i) * SEQ2 + (kt + 1) * 64 + kc * 8);
      }
    }
    f32x16 st[2];
    bf16x8 lf[8];
    __builtin_amdgcn_sched_barrier(0);
#pragma unroll
    for (int k2 = 0; k2 < 2; ++k2)
#pragma unroll
      for (int s = 0; s < 4; ++s) lf[k2 * 4 + s] = *(const bf16x8*)(sk + (k2 * 32 + kp) * LROW + (16 * s + 8 * hh) * 2);
    __builtin_amdgcn_sched_barrier(0);
#pragma unroll
    for (int k2 = 0; k2 < 2; ++k2) {
#pragma unroll
      for (int e = 0; e < 16; ++e) st[k2][e] = 0.f;
#pragma unroll
      for (int s = 0; s < 4; ++s) st[k2] = MFMA(lf[k2 * 4 + s], qf[s], st[k2]);
    }
    __builtin_amdgcn_sched_barrier(0);
#pragma unroll
    for (int k2 = 0; k2 < 2; ++k2)
#pragma unroll
      for (int s2 = 0; s2 < 2; ++s2)
#pragma unroll
        for (int dt = 0; dt < 2; ++dt)
          lf[(k2 * 2 + s2) * 2 + dt] = *(const bf16x8*)(sv + (dt * 32 + l31) * LROW + (k2 * 32 + 16 * s2 + 8 * hh) * 2);
    __builtin_amdgcn_sched_barrier(0);
    if (BOUNDED) {
      const float mnl = smax * L2E;
#pragma unroll
      for (int k2 = 0; k2 < 2; ++k2)
#pragma unroll
        for (int e = 0; e < 16; e += 2) {
          const float p0 = MODE == 2 ? fexp2(st[k2][e]) : fexp2(st[k2][e] * L2E - mnl), p1 = MODE == 2 ? fexp2(st[k2][e + 1]) : fexp2(st[k2][e + 1] * L2E - mnl);
          st[k2][e] = p0; st[k2][e + 1] = p1;
          const f2_t pp = {p0, p1};
          l2 += pp;
        }
    } else {
      float mx = st[0][0];
  #pragma unroll
      for (int e = 1; e < 16; ++e) mx = fmaxf(mx, st[0][e]);
  #pragma unroll
      for (int e = 0; e < 16; ++e) mx = fmaxf(mx, st[1][e]);
      mx = fmaxf(mx, shx(mx, 32, lane));
      const float mn = fmaxf(m, mx);
      const float mnl = mn * L2E;
      const float alpha = fexp2(m * L2E - mnl);
      float ls = 0.f;
  #pragma unroll
      for (int k2 = 0; k2 < 2; ++k2)
  #pragma unroll
        for (int e = 0; e < 16; ++e) { st[k2][e] = fexp2(st[k2][e] * L2E - mnl); ls += st[k2][e]; }
      l = l * alpha + ls; m = mn;
  #pragma unroll
      for (int e = 0; e < 16; ++e) { o[0][e] *= alpha; o[1][e] *= alpha; }
    }
#pragma unroll
    for (int k2 = 0; k2 < 2; ++k2)
#pragma unroll
      for (int s2 = 0; s2 < 2; ++s2) {
        bf16x8 pf = pack8(st[k2], s2);
#pragma unroll
        for (int dt = 0; dt < 2; ++dt) o[dt] = MFMA(lf[(k2 * 2 + s2) * 2 + dt], pf, o[dt]);
      }
  }
  l += l2[0] + l2[1];
  l += shx(l, 32, lane);
  const float inv = (PROBE == 11) ? 0.f : 1.f / l;
  bf16* d2 = dst + (size_t)(wave * 32 + l31) * D;
#pragma unroll
  for (int dt = 0; dt < 2; ++dt)
#pragma unroll
    for (int g = 0; g < 4; g += 2)
      store_pair(d2 + dt * 32 + 8 * g, hh, o[dt][4 * g] * inv, o[dt][4 * g + 1] * inv, o[dt][4 * g + 2] * inv, o[dt][4 * g + 3] * inv,
                 o[dt][4 * g + 4] * inv, o[dt][4 * g + 5] * inv, o[dt][4 * g + 6] * inv, o[dt][4 * g + 7] * inv);
  __syncthreads();
}
constexpr int GQA_ITEMS = 16 * 6 * 16;
DI float gqa_score_bound(const Params& p, int layer) {
  const int lane = tid_now() & 63;
  float a = fabsf(p.gqa_q_norm[layer * 64 + lane]), b = fabsf(p.gqa_k_norm[layer * 64 + lane]);
#pragma unroll
  for (int o = 32; o >= 1; o >>= 1) { a = fmaxf(a, shx(a, o, lane)); b = fmaxf(b, shx(b, o, lane)); }
  return 8.f * a * b * 1.0001f + 1e-3f;
}
DI void stage_gqa(const Params& p, int layer, int item, char* smem) {
  const int qt = item & 15, hq = (item >> 4) % 6, b = item / 96;
  const int kvh = hq / 3;
  const float bound = __int_as_float(__builtin_amdgcn_readfirstlane(__float_as_int(gqa_score_bound(p, layer))));
  const bf16* Q = p.QG + (size_t)(b * 6 + hq) * SEQ2 * 64; const bf16* K = p.KG + (size_t)(b * 2 + kvh) * SEQ2 * 64; const bf16* Vt = p.VGt + (size_t)(b * 2 + kvh) * 64 * SEQ2;
  bf16* dst = p.CAT + (size_t)(b * T + qt * 128) * D + 640 + hq * 64;
  if (bound * L2E < 100.f) flash_block<2>(Q, K, Vt, qt * 128, 0, 36, dst, smem, bound);
  else flash_block<1>(Q, K, Vt, qt * 128, 0, 36, dst, smem, bound);
}
constexpr int CTXATT_ITEMS = 384;
DI void stage_ctxatt(const Params& p, int item, char* smem) {
  const int qt = item & 1, head = (item >> 1) % 6, which = (item / 12) & 1, b = item / 24;
  bf16* dst = p.CAT + (size_t)(NTOK + b * CL + qt * 128) * D + (which == 0 ? 256 : 640) + head * 64;
  const int kvh = which == 0 ? b * 6 + head : b * 2 + head / 3;
  const bf16* Q = (which == 0 ? p.QN : p.QG) + (size_t)(b * 6 + head) * SEQ2 * 64;
  const bf16* K = (which == 0 ? p.KN : p.KG) + (size_t)kvh * SEQ2 * 64;
  const bf16* Vt = (which == 0 ? p.VNt : p.VGt) + (size_t)kvh * 64 * SEQ2;
  flash_block<0>(Q, K, Vt, T + qt * 128, 32, 36, dst, smem);
}

constexpr int OUTPROJ_ITEMS = 288 * 8;
DI void stage_outproj(const Params& p, int layer, int item, char* smem) {
  const int mt = item >> 3, nt = item & 7;
  if (layer == 1 && mt >= 256) return;
  const int row0 = mt * 128, n0 = nt * 128;
  f32x16 acc[2][2];
  gemm_core<true, true>(p.CAT + (size_t)row0 * D, p.wout + ((size_t)layer * D + n0) * D, smem, acc);
  const int lane = tid_now() & 63, wave = tid_now() >> 6, wm = wave >> 1, wn = wave & 1, l31 = lane & 31, hh = lane >> 5;
  const float* mrow = p.mod + ((size_t)layer * 17 + mod_row(row0)) * 6144;
  const float* g1 = mrow + 2048;
  const float* sc2 = mrow + 4096;
  const float* n2g = p.norm2_g + layer * D;
  float* amx = (float*)(smem + GEMM_SMEM);
  float amv[2];
#pragma unroll
  for (int tt = 0; tt < 2; ++tt) {
    const int row = row0 + wm * 64 + tt * 32 + l31;
    bf16* xb = p.XB + (size_t)row * D;
    float ss = 0.f, am = 0.f;
#pragma unroll
    for (int ft = 0; ft < 2; ++ft)
#pragma unroll
      for (int gp = 0; gp < 4; gp += 2) {
        {
          float4 xv[2], gv[2];
#pragma unroll
          for (int g = 0; g < 2; ++g) {
            const int n = n0 + wn * 64 + ft * 32 + 8 * (gp + g) + 4 * hh;
            { const u32x2 t = *(const u32x2*)(xb + n); const unsigned t0 = t[0], t1 = t[1]; xv[g] = float4{bf_lo(t0), bf_hi(t0), bf_lo(t1), bf_hi(t1)}; }
            gv[g] = *(const float4*)(g1 + n);
            if (PROBE == 2) { gv[g].x = gv[g].y = gv[g].z = gv[g].w = 0.f; }
          }
#pragma unroll
          for (int g = 0; g < 2; ++g) {
            const int e = 4 * (gp + g);
            const float4 o = {xv[g].x + gv[g].x * acc[ft][tt][e], xv[g].y + gv[g].y * acc[ft][tt][e + 1],
                              xv[g].z + gv[g].z * acc[ft][tt][e + 2], xv[g].w + gv[g].w * acc[ft][tt][e + 3]};
            ss += o.x * o.x + o.y * o.y + o.z * o.z + o.w * o.w;
            acc[ft][tt][e] = o.x; acc[ft][tt][e + 1] = o.y; acc[ft][tt][e + 2] = o.z; acc[ft][tt][e + 3] = o.w;
          }
          store_pair(xb + n0 + wn * 64 + ft * 32 + 8 * gp, hh, acc[ft][tt][4 * gp], acc[ft][tt][4 * gp + 1], acc[ft][tt][4 * gp + 2], acc[ft][tt][4 * gp + 3],
                     acc[ft][tt][4 * gp + 4], acc[ft][tt][4 * gp + 5], acc[ft][tt][4 * gp + 6], acc[ft][tt][4 * gp + 7]);
        }
        {
          float4 gg[2], sv[2];
#pragma unroll
          for (int g = 0; g < 2; ++g) {
            const int n = n0 + wn * 64 + ft * 32 + 8 * (gp + g) + 4 * hh;
            gg[g] = *(const float4*)(n2g + n); sv[g] = *(const float4*)(sc2 + n);
          }
#pragma unroll
          for (int g = 0; g < 2; ++g) {
            const int e = 4 * (gp + g);
            float4 o = {acc[ft][tt][e], acc[ft][tt][e + 1], acc[ft][tt][e + 2], acc[ft][tt][e + 3]};
            o.x *= gg[g].x * (1.f + sv[g].x); o.y *= gg[g].y * (1.f + sv[g].y); o.z *= gg[g].z * (1.f + sv[g].z); o.w *= gg[g].w * (1.f + sv[g].w);
            acc[ft][tt][e] = o.x; acc[ft][tt][e + 1] = o.y; acc[ft][tt][e + 2] = o.z; acc[ft][tt][e + 3] = o.w;
            am = fmaxf(am, fmaxf(fmaxf(fabsf(o.x), fabsf(o.y)), fmaxf(fabsf(o.z), fabsf(o.w))));
          }
        }
      }
    ss += shx(ss, 32, lane);
    am = fmaxf(am, shx(am, 32, lane));
    if (hh == 0) { p.ssq16[(size_t)(nt * 2 + wn) * MTOT + row] = ss; amx[((wm * 2 + tt) * 32 + l31) * 2 + wn] = am; }
    amv[tt] = am;
    asm volatile("" ::: "memory");
  }
  __syncthreads();
#pragma unroll
  for (int tt = 0; tt < 2; ++tt) {
    const int row = row0 + wm * 64 + tt * 32 + l31;
    const float am = fmaxf(fmaxf(amv[tt], amx[((wm * 2 + tt) * 32 + l31) * 2 + (wn ^ 1)]), 1e-30f);
    const float qs = 127.f / am;
    if (hh == 0 && wn == 0) p.hs8[(size_t)nt * MTOT + row] = am * (1.f / 127.f);
    bf16* hrow = p.H2 + (size_t)row * D + n0 + wn * 64;
    signed char* qrow = p.hq + (size_t)row * D + n0 + wn * 64;
#pragma unroll
    for (int ft = 0; ft < 2; ++ft)
#pragma unroll
      for (int g = 0; g < 4; g += 2) {
        store_pair(hrow + ft * 32 + 8 * g, hh, acc[ft][tt][4 * g], acc[ft][tt][4 * g + 1], acc[ft][tt][4 * g + 2], acc[ft][tt][4 * g + 3],
                   acc[ft][tt][4 * g + 4], acc[ft][tt][4 * g + 5], acc[ft][tt][4 * g + 6], acc[ft][tt][4 * g + 7]);
        float4 va = {acc[ft][tt][4 * g], acc[ft][tt][4 * g + 1], acc[ft][tt][4 * g + 2], acc[ft][tt][4 * g + 3]};
        float4 vb = {acc[ft][tt][4 * g + 4], acc[ft][tt][4 * g + 5], acc[ft][tt][4 * g + 6], acc[ft][tt][4 * g + 7]};
        unsigned qa = pack_i8x4(va, qs), qb = pack_i8x4(vb, qs);
        const auto rq = __builtin_amdgcn_permlane32_swap(qa, qb, false, false);
        u32x2 o8 = {rq[0], rq[1]};
        *(u32x2*)(qrow + ft * 32 + 8 * g + hh * 8) = o8;
      }
  }
}

constexpr int ROUTE_ITEMS = 288 * 8;
constexpr int QROW = 272;
DI int to_sortable(int b) { return b ^ ((b >> 31) & 0x7fffffff); }

#define CAND_LIST(X) \
  X(0,0,0) X(1,0,1) X(2,0,2) X(3,0,3) X(4,0,4) X(5,0,5) X(6,0,6) X(7,0,7) X(8,0,8) X(9,0,9) X(10,0,10) X(11,0,11) X(12,0,12) X(13,0,13) X(14,0,14) X(15,0,15) \
  X(16,1,1) X(17,1,2) X(18,1,3) X(19,1,4) X(20,1,5) X(21,1,6) X(22,1,7) \
  X(23,2,2) X(24,2,3) X(25,2,4) \
  X(26,3,3)


DI void ce_desc(int& a, int& b) { const int hi = max(a, b), lo = min(a, b); a = hi; b = lo; }
DI void bitonic_sort16_desc(int (&v)[16]) {
#pragma unroll
  for (int k = 2; k <= 16; k <<= 1)
#pragma unroll
    for (int j = k >> 1; j > 0; j >>= 1)
#pragma unroll
      for (int i = 0; i < 16; ++i) {
        const int l = i ^ j;
        if (l > i) { if ((i & k) == 0) ce_desc(v[i], v[l]); else ce_desc(v[l], v[i]); }
      }
}
DI void bitonic_merge16_desc(int (&v)[16]) {
#pragma unroll
  for (int j = 8; j > 0; j >>= 1)
#pragma unroll
    for (int i = 0; i < 16; ++i) { const int l = i ^ j; if (l > i) ce_desc(v[i], v[l]); }
}
DI void merge_top16(int (&a)[16], const int (&b)[16]) {
#pragma unroll
  for (int i = 0; i < 16; ++i) a[i] = max(a[i], b[15 - i]);
  bitonic_merge16_desc(a);
}
DI void stage_route(const Params& p, int layer, int item, char* smem) {
  const int mt = item >> 3, head = item & 7;
  if (layer == 1 && mt >= 256) return;
  const int row0 = mt * 128;
  const int tid = tid_now(), lane = tid & 63, wave = tid >> 6, wm = wave >> 1, wn = wave & 1, l31 = lane & 31, hh = lane >> 5;
  int t0[16], tk[16];
  char* Qs = smem;
  float* rs = (float*)(smem + GEMM_SMEM);
  if (tid < 128) {
    float sv[16];
#pragma unroll
    for (int s = 0; s < 16; ++s) sv[s] = p.ssq16[(size_t)s * MTOT + row0 + tid];
    float ssum = 0.f;
#pragma unroll
    for (int s = 0; s < 16; ++s) ssum += sv[s];
    rs[tid] = rsqrtf(ssum * (1.f / D) + EPS);
  }
#pragma unroll 1
  for (int pp = 0; pp < 2; ++pp) {
    {
      f32x16 acc[2][2];
      gemm_core<true, true>(p.H2 + (size_t)row0 * D, p.wq + ((size_t)layer * 2048 + (head * 2 + pp) * 128) * D, smem, acc);
      {
        const float* cqr = p.cq + ((size_t)layer * 17 + mod_row(row0)) * 2048 + (head * 2 + pp) * 128 + wn * 64 + 4 * hh;
#pragma unroll
        for (int tt = 0; tt < 2; ++tt) {
          const float rsd = rs[wm * 64 + tt * 32 + l31];
#pragma unroll
          for (int ft = 0; ft < 2; ++ft)
#pragma unroll
            for (int g = 0; g < 4; ++g) {
              const float4 cv = *(const float4*)(cqr + ft * 32 + 8 * g);
              acc[ft][tt][4 * g] = acc[ft][tt][4 * g] * rsd + cv.x; acc[ft][tt][4 * g + 1] = acc[ft][tt][4 * g + 1] * rsd + cv.y;
              acc[ft][tt][4 * g + 2] = acc[ft][tt][4 * g + 2] * rsd + cv.z; acc[ft][tt][4 * g + 3] = acc[ft][tt][4 * g + 3] * rsd + cv.w;
            }
        }
      }
#pragma unroll
      for (int tt = 0; tt < 2; ++tt)
#pragma unroll
        for (int ft = 0; ft < 2; ++ft)
#pragma unroll
          for (int g = 0; g < 4; ++g) {
            const int tok = wm * 64 + tt * 32 + l31, kf = wn * 64 + ft * 32 + 8 * g + 4 * hh;
            u32x2 o = {pack2(acc[ft][tt][4 * g], acc[ft][tt][4 * g + 1]), pack2(acc[ft][tt][4 * g + 2], acc[ft][tt][4 * g + 3])};
            *(u32x2*)(Qs + tok * QROW + kf * 2) = o;
          }
    }
    const __amdgpu_buffer_rsrc_t rK = __builtin_amdgcn_make_buffer_rsrc((void*)p.pk, 0, (unsigned)(PK_N * 2), 0x00020000);
    const int kso = (((layer * 8 + head) * 2 + pp) * 128) * 256;
    u32x4 ka[8];
#pragma unroll
    for (int s = 0; s < 8; ++s) ka[s] = __builtin_amdgcn_raw_buffer_load_b128(rK, (l31 * 128 + 8 * hh) * 2 + 32 * s, kso, 0);
    __syncthreads();
    {
#pragma unroll
      for (int r = 0; r < 16; ++r) tk[r] = (int)0x80000000;
#pragma unroll 1
      for (int nt = 0; nt < 4; ++nt) {
        int cur[16];
        {
          f32x16 sc;
#pragma unroll
          for (int e = 0; e < 16; ++e) sc[e] = 0.f;
#pragma unroll
          for (int s = 0; s < 8; ++s) {
            bf16x8 qb = *(const bf16x8*)(Qs + (wave * 32 + l31) * QROW + (16 * s + 8 * hh) * 2);
            sc = MFMA(__builtin_bit_cast(bf16x8, ka[s]), qb, sc);
          }
          {
            const int nn = nt < 3 ? nt + 1 : 3;
#pragma unroll
            for (int s = 0; s < 8; ++s) ka[s] = __builtin_amdgcn_raw_buffer_load_b128(rK, ((nn * 32 + l31) * 128 + 8 * hh) * 2 + 32 * s, kso, 0);
          }
#pragma unroll
          for (int e = 0; e < 16; ++e) {
            const int n = nt * 32 + crow(e, hh);
            int b = (__float_as_int(sc[e]) & ~127) | n;
            cur[e] = to_sortable(b);
          }
        }
        bitonic_sort16_desc(cur);
        merge_top16(tk, cur);
      }
      int pb[16];
#pragma unroll
      for (int i = 0; i < 16; ++i) pb[i] = shxi(tk[i], 32, lane);
      merge_top16(tk, pb);
    }
    if (pp == 0) {
#pragma unroll
      for (int r = 0; r < 16; ++r) t0[r] = tk[r];
    }
    __syncthreads();
  }
  char* recs = Qs + (tid_now() >> 6) * 32 * QROW;
  int cand[27];
  {
    float av[16], bv[16];
    unsigned pa[4] = {0u, 0u, 0u, 0u}, pbb[4] = {0u, 0u, 0u, 0u};
#pragma unroll
    for (int i = 0; i < 16; ++i) {
      int k1 = to_sortable(t0[i]), k2 = to_sortable(tk[i]);
      int a = hh ? k2 : k1, b = hh ? k1 : k2;
      av[i] = __int_as_float(a & ~127); bv[i] = __int_as_float(b & ~127);
      pa[i >> 2] |= (unsigned)(a & 127) << (8 * (i & 3));
      pbb[i >> 2] |= (unsigned)(b & 127) << (8 * (i & 3));
    }
    u32x4 ra_ = {pa[0], pa[1], pa[2], pa[3]}, rb_ = {pbb[0], pbb[1], pbb[2], pbb[3]};
    *(u32x4*)(recs + lane * 32) = ra_;
    *(u32x4*)(recs + lane * 32 + 16) = rb_;
#define MKC(c, i, j) { int b = __float_as_int(av[i] + bv[j]); cand[c] = (to_sortable(b) & ~63) | (c * 2 + hh); \
                       if (i == j && hh) cand[c] = (int)0x80000000; }
    CAND_LIST(MKC)
#undef MKC
  }
  int win[16], weid[16];
#pragma unroll
  for (int r = 0; r < 16; ++r) {
    int mx = cand[0];
#pragma unroll
    for (int c = 1; c < 27; ++c) mx = max(mx, cand[c]);
    mx = max(mx, shxi(mx, 32, lane));
#pragma unroll
    for (int c = 0; c < 27; ++c) cand[c] = (cand[c] == mx) ? (int)0x80000000 : cand[c];
    win[r] = mx;
  }
#pragma unroll
  for (int r = 0; r < 16; ++r) {
    const int code = win[r] & 63, c = code >> 1, hw = code & 1;
    const int i = (c >= 16) + (c >= 23) + (c >= 26);
    const int j = c - (i == 0 ? 0 : i == 1 ? 15 : i == 2 ? 21 : 23);
    const unsigned char* orec = (const unsigned char*)(recs + (l31 + 32 * hw) * 32);
    const int aiv = orec[i], biv = orec[16 + j];
    weid[r] = hw ? (biv * 128 + aiv) : (aiv * 128 + biv);
  }
  float gsum = 0.f, gv[16];
  const float v0 = __int_as_float(to_sortable(win[0]) & ~63);
#pragma unroll
  for (int r = 0; r < 16; ++r) { gv[r] = __expf(__int_as_float(to_sortable(win[r]) & ~63) - v0); gsum += gv[r]; }
  const float ginv = 1.f / gsum;
  const int row = row0 + (tid_now() >> 6) * 32 + (tid_now() & 31);
  if (hh == 0) {
    int4* d = (int4*)(p.ridx + ((size_t)row * 8 + head) * 32);
#pragma unroll
    for (int q = 0; q < 4; ++q) { int4 o = {weid[4 * q], weid[4 * q + 1], weid[4 * q + 2], weid[4 * q + 3]}; d[q] = o; }
  } else {
    float4* d = (float4*)((float*)p.ridx + ((size_t)row * 8 + head) * 32 + 16);
#pragma unroll
    for (int q = 0; q < 4; ++q) { float4 o = {gv[4 * q] * ginv, gv[4 * q + 1] * ginv, gv[4 * q + 2] * ginv, gv[4 * q + 3] * ginv}; d[q] = o; }
  }
  __syncthreads();
}

DI float dot2(unsigned a, unsigned b, float acc) {
  bf2_t x = __builtin_bit_cast(bf2_t, a), y = __builtin_bit_cast(bf2_t, b);
  return __builtin_amdgcn_fdot2_f32_bf16(x, y, acc, false);
}
DI float dot8(u32x4 a, u32x4 b, float acc) {
  const unsigned a0 = a[0], a1 = a[1], a2 = a[2], a3 = a[3], b0 = b[0], b1 = b[1], b2 = b[2], b3 = b[3];
  acc = dot2(a0, b0, acc); acc = dot2(a1, b1, acc); acc = dot2(a2, b2, acc); acc = dot2(a3, b3, acc);
  return acc;
}
DI void axpy8(float (&o)[8], float w, u32x4 v) {
  o[0] += w * bf_lo(v.x); o[1] += w * bf_hi(v.x); o[2] += w * bf_lo(v.y); o[3] += w * bf_hi(v.y);
  o[4] += w * bf_lo(v.z); o[5] += w * bf_hi(v.z); o[6] += w * bf_lo(v.w); o[7] += w * bf_hi(v.w);
}
constexpr int GATHER_ITEMS = MTOT / 4;
DI float dot4f8(unsigned u, unsigned hlo, unsigned hhi, float acc) {
  bf2_t a = __builtin_amdgcn_cvt_scalef32_pk_bf16_fp8((int)u, 1.0f, false);
  bf2_t b = __builtin_amdgcn_cvt_scalef32_pk_bf16_fp8((int)u, 1.0f, true);
  bf2_t x = __builtin_bit_cast(bf2_t, hlo), y = __builtin_bit_cast(bf2_t, hhi);
  acc = __builtin_amdgcn_fdot2_f32_bf16(a, x, acc, false);
  acc = __builtin_amdgcn_fdot2_f32_bf16(b, y, acc, false);
  return acc;
}
DI void axpy4f8(float& o0, float& o1, float& o2, float& o3, float w, unsigned v) {
  f2_t lo = __builtin_amdgcn_cvt_pk_f32_fp8((int)v, false), hi = __builtin_amdgcn_cvt_pk_f32_fp8((int)v, true);
  o0 += w * lo[0]; o1 += w * lo[1]; o2 += w * hi[0]; o3 += w * hi[1];
}
DI void stage_gather(const Params& p, int layer, int item) {
  const int lane = tid_now() & 63, wave = tid_now() >> 6;
  const int row = item * 4 + wave;
  if (layer == 1 && row >= NTOK) return;
  const int* rr = p.ridx + (size_t)row * 256 + (lane >> 4) * 32 + (lane & 15);
  const int idxA = rr[0], idxB = rr[128];
  const float gA = __int_as_float(rr[16]), gB = __int_as_float(rr[144]);
  const bf16* hr = p.H + (size_t)row * D + lane * 16;
  const u32x4 hA = *(const u32x4*)(hr), hB = *(const u32x4*)(hr + 8);
  const unsigned h0 = hA[0], h1 = hA[1], h2 = hA[2], h3 = hA[3], h4 = hB[0], h5 = hB[1], h6 = hB[2], h7 = hB[3];
  float o[16];
#pragma unroll
  for (int i = 0; i < 16; ++i) o[i] = 0.f;
  const __amdgpu_buffer_rsrc_t rU = __builtin_amdgcn_make_buffer_rsrc((void*)(p.pu8 + (size_t)layer * NEXP * D), 0, NEXP * D, 0x00020000);
  const __amdgpu_buffer_rsrc_t rV = __builtin_amdgcn_make_buffer_rsrc((void*)(p.pv8 + (size_t)layer * NEXP * D), 0, NEXP * D, 0x00020000);
  const int voff = lane * 16;
  u32x4 ua[16], va[16];
#pragma unroll
  for (int k = 0; k < 16; ++k) {
    const int e = __builtin_amdgcn_readlane(idxA, k);
    ua[k] = __builtin_amdgcn_raw_buffer_load_b128(rU, voff, e * D, 0);
  }
#pragma unroll
  for (int k = 0; k < 16; ++k) {
    const int e = __builtin_amdgcn_readlane(idxA, k);
    va[k] = __builtin_amdgcn_raw_buffer_load_b128(rV, voff, e * D, 0);
  }
#pragma unroll
  for (int head = 0; head < 8; ++head) {
    float part[16];
#pragma unroll
    for (int k = 0; k < 16; ++k) {
      const unsigned a0 = ua[k][0], a1 = ua[k][1], a2 = ua[k][2], a3 = ua[k][3];
      float s = dot4f8(a0, h0, h1, 0.f);
      s = dot4f8(a1, h2, h3, s); s = dot4f8(a2, h4, h5, s); s = dot4f8(a3, h6, h7, s);
      part[k] = s;
    }
    asm volatile("" ::: "memory");
    if (head < 7) {
#pragma unroll
      for (int k = 0; k < 16; ++k) {
        const int e = __builtin_amdgcn_readlane((head + 1) < 4 ? idxA : idxB, ((head + 1) & 3) * 16 + k);
        ua[k] = __builtin_amdgcn_raw_buffer_load_b128(rU, voff, e * D, 0);
      }
    }
    float r8[8], r4[4], r2[2], r1;
    {
      const bool up = lane & 32;
#pragma unroll
      for (int k = 0; k < 8; ++k) { float keep = up ? part[k + 8] : part[k], give = up ? part[k] : part[k + 8]; r8[k] = keep + shx(give, 32, lane); }
    }
    {
      const bool up = lane & 16;
#pragma unroll
      for (int k = 0; k < 4; ++k) { float keep = up ? r8[k + 4] : r8[k], give = up ? r8[k] : r8[k + 4]; r4[k] = keep + shx(give, 16, lane); }
    }
    {
      const bool up = lane & 8;
#pragma unroll
      for (int k = 0; k < 2; ++k) { float keep = up ? r4[k + 2] : r4[k], give = up ? r4[k] : r4[k + 2]; r2[k] = keep + shx(give, 8, lane); }
    }
    {
      const bool up = lane & 4;
      float keep = up ? r2[1] : r2[0], give = up ? r2[0] : r2[1];
      r1 = keep + shx(give, 4, lane);
    }
    r1 += shx(r1, 2, lane);
    r1 += shx(r1, 1, lane);
    const float myg = __int_as_float(__builtin_amdgcn_ds_bpermute(((head & 3) * 16 + ((lane >> 2) & 15)) << 2, __float_as_int(head < 4 ? gA : gB)));
    const float w = gelu_tanh(r1 * (1.f / SU)) * myg * (1.f / SV);
#pragma unroll
    for (int k = 0; k < 16; ++k) {
      const float wk = __int_as_float(__builtin_amdgcn_readlane(__float_as_int(w), k << 2));
      const unsigned a0 = va[k][0], a1 = va[k][1], a2 = va[k][2], a3 = va[k][3];
      axpy4f8(o[0], o[1], o[2], o[3], wk, a0); axpy4f8(o[4], o[5], o[6], o[7], wk, a1);
      axpy4f8(o[8], o[9], o[10], o[11], wk, a2); axpy4f8(o[12], o[13], o[14], o[15], wk, a3);
    }
    asm volatile("" ::: "memory");
    if (head < 7) {
#pragma unroll
      for (int k = 0; k < 16; ++k) {
        const int e = __builtin_amdgcn_readlane((head + 1) < 4 ? idxA : idxB, ((head + 1) & 3) * 16 + k);
        va[k] = __builtin_amdgcn_raw_buffer_load_b128(rV, voff, e * D, 0);
      }
    }
  }
  const float* g2 = p.mod + ((size_t)layer * 17 + mod_row(row)) * 6144 + 5120 + lane * 16;
  float* dr = xres_row(p, row) + lane * 16;
  float4 xv[4], gv[4];
#pragma unroll
  for (int q = 0; q < 4; ++q) { xv[q] = *(const float4*)(dr + 4 * q); gv[q] = *(const float4*)(g2 + 4 * q); }
#pragma unroll
  for (int q = 0; q < 4; ++q) {
    float4 r = {xv[q].x + gv[q].x * o[4 * q], xv[q].y + gv[q].y * o[4 * q + 1], xv[q].z + gv[q].z * o[4 * q + 2], xv[q].w + gv[q].w * o[4 * q + 3]};
    *(float4*)(dr + 4 * q) = r;
  }
}

constexpr int PEER_TPW = 4;
constexpr int PEER_TPI = 4 * PEER_TPW;
DI float bperm_f(float v, int src_lane) { return __int_as_float(__builtin_amdgcn_ds_bpermute(src_lane << 2, __float_as_int(v))); }
DI int bperm_i(int v, int src_lane) { return __builtin_amdgcn_ds_bpermute(src_lane << 2, v); }

DI __amdgpu_buffer_rsrc_t mk_rsrc(const void* ptr, unsigned bytes) { return __builtin_amdgcn_make_buffer_rsrc((void*)ptr, 0, bytes, 0x00020000); }
DI void stage_peer_u(const Params& p, int layer, int q, int tile, _Float16* __restrict__ partial) {
  const int tid = tid_now(), lane = tid & 63, g = lane >> 3, c = lane & 7;
  const int wave = __builtin_amdgcn_readfirstlane(tid >> 6);
  const int row_base = tile * PEER_TPI + wave * PEER_TPW;
  const __amdgpu_buffer_rsrc_t rU = mk_rsrc(p.pu8 + (size_t)layer * NEXP * D, NEXP * D);
  const __amdgpu_buffer_rsrc_t rRec = mk_rsrc(p.ridx, (unsigned)((size_t)MTOT * 1024));
  const __amdgpu_buffer_rsrc_t rH = mk_rsrc(p.hq, (unsigned)((size_t)MTOT * D));
  const __amdgpu_buffer_rsrc_t rP = mk_rsrc(partial, (unsigned)((size_t)8 * MTOT * 256));
  const int coff = q * 128 + c * 16;
  const int rec_v = ((lane >> 4) * 32 + (lane & 15)) * 4;
  const int i0 = 4 * (c & 1) + 2 * ((c >> 1) & 1) + ((c >> 2) & 1);
  const int pv0 = (8 * i0 + g) * 4;
  int idA[3], idB[3];
  u32x4 d[2][8]; u32x4 hv[2];
  auto load_idx = [&](int t, int slot) {
    const int so = (row_base + t) * 1024;
    idA[slot] = __builtin_amdgcn_raw_buffer_load_b32(rRec, rec_v, so, 0);
    idB[slot] = __builtin_amdgcn_raw_buffer_load_b32(rRec, rec_v + 512, so, 0);
  };
  auto issue = [&](int u) {
    const int t = u >> 1, hf = u & 1, slot = t % 3, buf = u & 1;
    if (hf == 0) hv[t & 1] = __builtin_amdgcn_raw_buffer_load_b128(rH, coff, (row_base + t) * D, 0);
#pragma unroll
    for (int i = 0; i < 8; ++i) {
      const int e = bperm_i(hf ? idB[slot] : idA[slot], (8 * i + g) & 63);
      d[buf][i] = __builtin_amdgcn_raw_buffer_load_b128(rU, e * D + coff, 0, 0);
    }
  };
  load_idx(0, 0); load_idx(1, 1);
  issue(0);
  int r[16];
#pragma unroll
  for (int u = 0; u < 2 * PEER_TPW; ++u) {
    const int t = u >> 1, hf = u & 1, buf = u & 1;
    asm volatile("" ::: "memory");
    if (hf == 0 && t + 2 < PEER_TPW) load_idx(t + 2, (t + 2) % 3);
    if (u + 1 < 2 * PEER_TPW) issue(u + 1);
    const int h0 = (int)hv[t & 1][0], h1 = (int)hv[t & 1][1], h2 = (int)hv[t & 1][2], h3 = (int)hv[t & 1][3];
#pragma unroll
    for (int i = 0; i < 8; ++i) {
      const int a0 = (int)d[buf][i][0], a1 = (int)d[buf][i][1], a2 = (int)d[buf][i][2], a3 = (int)d[buf][i][3];
      int s = __builtin_amdgcn_sdot4(a0, h0, 0, false);
      s = __builtin_amdgcn_sdot4(a1, h1, s, false); s = __builtin_amdgcn_sdot4(a2, h2, s, false); s = __builtin_amdgcn_sdot4(a3, h3, s, false);
      r[8 * hf + i] = s;
    }
    if (hf == 0) continue;
    asm volatile("" ::: "memory");
    int r8[8], r4[4], r2[2];
    {
      const bool up = c & 1;
#pragma unroll
      for (int b3 = 0; b3 < 2; ++b3)
#pragma unroll
        for (int m = 0; m < 4; ++m) { int lo = r[8 * b3 + m], hi = r[8 * b3 + 4 + m]; int keep = up ? hi : lo, give = up ? lo : hi; r8[4 * b3 + m] = keep + bperm_i(give, lane ^ 1); }
    }
    {
      const bool up = c & 2;
#pragma unroll
      for (int b3 = 0; b3 < 2; ++b3)
#pragma unroll
        for (int m = 0; m < 2; ++m) { int lo = r8[4 * b3 + m], hi = r8[4 * b3 + 2 + m]; int keep = up ? hi : lo, give = up ? lo : hi; r4[2 * b3 + m] = keep + bperm_i(give, lane ^ 2); }
    }
    {
      const bool up = c & 4;
#pragma unroll
      for (int b3 = 0; b3 < 2; ++b3) { int lo = r4[2 * b3], hi = r4[2 * b3 + 1]; int keep = up ? hi : lo, give = up ? lo : hi; r2[b3] = keep + bperm_i(give, lane ^ 4); }
    }
    const int so = (q * MTOT + row_base + t) * 256;
    const h2_t ph = {(_Float16)((float)r2[0] * (1.f / 64.f)), (_Float16)((float)r2[1] * (1.f / 64.f))};
    __builtin_amdgcn_raw_buffer_store_b32(__builtin_bit_cast(int, ph), rP, pv0, so, 0);
  }
}

constexpr int PEERC_RPW = 2;
DI void stage_peer_combine(const Params& p, int layer, int item, const _Float16* __restrict__ partial) {
  const int lane = tid_now() & 63, wave = tid_now() >> 6;
  const int rbase = (item * 4 + wave) * PEERC_RPW;
  const int mr = mod_row(rbase);
  int e0[PEERC_RPW], e1[PEERC_RPW];
  float g0[PEERC_RPW], g1[PEERC_RPW], ssum[PEERC_RPW];
  unsigned pab[PEERC_RPW][8];
  float hq[PEERC_RPW][8];
#pragma unroll
  for (int j = 0; j < PEERC_RPW; ++j) {
    const int* reci = p.ridx + (size_t)(rbase + j) * 256 + (lane >> 4) * 32 + (lane & 15);
    e0[j] = reci[0]; e1[j] = reci[128];
  }
#pragma unroll
  for (int j = 0; j < PEERC_RPW; ++j) {
    const int row = rbase + j;
#pragma unroll
    for (int q = 0; q < 8; ++q) {
      pab[j][q] = ((const unsigned*)partial)[((size_t)q * MTOT + row) * 64 + lane];
      hq[j][q] = p.hs8[(size_t)q * MTOT + row] * 64.f;
    }
    const int* reci = p.ridx + (size_t)row * 256 + (lane >> 4) * 32 + (lane & 15);
    g0[j] = __int_as_float(reci[16]); g1[j] = __int_as_float(reci[144]);
    ssum[j] = p.ssq16[(size_t)(lane & 15) * MTOT + row];
  }
  float2 er0[PEERC_RPW], er1[PEERC_RPW];
#pragma unroll
  for (int j = 0; j < PEERC_RPW; ++j) {
    er0[j] = *(const float2*)(p.esc + ((size_t)layer * NEXP + e0[j]) * 64 + 2 * mr);
    er1[j] = *(const float2*)(p.esc + ((size_t)layer * NEXP + e1[j]) * 64 + 2 * mr);
  }
#pragma unroll
  for (int j = 0; j < PEERC_RPW; ++j) {
    const int row = rbase + j;
    float s0 = 0.f, s1 = 0.f;
#pragma unroll
    for (int q = 0; q < 8; ++q) { const h2_t pv = __builtin_bit_cast(h2_t, pab[j][q]); s0 += (float)pv[0] * hq[j][q]; s1 += (float)pv[1] * hq[j][q]; }
    float t = ssum[j];
    t += shx(t, 1, lane); t += shx(t, 2, lane); t += shx(t, 4, lane); t += shx(t, 8, lane);
    const float rstd = rsqrtf(t * (1.f / D) + EPS);
    float* rec = (float*)(p.ridx + (size_t)row * 256 + (lane >> 4) * 32 + (lane & 15)) + 16;
    const _Float16 w0 = (_Float16)(gelu_tanh(s0 * er0[j].y * rstd + er0[j].x) * g0[j]), w1 = (_Float16)(gelu_tanh(s1 * er1[j].y * rstd + er1[j].x) * g1[j]);
    const h2_t w0p = {w0, w0}, w1p = {w1, w1};
    rec[0] = __builtin_bit_cast(float, w0p);
    rec[128] = __builtin_bit_cast(float, w1p);
  }
}

DI void axpy4f8_pk(f2_t& o01, f2_t& o23, f2_t w2, unsigned v) {
  f2_t lo = __builtin_amdgcn_cvt_pk_f32_fp8((int)v, false), hi = __builtin_amdgcn_cvt_pk_f32_fp8((int)v, true);
  o01 = __builtin_elementwise_fma(w2, lo, o01); o23 = __builtin_elementwise_fma(w2, hi, o23);
}
DI void stage_peer_v(const Params& p, int layer, int q, int tile, float dry = 1.f) {
  const int tid = tid_now(), lane = tid & 63, g = lane >> 3, c = lane & 7;
  const int wave = __builtin_amdgcn_readfirstlane(tid >> 6);
  const int row_base = tile * PEER_TPI + wave * PEER_TPW;
  const __amdgpu_buffer_rsrc_t rV = mk_rsrc(p.pv8 + (size_t)layer * NEXP * D, NEXP * D);
  const __amdgpu_buffer_rsrc_t rRec = mk_rsrc(p.ridx, (unsigned)((size_t)MTOT * 1024));
  const __amdgpu_buffer_rsrc_t rX = mk_rsrc(p.XB, (unsigned)((size_t)MTOT * D * 2));
  const int xrow0 = row_base;
  const int coff = q * 128 + c * 16;
  const int rec_v = ((lane >> 4) * 32 + (lane & 15)) * 4;
  int idA[3], idB[3]; float wA[3], wB[3];
  u32x4 d[2][8];
  auto load_idx = [&](int t, int slot) {
    const int so = (row_base + t) * 1024;
    idA[slot] = __builtin_amdgcn_raw_buffer_load_b32(rRec, rec_v, so, 0);
    idB[slot] = __builtin_amdgcn_raw_buffer_load_b32(rRec, rec_v + 512, so, 0);
    wA[slot] = __int_as_float(__builtin_amdgcn_raw_buffer_load_b32(rRec, rec_v + 64, so, 0));
    wB[slot] = __int_as_float(__builtin_amdgcn_raw_buffer_load_b32(rRec, rec_v + 576, so, 0));
  };
  const int dl = coff + 8 * (g & 1) + 4 * ((g >> 1) & 1) + 2 * ((g >> 2) & 1);
  unsigned xvb[2];
  auto issue = [&](int u) {
    const int t = u >> 1, hf = u & 1, slot = t % 3, buf = u & 1;
#pragma unroll
    for (int i = 0; i < 8; ++i) {
      const int e = bperm_i(hf ? idB[slot] : idA[slot], (8 * i + g) & 63);
      d[buf][i] = __builtin_amdgcn_raw_buffer_load_b128(rV, e * D + coff, 0, 0);
    }
    if (hf == 1) xvb[t & 1] = (unsigned)__builtin_amdgcn_raw_buffer_load_b32(rX, dl * 2, (xrow0 + t) * (D * 2), 0);
  };
  const float2 g2v = *(const float2*)(p.mod + ((size_t)layer * 17 + mod_row(row_base)) * 6144 + 5120 + dl);
  load_idx(0, 0); load_idx(1, 1);
  issue(0);
  h2_t oh[8];
#pragma unroll
  for (int u = 0; u < 2 * PEER_TPW; ++u) {
    const int t = u >> 1, hf = u & 1, buf = u & 1, slot = t % 3;
    asm volatile("" ::: "memory");
    if (hf == 0 && t + 2 < PEER_TPW) load_idx(t + 2, (t + 2) % 3);
    if (u + 1 < 2 * PEER_TPW) issue(u + 1);
#pragma unroll
    for (int i = 0; i < 8; ++i) {
      const h2_t w2 = __builtin_bit_cast(h2_t, bperm_f(hf ? wB[slot] : wA[slot], (8 * i + g) & 63));
#pragma unroll
      for (int j = 0; j < 4; ++j) {
        const int av = (int)d[buf][i][j];
        const h2_t lo = __builtin_amdgcn_cvt_scalef32_pk_f16_fp8(av, 1.0f, false), hi = __builtin_amdgcn_cvt_scalef32_pk_f16_fp8(av, 1.0f, true);
        if (hf == 0 && i == 0) { oh[2 * j] = w2 * lo; oh[2 * j + 1] = w2 * hi; }
        else { oh[2 * j] = __builtin_elementwise_fma(w2, lo, oh[2 * j]); oh[2 * j + 1] = __builtin_elementwise_fma(w2, hi, oh[2 * j + 1]); }
      }
    }
    if (hf == 0) continue;
    asm volatile("" ::: "memory");
    h2_t q4[4], q2[2], q1;
    {
      const bool up = g & 1;
#pragma unroll
      for (int k = 0; k < 4; ++k) {
        const h2_t keep = up ? oh[k + 4] : oh[k], give = up ? oh[k] : oh[k + 4];
        q4[k] = keep + __builtin_bit_cast(h2_t, bperm_i(__builtin_bit_cast(int, give), lane ^ 8));
      }
    }
    {
      const bool up = g & 2;
#pragma unroll
      for (int k = 0; k < 2; ++k) {
        const h2_t keep = up ? q4[k + 2] : q4[k], give = up ? q4[k] : q4[k + 2];
        q2[k] = keep + __builtin_bit_cast(h2_t, bperm_i(__builtin_bit_cast(int, give), lane ^ 16));
      }
    }
    {
      const auto sw = __builtin_amdgcn_permlane32_swap(__builtin_bit_cast(unsigned, q2[0]), __builtin_bit_cast(unsigned, q2[1]), false, false);
      const unsigned sa = sw[0], sb = sw[1];
      q1 = __builtin_bit_cast(h2_t, sa) + __builtin_bit_cast(h2_t, sb);
    }
    float r2[2] = {(float)q1[0] * (1.f / SV), (float)q1[1] * (1.f / SV)};
    const int so = (xrow0 + t) * (D * 2);
    const unsigned xv = xvb[t & 1];
    const float x0 = bf_lo(xv), x1 = bf_hi(xv);
    __builtin_amdgcn_raw_buffer_store_b32((int)pack2(x0 + dry * g2v.x * r2[0], x1 + dry * g2v.y * r2[1]), rX, dl * 2, so, 0);
  }
}

#include <hip/hip_cooperative_groups.h>
namespace cg = cooperative_groups;
constexpr int SMEM_BYTES = 40960;


#define XB_TMO      128
#define XB_XCNT(j)  (256  + 64 * (j))
#define XB_XSUB(j)  (1280 + 64 * (j))
#define XB_XGEN(j)  (2304 + 64 * (j))
#define XB_TOP      3328
#define XB_TOPGEN   3392
#define XCD_BAR_WORDS 3456
#define XB_SPIN_CAP (1u << 22)
#define LAS __attribute__((address_space(3)))
DI unsigned xb_ld(unsigned* p) { return __hip_atomic_load(p, __ATOMIC_RELAXED, __HIP_MEMORY_SCOPE_AGENT); }
DI unsigned xb_add(unsigned* p, unsigned v) { return __hip_atomic_fetch_add(p, v, __ATOMIC_RELAXED, __HIP_MEMORY_SCOPE_AGENT); }
DI unsigned xb_xcc_id() { unsigned x; asm volatile("s_getreg_b32 %0, hwreg(HW_REG_XCC_ID, 0, 4)" : "=s"(x)); return x & 0xFu; }
#define XB_SPIN(cond, bar) do { unsigned _sp = 0; while (cond) { __builtin_amdgcn_s_sleep(1); \
    if ((++_sp & 255u) == 0u) { if (xb_ld(&(bar)[XB_TMO])) break; if (_sp > XB_SPIN_CAP) { atomicAdd(&(bar)[XB_TMO], 1u); break; } } } } while (0)
struct XcdBarrier { unsigned* bar; volatile LAS unsigned* st; };
DI XcdBarrier xcd_barrier_post(unsigned* bar, volatile LAS unsigned* st) {
  XcdBarrier b; b.bar = bar; b.st = st;
  if (tid_now() == 0) (void)xb_add(&bar[XB_XCNT(xb_xcc_id())], 1u);
  return b;
}
DI void xcd_barrier_complete(unsigned* bar, unsigned x, unsigned& nloc, unsigned& nx) {
  const unsigned G = gridDim.x;
  unsigned sum, cnt, mine, sp = 0u;
  for (;;) {
    sum = 0u; cnt = 0u; mine = 0u;
#pragma unroll
    for (unsigned j = 0; j < 16; ++j) { const unsigned c = xb_ld(&bar[XB_XCNT(j)]); sum += c; cnt += (c > 0u) ? 1u : 0u; mine = (j == x) ? c : mine; }
    if (sum == G) break;
    __builtin_amdgcn_s_sleep(1);
    if ((++sp & 255u) == 0u) { if (xb_ld(&bar[XB_TMO])) break; if (sp > XB_SPIN_CAP) { atomicAdd(&bar[XB_TMO], 1u); break; } }
  }
  nloc = mine > 0u ? mine : 1u; nx = cnt > 0u ? cnt : 1u;
}
DI void xcd_barrier(const XcdBarrier& b) {
  asm volatile("s_waitcnt vmcnt(0)" ::: "memory");
  __syncthreads();
  if (tid_now() == 0) {
    unsigned* bar = b.bar;
    const unsigned bx = xb_xcc_id();
    __builtin_amdgcn_s_waitcnt(0);
    unsigned nloc = b.st[0], nx = b.st[1];
    if (nloc == 0u) { xcd_barrier_complete(bar, bx, nloc, nx); b.st[0] = nloc; b.st[1] = nx; }
    const unsigned old = xb_add(&bar[XB_XSUB(bx)], 1u);
    const unsigned gen = old / nloc;
    if (old + 1u == (gen + 1u) * nloc) {
      __builtin_amdgcn_s_sleep(64);
      __builtin_amdgcn_fence(__ATOMIC_RELEASE, "agent");
      asm volatile("s_waitcnt vmcnt(0)" ::: "memory");
      const unsigned og = xb_add(&bar[XB_TOP], 1u);
      const unsigned tg = og / nx;
      if (og + 1u == (tg + 1u) * nx) xb_add(&bar[XB_TOPGEN], 1u);
      else XB_SPIN(xb_ld(&bar[XB_TOPGEN]) == tg, bar);
      __builtin_amdgcn_fence(__ATOMIC_ACQUIRE, "agent");
      xb_add(&bar[XB_XGEN(bx)], 1u);
      asm volatile("s_waitcnt vmcnt(0)" ::: "memory");
    } else {
      XB_SPIN(xb_ld(&bar[XB_XGEN(bx)]) == gen, bar);
      __builtin_amdgcn_fence(__ATOMIC_ACQUIRE, "agent");
      asm volatile("s_waitcnt vmcnt(0)" ::: "memory");
    }
  }
  __syncthreads();
  __builtin_amdgcn_s_sleep(32);
}

constexpr int QCTR_STRIDE = 32;
constexpr int QCTR_WORDS = 16 * 8 * QCTR_STRIDE;
DI int q_pop(unsigned* ctr, volatile LAS int* slot) {
  __syncthreads();
  if (tid_now() == 0) *slot = (int)__hip_atomic_fetch_add(ctr, 1u, __ATOMIC_RELAXED, __HIP_MEMORY_SCOPE_AGENT);
  __syncthreads();
  return *slot;
}
template <class NF, class BF>
DI void run_queues(unsigned* ctr, int myx, volatile LAS int* slot, NF nitems_of_q, BF body) {
#pragma unroll 1
  for (int s = 0; s < 8; ++s) {
    const int q = (myx + s) & 7;
    const int n = nitems_of_q(q);
#pragma unroll 1
    for (;;) {
      const int idx = q_pop(ctr + q * QCTR_STRIDE, slot);
      if (idx >= n) break;
      body(q, idx);
    }
  }
}

#define GRID_BARRIER() xcd_barrier(xb)
#define REP(k) for (int rep_ = 0; rep_ < (DUP == (k) ? 2 : 1); ++rep_)

__global__ void __launch_bounds__(256, 3) mega_kernel(Params p) {
  __shared__ __attribute__((aligned(16))) char smem[SMEM_BYTES];
  cg::grid_group grid = cg::this_grid();
  const int G = gridDim.x, bid = blockIdx.x;
  uint4* xbw = (uint4*)(smem + SMEM_BYTES - 16);
  if (tid_now() == 0) *xbw = make_uint4(0u, 0u, 0u, 0u);
  volatile LAS int* qslot = (volatile LAS int*)xbw + 2;
  XcdBarrier xb = xcd_barrier_post(p.bar, (volatile LAS unsigned*)xbw);
  if (p.never) grid.sync();
  REP(1) for (int it = bid; it < MODP_ITEMS + CONVT_ITEMS + CONVK_ITEMS + 1; it += G) {
    if (it < MODP_ITEMS) stage_mod_partial(p, it, smem);
    else if (it < MODP_ITEMS + CONVT_ITEMS) stage_convT(p, it - MODP_ITEMS, smem);
    else if (it < MODP_ITEMS + CONVT_ITEMS + CONVK_ITEMS) stage_convS(p, it - MODP_ITEMS - CONVT_ITEMS);
    else stage_rope(p);
  }
  GRID_BARRIER();
  for (int it = bid; it < MODR_ITEMS; it += G) stage_mod_reduce(p, it);
  GRID_BARRIER();
#pragma unroll 1
  for (int l = 0; l < 2; ++l) {
    REP(2) for (int it = bid; it < MTOT / 8; it += G) stage_norm(p, l, 0, it);
    if (l == 0) for (int it = bid; it < CQP_ITEMS; it += G) stage_cq_partial(p, it, smem);
    GRID_BARRIER();
    {
      const int myx = xb_xcc_id() & 7;
      unsigned* ctr = p.qctr + (l * 8 + 0) * 8 * QCTR_STRIDE;
      const int nlat = l == 0 ? 288 : 256;
      run_queues(ctr, myx, qslot,
        [&](int q) { return nlat * (q < 2 ? 3 : 2) + (l == 0 ? 0 : 32); },
        [&](int q, int idx) {
          const int nN = q < 2 ? 3 : 2;
          int mt, nt;
          if (idx < nlat * nN) { mt = idx / nN; nt = q + 8 * (idx - mt * nN); }
          else { mt = 256 + (idx - nlat * nN); nt = q < 2 ? q + 16 : q + 8; }
          stage_inproj(p, l, mt * 18 + nt, smem);
          if (DUP == 3) stage_inproj(p, l, mt * 18 + nt, smem);
        });
    }
    if (l == 0) for (int it = bid; it < CQR_ITEMS; it += G) stage_cq_reduce(p, it);
    GRID_BARRIER();
    {
      const int myx = xb_xcc_id() & 7;
      run_queues(p.qctr + (l * 8 + 1) * 8 * QCTR_STRIDE, myx, qslot, [&](int) { return 192; },
        [&](int q, int idx) {
          const int b = q + 8 * (idx / 96), r = idx % 96;
          stage_gqa(p, l, b * 96 + r, smem);
          if (DUP == 40) stage_gqa(p, l, b * 96 + r, smem);
          constexpr int NV = CONVV_ITEMS / 2;
          const int g = q * 192 + idx;
          for (int f = g * NV / 1536; f < (g + 1) * NV / 1536; ++f) stage_convS(p, CONVK_ITEMS + l * NV + f);
          const int ncv = (l == 0 ? MTOT : NTOK) / CONV_TT;
          const int c0 = g * ncv / 1536, c1 = (g + 1) * ncv / 1536;
          if (c0 < c1) {
            __syncthreads();
            for (int f = c0; f < c1; ++f) { stage_conv(p, l, f, smem); if (DUP == 44) stage_conv(p, l, f, smem); }
          }
        });
      run_queues(p.qctr + (l * 8 + 2) * 8 * QCTR_STRIDE, myx, qslot, [&](int) { return 192; },
        [&](int q, int idx) {
          const int b = q + 8 * (idx / 96), r = idx % 96;
          stage_na2(p, l, b * 96 + r, smem);
          if (DUP == 43) stage_na2(p, l, b * 96 + r, smem);
          constexpr int NU = CONVU_ITEMS / 2;
          const int g = q * 192 + idx;
          stage_convU(p, l, g * NU / 1536, (g + 1) * NU / 1536, smem);
        });
      const int nctx = l == 0 ? CTXATT_ITEMS : 0;
      for (int it = bid; it < nctx; it += G) stage_ctxatt(p, it, smem);
    }
    GRID_BARRIER();
    {
      const int myx = xb_xcc_id() & 7, nlat = l == 0 ? 288 : 256;
      run_queues(p.qctr + (l * 8 + 3) * 8 * QCTR_STRIDE, myx, qslot, [&](int) { return nlat; },
        [&](int q, int idx) { stage_outproj(p, l, idx * 8 + q, smem); });
    }
    GRID_BARRIER();
    {
      const int myx = xb_xcc_id() & 7, nlat = l == 0 ? 288 : 256;
      run_queues(p.qctr + (l * 8 + 4) * 8 * QCTR_STRIDE, myx, qslot, [&](int) { return nlat; },
        [&](int q, int idx) { stage_route(p, l, idx * 8 + q, smem); if (DUP == 7) stage_route(p, l, idx * 8 + q, smem); });
    }
    GRID_BARRIER();
    {
      const int myx = xb_xcc_id() & 7;
      const int ntile = (l == 0 ? MTOT : NTOK) / PEER_TPI;
      _Float16* partial = (_Float16*)p.U;
      run_queues(p.qctr + (l * 8 + 5) * 8 * QCTR_STRIDE, myx, qslot, [&](int) { return ntile; },
        [&](int q, int idx) { stage_peer_u(p, l, q, idx, partial); if (DUP == 50) stage_peer_u(p, l, q, idx, partial); });
      GRID_BARRIER();
      for (int it = bid; it < (l == 0 ? MTOT : NTOK) / (4 * PEERC_RPW); it += G) stage_peer_combine(p, l, it, partial);
      GRID_BARRIER();
      run_queues(p.qctr + (l * 8 + 6) * 8 * QCTR_STRIDE, myx, qslot, [&](int) { return ntile; },
        [&](int q, int idx) { if (DUP == 51) stage_peer_v(p, l, q, idx, 0.f); stage_peer_v(p, l, q, idx); });
    }
    GRID_BARRIER();
  }
  for (int it = bid; it < NTOK / 8; it += G) stage_final(p, it);
}

extern "C" void kernel_launch(void* const* d_in, const int* in_sizes, int n_in, void* d_out, int out_size, void* d_ws, size_t ws_size,
                              hipStream_t stream) {
  Params p{};
  const float** f = (const float**)&p;
  for (int i = 0; i < 22; ++i) f[i] = (const float*)d_in[i];
  p.out = (float*)d_out;
  char* w = (char*)d_ws; size_t off = 0;
  auto take = [&](size_t bytes) { char* r = w + off; off += (bytes + 255) & ~(size_t)255; return r; };
  p.win = (bf16*)take((size_t)2 * INC * D * 2);
  p.wout = (bf16*)take((size_t)2 * D * D * 2);
  p.wq = (bf16*)take((size_t)2 * 2048 * D * 2);
  p.pk = (bf16*)take(PK_N * 2);
  p.pu8 = (unsigned char*)take(PU_N);
  p.pv8 = (unsigned char*)take(PU_N);
  p.esc = (float*)take((size_t)2 * NEXP * 64 * 4);
  p.ssq16 = (float*)take((size_t)16 * MTOT * 4);
  p.hs8 = (float*)take((size_t)8 * MTOT * 4);
  p.cqp = (float*)take((size_t)CQ_KS * 2 * 17 * 2048 * 4);
  p.cq = (float*)take((size_t)2 * 17 * 2048 * 4);
  p.hq = (signed char*)take((size_t)MTOT * D);
  p.modp = (float*)take((size_t)2 * 8 * 17 * 6144 * 4);
  p.mod = (float*)take((size_t)2 * 17 * 6144 * 4);
  p.ropetab = (float*)take(64 * 16 * 2 * 4);
  p.H = (bf16*)take((size_t)MTOT * D * 2);
  p.CAT = p.H;
  p.U = (bf16*)take((size_t)MTOT * 256 * 2);
  p.QN = (bf16*)take((size_t)NB * 6 * SEQ2 * 64 * 2);
  p.KN = (bf16*)take((size_t)NB * 6 * SEQ2 * 64 * 2);
  p.VNt = (bf16*)take((size_t)NB * 6 * SEQ2 * 64 * 2);
  p.QG = (bf16*)take((size_t)NB * 6 * SEQ2 * 64 * 2);
  p.KG = (bf16*)take((size_t)NB * 2 * SEQ2 * 64 * 2);
  p.VGt = (bf16*)take((size_t)NB * 2 * SEQ2 * 64 * 2);
  p.H2 = (bf16*)((char*)p.U + (size_t)8 * MTOT * 128 * 2);
  p.XC = nullptr;
  p.XB = (bf16*)take((size_t)MTOT * D * 2);
  p.ridx = (int*)take((size_t)MTOT * 256 * 4);
  p.rg = (float*)p.ridx;
  p.bar = (unsigned*)take(XCD_BAR_WORDS * 4);
  p.qctr = (unsigned*)take(QCTR_WORDS * 4);
  if (off > ws_size) return;
  static int grid_blocks = 0;
  if (!grid_blocks) {
    int dev = 0, cus = 0, per_cu = 0;
    hipGetDevice(&dev);
    hipDeviceGetAttribute(&cus, hipDeviceAttributeMultiprocessorCount, dev);
    hipOccupancyMaxActiveBlocksPerMultiprocessor(&per_cu, mega_kernel, 256, 0);
    if (per_cu > 3) per_cu = 3;
    grid_blocks = cus * per_cu;
  }
  void* args[] = {&p};
  hipMemsetAsync(p.bar, 0, (size_t)(XCD_BAR_WORDS + QCTR_WORDS) * 4, stream);
  hipLaunchCooperativeKernel((void*)mega_kernel, dim3(grid_blocks), dim3(256), args, 0, stream);
}
```

```cpp
#include <hip/hip_runtime.h>
#include <stdint.h>

typedef __attribute__((ext_vector_type(8))) short bf16x8;
typedef __attribute__((ext_vector_type(16))) float f32x16;
typedef __attribute__((ext_vector_type(2))) __bf16 bf2_t;
typedef __attribute__((ext_vector_type(2))) float f2_t;
typedef unsigned short bf16;
typedef __attribute__((ext_vector_type(2))) _Float16 h2_t;
typedef __attribute__((ext_vector_type(4))) unsigned u32x4;
typedef __attribute__((ext_vector_type(2))) unsigned u32x2;

#define DI __device__ __forceinline__
#ifndef PROBE
#define PROBE 0
#endif
#ifndef DUP
#define DUP 0
#endif
#define MFMA(a, b, c) __builtin_amdgcn_mfma_f32_32x32x16_bf16((a), (b), (c), 0, 0, 0)

constexpr int D = 1024, NB = 16, T = 2048, CL = 256;
constexpr int NTOK = NB * T;
constexpr int NCTX = NB * CL;
constexpr int MTOT = NTOK + NCTX;
constexpr int INC = 2304;
constexpr int SEQ2 = T + CL;
constexpr int NEXP = 16384;
constexpr float EPS = 1e-6f;
constexpr float L2E = 1.4426950408889634f;

struct Params {
  const float *x, *c, *ctx, *c_ctx, *norm1_g, *norm2_g, *w_ada, *b_ada, *w_in, *conv_w, *conv_b, *conv_ln_g,
      *conv_ln_b, *na_rel_bias, *gqa_q_norm, *gqa_k_norm, *w_out, *peer_w_q, *peer_keys, *peer_u, *peer_v, *final_norm_g;
  float* out;
  bf16 *win, *wout, *wq, *pk;
  unsigned char *pu8, *pv8;
  float *esc;
  float *ssq16, *hs8;
  bf16 *XB;
  float *cqp, *cq;
  bf16 *H2;
  signed char* hq;
  float *modp, *mod, *ropetab;
  bf16 *H, *U, *QN, *KN, *VNt, *QG, *KG, *VGt, *CAT;
  float *XC;
  int* ridx;
  float* rg;
  unsigned* bar;
  unsigned* qctr;
  int never;
  int pad_;
};

DI int tid_now() { int t; asm volatile("v_mov_b32 %0, %1" : "=v"(t) : "v"((int)__builtin_amdgcn_workitem_id_x())); return t; }
DI unsigned pack2(float a, float b) {
  f2_t v = {a, b};
  bf2_t r = __builtin_convertvector(v, bf2_t);
  return __builtin_bit_cast(unsigned, r);
}
DI float bf_lo(unsigned u) { return __uint_as_float(u << 16); }
DI float bf_hi(unsigned u) { return __uint_as_float(u & 0xffff0000u); }
DI int sidx(int r) { return (r >> 2) * 32 + (r & 3); }
DI int crow(int e, int h) { return (e & 3) + 8 * (e >> 2) + 4 * h; }
DI float fexp2(float x) { return __builtin_amdgcn_exp2f(x); }
DI float silu_f(float x) { return x / (1.f + __expf(-x)); }
DI float sigmoid_f(float x) { return 1.f / (1.f + __expf(-x)); }
DI float gelu_tanh(float x) {
  float u = 0.7978845608028654f * (x + 0.044715f * x * x * x);
  float t = 1.f - 2.f / (1.f + __expf(2.f * u));
  return 0.5f * x * (1.f + t);
}
DI float shx(float v, int m, int lane) { return __int_as_float(__builtin_amdgcn_ds_bpermute((lane ^ m) << 2, __float_as_int(v))); }
DI int shxi(int v, int m, int lane) { return __builtin_amdgcn_ds_bpermute((lane ^ m) << 2, v); }
DI float wave_sum(float v, int lane) {
#pragma unroll
  for (int o = 32; o >= 1; o >>= 1) v += shx(v, o, lane);
  return v;
}
DI float* xres_row(const Params& p, int row) { return row < NTOK ? p.out + (size_t)row * D : p.XC + (size_t)(row - NTOK) * D; }
DI const float* xin_row(const Params& p, int layer, int row) {
  if (layer == 0) return row < NTOK ? p.x + (size_t)row * D : p.ctx + (size_t)(row - NTOK) * D;
  return xres_row(p, row);
}
DI int mod_row(int row) { return row < NTOK ? (row >> 11) : 16; }
DI int batch_of(int row) { return row < NTOK ? (row >> 11) : ((row - NTOK) >> 8); }
DI int pos_of(int row) { return row < NTOK ? (row & 2047) : (T + ((row - NTOK) & 255)); }

DI int perm_in(int n) {
  if (n >= 512) return n;
  int c = n >> 6, w = n & 63;
  return w < 32 ? 32 * c + w : 256 + 32 * c + (w - 32);
}
DI size_t fm_index(int n, int k) { return ((size_t)(n >> 5) * 64 + (k >> 4)) * 512 + ((((k >> 3) & 1) * 32 + (n & 31)) * 8) + (k & 7); }
DI void convT_tile(const float* __restrict__ src, bf16* __restrict__ dst, int K, int N, int k0, int n0, bool perm, float* tile  ) {
  const int tx = tid_now() & 63, ty = tid_now() >> 6;
  const int ns = perm ? perm_in(n0 + tx) : n0 + tx;
#pragma unroll
  for (int i = 0; i < 16; ++i) { int k = ty + 4 * i; tile[k * 65 + tx] = src[(size_t)(k0 + k) * N + ns]; }
  __syncthreads();
#pragma unroll
  for (int i = 0; i < 2; ++i) {
    const int pr = tid_now() + 256 * i;
    const int n = pr & 63, kc = pr >> 6;
    const float* t = tile + (kc * 8) * 65 + n;
    u32x4 o = {pack2(t[0], t[65]), pack2(t[2 * 65], t[3 * 65]), pack2(t[4 * 65], t[5 * 65]), pack2(t[6 * 65], t[7 * 65])};
    *(u32x4*)(dst + fm_index(n0 + n, k0 + kc * 8)) = o;
  }
  __syncthreads();
}
constexpr int CONVT_ITEMS = 2 * 1344;
DI void stage_convT(const Params& p, int item, char* smem) {
  float* tile = (float*)smem;
  int l = item / 1344, r = item % 1344;
  if (r < 576) { int kt = r / 36, nt = r % 36; convT_tile(p.w_in + (size_t)l * D * INC, p.win + (size_t)l * INC * D, D, INC, kt * 64, nt * 64, true, tile); }
  else if (r < 832) { r -= 576; int kt = r / 16, nt = r % 16; convT_tile(p.w_out + (size_t)l * D * D, p.wout + (size_t)l * D * D, D, D, kt * 64, nt * 64, false, tile); }
  else { r -= 832; int kt = r / 32, nt = r % 32; convT_tile(p.peer_w_q + (size_t)l * D * 2048, p.wq + (size_t)l * 2048 * D, D, 2048, kt * 64, nt * 64, false, tile); }
}
constexpr size_t PK_N = (size_t)2 * 16 * 128 * 128, PU_N = (size_t)2 * NEXP * D;
constexpr float SU = 1024.f, SV = 64.f;
constexpr int CONVK_ITEMS = (int)(PK_N / 2048), CONVV_ITEMS = (int)(PU_N / 4096), CONVU_ITEMS = 2 * NEXP / 4;
constexpr int CONVS_ITEMS = CONVK_ITEMS + CONVV_ITEMS + CONVU_ITEMS;
DI unsigned pack_fp8x4(float4 a, float s) {
  int r = 0;
  r = __builtin_amdgcn_cvt_pk_fp8_f32(a.x * s, a.y * s, r, false);
  r = __builtin_amdgcn_cvt_pk_fp8_f32(a.z * s, a.w * s, r, true);
  return (unsigned)r;
}
DI unsigned pack_i8x4(float4 a, float s) {
  const int x = (int)rintf(a.x * s), y = (int)rintf(a.y * s), z = (int)rintf(a.z * s), w = (int)rintf(a.w * s);
  return (unsigned)(x & 255) | ((unsigned)(y & 255) << 8) | ((unsigned)(z & 255) << 16) | ((unsigned)(w & 255) << 24);
}
DI void stage_convS(const Params& p, int item) {
  if (item < CONVK_ITEMS) {
    size_t e = (size_t)item * 2048 + tid_now() * 8;
    const float* src = p.peer_keys + e;
    float4 a = ((const float4*)src)[0], b = ((const float4*)src)[1];
    u32x4 o = {pack2(a.x, a.y), pack2(a.z, a.w), pack2(b.x, b.y), pack2(b.z, b.w)};
    *(u32x4*)(p.pk + e) = o;
    return;
  }
  item -= CONVK_ITEMS;
  if (item < CONVV_ITEMS) {
    size_t e = (size_t)item * 4096 + tid_now() * 16;
    const float* src = p.peer_v + e;
    float4 a = ((const float4*)src)[0], b = ((const float4*)src)[1], c = ((const float4*)src)[2], d = ((const float4*)src)[3];
    u32x4 o = {pack_fp8x4(a, SV), pack_fp8x4(b, SV), pack_fp8x4(c, SV), pack_fp8x4(d, SV)};
    *(u32x4*)(p.pv8 + e) = o;
    return;
  }
  item -= CONVV_ITEMS;
  {
    const int lane = tid_now() & 63, wave = tid_now() >> 6;
    const int r = item * 4 + wave;
    const float* src = p.peer_u + (size_t)r * D + lane * 16;
    float4 a = ((const float4*)src)[0], b = ((const float4*)src)[1], c = ((const float4*)src)[2], d = ((const float4*)src)[3];
    float m = fmaxf(fmaxf(fmaxf(fabsf(a.x), fabsf(a.y)), fmaxf(fabsf(a.z), fabsf(a.w))), fmaxf(fmaxf(fabsf(b.x), fabsf(b.y)), fmaxf(fabsf(b.z), fabsf(b.w))));
    m = fmaxf(m, fmaxf(fmaxf(fmaxf(fabsf(c.x), fabsf(c.y)), fmaxf(fabsf(c.z), fabsf(c.w))), fmaxf(fmaxf(fabsf(d.x), fabsf(d.y)), fmaxf(fabsf(d.z), fabsf(d.w)))));
#pragma unroll
    for (int o = 32; o >= 1; o >>= 1) m = fmaxf(m, shx(m, o, lane));
    m = fmaxf(m, 1e-30f);
    const float s = 127.f / m;
    u32x4 o = {pack_i8x4(a, s), pack_i8x4(b, s), pack_i8x4(c, s), pack_i8x4(d, s)};
    *(u32x4*)(p.pu8 + (size_t)r * D + lane * 16) = o;
  }
}
DI float dotbf(unsigned a, unsigned b, float acc) {
  const bf2_t x = __builtin_bit_cast(bf2_t, a), y = __builtin_bit_cast(bf2_t, b);
  return __builtin_amdgcn_fdot2_f32_bf16(x, y, acc, false);
}
DI void stage_convU(const Params& p, int l, int f0, int f1, char* smem) {
  if (f0 >= f1) return;
  const int tid = tid_now(), lane = tid & 63, wave = tid >> 6;
  __syncthreads();
  for (int i = tid; i < 17 * 128; i += 256) {
    const int mr = i >> 7, c8 = i & 127;
    const float* sp = p.mod + ((size_t)l * 17 + mr) * 6144 + 3072 + c8 * 8;
    const float4 s0 = ((const float4*)sp)[0], s1 = ((const float4*)sp)[1];
    u32x4 o = {pack2(s0.x, s0.y), pack2(s0.z, s0.w), pack2(s1.x, s1.y), pack2(s1.z, s1.w)};
    *(u32x4*)(smem + ((mr * 2 + (c8 & 1)) * 64 + (c8 >> 1)) * 16) = o;
  }
  __syncthreads();
#pragma unroll 1
  for (int f = f0; f < f1; ++f) {
    const int r = (l * (NEXP / 4) + f) * 4 + wave;
    const float* src = p.peer_u + (size_t)r * D + lane * 16;
    float4 a = ((const float4*)src)[0], b = ((const float4*)src)[1], c = ((const float4*)src)[2], d = ((const float4*)src)[3];
    float m = fmaxf(fmaxf(fmaxf(fabsf(a.x), fabsf(a.y)), fmaxf(fabsf(a.z), fabsf(a.w))), fmaxf(fmaxf(fabsf(b.x), fabsf(b.y)), fmaxf(fabsf(b.z), fabsf(b.w))));
    m = fmaxf(m, fmaxf(fmaxf(fmaxf(fabsf(c.x), fabsf(c.y)), fmaxf(fabsf(c.z), fabsf(c.w))), fmaxf(fmaxf(fabsf(d.x), fabsf(d.y)), fmaxf(fabsf(d.z), fabsf(d.w)))));
#pragma unroll
    for (int o = 32; o >= 1; o >>= 1) m = fmaxf(m, shx(m, o, lane));
    m = fmaxf(m, 1e-30f);
    const float s = 127.f / m;
    u32x4 o = {pack_i8x4(a, s), pack_i8x4(b, s), pack_i8x4(c, s), pack_i8x4(d, s)};
    *(u32x4*)(p.pu8 + (size_t)r * D + lane * 16) = o;
    const unsigned u0 = pack2(a.x, a.y), u1 = pack2(a.z, a.w), u2 = pack2(b.x, b.y), u3 = pack2(b.z, b.w);
    const unsigned u4 = pack2(c.x, c.y), u5 = pack2(c.z, c.w), u6 = pack2(d.x, d.y), u7 = pack2(d.z, d.w);
    float tv[17];
#pragma unroll
    for (int mr = 0; mr < 17; ++mr) {
      const u32x4 sa = *(const u32x4*)(smem + ((mr * 2) * 64 + lane) * 16), sb = *(const u32x4*)(smem + ((mr * 2 + 1) * 64 + lane) * 16);
      const unsigned a0 = sa[0], a1 = sa[1], a2 = sa[2], a3 = sa[3], b0 = sb[0], b1 = sb[1], b2 = sb[2], b3 = sb[3];
      float t = dotbf(u0, a0, 0.f); t = dotbf(u1, a1, t); t = dotbf(u2, a2, t); t = dotbf(u3, a3, t);
      t = dotbf(u4, b0, t); t = dotbf(u5, b1, t); t = dotbf(u6, b2, t); t = dotbf(u7, b3, t);
      tv[mr] = t;
      if ((mr & 3) == 3) asm volatile("" ::: "memory");
    }
    const float t16 = wave_sum(tv[16], lane);
    float r8[8], r4[4], r2[2], r1;
    {
      const bool up = lane & 1;
#pragma unroll
      for (int k = 0; k < 8; ++k) { const float keep = up ? tv[k + 8] : tv[k], give = up ? tv[k] : tv[k + 8]; r8[k] = keep + shx(give, 1, lane); }
    }
    {
      const bool up = lane & 2;
#pragma unroll
      for (int k = 0; k < 4; ++k) { const float keep = up ? r8[k + 4] : r8[k], give = up ? r8[k] : r8[k + 4]; r4[k] = keep + shx(give, 2, lane); }
    }
    {
      const bool up = lane & 4;
#pragma unroll
      for (int k = 0; k < 2; ++k) { const float keep = up ? r4[k + 2] : r4[k], give = up ? r4[k] : r4[k + 2]; r2[k] = keep + shx(give, 4, lane); }
    }
    {
      const bool up = lane & 8;
      const float keep = up ? r2[1] : r2[0], give = up ? r2[0] : r2[1];
      r1 = keep + shx(give, 8, lane);
    }
    r1 += shx(r1, 16, lane);
    r1 += shx(r1, 32, lane);
    const int idx = 8 * (lane & 1) + 4 * ((lane >> 1) & 1) + 2 * ((lane >> 2) & 1) + ((lane >> 3) & 1);
    float* er = p.esc + (size_t)r * 64;
    const float2 ov = {lane < 16 ? r1 : t16, m * (1.f / 127.f)};
    if (lane < 17) *(float2*)(er + 2 * (lane < 16 ? idx : 16)) = ov;
  }
  __syncthreads();
}
constexpr int CQ_KS = 32;
constexpr int CQP_ITEMS = 2 * CQ_KS * 8;
DI void stage_cq_partial(const Params& p, int item, char* smem) {
  float* sc = (float*)smem;
  const int l = item / (CQ_KS * 8), r = item % (CQ_KS * 8), kc = r >> 3, nc = r & 7;
  for (int i = tid_now(); i < 17 * 32; i += 256) {
    const int rr = i >> 5, k = i & 31;
    sc[i] = p.mod[((size_t)l * 17 + rr) * 6144 + 3072 + kc * 32 + k];
  }
  const int n = nc * 256 + tid_now();
  const float* w = p.peer_w_q + ((size_t)l * D + kc * 32) * 2048 + n;
  float wv[32];
#pragma unroll
  for (int k = 0; k < 32; ++k) wv[k] = w[(size_t)k * 2048];
  __syncthreads();
  float acc[17];
#pragma unroll
  for (int i = 0; i < 17; ++i) acc[i] = 0.f;
#pragma unroll
  for (int k4 = 0; k4 < 8; ++k4)
#pragma unroll
    for (int i = 0; i < 17; ++i) {
      const float4 s = *(const float4*)(sc + i * 32 + k4 * 4);
      acc[i] += s.x * wv[4 * k4] + s.y * wv[4 * k4 + 1] + s.z * wv[4 * k4 + 2] + s.w * wv[4 * k4 + 3];
    }
#pragma unroll
  for (int i = 0; i < 17; ++i) p.cqp[(((size_t)l * CQ_KS + kc) * 17 + i) * 2048 + n] = acc[i];
  __syncthreads();
}
constexpr int CQR_ITEMS = 2 * 17 * 2048 / 256;
DI void stage_cq_reduce(const Params& p, int item) {
  const int idx = item * 256 + tid_now();
  const int l = idx / (17 * 2048), rem = idx % (17 * 2048);
  float v[CQ_KS];
#pragma unroll
  for (int kc = 0; kc < CQ_KS; ++kc) v[kc] = p.cqp[((size_t)l * CQ_KS + kc) * 17 * 2048 + rem];
  float s = 0.f;
#pragma unroll
  for (int kc = 0; kc < CQ_KS; ++kc) s += v[kc];
  p.cq[idx] = s;
}
DI void stage_rope(const Params& p) {
  for (int i = tid_now(); i < 64 * 16; i += 256) {
    int pos = i >> 4, f = i & 15;
    float inv = powf(10000.f, -(float)f / 16.f);
    float ang = (float)pos * inv;
    p.ropetab[2 * i] = cosf(ang); p.ropetab[2 * i + 1] = sinf(ang);
  }
}

constexpr int MODP_ITEMS = 2 * 8 * 24;
DI void stage_mod_partial(const Params& p, int item, char* smem) {
  float* sc = (float*)smem;
  int l = item / 192, r = item % 192, kc = r / 24, nc = r % 24;
  for (int i = tid_now(); i < 17 * 128; i += 256) {
    int rr = i >> 7, k = i & 127;
    float v = rr < 16 ? p.c[rr * D + kc * 128 + k] : p.c_ctx[kc * 128 + k];
    sc[i] = silu_f(v);
  }
  __syncthreads();
  float acc[17];
#pragma unroll
  for (int i = 0; i < 17; ++i) acc[i] = 0.f;
  const int n = nc * 256 + tid_now();
  const float* w = p.w_ada + ((size_t)l * D + kc * 128) * 6144 + n;
#pragma unroll 1
  for (int k0 = 0; k0 < 128; k0 += 32) {
    float wv[32];
#pragma unroll
    for (int k = 0; k < 32; ++k) wv[k] = w[(size_t)(k0 + k) * 6144];
#pragma unroll
    for (int k4 = 0; k4 < 8; ++k4)
#pragma unroll
      for (int i = 0; i < 17; ++i) {
        const float4 s = *(const float4*)(sc + i * 128 + k0 + k4 * 4);
        acc[i] += s.x * wv[4 * k4] + s.y * wv[4 * k4 + 1] + s.z * wv[4 * k4 + 2] + s.w * wv[4 * k4 + 3];
      }
  }
#pragma unroll
  for (int i = 0; i < 17; ++i) p.modp[(((size_t)l * 8 + kc) * 17 + i) * 6144 + n] = acc[i];
  __syncthreads();
}
constexpr int MODR_ITEMS = 2 * 17 * 6144 / 256;
DI void stage_mod_reduce(const Params& p, int item) {
  int idx = item * 256 + tid_now();
  int l = idx / (17 * 6144), rem = idx % (17 * 6144), n = rem % 6144;
  float s = p.b_ada[l * 6144 + n];
#pragma unroll
  for (int kc = 0; kc < 8; ++kc) s += p.modp[((size_t)l * 8 + kc) * 17 * 6144 + rem];
  p.mod[idx] = s;
}

DI void norm_row(const Params& p, const float* __restrict__ xr, const float* __restrict__ g, const float* __restrict__ sh,
                 const float* __restrict__ sc, bf16* __restrict__ hr, signed char* __restrict__ hq = nullptr, float* __restrict__ hsc = nullptr) {
  const int lane = tid_now() & 63;
  float4 v[4]; float ss = 0.f;
#pragma unroll
  for (int i = 0; i < 4; ++i) { v[i] = ((const float4*)xr)[lane + 64 * i]; ss += v[i].x * v[i].x + v[i].y * v[i].y + v[i].z * v[i].z + v[i].w * v[i].w; }
  ss = wave_sum(ss, lane);
  const float rstd = rsqrtf(ss * (1.f / D) + EPS);
#pragma unroll
  for (int i = 0; i < 4; ++i) {
    float4 gg = ((const float4*)g)[lane + 64 * i], s1 = ((const float4*)sh)[lane + 64 * i], s2 = ((const float4*)sc)[lane + 64 * i];
    float a = v[i].x * rstd * gg.x * (1.f + s2.x) + s1.x, b = v[i].y * rstd * gg.y * (1.f + s2.y) + s1.y;
    float c = v[i].z * rstd * gg.z * (1.f + s2.z) + s1.z, d = v[i].w * rstd * gg.w * (1.f + s2.w) + s1.w;
    u32x2 o = {pack2(a, b), pack2(c, d)};
    ((u32x2*)hr)[lane + 64 * i] = o;
    v[i].x = a; v[i].y = b; v[i].z = c; v[i].w = d;
  }
  if (hq != nullptr) {
    float m = 0.f;
#pragma unroll
    for (int i = 0; i < 4; ++i) m = fmaxf(m, fmaxf(fmaxf(fabsf(v[i].x), fabsf(v[i].y)), fmaxf(fabsf(v[i].z), fabsf(v[i].w))));
#pragma unroll
    for (int o = 32; o >= 1; o >>= 1) m = fmaxf(m, shx(m, o, lane));
    m = fmaxf(m, 1e-30f);
    const float s = 127.f / m;
#pragma unroll
    for (int i = 0; i < 4; ++i) ((unsigned*)hq)[lane + 64 * i] = pack_i8x4(v[i], s);
    if (lane == 0) *hsc = m * (1.f / 127.f);
  }
}
DI void stage_norm(const Params& p, int layer, int which, int item) {
  const int lane = tid_now() & 63;
  const int rowa = item * 8 + (tid_now() >> 6) * 2;
  const float* g = (which == 0 ? p.norm1_g : p.norm2_g) + layer * D;
  const float* mm = p.mod + ((size_t)layer * 17 + mod_row(rowa)) * 6144 + (which == 0 ? 0 : 3072);
  float4 v[2][4], gg[4], s1[4], s2[4];
#pragma unroll
  for (int j = 0; j < 2; ++j) {
    if (layer == 0) {
      const float* xr = xin_row(p, 0, rowa + j);
      u32x2* xw = (u32x2*)(p.XB + (size_t)(rowa + j) * D);
#pragma unroll
      for (int i = 0; i < 4; ++i) {
        v[j][i] = ((const float4*)xr)[lane + 64 * i];
        u32x2 o = {pack2(v[j][i].x, v[j][i].y), pack2(v[j][i].z, v[j][i].w)};
        xw[lane + 64 * i] = o;
      }
    } else {
      const u32x2* xr = (const u32x2*)(p.XB + (size_t)(rowa + j) * D);
#pragma unroll
      for (int i = 0; i < 4; ++i) { const u32x2 t = xr[lane + 64 * i]; const unsigned t0 = t[0], t1 = t[1]; v[j][i] = float4{bf_lo(t0), bf_hi(t0), bf_lo(t1), bf_hi(t1)}; }
    }
  }
#pragma unroll
  for (int i = 0; i < 4; ++i) { gg[i] = ((const float4*)g)[lane + 64 * i]; s1[i] = ((const float4*)mm)[lane + 64 * i]; s2[i] = ((const float4*)(mm + D))[lane + 64 * i]; }
#pragma unroll
  for (int j = 0; j < 2; ++j) {
    float ss = 0.f;
#pragma unroll
    for (int i = 0; i < 4; ++i) ss += v[j][i].x * v[j][i].x + v[j][i].y * v[j][i].y + v[j][i].z * v[j][i].z + v[j][i].w * v[j][i].w;
    ss = wave_sum(ss, lane);
    const float rstd = rsqrtf(ss * (1.f / D) + EPS);
    bf16* hr = p.H + (size_t)(rowa + j) * D;
#pragma unroll
    for (int i = 0; i < 4; ++i) {
      const float a = v[j][i].x * rstd * gg[i].x * (1.f + s2[i].x) + s1[i].x, b = v[j][i].y * rstd * gg[i].y * (1.f + s2[i].y) + s1[i].y;
      const float c = v[j][i].z * rstd * gg[i].z * (1.f + s2[i].z) + s1[i].z, d = v[j][i].w * rstd * gg[i].w * (1.f + s2[i].w) + s1[i].w;
      u32x2 o = {pack2(a, b), pack2(c, d)};
      ((u32x2*)hr)[lane + 64 * i] = o;
    }
  }
}
DI void stage_final(const Params& p, int item) {
  const int lane = tid_now() & 63;
  const int rowa = item * 8 + (tid_now() >> 6) * 2;
  float4 v[2][4], gg[4];
#pragma unroll
  for (int j = 0; j < 2; ++j) {
    const u32x2* xr = (const u32x2*)(p.XB + (size_t)(rowa + j) * D);
#pragma unroll
    for (int i = 0; i < 4; ++i) { const u32x2 t = xr[lane + 64 * i]; const unsigned t0 = t[0], t1 = t[1]; v[j][i] = float4{bf_lo(t0), bf_hi(t0), bf_lo(t1), bf_hi(t1)}; }
  }
#pragma unroll
  for (int i = 0; i < 4; ++i) gg[i] = ((const float4*)p.final_norm_g)[lane + 64 * i];
#pragma unroll
  for (int j = 0; j < 2; ++j) {
    float ss = 0.f;
#pragma unroll
    for (int i = 0; i < 4; ++i) ss += v[j][i].x * v[j][i].x + v[j][i].y * v[j][i].y + v[j][i].z * v[j][i].z + v[j][i].w * v[j][i].w;
    ss = wave_sum(ss, lane);
    const float rstd = rsqrtf(ss * (1.f / D) + EPS);
#pragma unroll
    for (int i = 0; i < 4; ++i) {
      float4 o = {v[j][i].x * rstd * gg[i].x, v[j][i].y * rstd * gg[i].y, v[j][i].z * rstd * gg[i].z, v[j][i].w * rstd * gg[i].w};
      ((float4*)(p.out + (size_t)(rowa + j) * D))[lane + 64 * i] = o;
    }
  }
}

constexpr int LROW = 144;
constexpr int LTILE = 128 * LROW;
constexpr int GEMM_SMEM = 2 * LTILE;

template <bool ORIENT_T, bool PEEL = false>
DI void gemm_core(const bf16* __restrict__ A, const bf16* __restrict__ W, char* smem, f32x16 (&acc)[2][2]) {
  const int tid = tid_now(), lane = tid & 63, wave = tid >> 6;
  const int wm = wave >> 1, wn = wave & 1, l31 = lane & 31, hh = lane >> 5;
  const int lrow = tid >> 3, kc = tid & 7;
#pragma unroll
  for (int i = 0; i < 2; ++i)
#pragma unroll
    for (int j = 0; j < 2; ++j)
#pragma unroll
      for (int e = 0; e < 16; ++e) acc[i][j][e] = 0.f;
  u32x4 ra[4];
  bf16x8 wf[2][4];
  const bf16* ap = A + (size_t)lrow * D + kc * 8;
  const bf16* wp = W + (size_t)(wn * 2) * 64 * 512 + lane * 8;
#pragma unroll
  for (int i = 0; i < 4; ++i) ra[i] = *(const u32x4*)(ap + (size_t)(32 * i) * D);
  if (PEEL) {
#pragma unroll
    for (int s = 0; s < 4; ++s)
#pragma unroll
      for (int ft = 0; ft < 2; ++ft) wf[ft][s] = *(const bf16x8*)(wp + (size_t)(ft * 64 + s) * 512);
    __builtin_amdgcn_sched_barrier(0);
  } else {
#pragma unroll
    for (int ft = 0; ft < 2; ++ft)
#pragma unroll
      for (int s = 0; s < 4; ++s) wf[ft][s] = *(const bf16x8*)(wp + (size_t)(ft * 64 + s) * 512);
  }
  auto ktile = [&](const int kt, const bool more) {
    char* sa = smem + (kt & 1) * LTILE;
#pragma unroll
    for (int i = 0; i < 4; ++i) *(u32x4*)(sa + (lrow + 32 * i) * LROW + kc * 16) = ra[i];
    __syncthreads();
    if (more) {
#pragma unroll
      for (int i = 0; i < 4; ++i) ra[i] = *(const u32x4*)(ap + (size_t)(32 * i) * D + (kt + 1) * 64);
    }
    if (PEEL) __builtin_amdgcn_sched_barrier(0);
#pragma unroll
    for (int s = 0; s < 4; ++s) {
      bf16x8 af[2];
#pragma unroll
      for (int t = 0; t < 2; ++t) af[t] = *(const bf16x8*)(sa + (wm * 64 + t * 32 + l31) * LROW + (s * 16 + hh * 8) * 2);
#pragma unroll
      for (int ft = 0; ft < 2; ++ft)
#pragma unroll
        for (int tt = 0; tt < 2; ++tt)
          acc[ft][tt] = ORIENT_T ? MFMA(wf[ft][s], af[tt], acc[ft][tt]) : MFMA(af[tt], wf[ft][s], acc[ft][tt]);
      if (more) {
#pragma unroll
        for (int ft = 0; ft < 2; ++ft) wf[ft][s] = *(const bf16x8*)(wp + (size_t)(ft * 64 + (kt + 1) * 4 + s) * 512);
      }
      if (PEEL) __builtin_amdgcn_sched_barrier(0);
    }
    };
  if (PEEL) {
#pragma unroll 1
    for (int kt = 0; kt < 15; ++kt) ktile(kt, true);
    ktile(15, false);
  } else {
#pragma unroll 1
    for (int kt = 0; kt < 16; ++kt) ktile(kt, kt + 1 < 16);
  }
  __syncthreads();
}

constexpr int INPROJ_ITEMS = 288 * 18;
DI void store4(bf16* dst, float a, float b, float c, float d) { u32x2 o = {pack2(a, b), pack2(c, d)}; *(u32x2*)dst = o; }
DI void store_pair(bf16* rowbase, int hh, float a0, float a1, float a2, float a3, float b0, float b1, float b2, float b3) {
  unsigned ax = pack2(a0, a1), ay = pack2(a2, a3), bx = pack2(b0, b1), by = pack2(b2, b3);
  const auto r0 = __builtin_amdgcn_permlane32_swap(ax, bx, false, false); ax = r0[0]; bx = r0[1];
  const auto r1 = __builtin_amdgcn_permlane32_swap(ay, by, false, false); ay = r1[0]; by = r1[1];
  u32x4 o = {ax, ay, bx, by};
  *(u32x4*)(rowbase + hh * 8) = o;
}

DI void stage_inproj(const Params& p, int layer, int item, char* smem) {
  const int mt = item / 18, nt = item % 18;
  if (layer == 1 && mt >= 256 && nt < 10) return;
  const int row0 = mt * 128, n0 = nt * 128;
  const bf16* A = p.H + (size_t)row0 * D;
  const bf16* W = p.win + ((size_t)layer * INC + n0) * D;
  const int lane = tid_now() & 63, wave = tid_now() >> 6, wm = wave >> 1, wn = wave & 1, l31 = lane & 31, hh = lane >> 5;
  const bool vtile = (nt >= 13 && nt <= 15) || nt == 17;
  f32x16 acc[2][2];
  const int b = batch_of(row0);
  if (vtile) {
    gemm_core<false, true>(A, W, smem, acc);
    bf16* base; int head;
    if (nt == 17) { head = wn; base = p.VGt + ((size_t)(b * 2 + head) * 64) * SEQ2; }
    else { head = (nt - 13) * 2 + wn; base = p.VNt + ((size_t)(b * 6 + head) * 64) * SEQ2; }
    const int pos0 = pos_of(row0) + wm * 64;
#pragma unroll
    for (int ft = 0; ft < 2; ++ft) {
      const int d = ft * 32 + l31;
#pragma unroll
      for (int tt = 0; tt < 2; ++tt)
#pragma unroll
        for (int g = 0; g < 4; g += 2)
          store_pair(base + (size_t)d * SEQ2 + pos0 + tt * 32 + 8 * g, hh, acc[ft][tt][4 * g], acc[ft][tt][4 * g + 1], acc[ft][tt][4 * g + 2], acc[ft][tt][4 * g + 3],
                     acc[ft][tt][4 * g + 4], acc[ft][tt][4 * g + 5], acc[ft][tt][4 * g + 6], acc[ft][tt][4 * g + 7]);
    }
    return;
  }
  gemm_core<true, true>(A, W, smem, acc);
  const int chunk = nt * 2 + wn;
#pragma unroll
  for (int tt = 0; tt < 2; ++tt) {
    const int row = row0 + wm * 64 + tt * 32 + l31;
    const int pos = pos_of(row);
    const bool isctx = row >= NTOK;
    if (chunk < 8) {
      bf16* dst = p.U + (size_t)row * 256 + 32 * chunk;
#pragma unroll
      for (int g = 0; g < 4; g += 2) {
        float u[8];
#pragma unroll
        for (int j = 0; j < 8; ++j) u[j] = acc[0][tt][4 * g + j] * sigmoid_f(acc[1][tt][4 * g + j]);
        store_pair(dst + 8 * g, hh, u[0], u[1], u[2], u[3], u[4], u[5], u[6], u[7]);
      }
    } else if (chunk < 14 || (chunk >= 20 && chunk < 26)) {
      const bool isq = chunk < 14;
      const int head = isq ? chunk - 8 : chunk - 20;
      const float sc = isq ? 0.125f : 1.f;
      bf16* dst = (isq ? p.QN : p.KN) + ((size_t)(b * 6 + head) * SEQ2 + pos) * 64;
#pragma unroll
      for (int ft = 0; ft < 2; ++ft)
#pragma unroll
        for (int g = 0; g < 4; g += 2)
          store_pair(dst + ft * 32 + 8 * g, hh, acc[ft][tt][4 * g] * sc, acc[ft][tt][4 * g + 1] * sc, acc[ft][tt][4 * g + 2] * sc, acc[ft][tt][4 * g + 3] * sc,
                     acc[ft][tt][4 * g + 4] * sc, acc[ft][tt][4 * g + 5] * sc, acc[ft][tt][4 * g + 6] * sc, acc[ft][tt][4 * g + 7] * sc);
    } else {
      const bool isq = chunk < 20;
      const int head = isq ? chunk - 14 : chunk - 32;
      const float* gn = (isq ? p.gqa_q_norm : p.gqa_k_norm) + layer * 64;
      float ss = 0.f;
#pragma unroll
      for (int ft = 0; ft < 2; ++ft)
#pragma unroll
        for (int e = 0; e < 16; ++e) ss += acc[ft][tt][e] * acc[ft][tt][e];
      ss += shx(ss, 32, lane);
      const float rstd = rsqrtf(ss * (1.f / 64.f) + EPS) ;
      const float sc = isq ? 0.125f : 1.f;
      bf16* dst = (isq ? p.QG + ((size_t)(b * 6 + head) * SEQ2 + pos) * 64 : p.KG + ((size_t)(b * 2 + head) * SEQ2 + pos) * 64);
      const int prow = pos >> 6, pcol = pos & 63;
#pragma unroll
      for (int g = 0; g < 4; g += 2) {
        float o1[8], o2[8];
#pragma unroll
        for (int j = 0; j < 8; ++j) {
          const int gg = g + (j >> 2);
          const int i = 8 * gg + 4 * hh + (j & 3);
          float x1 = acc[0][tt][4 * g + j] * rstd * gn[i];
          float x2 = acc[1][tt][4 * g + j] * rstd * gn[32 + i];
          if (!isctx && PROBE != 13) {
            const int ppos = (gg < 2) ? prow : pcol;
            const float2 cs = *(const float2*)(p.ropetab + 2 * (ppos * 16 + (i & 15)));
            float y1 = x1 * cs.x - x2 * cs.y, y2 = x1 * cs.y + x2 * cs.x;
            x1 = y1; x2 = y2;
          }
          o1[j] = x1 * sc; o2[j] = x2 * sc;
        }
        store_pair(dst + 8 * g, hh, o1[0], o1[1], o1[2], o1[3], o1[4], o1[5], o1[6], o1[7]);
        store_pair(dst + 32 + 8 * g, hh, o2[0], o2[1], o2[2], o2[3], o2[4], o2[5], o2[6], o2[7]);
      }
    }
  }
}

constexpr int CONV_TT = 16;
constexpr int CONV_SMEM = (CONV_TT + 30) * 512 + CONV_TT * 1024;
DI void stage_conv(const Params& p, int layer, int item, char* smem) {
  bf16* ub = (bf16*)smem;
  float* yb = (float*)(smem + (CONV_TT + 30) * 512);
  const int tid = tid_now();
  int row0, seq_lo, seq_hi;
  constexpr int NLAT = NTOK / CONV_TT;
  if (item < NLAT) { row0 = item * CONV_TT; seq_lo = row0 & ~2047; seq_hi = seq_lo + 2048; }
  else { row0 = NTOK + (item - NLAT) * CONV_TT; seq_lo = NTOK + (((item - NLAT) * CONV_TT) & ~255); seq_hi = seq_lo + 256; }
  for (int c = tid; c < (CONV_TT + 30) * 32; c += 256) {
    int r = c >> 5, cc = c & 31;
    int row = row0 - 15 + r;
    u32x4 v = {0u, 0u, 0u, 0u};
    if (row >= seq_lo && row < seq_hi) v = *(const u32x4*)(p.U + (size_t)row * 256 + cc * 8);
    *(u32x4*)(ub + r * 256 + cc * 8) = v;
  }
  __syncthreads();
  {
    const int ch = tid;
    float w[31];
#pragma unroll
    for (int j = 0; j < 31; ++j) w[j] = p.conv_w[((size_t)layer * 31 + j) * 256 + ch];
    const float bias = p.conv_b[layer * 256 + ch];
#pragma unroll 1
    for (int t0 = 0; t0 < CONV_TT; t0 += 8) {
      float in[38];
#pragma unroll
      for (int j = 0; j < 38; ++j) in[j] = __uint_as_float((unsigned)ub[(t0 + j) * 256 + ch] << 16);
#pragma unroll
      for (int t = 0; t < 8; ++t) {
        float a = bias;
#pragma unroll
        for (int j = 0; j < 31; ++j) a += in[t + j] * w[j];
        yb[(t0 + t) * 256 + ch] = a;
      }
    }
  }
  __syncthreads();
  {
    const int wave = tid >> 6, lane = tid & 63;
    const float4 g = ((const float4*)(p.conv_ln_g + layer * 256))[lane], bb = ((const float4*)(p.conv_ln_b + layer * 256))[lane];
    for (int t = wave * (CONV_TT / 4); t < (wave + 1) * (CONV_TT / 4); ++t) {
      float4 v = ((const float4*)(yb + t * 256))[lane];
      float mu = wave_sum(v.x + v.y + v.z + v.w, lane) * (1.f / 256.f);
      float dx = v.x - mu, dy = v.y - mu, dz = v.z - mu, dw = v.w - mu;
      float var = wave_sum(dx * dx + dy * dy + dz * dz + dw * dw, lane) * (1.f / 256.f);
      float rs = rsqrtf(var + EPS);
      float a = silu_f(dx * rs * g.x + bb.x), b = silu_f(dy * rs * g.y + bb.y), c = silu_f(dz * rs * g.z + bb.z), d = silu_f(dw * rs * g.w + bb.w);
      store4(p.CAT + (size_t)(row0 + t) * D + lane * 4, a, b, c, d);
    }
  }
  __syncthreads();
}

DI int kperm(int i) { return (i & 19) | ((i & 4) << 1) | ((i & 8) >> 1); }
DI int keyoff(int e, int h) { return (e & 3) + 4 * ((e >> 2) & 1) + 8 * h + 16 * (e >> 3); }
DI bf16x8 pack8(const f32x16& x, int s) {
  u32x4 r = {pack2(x[8 * s], x[8 * s + 1]), pack2(x[8 * s + 2], x[8 * s + 3]), pack2(x[8 * s + 4], x[8 * s + 5]), pack2(x[8 * s + 6], x[8 * s + 7])};
  return __builtin_bit_cast(bf16x8, r);
}

constexpr int NA_ITEMS = 6144 / 4;
DI void stage_na(const Params& p, int layer, int item) {
  const int lane = tid_now() & 63, wave = tid_now() >> 6, l31 = lane & 31, hh = lane >> 5;
  const int wi = item * 4 + wave;
  const int qhalf = wi & 1, head = (wi >> 1) % 6, br = wi / 12, r = br & 31, b = br >> 5;
  const int r0 = min(max(r - 4, 0), 24);
  const size_t hb = (size_t)(b * 6 + head);
  const bf16* Q = p.QN + (hb * SEQ2 + r * 64 + qhalf * 32 + l31) * 64;
  const bf16* Kb = p.KN + hb * SEQ2 * 64;
  const bf16* Vb = p.VNt + hb * 64 * SEQ2;
  const float* bias = p.na_rel_bias + ((size_t)layer * 6 + head) * 15 * 31;
  bf16x8 qf[4];
#pragma unroll
  for (int s = 0; s < 4; ++s) qf[s] = *(const bf16x8*)(Q + 16 * s + 8 * hh);
  f32x16 o[2];
#pragma unroll
  for (int e = 0; e < 16; ++e) { o[0][e] = 0.f; o[1][e] = 0.f; }
  float m = -1e30f, l = 0.f;
  const int qc = qhalf * 32 + l31;
  const int c0 = min(max(qc - 8, 0), 48);
  const int kp = kperm(l31);
#pragma unroll 1
  for (int t = 0; t < 24; ++t) {
    int key0, brow = 0, cs = 0;
    const bool local = t >= 8;
    if (!local) key0 = T + t * 32;
    else { brow = (t - 8) >> 1; cs = (t - 8) & 1; key0 = (r0 + brow) * 64 + cs * 32; }
    f32x16 st;
#pragma unroll
    for (int e = 0; e < 16; ++e) st[e] = 0.f;
    const bf16* kr = Kb + (size_t)(key0 + kp) * 64 + 8 * hh;
#pragma unroll
    for (int s = 0; s < 4; ++s) { bf16x8 kf = *(const bf16x8*)(kr + 16 * s); st = MFMA(kf, qf[s], st); }
    if (local) {
      const int rb = (r0 + brow) - r + 7;
#pragma unroll
      for (int e = 0; e < 16; ++e) {
        const int kc = cs * 32 + keyoff(e, hh);
        const bool valid = (kc >= c0) && (kc < c0 + 16);
        const int ci = min(max(kc - qc + 15, 0), 30);
        const float bv = (PROBE == 12) ? 0.f : bias[rb * 31 + ci];
        st[e] = valid ? st[e] + bv : -1e30f;
      }
    }
    float mx = st[0];
#pragma unroll
    for (int e = 1; e < 16; ++e) mx = fmaxf(mx, st[e]);
    mx = fmaxf(mx, shx(mx, 32, lane));
    const float mn = fmaxf(m, mx);
    const float alpha = exp2f((m - mn) * L2E);
    float ls = 0.f;
#pragma unroll
    for (int e = 0; e < 16; ++e) { st[e] = exp2f((st[e] - mn) * L2E); ls += st[e]; }
    l = l * alpha + ls; m = mn;
#pragma unroll
    for (int e = 0; e < 16; ++e) { o[0][e] *= alpha; o[1][e] *= alpha; }
    bf16x8 pf0 = pack8(st, 0), pf1 = pack8(st, 1);
#pragma unroll
    for (int dt = 0; dt < 2; ++dt) {
      const bf16* vr = Vb + (size_t)(dt * 32 + l31) * SEQ2 + key0 + 8 * hh;
      bf16x8 v0 = *(const bf16x8*)(vr), v1 = *(const bf16x8*)(vr + 16);
      o[dt] = MFMA(v0, pf0, o[dt]);
      o[dt] = MFMA(v1, pf1, o[dt]);
    }
  }
  l += shx(l, 32, lane);
  const float inv = (PROBE == 10) ? 0.f : 1.f / l;
  bf16* dst = p.CAT + (size_t)(b * T + r * 64 + qc) * D + 256 + head * 64;
#pragma unroll
  for (int dt = 0; dt < 2; ++dt)
#pragma unroll
    for (int g = 0; g < 4; g += 2)
      store_pair(dst + dt * 32 + 8 * g, hh, o[dt][4 * g] * inv, o[dt][4 * g + 1] * inv, o[dt][4 * g + 2] * inv, o[dt][4 * g + 3] * inv,
                 o[dt][4 * g + 4] * inv, o[dt][4 * g + 5] * inv, o[dt][4 * g + 6] * inv, o[dt][4 * g + 7] * inv);
}

constexpr int NA2_ITEMS = 16 * 6 * 16;
DI void stage_na2(const Params& p, int layer, int item, char* smem) {
  const int tid = tid_now(), lane = tid & 63, wave = tid >> 6, l31 = lane & 31, hh = lane >> 5;
  const int lrow = tid >> 3, kc8 = tid & 7;
  const int rp = item & 15, head = (item >> 4) % 6, b = item / 96;
  const int qrow = 2 * rp + ((lane >> 4) & 1), qc = wave * 16 + (lane & 15);
  const int r0w = min(max(qrow - 4, 0), 24);
  const int rlo = min(max(2 * rp - 4, 0), 24), rhi = min(max(2 * rp - 3, 0), 24) + 7;
  const int ntile = 4 + (rhi - rlo + 1);
  const size_t hb = (size_t)(b * 6 + head);
  const bf16* K = p.KN + hb * SEQ2 * 64;
  const bf16* Vt = p.VNt + hb * 64 * SEQ2;
  float* bl = (float*)(smem + 2 * 2 * 64 * LROW);
  for (int i = tid; i < 15 * 31; i += 256) bl[i] = p.na_rel_bias[((size_t)layer * 6 + head) * 465 + i];
  bf16x8 qf[4];
  const bf16* qp = p.QN + (hb * SEQ2 + qrow * 64 + qc) * 64 + 8 * hh;
#pragma unroll
  for (int s = 0; s < 4; ++s) qf[s] = *(const bf16x8*)(qp + 16 * s);
  f32x16 o[2];
#pragma unroll
  for (int e = 0; e < 16; ++e) { o[0][e] = 0.f; o[1][e] = 0.f; }
  float m = -1e30f, l = 0.f;
  const int kp = kperm(l31);
  const int c0 = min(max(qc - 8, 0), 48);
  const int kb = min(max(wave * 16 - 8, 0), 32);
  u32x4 rk[2], rv[2];
  auto key0_of = [&](int t) { return t < 4 ? T + 64 * t : (rlo + t - 4) * 64; };
  {
    const int k0 = key0_of(0);
#pragma unroll
    for (int i = 0; i < 2; ++i) {
      rk[i] = *(const u32x4*)(K + (size_t)(k0 + lrow + 32 * i) * 64 + kc8 * 8);
      rv[i] = *(const u32x4*)(Vt + (size_t)(lrow + 32 * i) * SEQ2 + k0 + kc8 * 8);
    }
  }
#pragma unroll 1
  for (int t = 0; t < ntile; ++t) {
    char* sk = smem + (t & 1) * 2 * 64 * LROW;
    char* sv = sk + 64 * LROW;
#pragma unroll
    for (int i = 0; i < 2; ++i) {
      *(u32x4*)(sk + (lrow + 32 * i) * LROW + kc8 * 16) = rk[i];
      *(u32x4*)(sv + (lrow + 32 * i) * LROW + kc8 * 16) = rv[i];
    }
    __syncthreads();
    if (t + 1 < ntile) {
      const int k0 = key0_of(t + 1);
#pragma unroll
      for (int i = 0; i < 2; ++i) {
        rk[i] = *(const u32x4*)(K + (size_t)(k0 + lrow + 32 * i) * 64 + kc8 * 8);
        rv[i] = *(const u32x4*)(Vt + (size_t)(lrow + 32 * i) * SEQ2 + k0 + kc8 * 8);
      }
    }
    const int R = rlo + t - 4;
    const bool local = t >= 4;
    const int nsub = local ? 1 : 2;
#pragma unroll 1
    for (int si = 0; si < nsub; ++si) {
      const int kbase = local ? kb : 32 * si;
      const bool loc = local;
      f32x16 st;
      bf16x8 lf[4];
      __builtin_amdgcn_sched_barrier(0);
#pragma unroll
      for (int s = 0; s < 4; ++s) lf[s] = *(const bf16x8*)(sk + (kbase + kp) * LROW + (16 * s + 8 * hh) * 2);
      __builtin_amdgcn_sched_barrier(0);
#pragma unroll
      for (int e = 0; e < 16; ++e) st[e] = 0.f;
#pragma unroll
      for (int s = 0; s < 4; ++s) st = MFMA(lf[s], qf[s], st);
      __builtin_amdgcn_sched_barrier(0);
#pragma unroll
      for (int s2 = 0; s2 < 2; ++s2)
#pragma unroll
        for (int dt = 0; dt < 2; ++dt) lf[s2 * 2 + dt] = *(const bf16x8*)(sv + (dt * 32 + l31) * LROW + (kbase + 16 * s2 + 8 * hh) * 2);
      __builtin_amdgcn_sched_barrier(0);
      if (loc) {
        const int c0e = ((unsigned)(R - r0w) < 8u) ? c0 : 4096;
        const float* brow = bl + (R - qrow + 7) * 31 + (15 - qc);
#pragma unroll
        for (int e = 0; e < 16; ++e) {
          const int kc = kbase + keyoff(e, hh);
          const bool valid = (unsigned)(kc - c0e) < 16u;
          const float bv = brow[kc];
          st[e] = valid ? st[e] + bv : -1e30f;
        }
      }
      float mx = st[0];
#pragma unroll
      for (int e = 1; e < 16; ++e) mx = fmaxf(mx, st[e]);
      mx = fmaxf(mx, shx(mx, 32, lane));
      const float mn = fmaxf(m, mx);
      const float mnl = mn * L2E;
      const float alpha = fexp2(m * L2E - mnl);
      f2_t ls2 = {0.f, 0.f};
#pragma unroll
      for (int e = 0; e < 16; e += 2) {
        const float p0 = fexp2(st[e] * L2E - mnl), p1 = fexp2(st[e + 1] * L2E - mnl);
        st[e] = p0; st[e + 1] = p1;
        const f2_t pp = {p0, p1};
        ls2 += pp;
      }
      l = l * alpha + (ls2[0] + ls2[1]); m = mn;
      const f2_t al2 = {alpha, alpha};
#pragma unroll
      for (int e = 0; e < 16; e += 2) {
        f2_t a0 = {o[0][e], o[0][e + 1]}, a1 = {o[1][e], o[1][e + 1]};
        a0 *= al2; a1 *= al2;
        o[0][e] = a0[0]; o[0][e + 1] = a0[1]; o[1][e] = a1[0]; o[1][e + 1] = a1[1];
      }
#pragma unroll
      for (int s2 = 0; s2 < 2; ++s2) {
        bf16x8 pf = pack8(st, s2);
#pragma unroll
        for (int dt = 0; dt < 2; ++dt) o[dt] = MFMA(lf[s2 * 2 + dt], pf, o[dt]);
      }
    }
  }
  l += shx(l, 32, lane);
  const float inv = 1.f / l;
  bf16* dst = p.CAT + (size_t)(b * T + qrow * 64 + qc) * D + 256 + head * 64;
#pragma unroll
  for (int dt = 0; dt < 2; ++dt)
#pragma unroll
    for (int g = 0; g < 4; g += 2)
      store_pair(dst + dt * 32 + 8 * g, hh, o[dt][4 * g] * inv, o[dt][4 * g + 1] * inv, o[dt][4 * g + 2] * inv, o[dt][4 * g + 3] * inv,
                 o[dt][4 * g + 4] * inv, o[dt][4 * g + 5] * inv, o[dt][4 * g + 6] * inv, o[dt][4 * g + 7] * inv);
  __syncthreads();
}

template <int MODE>
DI void flash_block(const bf16* __restrict__ Q, const bf16* __restrict__ K, const bf16* __restrict__ Vt, int q0, int kt0, int kt1,
                    bf16* __restrict__ dst  , char* smem, float smax = 0.f) {
  const int tid = tid_now(), lane = tid & 63, wave = tid >> 6, l31 = lane & 31, hh = lane >> 5;
  const int lrow = tid >> 3, kc = tid & 7;
  bf16x8 qf[4];
  const bf16* qp = Q + (size_t)(q0 + wave * 32 + l31) * 64 + 8 * hh;
#pragma unroll
  for (int s = 0; s < 4; ++s) qf[s] = *(const bf16x8*)(qp + 16 * s);
  constexpr bool BOUNDED = MODE != 0;
  if (MODE == 2) {
#pragma unroll
    for (int s = 0; s < 4; ++s) {
      u32x4 w = __builtin_bit_cast(u32x4, qf[s]);
      const unsigned w0 = w[0], w1 = w[1], w2 = w[2], w3 = w[3];
      u32x4 o = {pack2(bf_lo(w0) * L2E, bf_hi(w0) * L2E), pack2(bf_lo(w1) * L2E, bf_hi(w1) * L2E),
                 pack2(bf_lo(w2) * L2E, bf_hi(w2) * L2E), pack2(bf_lo(w3) * L2E, bf_hi(w3) * L2E)};
      qf[s] = __builtin_bit_cast(bf16x8, o);
    }
  }
  f32x16 o[2];
#pragma unroll
  for (int e = 0; e < 16; ++e) { o[0][e] = 0.f; o[1][e] = 0.f; }
  float m = -1e30f, l = 0.f;
  f2_t l2 = {0.f, 0.f};
  const int kp = kperm(l31);
  u32x4 rk[2], rv[2];
#pragma unroll
  for (int i = 0; i < 2; ++i) {
    rk[i] = *(const u32x4*)(K + (size_t)(kt0 * 64 + lrow + 32 * i) * 64 + kc * 8);
    rv[i] = *(const u32x4*)(Vt + (size_t)(lrow + 32 * i) * SEQ2 + kt0 * 64 + kc * 8);
  }
#pragma unroll 1
  for (int kt = kt0; kt < kt1; ++kt) {
    char* sk = smem + ((kt - kt0) & 1) * 2 * 64 * LROW;
    char* sv = sk + 64 * LROW;
#pragma unroll
    for (int i = 0; i < 2; ++i) {
      *(u32x4*)(sk + (lrow + 32 * i) * LROW + kc * 16) = rk[i];
      *(u32x4*)(sv + (lrow + 32 * i) * LROW + kc * 16) = rv[i];
    }
    __syncthreads();
    if (kt + 1 < kt1) {
#pragma unroll
      for (int i = 0; i < 2; ++i) {
        rk[i] = *(const u32x4*)(K + (size_t)((kt + 1) * 64 + lrow + 32 * i) * 64 + kc * 8);
        rv[i] = *(const u32x4*)(Vt + (size_t)(lrow + 32 * i) * SEQ2 + (kt + 1) * 64 + kc * 8);
      }
    }
    f32x16 st[2];
    bf16x8 lf[8];
    __builtin_amdgcn_sched_barrier(0);
#pragma unroll
    for (int k2 = 0; k2 < 2; ++k2)
#pragma unroll
      for (int s = 0; s < 4; ++s) lf[k2 * 4 + s] = *(const bf16x8*)(sk + (k2 * 32 + kp) * LROW + (16 * s + 8 * hh) * 2);
    __builtin_amdgcn_sched_barrier(0);
#pragma unroll
    for (int k2 = 0; k2 < 2; ++k2) {
#pragma unroll
      for (int e = 0; e < 16; ++e) st[k2][e] = 0.f;
#pragma unroll
      for (int s = 0; s < 4; ++s) st[k2] = MFMA(lf[k2 * 4 + s], qf[s], st[k2]);
    }
    __builtin_amdgcn_sched_barrier(0);
#pragma unroll
    for (int k2 = 0; k2 < 2; ++k2)
#pragma unroll
      for (int s2 = 0; s2 < 2; ++s2)
#pragma unroll
        for (int dt = 0; dt < 2; ++dt)
          lf[(k2 * 2 + s2) * 2 + dt] = *(const bf16x8*)(sv + (dt * 32 + l31) * LROW + (k2 * 32 + 16 * s2 + 8 * hh) * 2);
    __builtin_amdgcn_sched_barrier(0);
    if (BOUNDED) {
      const float mnl = smax * L2E;
#pragma unroll
      for (int k2 = 0; k2 < 2; ++k2)
#pragma unroll
        for (int e = 0; e < 16; e += 2) {
          const float p0 = MODE == 2 ? fexp2(st[k2][e]) : fexp2(st[k2][e] * L2E - mnl), p1 = MODE == 2 ? fexp2(st[k2][e + 1]) : fexp2(st[k2][e + 1] * L2E - mnl);
          st[k2][e] = p0; st[k2][e + 1] = p1;
          const f2_t pp = {p0, p1};
          l2 += pp;
        }
    } else {
      float mx = st[0][0];
  #pragma unroll
      for (int e = 1; e < 16; ++e) mx = fmaxf(mx, st[0][e]);
  #pragma unroll
      for (int e = 0; e < 16; ++e) mx = fmaxf(mx, st[1][e]);
      mx = fmaxf(mx, shx(mx, 32, lane));
      const float mn = fmaxf(m, mx);
      const float mnl = mn * L2E;
      const float alpha = fexp2(m * L2E - mnl);
      float ls = 0.f;
  #pragma unroll
      for (int k2 = 0; k2 < 2; ++k2)
  #pragma unroll
        for (int e = 0; e < 16; ++e) { st[k2][e] = fexp2(st[k2][e] * L2E - mnl); ls += st[k2][e]; }
      l = l * alpha + ls; m = mn;
  #pragma unroll
      for (int e = 0; e < 16; ++e) { o[0][e] *= alpha; o[1][e] *= alpha; }
    }
#pragma unroll
    for (int k2 = 0; k2 < 2; ++k2)
#pragma unroll
      for (int s2 = 0; s2 < 2; ++s2) {
        bf16x8 pf = pack8(st[k2], s2);
#pragma unroll
        for (int dt = 0; dt < 2; ++dt) o[dt] = MFMA(lf[(k2 * 2 + s2) * 2 + dt], pf, o[dt]);
      }
  }
  l += l2[0] + l2[1];
  l += shx(l, 32, lane);
  const float inv = (PROBE == 11) ? 0.f : 1.f / l;
  bf16* d2 = dst + (size_t)(wave * 32 + l31) * D;
#pragma unroll
  for (int dt = 0; dt < 2; ++dt)
#pragma unroll
    for (int g = 0; g < 4; g += 2)
      store_pair(d2 + dt * 32 + 8 * g, hh, o[dt][4 * g] * inv, o[dt][4 * g + 1] * inv, o[dt][4 * g + 2] * inv, o[dt][4 * g + 3] * inv,
                 o[dt][4 * g + 4] * inv, o[dt][4 * g + 5] * inv, o[dt][4 * g + 6] * inv, o[dt][4 * g + 7] * inv);
  __syncthreads();
}
constexpr int GQA_ITEMS = 16 * 6 * 16;
DI float gqa_score_bound(const Params& p, int layer) {
  const int lane = tid_now() & 63;
  float a = fabsf(p.gqa_q_norm[layer * 64 + lane]), b = fabsf(p.gqa_k_norm[layer * 64 + lane]);
#pragma unroll
  for (int o = 32; o >= 1; o >>= 1) { a = fmaxf(a, shx(a, o, lane)); b = fmaxf(b, shx(b, o, lane)); }
  return 8.f * a * b * 1.0001f + 1e-3f;
}
DI void stage_gqa(const Params& p, int layer, int item, char* smem) {
  const int qt = item & 15, hq = (item >> 4) % 6, b = item / 96;
  const int kvh = hq / 3;
  const float bound = __int_as_float(__builtin_amdgcn_readfirstlane(__float_as_int(gqa_score_bound(p, layer))));
  const bf16* Q = p.QG + (size_t)(b * 6 + hq) * SEQ2 * 64; const bf16* K = p.KG + (size_t)(b * 2 + kvh) * SEQ2 * 64; const bf16* Vt = p.VGt + (size_t)(b * 2 + kvh) * 64 * SEQ2;
  bf16* dst = p.CAT + (size_t)(b * T + qt * 128) * D + 640 + hq * 64;
  if (bound * L2E < 100.f) flash_block<2>(Q, K, Vt, qt * 128, 0, 36, dst, smem, bound);
  else flash_block<1>(Q, K, Vt, qt * 128, 0, 36, dst, smem, bound);
}
constexpr int CTXATT_ITEMS = 384;
DI void stage_ctxatt(const Params& p, int item, char* smem) {
  const int qt = item & 1, head = (item >> 1) % 6, which = (item / 12) & 1, b = item / 24;
  bf16* dst = p.CAT + (size_t)(NTOK + b * CL + qt * 128) * D + (which == 0 ? 256 : 640) + head * 64;
  const int kvh = which == 0 ? b * 6 + head : b * 2 + head / 3;
  const bf16* Q = (which == 0 ? p.QN : p.QG) + (size_t)(b * 6 + head) * SEQ2 * 64;
  const bf16* K = (which == 0 ? p.KN : p.KG) + (size_t)kvh * SEQ2 * 64;
  const bf16* Vt = (which == 0 ? p.VNt : p.VGt) + (size_t)kvh * 64 * SEQ2;
  flash_block<0>(Q, K, Vt, T + qt * 128, 32, 36, dst, smem);
}

constexpr int OUTPROJ_ITEMS = 288 * 8;
DI void stage_outproj(const Params& p, int layer, int item, char* smem) {
  const int mt = item >> 3, nt = item & 7;
  if (layer == 1 && mt >= 256) return;
  const int row0 = mt * 128, n0 = nt * 128;
  f32x16 acc[2][2];
  gemm_core<true, true>(p.CAT + (size_t)row0 * D, p.wout + ((size_t)layer * D + n0) * D, smem, acc);
  const int lane = tid_now() & 63, wave = tid_now() >> 6, wm = wave >> 1, wn = wave & 1, l31 = lane & 31, hh = lane >> 5;
  const float* mrow = p.mod + ((size_t)layer * 17 + mod_row(row0)) * 6144;
  const float* g1 = mrow + 2048;
  const float* sc2 = mrow + 4096;
  const float* n2g = p.norm2_g + layer * D;
  float* amx = (float*)(smem + GEMM_SMEM);
  float amv[2];
#pragma unroll
  for (int tt = 0; tt < 2; ++tt) {
    const int row = row0 + wm * 64 + tt * 32 + l31;
    bf16* xb = p.XB + (size_t)row * D;
    float ss = 0.f, am = 0.f;
#pragma unroll
    for (int ft = 0; ft < 2; ++ft)
#pragma unroll
      for (int gp = 0; gp < 4; gp += 2) {
        {
          float4 xv[2], gv[2];
#pragma unroll
          for (int g = 0; g < 2; ++g) {
            const int n = n0 + wn * 64 + ft * 32 + 8 * (gp + g) + 4 * hh;
            { const u32x2 t = *(const u32x2*)(xb + n); const unsigned t0 = t[0], t1 = t[1]; xv[g] = float4{bf_lo(t0), bf_hi(t0), bf_lo(t1), bf_hi(t1)}; }
            gv[g] = *(const float4*)(g1 + n);
            if (PROBE == 2) { gv[g].x = gv[g].y = gv[g].z = gv[g].w = 0.f; }
          }
#pragma unroll
          for (int g = 0; g < 2; ++g) {
            const int e = 4 * (gp + g);
            const float4 o = {xv[g].x + gv[g].x * acc[ft][tt][e], xv[g].y + gv[g].y * acc[ft][tt][e + 1],
                              xv[g].z + gv[g].z * acc[ft][tt][e + 2], xv[g].w + gv[g].w * acc[ft][tt][e + 3]};
            ss += o.x * o.x + o.y * o.y + o.z * o.z + o.w * o.w;
            acc[ft][tt][e] = o.x; acc[ft][tt][e + 1] = o.y; acc[ft][tt][e + 2] = o.z; acc[ft][tt][e + 3] = o.w;
          }
          store_pair(xb + n0 + wn * 64 + ft * 32 + 8 * gp, hh, acc[ft][tt][4 * gp], acc[ft][tt][4 * gp + 1], acc[ft][tt][4 * gp + 2], acc[ft][tt][4 * gp + 3],
                     acc[ft][tt][4 * gp + 4], acc[ft][tt][4 * gp + 5], acc[ft][tt][4 * gp + 6], acc[ft][tt][4 * gp + 7]);
        }
        {
          float4 gg[2], sv[2];
#pragma unroll
          for (int g = 0; g < 2; ++g) {
            const int n = n0 + wn * 64 + ft * 32 + 8 * (gp + g) + 4 * hh;
            gg[g] = *(const float4*)(n2g + n); sv[g] = *(const float4*)(sc2 + n);
          }
#pragma unroll
          for (int g = 0; g < 2; ++g) {
            const int e = 4 * (gp + g);
            float4 o = {acc[ft][tt][e], acc[ft][tt][e + 1], acc[ft][tt][e + 2], acc[ft][tt][e + 3]};
            o.x *= gg[g].x * (1.f + sv[g].x); o.y *= gg[g].y * (1.f + sv[g].y); o.z *= gg[g].z * (1.f + sv[g].z); o.w *= gg[g].w * (1.f + sv[g].w);
            acc[ft][tt][e] = o.x; acc[ft][tt][e + 1] = o.y; acc[ft][tt][e + 2] = o.z; acc[ft][tt][e + 3] = o.w;
            am = fmaxf(am, fmaxf(fmaxf(fabsf(o.x), fabsf(o.y)), fmaxf(fabsf(o.z), fabsf(o.w))));
          }
        }
      }
    ss += shx(ss, 32, lane);
    am = fmaxf(am, shx(am, 32, lane));
    if (hh == 0) { p.ssq16[(size_t)(nt * 2 + wn) * MTOT + row] = ss; amx[((wm * 2 + tt) * 32 + l31) * 2 + wn] = am; }
    amv[tt] = am;
    asm volatile("" ::: "memory");
  }
  __syncthreads();
#pragma unroll
  for (int tt = 0; tt < 2; ++tt) {
    const int row = row0 + wm * 64 + tt * 32 + l31;
    const float am = fmaxf(fmaxf(amv[tt], amx[((wm * 2 + tt) * 32 + l31) * 2 + (wn ^ 1)]), 1e-30f);
    const float qs = 127.f / am;
    if (hh == 0 && wn == 0) p.hs8[(size_t)nt * MTOT + row] = am * (1.f / 127.f);
    bf16* hrow = p.H2 + (size_t)row * D + n0 + wn * 64;
    signed char* qrow = p.hq + (size_t)row * D + n0 + wn * 64;
#pragma unroll
    for (int ft = 0; ft < 2; ++ft)
#pragma unroll
      for (int g = 0; g < 4; g += 2) {
        store_pair(hrow + ft * 32 + 8 * g, hh, acc[ft][tt][4 * g], acc[ft][tt][4 * g + 1], acc[ft][tt][4 * g + 2], acc[ft][tt][4 * g + 3],
                   acc[ft][tt][4 * g + 4], acc[ft][tt][4 * g + 5], acc[ft][tt][4 * g + 6], acc[ft][tt][4 * g + 7]);
        float4 va = {acc[ft][tt][4 * g], acc[ft][tt][4 * g + 1], acc[ft][tt][4 * g + 2], acc[ft][tt][4 * g + 3]};
        float4 vb = {acc[ft][tt][4 * g + 4], acc[ft][tt][4 * g + 5], acc[ft][tt][4 * g + 6], acc[ft][tt][4 * g + 7]};
        unsigned qa = pack_i8x4(va, qs), qb = pack_i8x4(vb, qs);
        const auto rq = __builtin_amdgcn_permlane32_swap(qa, qb, false, false);
        u32x2 o8 = {rq[0], rq[1]};
        *(u32x2*)(qrow + ft * 32 + 8 * g + hh * 8) = o8;
      }
  }
}

constexpr int ROUTE_ITEMS = 288 * 8;
constexpr int QROW = 272;
DI int to_sortable(int b) { return b ^ ((b >> 31) & 0x7fffffff); }

#define CAND_LIST(X) \
  X(0,0,0) X(1,0,1) X(2,0,2) X(3,0,3) X(4,0,4) X(5,0,5) X(6,0,6) X(7,0,7) X(8,0,8) X(9,0,9) X(10,0,10) X(11,0,11) X(12,0,12) X(13,0,13) X(14,0,14) X(15,0,15) \
  X(16,1,1) X(17,1,2) X(18,1,3) X(19,1,4) X(20,1,5) X(21,1,6) X(22,1,7) \
  X(23,2,2) X(24,2,3) X(25,2,4) \
  X(26,3,3)


DI void ce_desc(int& a, int& b) { const int hi = max(a, b), lo = min(a, b); a = hi; b = lo; }
DI void bitonic_sort16_desc(int (&v)[16]) {
#pragma unroll
  for (int k = 2; k <= 16; k <<= 1)
#pragma unroll
    for (int j = k >> 1; j > 0; j >>= 1)
#pragma unroll
      for (int i = 0; i < 16; ++i) {
        const int l = i ^ j;
        if (l > i) { if ((i & k) == 0) ce_desc(v[i], v[l]); else ce_desc(v[l], v[i]); }
      }
}
DI void bitonic_merge16_desc(int (&v)[16]) {
#pragma unroll
  for (int j = 8; j > 0; j >>= 1)
#pragma unroll
    for (int i = 0; i < 16; ++i) { const int l = i ^ j; if (l > i) ce_desc(v[i], v[l]); }
}
DI void merge_top16(int (&a)[16], const int (&b)[16]) {
#pragma unroll
  for (int i = 0; i < 16; ++i) a[i] = max(a[i], b[15 - i]);
  bitonic_merge16_desc(a);
}
DI void stage_route(const Params& p, int layer, int item, char* smem) {
  const int mt = item >> 3, head = item & 7;
  if (layer == 1 && mt >= 256) return;
  const int row0 = mt * 128;
  const int tid = tid_now(), lane = tid & 63, wave = tid >> 6, wm = wave >> 1, wn = wave & 1, l31 = lane & 31, hh = lane >> 5;
  int t0[16], tk[16];
  char* Qs = smem;
  float* rs = (float*)(smem + GEMM_SMEM);
  if (tid < 128) {
    float sv[16];
#pragma unroll
    for (int s = 0; s < 16; ++s) sv[s] = p.ssq16[(size_t)s * MTOT + row0 + tid];
    float ssum = 0.f;
#pragma unroll
    for (int s = 0; s < 16; ++s) ssum += sv[s];
    rs[tid] = rsqrtf(ssum * (1.f / D) + EPS);
  }
#pragma unroll 1
  for (int pp = 0; pp < 2; ++pp) {
    {
      f32x16 acc[2][2];
      gemm_core<true, true>(p.H2 + (size_t)row0 * D, p.wq + ((size_t)layer * 2048 + (head * 2 + pp) * 128) * D, smem, acc);
      {
        const float* cqr = p.cq + ((size_t)layer * 17 + mod_row(row0)) * 2048 + (head * 2 + pp) * 128 + wn * 64 + 4 * hh;
#pragma unroll
        for (int tt = 0; tt < 2; ++tt) {
          const float rsd = rs[wm * 64 + tt * 32 + l31];
#pragma unroll
          for (int ft = 0; ft < 2; ++ft)
#pragma unroll
            for (int g = 0; g < 4; ++g) {
              const float4 cv = *(const float4*)(cqr + ft * 32 + 8 * g);
              acc[ft][tt][4 * g] = acc[ft][tt][4 * g] * rsd + cv.x; acc[ft][tt][4 * g + 1] = acc[ft][tt][4 * g + 1] * rsd + cv.y;
              acc[ft][tt][4 * g + 2] = acc[ft][tt][4 * g + 2] * rsd + cv.z; acc[ft][tt][4 * g + 3] = acc[ft][tt][4 * g + 3] * rsd + cv.w;
            }
        }
      }
#pragma unroll
      for (int tt = 0; tt < 2; ++tt)
#pragma unroll
        for (int ft = 0; ft < 2; ++ft)
#pragma unroll
          for (int g = 0; g < 4; ++g) {
            const int tok = wm * 64 + tt * 32 + l31, kf = wn * 64 + ft * 32 + 8 * g + 4 * hh;
            u32x2 o = {pack2(acc[ft][tt][4 * g], acc[ft][tt][4 * g + 1]), pack2(acc[ft][tt][4 * g + 2], acc[ft][tt][4 * g + 3])};
            *(u32x2*)(Qs + tok * QROW + kf * 2) = o;
          }
    }
    const __amdgpu_buffer_rsrc_t rK = __builtin_amdgcn_make_buffer_rsrc((void*)p.pk, 0, (unsigned)(PK_N * 2), 0x00020000);
    const int kso = (((layer * 8 + head) * 2 + pp) * 128) * 256;
    u32x4 ka[8];
#pragma unroll
    for (int s = 0; s < 8; ++s) ka[s] = __builtin_amdgcn_raw_buffer_load_b128(rK, (l31 * 128 + 8 * hh) * 2 + 32 * s, kso, 0);
    __syncthreads();
    {
#pragma unroll
      for (int r = 0; r < 16; ++r) tk[r] = (int)0x80000000;
#pragma unroll 1
      for (int nt = 0; nt < 4; ++nt) {
        int cur[16];
        {
          f32x16 sc;
#pragma unroll
          for (int e = 0; e < 16; ++e) sc[e] = 0.f;
#pragma unroll
          for (int s = 0; s < 8; ++s) {
            bf16x8 qb = *(const bf16x8*)(Qs + (wave * 32 + l31) * QROW + (16 * s + 8 * hh) * 2);
            sc = MFMA(__builtin_bit_cast(bf16x8, ka[s]), qb, sc);
          }
          {
            const int nn = nt < 3 ? nt + 1 : 3;
#pragma unroll
            for (int s = 0; s < 8; ++s) ka[s] = __builtin_amdgcn_raw_buffer_load_b128(rK, ((nn * 32 + l31) * 128 + 8 * hh) * 2 + 32 * s, kso, 0);
          }
#pragma unroll
          for (int e = 0; e < 16; ++e) {
            const int n = nt * 32 + crow(e, hh);
            int b = (__float_as_int(sc[e]) & ~127) | n;
            cur[e] = to_sortable(b);
          }
        }
        bitonic_sort16_desc(cur);
        merge_top16(tk, cur);
      }
      int pb[16];
#pragma unroll
      for (int i = 0; i < 16; ++i) pb[i] = shxi(tk[i], 32, lane);
      merge_top16(tk, pb);
    }
    if (pp == 0) {
#pragma unroll
      for (int r = 0; r < 16; ++r) t0[r] = tk[r];
    }
    __syncthreads();
  }
  char* recs = Qs + (tid_now() >> 6) * 32 * QROW;
  int cand[27];
  {
    float av[16], bv[16];
    unsigned pa[4] = {0u, 0u, 0u, 0u}, pbb[4] = {0u, 0u, 0u, 0u};
#pragma unroll
    for (int i = 0; i < 16; ++i) {
      int k1 = to_sortable(t0[i]), k2 = to_sortable(tk[i]);
      int a = hh ? k2 : k1, b = hh ? k1 : k2;
      av[i] = __int_as_float(a & ~127); bv[i] = __int_as_float(b & ~127);
      pa[i >> 2] |= (unsigned)(a & 127) << (8 * (i & 3));
      pbb[i >> 2] |= (unsigned)(b & 127) << (8 * (i & 3));
    }
    u32x4 ra_ = {pa[0], pa[1], pa[2], pa[3]}, rb_ = {pbb[0], pbb[1], pbb[2], pbb[3]};
    *(u32x4*)(recs + lane * 32) = ra_;
    *(u32x4*)(recs + lane * 32 + 16) = rb_;
#define MKC(c, i, j) { int b = __float_as_int(av[i] + bv[j]); cand[c] = (to_sortable(b) & ~63) | (c * 2 + hh); \
                       if (i == j && hh) cand[c] = (int)0x80000000; }
    CAND_LIST(MKC)
#undef MKC
  }
  int win[16], weid[16];
#pragma unroll
  for (int r = 0; r < 16; ++r) {
    int mx = cand[0];
#pragma unroll
    for (int c = 1; c < 27; ++c) mx = max(mx, cand[c]);
    mx = max(mx, shxi(mx, 32, lane));
#pragma unroll
    for (int c = 0; c < 27; ++c) cand[c] = (cand[c] == mx) ? (int)0x80000000 : cand[c];
    win[r] = mx;
  }
#pragma unroll
  for (int r = 0; r < 16; ++r) {
    const int code = win[r] & 63, c = code >> 1, hw = code & 1;
    const int i = (c >= 16) + (c >= 23) + (c >= 26);
    const int j = c - (i == 0 ? 0 : i == 1 ? 15 : i == 2 ? 21 : 23);
    const unsigned char* orec = (const unsigned char*)(recs + (l31 + 32 * hw) * 32);
    const int aiv = orec[i], biv = orec[16 + j];
    weid[r] = hw ? (biv * 128 + aiv) : (aiv * 128 + biv);
  }
  float gsum = 0.f, gv[16];
  const float v0 = __int_as_float(to_sortable(win[0]) & ~63);
#pragma unroll
  for (int r = 0; r < 16; ++r) { gv[r] = __expf(__int_as_float(to_sortable(win[r]) & ~63) - v0); gsum += gv[r]; }
  const float ginv = 1.f / gsum;
  const int row = row0 + (tid_now() >> 6) * 32 + (tid_now() & 31);
  if (hh == 0) {
    int4* d = (int4*)(p.ridx + ((size_t)row * 8 + head) * 32);
#pragma unroll
    for (int q = 0; q < 4; ++q) { int4 o = {weid[2 * q], __float_as_int(gv[2 * q] * ginv), weid[2 * q + 1], __float_as_int(gv[2 * q + 1] * ginv)}; d[q] = o; }
  } else {
    int4* d = (int4*)(p.ridx + ((size_t)row * 8 + head) * 32 + 16);
#pragma unroll
    for (int q = 0; q < 4; ++q) { int4 o = {weid[8 + 2 * q], __float_as_int(gv[8 + 2 * q] * ginv), weid[9 + 2 * q], __float_as_int(gv[9 + 2 * q] * ginv)}; d[q] = o; }
  }
  __syncthreads();
}

DI float dot2(unsigned a, unsigned b, float acc) {
  bf2_t x = __builtin_bit_cast(bf2_t, a), y = __builtin_bit_cast(bf2_t, b);
  return __builtin_amdgcn_fdot2_f32_bf16(x, y, acc, false);
}
DI float dot8(u32x4 a, u32x4 b, float acc) {
  const unsigned a0 = a[0], a1 = a[1], a2 = a[2], a3 = a[3], b0 = b[0], b1 = b[1], b2 = b[2], b3 = b[3];
  acc = dot2(a0, b0, acc); acc = dot2(a1, b1, acc); acc = dot2(a2, b2, acc); acc = dot2(a3, b3, acc);
  return acc;
}
DI void axpy8(float (&o)[8], float w, u32x4 v) {
  o[0] += w * bf_lo(v.x); o[1] += w * bf_hi(v.x); o[2] += w * bf_lo(v.y); o[3] += w * bf_hi(v.y);
  o[4] += w * bf_lo(v.z); o[5] += w * bf_hi(v.z); o[6] += w * bf_lo(v.w); o[7] += w * bf_hi(v.w);
}
constexpr int GATHER_ITEMS = MTOT / 4;
DI float dot4f8(unsigned u, unsigned hlo, unsigned hhi, float acc) {
  bf2_t a = __builtin_amdgcn_cvt_scalef32_pk_bf16_fp8((int)u, 1.0f, false);
  bf2_t b = __builtin_amdgcn_cvt_scalef32_pk_bf16_fp8((int)u, 1.0f, true);
  bf2_t x = __builtin_bit_cast(bf2_t, hlo), y = __builtin_bit_cast(bf2_t, hhi);
  acc = __builtin_amdgcn_fdot2_f32_bf16(a, x, acc, false);
  acc = __builtin_amdgcn_fdot2_f32_bf16(b, y, acc, false);
  return acc;
}
DI void axpy4f8(float& o0, float& o1, float& o2, float& o3, float w, unsigned v) {
  f2_t lo = __builtin_amdgcn_cvt_pk_f32_fp8((int)v, false), hi = __builtin_amdgcn_cvt_pk_f32_fp8((int)v, true);
  o0 += w * lo[0]; o1 += w * lo[1]; o2 += w * hi[0]; o3 += w * hi[1];
}
DI void stage_gather(const Params& p, int layer, int item) {
  const int lane = tid_now() & 63, wave = tid_now() >> 6;
  const int row = item * 4 + wave;
  if (layer == 1 && row >= NTOK) return;
  const int* rr = p.ridx + (size_t)row * 256 + (lane >> 4) * 32 + (lane & 15);
  const int idxA = rr[0], idxB = rr[128];
  const float gA = __int_as_float(rr[16]), gB = __int_as_float(rr[144]);
  const bf16* hr = p.H + (size_t)row * D + lane * 16;
  const u32x4 hA = *(const u32x4*)(hr), hB = *(const u32x4*)(hr + 8);
  const unsigned h0 = hA[0], h1 = hA[1], h2 = hA[2], h3 = hA[3], h4 = hB[0], h5 = hB[1], h6 = hB[2], h7 = hB[3];
  float o[16];
#pragma unroll
  for (int i = 0; i < 16; ++i) o[i] = 0.f;
  const __amdgpu_buffer_rsrc_t rU = __builtin_amdgcn_make_buffer_rsrc((void*)(p.pu8 + (size_t)layer * NEXP * D), 0, NEXP * D, 0x00020000);
  const __amdgpu_buffer_rsrc_t rV = __builtin_amdgcn_make_buffer_rsrc((void*)(p.pv8 + (size_t)layer * NEXP * D), 0, NEXP * D, 0x00020000);
  const int voff = lane * 16;
  u32x4 ua[16], va[16];
#pragma unroll
  for (int k = 0; k < 16; ++k) {
    const int e = __builtin_amdgcn_readlane(idxA, k);
    ua[k] = __builtin_amdgcn_raw_buffer_load_b128(rU, voff, e * D, 0);
  }
#pragma unroll
  for (int k = 0; k < 16; ++k) {
    const int e = __builtin_amdgcn_readlane(idxA, k);
    va[k] = __builtin_amdgcn_raw_buffer_load_b128(rV, voff, e * D, 0);
  }
#pragma unroll
  for (int head = 0; head < 8; ++head) {
    float part[16];
#pragma unroll
    for (int k = 0; k < 16; ++k) {
      const unsigned a0 = ua[k][0], a1 = ua[k][1], a2 = ua[k][2], a3 = ua[k][3];
      float s = dot4f8(a0, h0, h1, 0.f);
      s = dot4f8(a1, h2, h3, s); s = dot4f8(a2, h4, h5, s); s = dot4f8(a3, h6, h7, s);
      part[k] = s;
    }
    asm volatile("" ::: "memory");
    if (head < 7) {
#pragma unroll
      for (int k = 0; k < 16; ++k) {
        const int e = __builtin_amdgcn_readlane((head + 1) < 4 ? idxA : idxB, ((head + 1) & 3) * 16 + k);
        ua[k] = __builtin_amdgcn_raw_buffer_load_b128(rU, voff, e * D, 0);
      }
    }
    float r8[8], r4[4], r2[2], r1;
    {
      const bool up = lane & 32;
#pragma unroll
      for (int k = 0; k < 8; ++k) { float keep = up ? part[k + 8] : part[k], give = up ? part[k] : part[k + 8]; r8[k] = keep + shx(give, 32, lane); }
    }
    {
      const bool up = lane & 16;
#pragma unroll
      for (int k = 0; k < 4; ++k) { float keep = up ? r8[k + 4] : r8[k], give = up ? r8[k] : r8[k + 4]; r4[k] = keep + shx(give, 16, lane); }
    }
    {
      const bool up = lane & 8;
#pragma unroll
      for (int k = 0; k < 2; ++k) { float keep = up ? r4[k + 2] : r4[k], give = up ? r4[k] : r4[k + 2]; r2[k] = keep + shx(give, 8, lane); }
    }
    {
      const bool up = lane & 4;
      float keep = up ? r2[1] : r2[0], give = up ? r2[0] : r2[1];
      r1 = keep + shx(give, 4, lane);
    }
    r1 += shx(r1, 2, lane);
    r1 += shx(r1, 1, lane);
    const float myg = __int_as_float(__builtin_amdgcn_ds_bpermute(((head & 3) * 16 + ((lane >> 2) & 15)) << 2, __float_as_int(head < 4 ? gA : gB)));
    const float w = gelu_tanh(r1 * (1.f / SU)) * myg * (1.f / SV);
#pragma unroll
    for (int k = 0; k < 16; ++k) {
      const float wk = __int_as_float(__builtin_amdgcn_readlane(__float_as_int(w), k << 2));
      const unsigned a0 = va[k][0], a1 = va[k][1], a2 = va[k][2], a3 = va[k][3];
      axpy4f8(o[0], o[1], o[2], o[3], wk, a0); axpy4f8(o[4], o[5], o[6], o[7], wk, a1);
      axpy4f8(o[8], o[9], o[10], o[11], wk, a2); axpy4f8(o[12], o[13], o[14], o[15], wk, a3);
    }
    asm volatile("" ::: "memory");
    if (head < 7) {
#pragma unroll
      for (int k = 0; k < 16; ++k) {
        const int e = __builtin_amdgcn_readlane((head + 1) < 4 ? idxA : idxB, ((head + 1) & 3) * 16 + k);
        va[k] = __builtin_amdgcn_raw_buffer_load_b128(rV, voff, e * D, 0);
      }
    }
  }
  const float* g2 = p.mod + ((size_t)layer * 17 + mod_row(row)) * 6144 + 5120 + lane * 16;
  float* dr = xres_row(p, row) + lane * 16;
  float4 xv[4], gv[4];
#pragma unroll
  for (int q = 0; q < 4; ++q) { xv[q] = *(const float4*)(dr + 4 * q); gv[q] = *(const float4*)(g2 + 4 * q); }
#pragma unroll
  for (int q = 0; q < 4; ++q) {
    float4 r = {xv[q].x + gv[q].x * o[4 * q], xv[q].y + gv[q].y * o[4 * q + 1], xv[q].z + gv[q].z * o[4 * q + 2], xv[q].w + gv[q].w * o[4 * q + 3]};
    *(float4*)(dr + 4 * q) = r;
  }
}

constexpr int PEER_TPW = 4;
constexpr int PEER_TPI = 4 * PEER_TPW;
DI float bperm_f(float v, int src_lane) { return __int_as_float(__builtin_amdgcn_ds_bpermute(src_lane << 2, __float_as_int(v))); }
DI int bperm_i(int v, int src_lane) { return __builtin_amdgcn_ds_bpermute(src_lane << 2, v); }

DI __amdgpu_buffer_rsrc_t mk_rsrc(const void* ptr, unsigned bytes) { return __builtin_amdgcn_make_buffer_rsrc((void*)ptr, 0, bytes, 0x00020000); }
DI void stage_peer_u(const Params& p, int layer, int q, int tile, _Float16* __restrict__ partial) {
  const int tid = tid_now(), lane = tid & 63, g = lane >> 3, c = lane & 7;
  const int wave = __builtin_amdgcn_readfirstlane(tid >> 6);
  const int row_base = tile * PEER_TPI + wave * PEER_TPW;
  const __amdgpu_buffer_rsrc_t rU = mk_rsrc(p.pu8 + (size_t)layer * NEXP * D, NEXP * D);
  const __amdgpu_buffer_rsrc_t rRec = mk_rsrc(p.ridx, (unsigned)((size_t)MTOT * 1024));
  const __amdgpu_buffer_rsrc_t rH = mk_rsrc(p.hq, (unsigned)((size_t)MTOT * D));
  const __amdgpu_buffer_rsrc_t rP = mk_rsrc(partial, (unsigned)((size_t)8 * MTOT * 256));
  const int coff = q * 128 + c * 16;
  const int rec_v = ((lane >> 4) * 32 + (lane & 15) * 2) * 4;
  const int i0 = 4 * (c & 1) + 2 * ((c >> 1) & 1) + ((c >> 2) & 1);
  const int pv0 = (8 * i0 + g) * 4;
  int idA[3], idB[3];
  u32x4 d[2][8]; u32x4 hv[2];
  auto load_idx = [&](int t, int slot) {
    const int so = (row_base + t) * 1024;
    idA[slot] = __builtin_amdgcn_raw_buffer_load_b32(rRec, rec_v, so, 0);
    idB[slot] = __builtin_amdgcn_raw_buffer_load_b32(rRec, rec_v + 512, so, 0);
  };
  auto issue = [&](int u) {
    const int t = u >> 1, hf = u & 1, slot = t % 3, buf = u & 1;
    if (hf == 0) hv[t & 1] = __builtin_amdgcn_raw_buffer_load_b128(rH, coff, (row_base + t) * D, 0);
#pragma unroll
    for (int i = 0; i < 8; ++i) {
      const int e = bperm_i(hf ? idB[slot] : idA[slot], (8 * i + g) & 63);
      d[buf][i] = __builtin_amdgcn_raw_buffer_load_b128(rU, e * D + coff, 0, 0);
    }
  };
  load_idx(0, 0); load_idx(1, 1);
  issue(0);
  int r[16];
#pragma unroll
  for (int u = 0; u < 2 * PEER_TPW; ++u) {
    const int t = u >> 1, hf = u & 1, buf = u & 1;
    asm volatile("" ::: "memory");
    if (hf == 0 && t + 2 < PEER_TPW) load_idx(t + 2, (t + 2) % 3);
    if (u + 1 < 2 * PEER_TPW) issue(u + 1);
    const int h0 = (int)hv[t & 1][0], h1 = (int)hv[t & 1][1], h2 = (int)hv[t & 1][2], h3 = (int)hv[t & 1][3];
#pragma unroll
    for (int i = 0; i < 8; ++i) {
      const int a0 = (int)d[buf][i][0], a1 = (int)d[buf][i][1], a2 = (int)d[buf][i][2], a3 = (int)d[buf][i][3];
      int s = __builtin_amdgcn_sdot4(a0, h0, 0, false);
      s = __builtin_amdgcn_sdot4(a1, h1, s, false); s = __builtin_amdgcn_sdot4(a2, h2, s, false); s = __builtin_amdgcn_sdot4(a3, h3, s, false);
      r[8 * hf + i] = s;
    }
    if (hf == 0) continue;
    asm volatile("" ::: "memory");
    int r8[8], r4[4], r2[2];
    {
      const bool up = c & 1;
#pragma unroll
      for (int b3 = 0; b3 < 2; ++b3)
#pragma unroll
        for (int m = 0; m < 4; ++m) { int lo = r[8 * b3 + m], hi = r[8 * b3 + 4 + m]; int keep = up ? hi : lo, give = up ? lo : hi; r8[4 * b3 + m] = keep + bperm_i(give, lane ^ 1); }
    }
    {
      const bool up = c & 2;
#pragma unroll
      for (int b3 = 0; b3 < 2; ++b3)
#pragma unroll
        for (int m = 0; m < 2; ++m) { int lo = r8[4 * b3 + m], hi = r8[4 * b3 + 2 + m]; int keep = up ? hi : lo, give = up ? lo : hi; r4[2 * b3 + m] = keep + bperm_i(give, lane ^ 2); }
    }
    {
      const bool up = c & 4;
#pragma unroll
      for (int b3 = 0; b3 < 2; ++b3) { int lo = r4[2 * b3], hi = r4[2 * b3 + 1]; int keep = up ? hi : lo, give = up ? lo : hi; r2[b3] = keep + bperm_i(give, lane ^ 4); }
    }
    const int so = (q * MTOT + row_base + t) * 256;
    const h2_t ph = {(_Float16)((float)r2[0] * (1.f / 64.f)), (_Float16)((float)r2[1] * (1.f / 64.f))};
    __builtin_amdgcn_raw_buffer_store_b32(__builtin_bit_cast(int, ph), rP, pv0, so, 0);
  }
}

constexpr int PEERC_RPW = 2;
DI void stage_peer_combine(const Params& p, int layer, int item, const _Float16* __restrict__ partial) {
  const int lane = tid_now() & 63, wave = tid_now() >> 6;
  const int rbase = (item * 4 + wave) * PEERC_RPW;
  const int mr = mod_row(rbase);
  int e0[PEERC_RPW], e1[PEERC_RPW];
  float g0[PEERC_RPW], g1[PEERC_RPW], ssum[PEERC_RPW];
  unsigned pab[PEERC_RPW][8];
  float hq[PEERC_RPW][8];
#pragma unroll
  for (int j = 0; j < PEERC_RPW; ++j) {
    const int* reci = p.ridx + (size_t)(rbase + j) * 256 + (lane >> 4) * 32 + (lane & 15) * 2;
    e0[j] = reci[0]; e1[j] = reci[128];
  }
#pragma unroll
  for (int j = 0; j < PEERC_RPW; ++j) {
    const int row = rbase + j;
#pragma unroll
    for (int q = 0; q < 8; ++q) {
      pab[j][q] = ((const unsigned*)partial)[((size_t)q * MTOT + row) * 64 + lane];
      hq[j][q] = p.hs8[(size_t)q * MTOT + row] * 64.f;
    }
    const int* reci = p.ridx + (size_t)row * 256 + (lane >> 4) * 32 + (lane & 15) * 2;
    g0[j] = __int_as_float(reci[1]); g1[j] = __int_as_float(reci[129]);
    ssum[j] = p.ssq16[(size_t)(lane & 15) * MTOT + row];
  }
  float2 er0[PEERC_RPW], er1[PEERC_RPW];
#pragma unroll
  for (int j = 0; j < PEERC_RPW; ++j) {
    er0[j] = *(const float2*)(p.esc + ((size_t)layer * NEXP + e0[j]) * 64 + 2 * mr);
    er1[j] = *(const float2*)(p.esc + ((size_t)layer * NEXP + e1[j]) * 64 + 2 * mr);
  }
#pragma unroll
  for (int j = 0; j < PEERC_RPW; ++j) {
    const int row = rbase + j;
    float s0 = 0.f, s1 = 0.f;
#pragma unroll
    for (int q = 0; q < 8; ++q) { const h2_t pv = __builtin_bit_cast(h2_t, pab[j][q]); s0 += (float)pv[0] * hq[j][q]; s1 += (float)pv[1] * hq[j][q]; }
    float t = ssum[j];
    t += shx(t, 1, lane); t += shx(t, 2, lane); t += shx(t, 4, lane); t += shx(t, 8, lane);
    const float rstd = rsqrtf(t * (1.f / D) + EPS);
    float* rec = (float*)(p.ridx + (size_t)row * 256 + (lane >> 4) * 32 + (lane & 15) * 2) + 1;
    const _Float16 w0 = (_Float16)(gelu_tanh(s0 * er0[j].y * rstd + er0[j].x) * g0[j]), w1 = (_Float16)(gelu_tanh(s1 * er1[j].y * rstd + er1[j].x) * g1[j]);
    const h2_t w0p = {w0, w0}, w1p = {w1, w1};
    rec[0] = __builtin_bit_cast(float, w0p);
    rec[128] = __builtin_bit_cast(float, w1p);
  }
}

DI void axpy4f8_pk(f2_t& o01, f2_t& o23, f2_t w2, unsigned v) {
  f2_t lo = __builtin_amdgcn_cvt_pk_f32_fp8((int)v, false), hi = __builtin_amdgcn_cvt_pk_f32_fp8((int)v, true);
  o01 = __builtin_elementwise_fma(w2, lo, o01); o23 = __builtin_elementwise_fma(w2, hi, o23);
}
DI void stage_peer_v(const Params& p, int layer, int q, int tile, float dry = 1.f) {
  const int tid = tid_now(), lane = tid & 63, g = lane >> 3, c = lane & 7;
  const int wave = __builtin_amdgcn_readfirstlane(tid >> 6);
  const int row_base = tile * PEER_TPI + wave * PEER_TPW;
  const __amdgpu_buffer_rsrc_t rV = mk_rsrc(p.pv8 + (size_t)layer * NEXP * D, NEXP * D);
  const __amdgpu_buffer_rsrc_t rRec = mk_rsrc(p.ridx, (unsigned)((size_t)MTOT * 1024));
  const __amdgpu_buffer_rsrc_t rX = mk_rsrc(p.XB, (unsigned)((size_t)MTOT * D * 2));
  const int xrow0 = row_base;
  const int coff = q * 128 + c * 16;
  const int rec_v = ((lane >> 4) * 32 + (lane & 15) * 2) * 4;
  int idA[3], idB[3]; float wA[3], wB[3];
  u32x4 d[2][8];
  auto load_idx = [&](int t, int slot) {
    const int so = (row_base + t) * 1024;
    const u32x2 pa = __builtin_amdgcn_raw_buffer_load_b64(rRec, rec_v, so, 0), pb = __builtin_amdgcn_raw_buffer_load_b64(rRec, rec_v + 512, so, 0);
    const unsigned pa0 = pa[0], pa1 = pa[1], pb0 = pb[0], pb1 = pb[1];
    idA[slot] = (int)pa0; wA[slot] = __uint_as_float(pa1);
    idB[slot] = (int)pb0; wB[slot] = __uint_as_float(pb1);
  };
  const int dl = coff + 8 * (g & 1) + 4 * ((g >> 1) & 1) + 2 * ((g >> 2) & 1);
  unsigned xvb[2];
  auto issue = [&](int u) {
    const int t = u >> 1, hf = u & 1, slot = t % 3, buf = u & 1;
#pragma unroll
    for (int i = 0; i < 8; ++i) {
      const int e = bperm_i(hf ? idB[slot] : idA[slot], (8 * i + g) & 63);
      d[buf][i] = __builtin_amdgcn_raw_buffer_load_b128(rV, e * D + coff, 0, 0);
    }
    if (hf == 1) xvb[t & 1] = (unsigned)__builtin_amdgcn_raw_buffer_load_b32(rX, dl * 2, (xrow0 + t) * (D * 2), 0);
  };
  const float2 g2v = *(const float2*)(p.mod + ((size_t)layer * 17 + mod_row(row_base)) * 6144 + 5120 + dl);
  load_idx(0, 0); load_idx(1, 1);
  issue(0);
  h2_t oh[8];
#pragma unroll
  for (int u = 0; u < 2 * PEER_TPW; ++u) {
    const int t = u >> 1, hf = u & 1, buf = u & 1, slot = t % 3;
    asm volatile("" ::: "memory");
    if (hf == 0 && t + 2 < PEER_TPW) load_idx(t + 2, (t + 2) % 3);
    if (u + 1 < 2 * PEER_TPW) issue(u + 1);
#pragma unroll
    for (int i = 0; i < 8; ++i) {
      const h2_t w2 = __builtin_bit_cast(h2_t, bperm_f(hf ? wB[slot] : wA[slot], (8 * i + g) & 63));
#pragma unroll
      for (int j = 0; j < 4; ++j) {
        const int av = (int)d[buf][i][j];
        const h2_t lo = __builtin_amdgcn_cvt_scalef32_pk_f16_fp8(av, 1.0f, false), hi = __builtin_amdgcn_cvt_scalef32_pk_f16_fp8(av, 1.0f, true);
        if (hf == 0 && i == 0) { oh[2 * j] = w2 * lo; oh[2 * j + 1] = w2 * hi; }
        else { oh[2 * j] = __builtin_elementwise_fma(w2, lo, oh[2 * j]); oh[2 * j + 1] = __builtin_elementwise_fma(w2, hi, oh[2 * j + 1]); }
      }
    }
    if (hf == 0) continue;
    asm volatile("" ::: "memory");
    h2_t q4[4], q2[2], q1;
    {
      const bool up = g & 1;
#pragma unroll
      for (int k = 0; k < 4; ++k) {
        const h2_t keep = up ? oh[k + 4] : oh[k], give = up ? oh[k] : oh[k + 4];
        q4[k] = keep + __builtin_bit_cast(h2_t, bperm_i(__builtin_bit_cast(int, give), lane ^ 8));
      }
    }
    {
      const bool up = g & 2;
#pragma unroll
      for (int k = 0; k < 2; ++k) {
        const h2_t keep = up ? q4[k + 2] : q4[k], give = up ? q4[k] : q4[k + 2];
        q2[k] = keep + __builtin_bit_cast(h2_t, bperm_i(__builtin_bit_cast(int, give), lane ^ 16));
      }
    }
    {
      const auto sw = __builtin_amdgcn_permlane32_swap(__builtin_bit_cast(unsigned, q2[0]), __builtin_bit_cast(unsigned, q2[1]), false, false);
      const unsigned sa = sw[0], sb = sw[1];
      q1 = __builtin_bit_cast(h2_t, sa) + __builtin_bit_cast(h2_t, sb);
    }
    float r2[2] = {(float)q1[0] * (1.f / SV), (float)q1[1] * (1.f / SV)};
    const int so = (xrow0 + t) * (D * 2);
    const unsigned xv = xvb[t & 1];
    const float x0 = bf_lo(xv), x1 = bf_hi(xv);
    __builtin_amdgcn_raw_buffer_store_b32((int)pack2(x0 + dry * g2v.x * r2[0], x1 + dry * g2v.y * r2[1]), rX, dl * 2, so, 0);
  }
}

#include <hip/hip_cooperative_groups.h>
namespace cg = cooperative_groups;
constexpr int SMEM_BYTES = 40960;


#define XB_TMO      128
#define XB_XCNT(j)  (256  + 64 * (j))
#define XB_XSUB(j)  (1280 + 64 * (j))
#define XB_XGEN(j)  (2304 + 64 * (j))
#define XB_TOP      3328
#define XB_TOPGEN   3392
#define XCD_BAR_WORDS 3456
#define XB_SPIN_CAP (1u << 22)
#define LAS __attribute__((address_space(3)))
DI unsigned xb_ld(unsigned* p) { return __hip_atomic_load(p, __ATOMIC_RELAXED, __HIP_MEMORY_SCOPE_AGENT); }
DI unsigned xb_add(unsigned* p, unsigned v) { return __hip_atomic_fetch_add(p, v, __ATOMIC_RELAXED, __HIP_MEMORY_SCOPE_AGENT); }
DI unsigned xb_xcc_id() { unsigned x; asm volatile("s_getreg_b32 %0, hwreg(HW_REG_XCC_ID, 0, 4)" : "=s"(x)); return x & 0xFu; }
#define XB_SPIN(cond, bar) do { unsigned _sp = 0; while (cond) { __builtin_amdgcn_s_sleep(1); \
    if ((++_sp & 255u) == 0u) { if (xb_ld(&(bar)[XB_TMO])) break; if (_sp > XB_SPIN_CAP) { atomicAdd(&(bar)[XB_TMO], 1u); break; } } } } while (0)
struct XcdBarrier { unsigned* bar; volatile LAS unsigned* st; };
DI XcdBarrier xcd_barrier_post(unsigned* bar, volatile LAS unsigned* st) {
  XcdBarrier b; b.bar = bar; b.st = st;
  if (tid_now() == 0) (void)xb_add(&bar[XB_XCNT(xb_xcc_id())], 1u);
  return b;
}
DI void xcd_barrier_complete(unsigned* bar, unsigned x, unsigned& nloc, unsigned& nx) {
  const unsigned G = gridDim.x;
  unsigned sum, cnt, mine, sp = 0u;
  for (;;) {
    sum = 0u; cnt = 0u; mine = 0u;
#pragma unroll
    for (unsigned j = 0; j < 16; ++j) { const unsigned c = xb_ld(&bar[XB_XCNT(j)]); sum += c; cnt += (c > 0u) ? 1u : 0u; mine = (j == x) ? c : mine; }
    if (sum == G) break;
    __builtin_amdgcn_s_sleep(1);
    if ((++sp & 255u) == 0u) { if (xb_ld(&bar[XB_TMO])) break; if (sp > XB_SPIN_CAP) { atomicAdd(&bar[XB_TMO], 1u); break; } }
  }
  nloc = mine > 0u ? mine : 1u; nx = cnt > 0u ? cnt : 1u;
}
DI void xcd_barrier(const XcdBarrier& b) {
  asm volatile("s_waitcnt vmcnt(0)" ::: "memory");
  __syncthreads();
  if (tid_now() == 0) {
    unsigned* bar = b.bar;
    const unsigned bx = xb_xcc_id();
    __builtin_amdgcn_s_waitcnt(0);
    unsigned nloc = b.st[0], nx = b.st[1];
    if (nloc == 0u) { xcd_barrier_complete(bar, bx, nloc, nx); b.st[0] = nloc; b.st[1] = nx; }
    const unsigned old = xb_add(&bar[XB_XSUB(bx)], 1u);
    const unsigned gen = old / nloc;
    if (old + 1u == (gen + 1u) * nloc) {
      __builtin_amdgcn_s_sleep(64);
      __builtin_amdgcn_fence(__ATOMIC_RELEASE, "agent");
      asm volatile("s_waitcnt vmcnt(0)" ::: "memory");
      const unsigned og = xb_add(&bar[XB_TOP], 1u);
      const unsigned tg = og / nx;
      if (og + 1u == (tg + 1u) * nx) xb_add(&bar[XB_TOPGEN], 1u);
      else XB_SPIN(xb_ld(&bar[XB_TOPGEN]) == tg, bar);
      __builtin_amdgcn_fence(__ATOMIC_ACQUIRE, "agent");
      xb_add(&bar[XB_XGEN(bx)], 1u);
      asm volatile("s_waitcnt vmcnt(0)" ::: "memory");
    } else {
      XB_SPIN(xb_ld(&bar[XB_XGEN(bx)]) == gen, bar);
      __builtin_amdgcn_fence(__ATOMIC_ACQUIRE, "agent");
      asm volatile("s_waitcnt vmcnt(0)" ::: "memory");
    }
  }
  __syncthreads();
  __builtin_amdgcn_s_sleep(32);
}

constexpr int QCTR_STRIDE = 32;
constexpr int QCTR_WORDS = 16 * 8 * QCTR_STRIDE;
DI int q_pop(unsigned* ctr, volatile LAS int* slot) {
  __syncthreads();
  if (tid_now() == 0) *slot = (int)__hip_atomic_fetch_add(ctr, 1u, __ATOMIC_RELAXED, __HIP_MEMORY_SCOPE_AGENT);
  __syncthreads();
  return *slot;
}
template <class NF, class BF>
DI void run_queues(unsigned* ctr, int myx, volatile LAS int* slot, NF nitems_of_q, BF body) {
#pragma unroll 1
  for (int s = 0; s < 8; ++s) {
    const int q = (myx + s) & 7;
    const int n = nitems_of_q(q);
#pragma unroll 1
    for (;;) {
      const int idx = q_pop(ctr + q * QCTR_STRIDE, slot);
      if (idx >= n) break;
      body(q, idx);
    }
  }
}

#define GRID_BARRIER() xcd_barrier(xb)
#define REP(k) for (int rep_ = 0; rep_ < (DUP == (k) ? 2 : 1); ++rep_)

__global__ void __launch_bounds__(256, 3) mega_kernel(Params p) {
  __shared__ __attribute__((aligned(16))) char smem[SMEM_BYTES];
  cg::grid_group grid = cg::this_grid();
  const int G = gridDim.x, bid = blockIdx.x;
  uint4* xbw = (uint4*)(smem + SMEM_BYTES - 16);
  if (tid_now() == 0) *xbw = make_uint4(0u, 0u, 0u, 0u);
  volatile LAS int* qslot = (volatile LAS int*)xbw + 2;
  XcdBarrier xb = xcd_barrier_post(p.bar, (volatile LAS unsigned*)xbw);
  if (p.never) grid.sync();
  REP(1) for (int it = bid; it < MODP_ITEMS + CONVT_ITEMS + CONVK_ITEMS + 1; it += G) {
    if (it < MODP_ITEMS) stage_mod_partial(p, it, smem);
    else if (it < MODP_ITEMS + CONVT_ITEMS) stage_convT(p, it - MODP_ITEMS, smem);
    else if (it < MODP_ITEMS + CONVT_ITEMS + CONVK_ITEMS) stage_convS(p, it - MODP_ITEMS - CONVT_ITEMS);
    else stage_rope(p);
  }
  GRID_BARRIER();
  for (int it = bid; it < MODR_ITEMS; it += G) stage_mod_reduce(p, it);
  GRID_BARRIER();
#pragma unroll 1
  for (int l = 0; l < 2; ++l) {
    REP(2) for (int it = bid; it < MTOT / 8; it += G) stage_norm(p, l, 0, it);
    if (l == 0) for (int it = bid; it < CQP_ITEMS; it += G) stage_cq_partial(p, it, smem);
    GRID_BARRIER();
    {
      const int myx = xb_xcc_id() & 7;
      unsigned* ctr = p.qctr + (l * 8 + 0) * 8 * QCTR_STRIDE;
      const int nlat = l == 0 ? 288 : 256;
      run_queues(ctr, myx, qslot,
        [&](int q) { return nlat * (q < 2 ? 3 : 2) + (l == 0 ? 0 : 32); },
        [&](int q, int idx) {
          const int nN = q < 2 ? 3 : 2;
          int mt, nt;
          if (idx < nlat * nN) { mt = idx / nN; nt = q + 8 * (idx - mt * nN); }
          else { mt = 256 + (idx - nlat * nN); nt = q < 2 ? q + 16 : q + 8; }
          stage_inproj(p, l, mt * 18 + nt, smem);
          if (DUP == 3) stage_inproj(p, l, mt * 18 + nt, smem);
        });
    }
    if (l == 0) for (int it = bid; it < CQR_ITEMS; it += G) stage_cq_reduce(p, it);
    GRID_BARRIER();
    {
      const int myx = xb_xcc_id() & 7;
      run_queues(p.qctr + (l * 8 + 1) * 8 * QCTR_STRIDE, myx, qslot, [&](int) { return 192; },
        [&](int q, int idx) {
          const int b = q + 8 * (idx / 96), r = idx % 96;
          stage_gqa(p, l, b * 96 + r, smem);
          if (DUP == 40) stage_gqa(p, l, b * 96 + r, smem);
          constexpr int NV = CONVV_ITEMS / 2;
          const int g = q * 192 + idx;
          for (int f = g * NV / 1536; f < (g + 1) * NV / 1536; ++f) stage_convS(p, CONVK_ITEMS + l * NV + f);
          const int ncv = (l == 0 ? MTOT : NTOK) / CONV_TT;
          const int c0 = g * ncv / 1536, c1 = (g + 1) * ncv / 1536;
          if (c0 < c1) {
            __syncthreads();
            for (int f = c0; f < c1; ++f) { stage_conv(p, l, f, smem); if (DUP == 44) stage_conv(p, l, f, smem); }
          }
        });
      run_queues(p.qctr + (l * 8 + 2) * 8 * QCTR_STRIDE, myx, qslot, [&](int) { return 192; },
        [&](int q, int idx) {
          const int b = q + 8 * (idx / 96), r = idx % 96;
          stage_na2(p, l, b * 96 + r, smem);
          if (DUP == 43) stage_na2(p, l, b * 96 + r, smem);
          constexpr int NU = CONVU_ITEMS / 2;
          const int g = q * 192 + idx;
          stage_convU(p, l, g * NU / 1536, (g + 1) * NU / 1536, smem);
        });
      const int nctx = l == 0 ? CTXATT_ITEMS : 0;
      for (int it = bid; it < nctx; it += G) stage_ctxatt(p, it, smem);
    }
    GRID_BARRIER();
    {
      const int myx = xb_xcc_id() & 7, nlat = l == 0 ? 288 : 256;
      run_queues(p.qctr + (l * 8 + 3) * 8 * QCTR_STRIDE, myx, qslot, [&](int) { return nlat; },
        [&](int q, int idx) { stage_outproj(p, l, (q * (nlat / 8) + (idx >> 3)) * 8 + (idx & 7), smem); });
    }
    GRID_BARRIER();
    {
      const int myx = xb_xcc_id() & 7, nlat = l == 0 ? 288 : 256;
      run_queues(p.qctr + (l * 8 + 4) * 8 * QCTR_STRIDE, myx, qslot, [&](int) { return nlat; },
        [&](int q, int idx) { stage_route(p, l, idx * 8 + q, smem); if (DUP == 7) stage_route(p, l, idx * 8 + q, smem); });
    }
    GRID_BARRIER();
    {
      const int myx = xb_xcc_id() & 7;
      const int ntile = (l == 0 ? MTOT : NTOK) / PEER_TPI;
      _Float16* partial = (_Float16*)p.U;
      run_queues(p.qctr + (l * 8 + 5) * 8 * QCTR_STRIDE, myx, qslot, [&](int) { return ntile; },
        [&](int q, int idx) { stage_peer_u(p, l, q, idx, partial); if (DUP == 50) stage_peer_u(p, l, q, idx, partial); });
      GRID_BARRIER();
      for (int it = bid; it < (l == 0 ? MTOT : NTOK) / (4 * PEERC_RPW); it += G) stage_peer_combine(p, l, it, partial);
      GRID_BARRIER();
      run_queues(p.qctr + (l * 8 + 6) * 8 * QCTR_STRIDE, myx, qslot, [&](int) { return ntile; },
        [&](int q, int idx) { if (DUP == 51) stage_peer_v(p, l, q, idx, 0.f); stage_peer_v(p, l, q, idx); });
    }
    GRID_BARRIER();
  }
  for (int it = bid; it < NTOK / 8; it += G) stage_final(p, it);
}

extern "C" void kernel_launch(void* const* d_in, const int* in_sizes, int n_in, void* d_out, int out_size, void* d_ws, size_t ws_size,
                              hipStream_t stream) {
  Params p{};
  const float** f = (const float**)&p;
  for (int i = 0; i < 22; ++i) f[i] = (const float*)d_in[i];
  p.out = (float*)d_out;
  char* w = (char*)d_ws; size_t off = 0;
  auto take = [&](size_t bytes) { char* r = w + off; off += (bytes + 255) & ~(size_t)255; return r; };
  p.win = (bf16*)take((size_t)2 * INC * D * 2);
  p.wout = (bf16*)take((size_t)2 * D * D * 2);
  p.wq = (bf16*)take((size_t)2 * 2048 * D * 2);
  p.pk = (bf16*)take(PK_N * 2);
  p.pu8 = (unsigned char*)take(PU_N);
  p.pv8 = (unsigned char*)take(PU_N);
  p.esc = (float*)take((size_t)2 * NEXP * 64 * 4);
  p.ssq16 = (float*)take((size_t)16 * MTOT * 4);
  p.hs8 = (float*)take((size_t)8 * MTOT * 4);
  p.cqp = (float*)take((size_t)CQ_KS * 2 * 17 * 2048 * 4);
  p.cq = (float*)take((size_t)2 * 17 * 2048 * 4);
  p.hq = (signed char*)take((size_t)MTOT * D);
  p.modp = (float*)take((size_t)2 * 8 * 17 * 6144 * 4);
  p.mod = (float*)take((size_t)2 * 17 * 6144 * 4);
  p.ropetab = (float*)take(64 * 16 * 2 * 4);
  p.H = (bf16*)take((size_t)MTOT * D * 2);
  p.CAT = p.H;
  p.U = (bf16*)take((size_t)MTOT * 256 * 2);
  p.QN = (bf16*)take((size_t)NB * 6 * SEQ2 * 64 * 2);
  p.KN = (bf16*)take((size_t)NB * 6 * SEQ2 * 64 * 2);
  p.VNt = (bf16*)take((size_t)NB * 6 * SEQ2 * 64 * 2);
  p.QG = (bf16*)take((size_t)NB * 6 * SEQ2 * 64 * 2);
  p.KG = (bf16*)take((size_t)NB * 2 * SEQ2 * 64 * 2);
  p.VGt = (bf16*)take((size_t)NB * 2 * SEQ2 * 64 * 2);
  p.H2 = (bf16*)((char*)p.U + (size_t)8 * MTOT * 128 * 2);
  p.XC = nullptr;
  p.XB = (bf16*)take((size_t)MTOT * D * 2);
  p.ridx = (int*)take((size_t)MTOT * 256 * 4);
  p.rg = (float*)p.ridx;
  p.bar = (unsigned*)take(XCD_BAR_WORDS * 4);
  p.qctr = (unsigned*)take(QCTR_WORDS * 4);
  if (off > ws_size) return;
  static int grid_blocks = 0;
  if (!grid_blocks) {
    int dev = 0, cus = 0, per_cu = 0;
    hipGetDevice(&dev);
    hipDeviceGetAttribute(&cus, hipDeviceAttributeMultiprocessorCount, dev);
    hipOccupancyMaxActiveBlocksPerMultiprocessor(&per_cu, mega_kernel, 256, 0);
    if (per_cu > 3) per_cu = 3;
    grid_blocks = cus * per_cu;
  }
  void* args[] = {&p};
  hipMemsetAsync(p.bar, 0, (size_t)(XCD_BAR_WORDS + QCTR_WORDS) * 4, stream);
  hipLaunchCooperativeKernel((void*)mega_kernel, dim3(grid_blocks), dim3(256), args, 0, stream);
}
```
